# Optimizing an MI355X kernel written in HIP

```python
import jax, jax.numpy as jnp
from jax import lax
import numpy as np


D_MODEL = 1024
BATCH = 4
SEQ = 4096
DEPTH = 4

D_MIX = D_MODEL
D_CONV = D_MIX // 4
D_CONF = D_MIX // 4
D_DN = D_MIX // 2
N_CONV_GROUPS = 4
N_CONF_GROUPS = 4
DN_HEADS = 4
DN_HEAD_DIM = D_DN // DN_HEADS
SHORT_CONV_W = 3
CONF_CONV_W = 31
DN_CONV_W = 4
DN_CHUNK = 64
D_FF = ((8 * D_MODEL + 3 * 256 - 1) // (3 * 256)) * 256
IN_COLS = 3 * D_CONV + 2 * D_CONF + 4 * D_DN + 2 * DN_HEADS
N_MOD = 6
EPS = 1e-6

kernel_name = 'hymba_conv_conformer_gdn_adaln_trunk'


def rmsnorm(x, g):
    xf = x.astype(jnp.float32)
    y = xf * lax.rsqrt(jnp.mean(xf * xf, axis=-1, keepdims=True) + EPS)
    return y.astype(x.dtype) * g


def layernorm(x, g, b):
    xf = x.astype(jnp.float32)
    mu = jnp.mean(xf, axis=-1, keepdims=True)
    var = jnp.mean(jnp.square(xf - mu), axis=-1, keepdims=True)
    return ((xf - mu) * lax.rsqrt(var + 1e-5)).astype(x.dtype) * g + b


def causal_dwconv(x, w):
    K, C = w.shape
    xp = jnp.pad(x, ((0, 0), (K - 1, 0), (0, 0)))
    return lax.conv_general_dilated(xp, w[:, None, :].astype(x.dtype), window_strides=(1,), padding='VALID',
                                    dimension_numbers=('NWC', 'WIO', 'NWC'), feature_group_count=C)


def l2norm(x):
    return x * lax.rsqrt(jnp.sum(x * x, axis=-1, keepdims=True) + EPS)


def chunk_gated_delta_rule(q, k, v, g, beta):
    Bsz, T, H, Dk = q.shape
    C = DN_CHUNK
    N = T // C
    def to_chunks(t):
        return t.reshape(Bsz, N, C, H, -1).transpose(0, 3, 1, 2, 4)
    q = to_chunks(q) * (Dk ** -0.5)
    k = to_chunks(k)
    v = to_chunks(v)
    beta = beta.reshape(Bsz, N, C, H).transpose(0, 3, 1, 2)
    g = jnp.cumsum(g.reshape(Bsz, N, C, H).transpose(0, 3, 1, 2), axis=-1)
    causal = jnp.tril(jnp.ones((C, C), dtype=bool))
    strict = jnp.tril(jnp.ones((C, C), dtype=bool), -1)
    diff = g[..., :, None] - g[..., None, :]
    decay = jnp.where(causal, jnp.exp(jnp.where(causal, diff, 0.0)), 0.0)
    k_beta = k * beta[..., None]
    v_beta = v * beta[..., None]
    Lm = jnp.where(strict, jnp.einsum('bhncd,bhnsd->bhncs', k_beta, k) * decay, 0.0)
    eye = jnp.eye(C, dtype=q.dtype)
    Tm = lax.linalg.triangular_solve(eye + Lm, jnp.broadcast_to(eye, Lm.shape), left_side=True,
                                     lower=True, unit_diagonal=True)
    u = jnp.einsum('bhncs,bhnse->bhnce', Tm, v_beta)
    w = jnp.einsum('bhncs,bhnsd->bhncd', Tm, k_beta * jnp.exp(g)[..., None])
    qk = jnp.where(causal, jnp.einsum('bhncd,bhnsd->bhncs', q, k) * decay, 0.0)

    def step(S, inp):
        q_i, k_i, u_i, w_i, g_i, qk_i = inp
        v_new = u_i - jnp.einsum('bhcd,bhde->bhce', w_i, S)
        o = (jnp.einsum('bhcd,bhde->bhce', q_i * jnp.exp(g_i)[..., None], S)
             + jnp.einsum('bhcs,bhse->bhce', qk_i, v_new))
        g_last = g_i[..., -1]
        S = (S * jnp.exp(g_last)[..., None, None]
             + jnp.einsum('bhcd,bhce->bhde', k_i * jnp.exp(g_last[..., None] - g_i)[..., None], v_new))
        return S, o

    xs = tuple(jnp.moveaxis(t, 2, 0) for t in (q, k, u, w, g, qk))
    S0 = jnp.zeros((Bsz, H, Dk, v.shape[-1]), jnp.float32)
    _, o = lax.scan(step, S0, xs)
    return o.transpose(1, 0, 3, 2, 4).reshape(Bsz, T, H, -1)


def setup_inputs(seed: int = 0) -> dict:
    key = jax.random.key(seed)
    ks = jax.random.split(key, 24)
    f32 = jnp.float32
    def nrm(k, shape, scale):
        return jax.random.normal(k, shape, f32) * scale
    L, D = DEPTH, D_MODEL
    dt = jax.random.uniform(ks[13], (L, DN_HEADS), f32, minval=1e-3, maxval=0.1)
    return {
        'x': nrm(ks[0], (BATCH, SEQ, D), 1.0),
        'c': nrm(ks[1], (BATCH, D), 1.0),
        'w_ada': nrm(ks[2], (L, D, N_MOD * D), 0.5 * D ** -0.5),
        'b_ada': nrm(ks[3], (L, N_MOD * D), 0.02),
        'norm_mix_g': 1.0 + nrm(ks[4], (L, D), 0.02),
        'norm_ffn_g': 1.0 + nrm(ks[5], (L, D), 0.02),
        'w_in': nrm(ks[6], (L, D, IN_COLS), D ** -0.5),
        'conv_a_w': nrm(ks[7], (L, SHORT_CONV_W, D_CONV), SHORT_CONV_W ** -0.5),
        'conf_dw_w': nrm(ks[8], (L, CONF_CONV_W, D_CONF), CONF_CONV_W ** -0.5),
        'conf_dw_b': nrm(ks[9], (L, D_CONF), 0.02),
        'conf_ln_g': 1.0 + nrm(ks[10], (L, D_CONF), 0.02),
        'conf_ln_b': nrm(ks[11], (L, D_CONF), 0.02),
        'dn_conv_w': nrm(ks[12], (L, DN_CONV_W, 3 * D_DN), DN_CONV_W ** -0.5),
        'dn_a_log': jnp.log(jax.random.uniform(ks[14], (L, DN_HEADS), f32, minval=1.0, maxval=16.0)),
        'dn_dt_bias': dt + jnp.log(-jnp.expm1(-dt)),
        'dn_norm_g': 1.0 + nrm(ks[15], (L, DN_HEAD_DIM), 0.02),
        'w_out': nrm(ks[16], (L, D_MIX, D), D_MIX ** -0.5),
        'w_ffn_in': nrm(ks[17], (L, D, 2 * D_FF), D ** -0.5),
        'w_ffn_out': nrm(ks[18], (L, D_FF, D), D_FF ** -0.5),
        'final_norm_g': 1.0 + nrm(ks[19], (D,), 0.02),
    }


def reference(x, c, w_ada, b_ada, norm_mix_g, norm_ffn_g, w_in, conv_a_w, conf_dw_w, conf_dw_b,
              conf_ln_g, conf_ln_b, dn_conv_w, dn_a_log, dn_dt_bias, dn_norm_g, w_out,
              w_ffn_in, w_ffn_out, final_norm_g):
    Bsz, T, _ = x.shape
    c_act = jax.nn.silu(c)
    sizes = [D_CONV] * 3 + [D_CONF] * 2 + [D_DN] * 4 + [DN_HEADS] * 2
    split_idx = np.cumsum(sizes)[:-1].tolist()
    for l in range(DEPTH):
        mod = (c_act @ w_ada[l] + b_ada[l])[:, None, :]
        sh1, sc1, g1, sh2, sc2, g2 = jnp.split(mod, N_MOD, axis=-1)

        h = rmsnorm(x, norm_mix_g[l]) * (1.0 + sc1) + sh1
        proj = h @ w_in[l]
        (a_b, a_c, a_v, b_a, b_g, c_q, c_k, c_v, c_z, c_alpha, c_beta) = jnp.split(proj, split_idx, axis=-1)

        y_a = a_b * causal_dwconv(a_c * a_v, conv_a_w[l])

        u = b_a * jax.nn.sigmoid(b_g)
        u = causal_dwconv(u, conf_dw_w[l]) + conf_dw_b[l]
        y_b = jax.nn.silu(layernorm(u, conf_ln_g[l], conf_ln_b[l]))

        qkv = jax.nn.silu(causal_dwconv(jnp.concatenate([c_q, c_k, c_v], axis=-1), dn_conv_w[l]))
        q, k, v = jnp.split(qkv.astype(jnp.float32), 3, axis=-1)
        q = l2norm(q.reshape(Bsz, T, DN_HEADS, DN_HEAD_DIM))
        k = l2norm(k.reshape(Bsz, T, DN_HEADS, DN_HEAD_DIM))
        v = v.reshape(Bsz, T, DN_HEADS, DN_HEAD_DIM)
        gdec = -jnp.exp(dn_a_log[l].astype(jnp.float32)) * jax.nn.softplus(
            c_alpha.astype(jnp.float32) + dn_dt_bias[l].astype(jnp.float32))
        beta = jax.nn.sigmoid(c_beta.astype(jnp.float32))
        o = chunk_gated_delta_rule(q, k, v, gdec, beta).astype(x.dtype)
        z = c_z.reshape(Bsz, T, DN_HEADS, DN_HEAD_DIM)
        y_c = (rmsnorm(o, dn_norm_g[l]) * jax.nn.silu(z)).reshape(Bsz, T, D_DN)

        mix = jnp.concatenate([y_a, y_b, y_c], axis=-1) @ w_out[l]
        x = x + g1 * mix

        h = rmsnorm(x, norm_ffn_g[l]) * (1.0 + sc2) + sh2
        gate, up = jnp.split(h @ w_ffn_in[l], 2, axis=-1)
        x = x + g2 * ((jax.nn.silu(gate) * up) @ w_ffn_out[l])
    return rmsnorm(x, final_norm_g)
```

```cpp
#include <hip/hip_runtime.h>
#include <hip/hip_cooperative_groups.h>
#include <cstdio>
namespace cg = cooperative_groups;

#ifndef ONE_LAUNCH
#define ONE_LAUNCH 1
#endif
#ifndef REPEAT_MASK
#define REPEAT_MASK 0
#endif

#define LAS __attribute__((address_space(3)))
typedef unsigned short bf16_t;
typedef short bf16x8 __attribute__((ext_vector_type(8)));
typedef float f32x4 __attribute__((ext_vector_type(4)));
typedef float f32x2 __attribute__((ext_vector_type(2)));
typedef unsigned u32x4 __attribute__((ext_vector_type(4)));
typedef unsigned u32x2 __attribute__((ext_vector_type(2)));
typedef __bf16 nbf16x2 __attribute__((ext_vector_type(2)));

constexpr int MTOK = 16384, DM = 1024, NL = 4, NB = 4, SEQ = 4096;
constexpr int NIN = 3336, NINP = 3584, DFF = 2816, NF1 = 2 * DFF, NMOD = 6 * DM;
constexpr int LDS_BYTES = 131072 + 64 + 6144, LDS_BAR_OFF = 131072, LDS_CW_OFF = 131072 + 64;
constexpr int NPH = 2 + 7 * NL;

constexpr size_t SZ_WIN = (size_t)NL * NINP * DM * 2, SZ_WOUT = (size_t)NL * DM * DM * 2, SZ_WF1 = (size_t)NL * NF1 * DM * 2, SZ_WF2 = (size_t)NL * DM * DFF * 2;
constexpr size_t WS_WIN = 0, WS_WOUT = WS_WIN + SZ_WIN, WS_WF1 = WS_WOUT + SZ_WOUT, WS_WF2 = WS_WF1 + SZ_WF1;
constexpr size_t WS_MOD = WS_WF2 + SZ_WF2;
constexpr size_t WS_ALAST = WS_MOD + (size_t)NL * NB * NMOD * 4;
constexpr size_t WS_H = WS_ALAST + 4096;
constexpr size_t WS_YCAT = WS_H + (size_t)MTOK * DM * 2;
constexpr size_t WS_PROJ = WS_YCAT + (size_t)MTOK * DM * 2;
constexpr int ITEM_BYTES = 90112, OFF_W = 0, OFF_Q = 16384, OFF_KT = 32768, OFF_QK = 49152, OFF_U = 57344;
constexpr size_t WS_DELTA = WS_PROJ + (size_t)MTOK * NINP * 2;
constexpr size_t WS_BAR = WS_DELTA + (size_t)1024 * ITEM_BYTES;
constexpr size_t WS_END = WS_BAR + 16384;

struct P {
    const float *x, *c, *w_ada, *b_ada, *norm_mix_g, *norm_ffn_g, *w_in, *conv_a_w, *conf_dw_w, *conf_dw_b, *conf_ln_g, *conf_ln_b,
        *dn_conv_w, *dn_a_log, *dn_dt_bias, *dn_norm_g, *w_out, *w_ffn_in, *w_ffn_out, *final_norm_g;
    float* out; unsigned char* ws; int ph_lo, ph_hi;
};

__device__ __forceinline__ float bf2f(bf16_t v) { return __uint_as_float(((unsigned)v) << 16); }
__device__ __forceinline__ unsigned pk2(float a, float b) { f32x2 v = {a, b}; nbf16x2 r = __builtin_convertvector(v, nbf16x2); return __builtin_bit_cast(unsigned, r); }
__device__ __forceinline__ bf16_t f2bf(float a) { return (bf16_t)(pk2(a, 0.f) & 0xffffu); }
__device__ __forceinline__ float lo16(unsigned w) { return __uint_as_float(w << 16); }
__device__ __forceinline__ float hi16(unsigned w) { return __uint_as_float(w & 0xffff0000u); }
__device__ __forceinline__ float sigmoid_f(float v) { return __builtin_amdgcn_rcpf(1.f + __expf(-v)); }
__device__ __forceinline__ float silu_f(float v) { return v * sigmoid_f(v); }
__device__ __forceinline__ float wave_sum(float v) {
#pragma unroll
    for (int o = 32; o; o >>= 1) v += __shfl_xor(v, o);
    return v;
}
__device__ __forceinline__ void unpack8(const u32x4 w, float (&f)[8]) {
    f[0] = lo16(w.x); f[1] = hi16(w.x); f[2] = lo16(w.y); f[3] = hi16(w.y); f[4] = lo16(w.z); f[5] = hi16(w.z); f[6] = lo16(w.w); f[7] = hi16(w.w);
}
__device__ __forceinline__ u32x4 pack8(const float (&f)[8]) { u32x4 w; w.x = pk2(f[0], f[1]); w.y = pk2(f[2], f[3]); w.z = pk2(f[4], f[5]); w.w = pk2(f[6], f[7]); return w; }
#define MFMA16(a, b, c) __builtin_amdgcn_mfma_f32_16x16x32_bf16((a), (b), (c), 0, 0, 0)

namespace pg8 {
constexpr int BM = 256, BK = 64, HALF = 128, HTB = HALF * BK * 2, STAGE_BYTES = 8 * HTB, NXCD = 8, WGM = 8;
__host__ __device__ __forceinline__ int lds_byte(int r, int c) { const int st = (r >> 4) * 2 + (c >> 5), rr = r & 15, cc = c & 31, ob = rr * 64 + cc * 2; return st * 1024 + (ob ^ (((ob >> 9) & 1) << 5)); }
__host__ __device__ __forceinline__ void stage_rc(int b, int& R, int& C) { const int st = b / 1024, sb = b % 1024, swz = sb ^ (((sb >> 9) & 1) << 5); R = (st >> 1) * 16 + swz / 64; C = (st & 1) * 32 + (swz % 64) / 2; }
__host__ __device__ __forceinline__ int perm32(int rho) { const int n = rho >> 4, i = rho & 15; return 8 * (i >> 2) + 4 * n + (i & 3); }
struct Unit { int pm, pn; };
struct Gemm { const bf16_t* A; const bf16_t* Bt; int M, N, K; };
struct StaticOrder {
    int nM, nN, nwg, G, c;
    __device__ void init(int M, int N, int G_, int c_) { nM = M / BM; nN = N / BM; nwg = nM * nN; G = G_; c = c_; }
    __device__ bool next(int i, Unit& u) const {
        const long L = (long)i * G + c; if (L >= nwg) return false;
        int wgid = (int)L; { const int q = nwg / NXCD, r = nwg % NXCD, xcd = wgid % NXCD, off = wgid / NXCD; wgid = (xcd < r ? xcd * (q + 1) : r * (q + 1) + (xcd - r) * q) + off; }
        const int nig = WGM * nN, gid = wgid / nig, fm = gid * WGM, gsz = (nM - fm) < WGM ? (nM - fm) : WGM;
        u.pm = fm + ((wgid % nig) % gsz); u.pn = (wgid % nig) / gsz; return true;
    }
};

struct EpiProj {
    static constexpr bool PERM = true;
    bf16_t* O; int ldc;
    __device__ __forceinline__ void operator()(const f32x4 (&acc)[2][2][4][2], const Unit& u, int wr, int wc, int fr, int fq) const {
        const int row0 = u.pm * BM + wr * 64 + fr, col0 = u.pn * BM + wc * 32 + 8 * fq;
#pragma unroll
        for (int ai = 0; ai < 2; ++ai)
#pragma unroll
            for (int m = 0; m < 4; ++m) { bf16_t* rowp = O + (size_t)(row0 + ai * HALF + m * 16) * ldc + col0;
#pragma unroll
                for (int bj = 0; bj < 2; ++bj) { const f32x4 v0 = acc[ai][bj][m][0], v1 = acc[ai][bj][m][1];
                    u32x4 w; w.x = pk2(v0[0], v0[1]); w.y = pk2(v0[2], v0[3]); w.z = pk2(v1[0], v1[1]); w.w = pk2(v1[2], v1[3]);
                    *(u32x4*)(rowp + bj * HALF) = w; } }
    }
};
struct EpiSwiGLU {
    static constexpr bool PERM = true;
    bf16_t* O;
    __device__ __forceinline__ void operator()(const f32x4 (&acc)[2][2][4][2], const Unit& u, int wr, int wc, int fr, int fq) const {
        const int row0 = u.pm * BM + wr * 64 + fr, col0 = u.pn * HALF + wc * 32 + 8 * fq;
#pragma unroll
        for (int ai = 0; ai < 2; ++ai)
#pragma unroll
            for (int m = 0; m < 4; ++m) {
                const f32x4 g0 = acc[ai][0][m][0], g1 = acc[ai][0][m][1], u0 = acc[ai][1][m][0], u1 = acc[ai][1][m][1];
                float v[8];
#pragma unroll
                for (int i = 0; i < 4; ++i) { v[i] = silu_f(g0[i]) * u0[i]; v[4 + i] = silu_f(g1[i]) * u1[i]; }
                *(u32x4*)(O + (size_t)(row0 + ai * HALF + m * 16) * DFF + col0) = pack8(v);
            }
    }
};
struct EpiResid {
    static constexpr bool PERM = false;
    const float* base; float* out; const float* gate;
    __device__ __forceinline__ void operator()(const f32x4 (&acc)[2][2][4][2], const Unit& u, int wr, int wc, int fr, int fq) const {
        const int row0 = u.pm * BM + wr * 64 + fr, col0 = u.pn * BM + wc * 32 + 4 * fq;
        const float* gp = gate + (size_t)(u.pm >> 4) * NMOD + col0;
        f32x4 gv[2][2];
#pragma unroll
        for (int bj = 0; bj < 2; ++bj)
#pragma unroll
            for (int n = 0; n < 2; ++n) gv[bj][n] = *(const f32x4*)(gp + bj * HALF + n * 16);
#pragma unroll
        for (int ai = 0; ai < 2; ++ai) {
            f32x4 bv[4][2][2];
#pragma unroll
            for (int m = 0; m < 4; ++m) { const size_t ro = (size_t)(row0 + ai * HALF + m * 16) * DM + col0;
#pragma unroll
                for (int bj = 0; bj < 2; ++bj)
#pragma unroll
                    for (int n = 0; n < 2; ++n) bv[m][bj][n] = *(const f32x4*)(base + ro + bj * HALF + n * 16); }
#pragma unroll
            for (int m = 0; m < 4; ++m) { const size_t ro = (size_t)(row0 + ai * HALF + m * 16) * DM + col0;
#pragma unroll
                for (int bj = 0; bj < 2; ++bj)
#pragma unroll
                    for (int n = 0; n < 2; ++n) *(f32x4*)(out + ro + bj * HALF + n * 16) = bv[m][bj][n] + gv[bj][n] * acc[ai][bj][m][n]; }
        }
    }
};

template <class Epi>
__device__ __forceinline__ void gemm_phase(const int tidx, LAS unsigned char* lds, const Gemm g, const StaticOrder& S, const Epi& E) {
    const int tid = tidx, wid = __builtin_amdgcn_readfirstlane(tid >> 6), lane = tid & 63, wr = wid >> 2, wc = wid & 3, fr = lane & 15, fq = lane >> 4;
    const int K = g.K, nt = K / BK;
    unsigned voffA[2], voffB[2];
#pragma unroll
    for (int i = 0; i < 2; ++i) { int R, C; stage_rc(tid * 16 + i * 8192, R, C); const int Rb = Epi::PERM ? ((R & ~31) + perm32(R & 31)) : R;
        voffA[i] = (unsigned)(R * K + C) * 2u; voffB[i] = (unsigned)(Rb * K + C) * 2u; }
    const size_t kstep = (size_t)(BK * 2);
    const size_t hstep = (size_t)HALF * K * 2;
    const size_t tstep = 2 * hstep;
    const unsigned ldsw = (unsigned)wid * 1024u;
    const int aoff = lds_byte(wr * 64 + fr, fq * 8), boff = lds_byte(wc * 32 + fr, fq * 8);
#define PG8_SA(b, h) (((b) * 2 + (h)) * HTB)
#define PG8_SB(b, h) ((4 + (b) * 2 + (h)) * HTB)
#define PG8_STAGE(bufoff, gbase, voff) do { _Pragma("unroll") for (int _i = 0; _i < 2; ++_i) \
        __builtin_amdgcn_global_load_lds((const unsigned*)((const char*)(gbase) + (voff)[_i]), (LAS unsigned*)(lds + (bufoff) + ldsw + _i * 8192), 16, 0, 0); } while (0)
#define PG8_LDA(dst, b, h) do { _Pragma("unroll") for (int m = 0; m < 4; ++m) _Pragma("unroll") for (int k = 0; k < 2; ++k) dst[m][k] = *(const LAS bf16x8*)(lds + PG8_SA(b, h) + aoff + m * 2048 + k * 1024); } while (0)
#define PG8_LDB(dst, b, h) do { _Pragma("unroll") for (int n = 0; n < 2; ++n) _Pragma("unroll") for (int k = 0; k < 2; ++k) dst[n][k] = *(const LAS bf16x8*)(lds + PG8_SB(b, h) + boff + n * 2048 + k * 1024); } while (0)
#define PG8_MMA(ai, bj, At, Bt) do { __builtin_amdgcn_s_setprio(1); _Pragma("unroll") for (int m = 0; m < 4; ++m) _Pragma("unroll") for (int n = 0; n < 2; ++n) _Pragma("unroll") for (int k = 0; k < 2; ++k) \
        acc[ai][bj][m][n] = __builtin_amdgcn_mfma_f32_16x16x32_bf16(Bt[n][k], At[m][k], acc[ai][bj][m][n], 0, 0, 0); __builtin_amdgcn_s_setprio(0); } while (0)
#define PG8_WAIT_V(n) asm volatile("s_waitcnt vmcnt(" #n ")" ::: "memory")
#define PG8_WAIT_L(n) asm volatile("s_waitcnt lgkmcnt(" #n ")" ::: "memory")
#define PG8_BAR __builtin_amdgcn_s_barrier()
#define PG8_SCHED __builtin_amdgcn_sched_barrier(0)
    Unit cur, nxt; int ui = 0;
    if (!S.next(0, cur)) return;
    f32x4 acc[2][2][4][2];
#pragma unroll
    for (int a = 0; a < 2; ++a)
#pragma unroll
        for (int b = 0; b < 2; ++b)
#pragma unroll
            for (int m = 0; m < 4; ++m)
#pragma unroll
                for (int n = 0; n < 2; ++n) acc[a][b][m][n] = (f32x4){0.f, 0.f, 0.f, 0.f};
    bf16x8 At[4][2], B0[2][2], B1[2][2];
    const char* cA = (const char*)g.A + (size_t)cur.pm * tstep; const char* cB = (const char*)g.Bt + (size_t)cur.pn * tstep;
    PG8_STAGE(PG8_SB(0, 0), cB, voffB); PG8_STAGE(PG8_SA(0, 0), cA, voffA); PG8_STAGE(PG8_SB(0, 1), cB + hstep, voffB); PG8_STAGE(PG8_SA(0, 1), cA + hstep, voffA);
    if (wr == 1) PG8_BAR;
    PG8_WAIT_V(4); PG8_BAR;
    PG8_STAGE(PG8_SB(1, 0), cB + kstep, voffB); PG8_STAGE(PG8_SA(1, 0), cA + kstep, voffA); PG8_STAGE(PG8_SB(1, 1), cB + hstep + kstep, voffB);
    PG8_WAIT_V(6); PG8_BAR;
    for (;;) {
        const bool has_next = S.next(ui + 1, nxt);
        const char* nA = has_next ? (const char*)g.A + (size_t)nxt.pm * tstep : cA; const char* nB = has_next ? (const char*)g.Bt + (size_t)nxt.pn * tstep : cB;
        for (int t = 0; t < nt; t += 2) {
            const bool last = (t == nt - 2);
            const char* a1 = cA + (size_t)(t + 1) * kstep;
            const char* a2 = last ? nA : cA + (size_t)(t + 2) * kstep; const char* b2 = last ? nB : cB + (size_t)(t + 2) * kstep;
            const char* a3 = a2 + kstep; const char* b3 = b2 + kstep;
            PG8_LDB(B0, 0, 0); PG8_SCHED; PG8_LDA(At, 0, 0); PG8_STAGE(PG8_SA(1, 1), a1 + hstep, voffA);
            PG8_WAIT_L(8); PG8_BAR; PG8_WAIT_L(0); PG8_MMA(0, 0, At, B0); PG8_BAR; PG8_SCHED;
            PG8_LDB(B1, 0, 1); PG8_STAGE(PG8_SB(0, 0), b2, voffB);
            PG8_BAR; PG8_WAIT_L(0); PG8_MMA(0, 1, At, B1); PG8_BAR;
            PG8_LDA(At, 0, 1); PG8_STAGE(PG8_SA(0, 0), a2, voffA);
            PG8_BAR; PG8_WAIT_L(0); PG8_MMA(1, 0, At, B0); PG8_BAR; PG8_SCHED;
            PG8_STAGE(PG8_SB(0, 1), b2 + hstep, voffB);
            PG8_WAIT_V(6); PG8_BAR; PG8_MMA(1, 1, At, B1); PG8_BAR;
            PG8_LDB(B0, 1, 0); PG8_SCHED; PG8_LDA(At, 1, 0); PG8_STAGE(PG8_SA(0, 1), a2 + hstep, voffA);
            PG8_WAIT_L(8); PG8_BAR; PG8_WAIT_L(0); PG8_MMA(0, 0, At, B0); PG8_BAR; PG8_SCHED;
            PG8_LDB(B1, 1, 1); PG8_STAGE(PG8_SB(1, 0), b3, voffB);
            PG8_BAR; PG8_WAIT_L(0); PG8_MMA(0, 1, At, B1); PG8_BAR;
            PG8_LDA(At, 1, 1); PG8_STAGE(PG8_SA(1, 0), a3, voffA);
            PG8_BAR; PG8_WAIT_L(0); PG8_MMA(1, 0, At, B0); PG8_BAR; PG8_SCHED;
            PG8_STAGE(PG8_SB(1, 1), b3 + hstep, voffB);
            PG8_WAIT_V(6); PG8_BAR; PG8_MMA(1, 1, At, B1); PG8_BAR;
        }
        E(acc, cur, wr, wc, fr, fq);
        if (!has_next) break;
#pragma unroll
        for (int a = 0; a < 2; ++a)
#pragma unroll
            for (int b = 0; b < 2; ++b)
#pragma unroll
                for (int m = 0; m < 4; ++m)
#pragma unroll
                    for (int n = 0; n < 2; ++n) acc[a][b][m][n] = (f32x4){0.f, 0.f, 0.f, 0.f};
        cur = nxt; cA = nA; cB = nB; ++ui;
    }
    PG8_WAIT_V(0);
    if (wr == 0) PG8_BAR;
    PG8_BAR;
#undef PG8_SA
#undef PG8_SB
#undef PG8_STAGE
#undef PG8_LDA
#undef PG8_LDB
#undef PG8_MMA
#undef PG8_WAIT_V
#undef PG8_WAIT_L
#undef PG8_BAR
#undef PG8_SCHED
}
}

__device__ __forceinline__ void phase_prep(const int tidx, const P& p, LAS unsigned char* L) {
    const int tid = tidx;
    constexpr int NADA = NL * 96, TPL = 3264, TOTAL = NADA + NL * TPL;
    float* mod = (float*)(p.ws + WS_MOD);
    for (int it = blockIdx.x; it < NADA; it += gridDim.x) {
        __syncthreads();
        {
            const int l = it / 96, n0 = (it % 96) * 64;
            LAS float* cact = (LAS float*)L;
            LAS float* red = cact + 4096;
            for (int i = tid; i < 4096; i += 512) cact[i] = silu_f(p.c[i]);
            __syncthreads();
            const int kg = tid >> 6, nn = tid & 63;
            const float* w = p.w_ada + ((size_t)l * DM + kg * 128) * NMOD + n0 + nn;
            float a0 = 0.f, a1 = 0.f, a2 = 0.f, a3 = 0.f;
#pragma unroll 8
            for (int k = 0; k < 128; ++k) { const float wv = w[(size_t)k * NMOD]; const int kk = kg * 128 + k;
                a0 += cact[kk] * wv; a1 += cact[1024 + kk] * wv; a2 += cact[2048 + kk] * wv; a3 += cact[3072 + kk] * wv; }
            red[(kg * 4 + 0) * 64 + nn] = a0; red[(kg * 4 + 1) * 64 + nn] = a1; red[(kg * 4 + 2) * 64 + nn] = a2; red[(kg * 4 + 3) * 64 + nn] = a3;
            __syncthreads();
            if (tid < 256) { const int b = tid >> 6; float s = p.b_ada[l * NMOD + n0 + nn];
#pragma unroll
                for (int k2 = 0; k2 < 8; ++k2) s += red[(k2 * 4 + b) * 64 + nn];
                mod[(size_t)(l * NB + b) * NMOD + n0 + nn] = s; }
        }
    }
    constexpr int NTT = NL * TPL;
    for (int it0 = blockIdx.x * 4; it0 < NTT; it0 += gridDim.x * 4) {
        __syncthreads();
        bf16_t* dstp[4]; int kd[4];
#pragma unroll
        for (int tt = 0; tt < 4; ++tt) {
            const int j = it0 + tt, l = j / TPL; int r = j % TPL;
            const float* src; bf16_t* dst; int Ns, Nvalid, Kd, k0, ns0, nd0;
            if (r < 896) { const int kt = r / 56, nt = r % 56; src = p.w_in + (size_t)l * DM * NIN; Ns = NIN; Nvalid = NIN; Kd = DM; k0 = kt * 64; nd0 = nt * 64; ns0 = nd0;
                dst = (bf16_t*)(p.ws + WS_WIN) + (size_t)l * NINP * DM; }
            else if (r < 1152) { r -= 896; const int kt = r / 16, nt = r % 16; src = p.w_out + (size_t)l * DM * DM; Ns = DM; Nvalid = DM; Kd = DM; k0 = kt * 64; nd0 = nt * 64; ns0 = nd0;
                dst = (bf16_t*)(p.ws + WS_WOUT) + (size_t)l * DM * DM; }
            else if (r < 2560) { r -= 1152; const int kt = r / 88, nt = r % 88; src = p.w_ffn_in + (size_t)l * DM * NF1; Ns = NF1; Nvalid = NF1; Kd = DM; k0 = kt * 64; nd0 = nt * 64;
                const int pn = nd0 >> 8, half = (nd0 >> 7) & 1, sub = nd0 & 127; ns0 = half * DFF + pn * 128 + sub;
                dst = (bf16_t*)(p.ws + WS_WF1) + (size_t)l * NF1 * DM; }
            else { r -= 2560; const int kt = r / 16, nt = r % 16; src = p.w_ffn_out + (size_t)l * DFF * DM; Ns = DM; Nvalid = DM; Kd = DFF; k0 = kt * 64; nd0 = nt * 64; ns0 = nd0;
                dst = (bf16_t*)(p.ws + WS_WF2) + (size_t)l * DM * DFF; }
            LAS float* tile = (LAS float*)L + tt * (64 * 65);
            const int kk = tid >> 4, c4 = (tid & 15) * 4;
            f32x4 v0 = {0.f, 0.f, 0.f, 0.f}, v1 = {0.f, 0.f, 0.f, 0.f};
            if (ns0 + c4 < Nvalid) { v0 = *(const f32x4*)(src + (size_t)(k0 + kk) * Ns + ns0 + c4); v1 = *(const f32x4*)(src + (size_t)(k0 + kk + 32) * Ns + ns0 + c4); }
            tile[kk * 65 + c4 + 0] = v0[0]; tile[kk * 65 + c4 + 1] = v0[1]; tile[kk * 65 + c4 + 2] = v0[2]; tile[kk * 65 + c4 + 3] = v0[3];
            tile[(kk + 32) * 65 + c4 + 0] = v1[0]; tile[(kk + 32) * 65 + c4 + 1] = v1[1]; tile[(kk + 32) * 65 + c4 + 2] = v1[2]; tile[(kk + 32) * 65 + c4 + 3] = v1[3];
            dstp[tt] = dst + (size_t)nd0 * Kd + k0; kd[tt] = Kd;
        }
        __syncthreads();
#pragma unroll
        for (int tt = 0; tt < 4; ++tt) {
            LAS float* tile = (LAS float*)L + tt * (64 * 65);
            const int nn = tid >> 3, k8 = (tid & 7) * 8; float f[8];
#pragma unroll
            for (int i = 0; i < 8; ++i) f[i] = tile[(k8 + i) * 65 + nn];
            *(u32x4*)(dstp[tt] + (size_t)nn * kd[tt] + k8) = pack8(f);
        }
    }
}

__device__ __forceinline__ void phase_norm(const int tidx, const float* xin, const float* g, const float* modl, int shoff, int scoff, bf16_t* hout) {
    const int wave = tidx >> 6, lane = tidx & 63;
    for (int row0 = (blockIdx.x * 8 + wave) * 2; row0 < MTOK; row0 += gridDim.x * 16) {
        const int b = row0 >> 12;
        f32x4 v[2][4], gg[4], sc[4], sh[4];
#pragma unroll
        for (int rr = 0; rr < 2; ++rr)
#pragma unroll
            for (int i = 0; i < 4; ++i) v[rr][i] = *(const f32x4*)(xin + (size_t)(row0 + rr) * DM + i * 256 + lane * 4);
#pragma unroll
        for (int i = 0; i < 4; ++i) { const int k = i * 256 + lane * 4;
            gg[i] = *(const f32x4*)(g + k); sc[i] = *(const f32x4*)(modl + (size_t)b * NMOD + scoff + k); sh[i] = *(const f32x4*)(modl + (size_t)b * NMOD + shoff + k); }
#pragma unroll
        for (int rr = 0; rr < 2; ++rr) {
            float ss = 0.f;
#pragma unroll
            for (int i = 0; i < 4; ++i) ss += v[rr][i][0] * v[rr][i][0] + v[rr][i][1] * v[rr][i][1] + v[rr][i][2] * v[rr][i][2] + v[rr][i][3] * v[rr][i][3];
            ss = wave_sum(ss);
            const float rinv = rsqrtf(ss * (1.f / DM) + 1e-6f);
#pragma unroll
            for (int i = 0; i < 4; ++i) { const int k = i * 256 + lane * 4;
                const f32x4 y = v[rr][i] * rinv * gg[i] * (sc[i] + 1.f) + sh[i];
                u32x2 w; w.x = pk2(y[0], y[1]); w.y = pk2(y[2], y[3]);
                *(u32x2*)(hout + (size_t)(row0 + rr) * DM + k) = w; }
        }
    }
}
__device__ __forceinline__ void phase_final(const int tidx, float* x, const float* g) {
    const int wave = tidx >> 6, lane = tidx & 63;
    for (int row0 = (blockIdx.x * 8 + wave) * 2; row0 < MTOK; row0 += gridDim.x * 16) {
        f32x4 v[2][4], gg[4];
#pragma unroll
        for (int rr = 0; rr < 2; ++rr)
#pragma unroll
            for (int i = 0; i < 4; ++i) v[rr][i] = *(const f32x4*)(x + (size_t)(row0 + rr) * DM + i * 256 + lane * 4);
#pragma unroll
        for (int i = 0; i < 4; ++i) gg[i] = *(const f32x4*)(g + i * 256 + lane * 4);
#pragma unroll
        for (int rr = 0; rr < 2; ++rr) {
            float ss = 0.f;
#pragma unroll
            for (int i = 0; i < 4; ++i) ss += v[rr][i][0] * v[rr][i][0] + v[rr][i][1] * v[rr][i][1] + v[rr][i][2] * v[rr][i][2] + v[rr][i][3] * v[rr][i][3];
            ss = wave_sum(ss);
            const float rinv = rsqrtf(ss * (1.f / DM) + 1e-6f);
#pragma unroll
            for (int i = 0; i < 4; ++i) *(f32x4*)(x + (size_t)(row0 + rr) * DM + i * 256 + lane * 4) = v[rr][i] * rinv * gg[i];
        }
    }
}


__device__ __forceinline__ void norm_panel(const int tidx, const float* xin, const float* g, const float* modl, int shoff, int scoff, bf16_t* hout, int rbeg, int nrows) {
    const int wave = tidx >> 6, lane = tidx & 63;
    const int b = rbeg >> 12;
    f32x4 gg[4], sc[4], sh[4];
#pragma unroll
    for (int i = 0; i < 4; ++i) { const int k = i * 256 + lane * 4;
        gg[i] = *(const f32x4*)(g + k); sc[i] = *(const f32x4*)(modl + (size_t)b * NMOD + scoff + k); sh[i] = *(const f32x4*)(modl + (size_t)b * NMOD + shoff + k); }
    for (int row0 = rbeg + wave * 2; row0 < rbeg + nrows; row0 += 16) {
        f32x4 v[2][4];
#pragma unroll
        for (int rr = 0; rr < 2; ++rr)
#pragma unroll
            for (int i = 0; i < 4; ++i) v[rr][i] = *(const f32x4*)(xin + (size_t)(row0 + rr) * DM + i * 256 + lane * 4);
#pragma unroll
        for (int rr = 0; rr < 2; ++rr) {
            float ss = 0.f;
#pragma unroll
            for (int i = 0; i < 4; ++i) ss += v[rr][i][0] * v[rr][i][0] + v[rr][i][1] * v[rr][i][1] + v[rr][i][2] * v[rr][i][2] + v[rr][i][3] * v[rr][i][3];
            ss = wave_sum(ss);
            const float rinv = rsqrtf(ss * (1.f / DM) + 1e-6f);
#pragma unroll
            for (int i = 0; i < 4; ++i) { const int k = i * 256 + lane * 4;
                const f32x4 y = v[rr][i] * rinv * gg[i] * (sc[i] + 1.f) + sh[i];
                u32x2 w; w.x = pk2(y[0], y[1]); w.y = pk2(y[2], y[3]);
                *(u32x2*)(hout + (size_t)(row0 + rr) * DM + k) = w; }
        }
    }
}
__device__ __forceinline__ void final_panel(const int tidx, float* x, const float* g, int rbeg, int nrows) {
    const int wave = tidx >> 6, lane = tidx & 63;
    f32x4 gg[4];
#pragma unroll
    for (int i = 0; i < 4; ++i) gg[i] = *(const f32x4*)(g + i * 256 + lane * 4);
    for (int row0 = rbeg + wave * 2; row0 < rbeg + nrows; row0 += 16) {
        f32x4 v[2][4];
#pragma unroll
        for (int rr = 0; rr < 2; ++rr)
#pragma unroll
            for (int i = 0; i < 4; ++i) v[rr][i] = *(const f32x4*)(x + (size_t)(row0 + rr) * DM + i * 256 + lane * 4);
#pragma unroll
        for (int rr = 0; rr < 2; ++rr) {
            float ss = 0.f;
#pragma unroll
            for (int i = 0; i < 4; ++i) ss += v[rr][i][0] * v[rr][i][0] + v[rr][i][1] * v[rr][i][1] + v[rr][i][2] * v[rr][i][2] + v[rr][i][3] * v[rr][i][3];
            ss = wave_sum(ss);
            const float rinv = rsqrtf(ss * (1.f / DM) + 1e-6f);
#pragma unroll
            for (int i = 0; i < 4; ++i) *(f32x4*)(x + (size_t)(row0 + rr) * DM + i * 256 + lane * 4) = v[rr][i] * rinv * gg[i];
        }
    }
}
__device__ __forceinline__ void panel_post(const int tidx, unsigned* cnt0, const pg8::StaticOrder& S) {
    asm volatile("s_waitcnt vmcnt(0)" ::: "memory");
    __syncthreads();
    if (tidx == 0) {
        __builtin_amdgcn_fence(__ATOMIC_RELEASE, "agent");
        asm volatile("s_waitcnt vmcnt(0)" ::: "memory");
        pg8::Unit u;
        for (int i = 0; S.next(i, u); ++i) (void)__hip_atomic_fetch_add(cnt0 + u.pm, 1u, __ATOMIC_RELAXED, __HIP_MEMORY_SCOPE_AGENT);
    }
}
__device__ __forceinline__ void panel_wait(const int tidx, unsigned* cnt) {
    if (tidx == 0) {
        unsigned sp = 0;
        while (__hip_atomic_load(cnt, __ATOMIC_RELAXED, __HIP_MEMORY_SCOPE_AGENT) < 4u) { __builtin_amdgcn_s_sleep(1); if (++sp > (1u << 22)) break; }
        __builtin_amdgcn_fence(__ATOMIC_ACQUIRE, "agent");
        asm volatile("s_waitcnt vmcnt(0)" ::: "memory");
    }
    __syncthreads();
}

__device__ __forceinline__ void phase_dprep(const int tidx, const P& p, int l, LAS unsigned char* L) {
    LAS bf16_t* Qn = (LAS bf16_t*)(L + 0);
    LAS bf16_t* Kn = (LAS bf16_t*)(L + 17408);
    LAS bf16_t* KbgT = (LAS bf16_t*)(L + 34816);
    LAS bf16_t* KtlT = (LAS bf16_t*)(L + 53248);
    LAS bf16_t* VbT = (LAS bf16_t*)(L + 71680);
    LAS float* Lm = (LAS float*)(L + 90112);
    LAS bf16_t* Tm = (LAS bf16_t*)(L + 107520);
    LAS bf16_t* QKm = (LAS bf16_t*)(L + 116736);
    LAS float* gcs = (LAS float*)(L + 125952);
    LAS float* betas = gcs + 64;
    LAS float* cwl = (LAS float*)(L + LDS_CW_OFF);
    const bf16_t* proj = (const bf16_t*)(p.ws + WS_PROJ);
    float* alast = (float*)(p.ws + WS_ALAST);
    for (int item = blockIdx.x; item < 1024; item += gridDim.x) {
        __syncthreads();
        int tid = tidx; asm volatile("" : "+v"(tid));
        const int lane = tid & 63, wave = tid >> 6, r = lane & 15, q = lane >> 4;
        const int h = item & 3, n = (item >> 2) & 63, b = item >> 8;
        const int t0 = b * SEQ + n * 64;
        unsigned char* itp = p.ws + WS_DELTA + (size_t)item * ITEM_BYTES;
        const int run = (tid >> 4) & 15, d0 = (tid & 15) * 8, tk0 = run * 4, whichA = tid >> 8;
        u32x4 rawA[7], rawB[7];
#pragma unroll
        for (int rr = 0; rr < 7; ++rr) {
            const int pos = n * 64 + tk0 - 3 + rr;
            rawA[rr] = (u32x4){0u, 0u, 0u, 0u}; rawB[rr] = (u32x4){0u, 0u, 0u, 0u};
            if (pos >= 0) { const bf16_t* pr = proj + (size_t)(t0 + tk0 - 3 + rr) * NINP + 1280 + h * 128 + d0;
                rawA[rr] = *(const u32x4*)(pr + whichA * 512);
                if (tid < 256) rawB[rr] = *(const u32x4*)(pr + 1024); }
        }
        if (tid < 384) {
#pragma unroll
            for (int j = 0; j < 4; ++j) cwl[j * 384 + tid] = p.dn_conv_w[(size_t)(l * 4 + j) * 1536 + (tid >> 7) * 512 + h * 128 + (tid & 127)];
        }
        if (wave == 7) {
            const bf16_t* pr = proj + (size_t)(t0 + lane) * NINP;
            const float alpha = bf2f(pr[3328 + h]), braw = bf2f(pr[3332 + h]);
            const float xx = alpha + p.dn_dt_bias[l * 4 + h];
            const float sp = fmaxf(xx, 0.f) + log1pf(__expf(-fabsf(xx)));
            float gc = -__expf(p.dn_a_log[l * 4 + h]) * sp;
#pragma unroll
            for (int o = 1; o < 64; o <<= 1) { const float tv = __shfl_up(gc, o); if (lane >= o) gc += tv; }
            gcs[lane] = gc; betas[lane] = sigmoid_f(braw);
        }
        __syncthreads();
        const float gl = gcs[63];
#pragma unroll
        for (int pass = 0; pass < 2; ++pass) {
            if (pass == 1 && tid >= 256) break;
            const int which = pass ? 2 : whichA;
            const LAS float* cw = cwl + which * 128 + d0;
            float y[4][8];
#pragma unroll
            for (int i = 0; i < 4; ++i)
#pragma unroll
                for (int d = 0; d < 8; ++d) y[i][d] = 0.f;
#pragma unroll
            for (int j = 0; j < 4; ++j) {
                const f32x4 w0 = *(const LAS f32x4*)(cw + j * 384), w1 = *(const LAS f32x4*)(cw + j * 384 + 4);
#pragma unroll
                for (int i = 0; i < 4; ++i) { float rf[8]; unpack8(pass ? rawB[i + j] : rawA[i + j], rf);
#pragma unroll
                    for (int d = 0; d < 4; ++d) { y[i][d] += w0[d] * rf[d]; y[i][4 + d] += w1[d] * rf[4 + d]; } }
            }
#pragma unroll
            for (int i = 0; i < 4; ++i) {
#pragma unroll
                for (int d = 0; d < 8; ++d) y[i][d] = silu_f(y[i][d]);
                if (which < 2) {
                    float ss = 0.f;
#pragma unroll
                    for (int d = 0; d < 8; ++d) ss += y[i][d] * y[i][d];
                    ss += __shfl_xor(ss, 1); ss += __shfl_xor(ss, 2); ss += __shfl_xor(ss, 4); ss += __shfl_xor(ss, 8);
                    float rinv = rsqrtf(ss + 1e-6f);
                    if (which == 0) rinv *= 0.08838834764831845f;
#pragma unroll
                    for (int d = 0; d < 8; ++d) y[i][d] *= rinv;
                }
            }
            if (which == 0) {
#pragma unroll
                for (int i = 0; i < 4; ++i) *(LAS u32x4*)(Qn + (tk0 + i) * 136 + d0) = pack8(y[i]);
            } else if (which == 1) {
                float f1[4], f2[4];
#pragma unroll
                for (int i = 0; i < 4; ++i) { const float gc = gcs[tk0 + i]; f1[i] = betas[tk0 + i] * __expf(gc); f2[i] = __expf(gl - gc); }
#pragma unroll
                for (int i = 0; i < 4; ++i) *(LAS u32x4*)(Kn + (tk0 + i) * 136 + d0) = pack8(y[i]);
#pragma unroll
                for (int d = 0; d < 8; ++d) {
                    u32x2 a, c; a.x = pk2(y[0][d] * f1[0], y[1][d] * f1[1]); a.y = pk2(y[2][d] * f1[2], y[3][d] * f1[3]); c.x = pk2(y[0][d] * f2[0], y[1][d] * f2[1]); c.y = pk2(y[2][d] * f2[2], y[3][d] * f2[3]);
                    *(LAS u32x2*)(KbgT + (d0 + d) * 72 + tk0) = a; *(LAS u32x2*)(KtlT + (d0 + d) * 72 + tk0) = c; }
            } else {
                float bt[4];
#pragma unroll
                for (int i = 0; i < 4; ++i) bt[i] = betas[tk0 + i];
#pragma unroll
                for (int d = 0; d < 8; ++d) { u32x2 a; a.x = pk2(y[0][d] * bt[0], y[1][d] * bt[1]); a.y = pk2(y[2][d] * bt[2], y[3][d] * bt[3]);
                    *(LAS u32x2*)(VbT + (d0 + d) * 72 + tk0) = a; }
            }
        }
        __syncthreads();
        {
            const int mat = wave >> 2, cb = wave & 3;
            LAS bf16_t* Asrc = mat ? Qn : Kn;
            bf16x8 a[4];
#pragma unroll
            for (int kb = 0; kb < 4; ++kb) a[kb] = *(LAS bf16x8*)(Asrc + (16 * cb + r) * 136 + 32 * kb + 8 * q);
#pragma unroll
            for (int sb = 0; sb < 4; ++sb) {
                f32x4 acc = {0.f, 0.f, 0.f, 0.f};
                if (sb <= cb) {
#pragma unroll
                    for (int kb = 0; kb < 4; ++kb) { const bf16x8 bb = *(LAS bf16x8*)(Kn + (16 * sb + r) * 136 + 32 * kb + 8 * q); acc = MFMA16(a[kb], bb, acc); }
                }
                const int s = 16 * sb + r; const float gs = gcs[s];
#pragma unroll
                for (int j = 0; j < 4; ++j) { const int c = 16 * cb + 4 * q + j; const float dec = __expf(gcs[c] - gs);
                    if (mat == 0) Lm[c * 68 + s] = (s < c) ? acc[j] * betas[c] * dec : 0.f;
                    else QKm[c * 72 + s] = f2bf((s <= c) ? acc[j] * dec : 0.f); }
            }
        }
        __syncthreads();
        if (wave == 0) {
            float t[64];
            int zoff; asm volatile("v_mov_b32 %0, 0" : "=v"(zoff));
            LAS float* Lz = Lm + zoff;
            f32x4 rowbuf[2][16];
            t[0] = (lane == 0) ? 1.f : 0.f;
            rowbuf[1][0] = *(LAS f32x4*)(Lz + 1 * 68);
#pragma unroll
            for (int i = 1; i < 64; ++i) {
                if (i + 1 < 64) {
#pragma unroll
                    for (int j4 = 0; j4 < (i + 4) / 4; ++j4) rowbuf[(i + 1) & 1][j4] = *(LAS f32x4*)(Lz + (i + 1) * 68 + 4 * j4);
                }
                __builtin_amdgcn_sched_barrier(0);
                float acc0 = (i == lane) ? 1.f : 0.f, acc1 = 0.f;
#pragma unroll
                for (int j = 0; j < i; ++j) { if (j & 1) acc1 -= rowbuf[i & 1][j >> 2][j & 3] * t[j]; else acc0 -= rowbuf[i & 1][j >> 2][j & 3] * t[j]; }
                t[i] = acc0 + acc1;
                __builtin_amdgcn_sched_barrier(0);
            }
#pragma unroll
            for (int i = 0; i < 64; ++i) Tm[i * 72 + lane] = f2bf(t[i]);
            if (lane == 0) alast[item] = __expf(gl);
        } else {
            for (int jb = wave - 1; jb < 40; jb += 7) {
                if (jb < 16) {
                    const int tb = jb >> 2, kb = jb & 3, tok = 16 * tb + r;
                    const u32x2 lo = *(LAS u32x2*)(Qn + tok * 136 + 32 * kb + 4 * q), hi = *(LAS u32x2*)(Qn + tok * 136 + 32 * kb + 16 + 4 * q);
                    const float e = __expf(gcs[tok]);
                    u32x4 w; w.x = pk2(lo16(lo.x) * e, hi16(lo.x) * e); w.y = pk2(lo16(lo.y) * e, hi16(lo.y) * e); w.z = pk2(lo16(hi.x) * e, hi16(hi.x) * e); w.w = pk2(lo16(hi.y) * e, hi16(hi.y) * e);
                    *(u32x4*)(itp + OFF_Q + (size_t)(jb * 64 + lane) * 16) = w;
                } else if (jb < 32) {
                    const int f = jb - 16, db = f >> 1, kb = f & 1, dk = 16 * db + r;
                    const u32x2 lo = *(LAS u32x2*)(KtlT + dk * 72 + 32 * kb + 4 * q), hi = *(LAS u32x2*)(KtlT + dk * 72 + 32 * kb + 16 + 4 * q);
                    u32x4 w; w.x = lo.x; w.y = lo.y; w.z = hi.x; w.w = hi.y;
                    *(u32x4*)(itp + OFF_KT + (size_t)(f * 64 + lane) * 16) = w;
                } else {
                    const int f = jb - 32, tb = f >> 1, kb = f & 1, tok = 16 * tb + r;
                    const u32x2 lo = *(LAS u32x2*)(QKm + tok * 72 + 32 * kb + 4 * q), hi = *(LAS u32x2*)(QKm + tok * 72 + 32 * kb + 16 + 4 * q);
                    u32x4 w; w.x = lo.x; w.y = lo.y; w.z = hi.x; w.w = hi.y;
                    *(u32x4*)(itp + OFF_QK + (size_t)(f * 64 + lane) * 16) = w;
                }
            }
        }
        __syncthreads();
        {
            const int s = wave;
            bf16x8 vb[2];
#pragma unroll
            for (int kb = 0; kb < 2; ++kb) vb[kb] = *(LAS bf16x8*)(VbT + (16 * s + r) * 72 + 32 * kb + 8 * q);
#pragma unroll
            for (int tb = 0; tb < 4; ++tb) {
                f32x4 acc = {0.f, 0.f, 0.f, 0.f};
#pragma unroll
                for (int kb = 0; kb < 2; ++kb) { const bf16x8 a = *(LAS bf16x8*)(Tm + (16 * tb + r) * 72 + 32 * kb + 8 * q); acc = MFMA16(a, vb[kb], acc); }
                *(f32x4*)(itp + OFF_U + (size_t)((s * 4 + tb) * 64 + lane) * 16) = acc;
            }
            const int kbp = wave & 3, tbh = wave >> 2;
            bf16x8 ka[2][2];
#pragma unroll
            for (int d = 0; d < 2; ++d)
#pragma unroll
                for (int kb = 0; kb < 2; ++kb) ka[d][kb] = *(LAS bf16x8*)(KbgT + (16 * (2 * kbp + d) + r) * 72 + 32 * kb + 8 * q);
#pragma unroll
            for (int tt = 0; tt < 2; ++tt) {
                const int tb = 2 * tbh + tt;
                f32x4 a0 = {0.f, 0.f, 0.f, 0.f}, a1 = {0.f, 0.f, 0.f, 0.f};
#pragma unroll
                for (int kb = 0; kb < 2; ++kb) { const bf16x8 tf = *(LAS bf16x8*)(Tm + (16 * tb + r) * 72 + 32 * kb + 8 * q); a0 = MFMA16(ka[0][kb], tf, a0); a1 = MFMA16(ka[1][kb], tf, a1); }
                u32x4 w; w.x = pk2(a0[0], a0[1]); w.y = pk2(a0[2], a0[3]); w.z = pk2(a1[0], a1[1]); w.w = pk2(a1[2], a1[3]);
                *(u32x4*)(itp + OFF_W + (size_t)((tb * 4 + kbp) * 64 + lane) * 16) = w;
            }
        }
    }
}

__device__ __forceinline__ void mixer_a(const int tidx, const P& p, int l, int blk, int nblk) {
    const bf16_t* proj = (const bf16_t*)(p.ws + WS_PROJ); bf16_t* ycat = (bf16_t*)(p.ws + WS_YCAT);
    for (int unit = blk * 512 + tidx; unit < MTOK * 32; unit += nblk * 512) {
        const int t = unit >> 5, c0 = (unit & 31) * 8, pos = t & (SEQ - 1);
        float acc[8];
#pragma unroll
        for (int i = 0; i < 8; ++i) acc[i] = 0.f;
#pragma unroll
        for (int j = 0; j < 3; ++j) {
            if (pos - 2 + j >= 0) {
                const bf16_t* pr = proj + (size_t)(t - 2 + j) * NINP;
                float fc[8], fv[8]; unpack8(*(const u32x4*)(pr + 256 + c0), fc); unpack8(*(const u32x4*)(pr + 512 + c0), fv);
                const float* wp = p.conv_a_w + (size_t)(l * 3 + j) * 256 + c0;
                const f32x4 w0 = *(const f32x4*)wp, w1 = *(const f32x4*)(wp + 4);
#pragma unroll
                for (int i = 0; i < 4; ++i) { acc[i] += w0[i] * fc[i] * fv[i]; acc[4 + i] += w1[i] * fc[4 + i] * fv[4 + i]; }
            }
        }
        float fb[8]; unpack8(*(const u32x4*)(proj + (size_t)t * NINP + c0), fb);
#pragma unroll
        for (int i = 0; i < 8; ++i) acc[i] *= fb[i];
        *(u32x4*)(ycat + (size_t)t * DM + c0) = pack8(acc);
    }
}
__device__ __forceinline__ void mixer_b(const int tidx, const P& p, int l, int blk, int nblk, LAS unsigned char* L) {
    const bf16_t* proj = (const bf16_t*)(p.ws + WS_PROJ); bf16_t* ycat = (bf16_t*)(p.ws + WS_YCAT);
    LAS float* ut = (LAS float*)L;
    LAS float* co = (LAS float*)(L + 63488);
    const int tid = tidx, wave = tid >> 6, lane = tid & 63;
    for (int run = blk; run < MTOK / 32; run += nblk) {
        __syncthreads();
        const int t0 = run * 32, pos0 = t0 & (SEQ - 1);
        {
            u32x4 ra[4], rg[4];
#pragma unroll
            for (int it = 0; it < 4; ++it) { const int idx = tid + 512 * it, rr = idx >> 5, c0 = (idx & 31) * 8;
                ra[it] = (u32x4){0u, 0u, 0u, 0u}; rg[it] = (u32x4){0u, 0u, 0u, 0u};
                if (idx < 62 * 32 && pos0 - 30 + rr >= 0) { const bf16_t* pr = proj + (size_t)(t0 - 30 + rr) * NINP; ra[it] = *(const u32x4*)(pr + 768 + c0); rg[it] = *(const u32x4*)(pr + 1024 + c0); } }
#pragma unroll
            for (int it = 0; it < 4; ++it) { const int idx = tid + 512 * it, rr = idx >> 5, c0 = (idx & 31) * 8;
                if (idx < 62 * 32) { float fa[8], fg[8], u[8]; unpack8(ra[it], fa); unpack8(rg[it], fg);
#pragma unroll
                    for (int i = 0; i < 8; ++i) u[i] = fa[i] * sigmoid_f(fg[i]);
                    *(LAS f32x4*)(ut + rr * 256 + c0) = (f32x4){u[0], u[1], u[2], u[3]}; *(LAS f32x4*)(ut + rr * 256 + c0 + 4) = (f32x4){u[4], u[5], u[6], u[7]}; } }
        }
        __syncthreads();
        {
            const int c = tid & 255, half = tid >> 8;
            float w[31], win[46];
#pragma unroll
            for (int j = 0; j < 31; ++j) w[j] = p.conf_dw_w[(size_t)(l * 31 + j) * 256 + c];
            const float bias = p.conf_dw_b[l * 256 + c];
#pragma unroll
            for (int k = 0; k < 46; ++k) win[k] = ut[(half * 16 + k) * 256 + c];
#pragma unroll
            for (int tt = 0; tt < 16; ++tt) { float acc = bias;
#pragma unroll
                for (int j = 0; j < 31; ++j) acc += w[j] * win[tt + j];
                co[(half * 16 + tt) * 256 + c] = acc; }
        }
        __syncthreads();
#pragma unroll
        for (int i = 0; i < 4; ++i) {
            const int tl = wave * 4 + i;
            const f32x4 v = *(LAS f32x4*)(co + tl * 256 + lane * 4);
            const float mean = wave_sum(v[0] + v[1] + v[2] + v[3]) * (1.f / 256.f);
            const f32x4 d = v - mean;
            const float var = wave_sum(d[0] * d[0] + d[1] * d[1] + d[2] * d[2] + d[3] * d[3]) * (1.f / 256.f);
            const float rs = rsqrtf(var + 1e-5f);
            const f32x4 gg = *(const f32x4*)(p.conf_ln_g + l * 256 + lane * 4), bb = *(const f32x4*)(p.conf_ln_b + l * 256 + lane * 4);
            const f32x4 y = d * rs * gg + bb;
            u32x2 wv; wv.x = pk2(silu_f(y[0]), silu_f(y[1])); wv.y = pk2(silu_f(y[2]), silu_f(y[3]));
            *(u32x2*)(ycat + (size_t)(t0 + tl) * DM + 256 + lane * 4) = wv;
        }
    }
}

constexpr int SCAN_BLOCKS = 128, SCAN_BUF = 64512;
__device__ __forceinline__ void phase_scan(const int tidx, const P& p, int l, LAS unsigned char* L) {
    const int tid = tidx, lane = tid & 63, wave = tid >> 6, r = lane & 15, q = lane >> 4;
    if ((int)blockIdx.x >= SCAN_BLOCKS) {
        const int blk = blockIdx.x - SCAN_BLOCKS, nblk = gridDim.x - SCAN_BLOCKS;
        mixer_a(tidx, p, l, blk, nblk);
        mixer_b(tidx, p, l, blk, nblk, L);
        return;
    }
    const int item = blockIdx.x, xcd = item & 7, jj = item >> 3, s = jj & 7, bh = xcd * 2 + (jj >> 3), b = bh >> 2, h = bh & 3;
    const unsigned char* dl = p.ws + WS_DELTA;
    const float* alast = (const float*)(p.ws + WS_ALAST);
    float* obuf = (float*)(p.ws + WS_H);
#define SB_ __builtin_amdgcn_sched_barrier(0)
#define SCAN_COMPUTE(buf, n_) do { \
            const float al = __builtin_bit_cast(float, __builtin_amdgcn_readlane(__builtin_bit_cast(int, al_all), (n_))); \
            const LAS bf16x8* Wf = (const LAS bf16x8*)((buf) + OFF_W) + lane; const LAS bf16x8* Qf = (const LAS bf16x8*)((buf) + OFF_Q) + lane; \
            const LAS bf16x8* Kf = (const LAS bf16x8*)((buf) + OFF_KT) + lane; const LAS bf16x8* QKf = (const LAS bf16x8*)((buf) + OFF_QK) + lane; \
            const LAS f32x4* Uf = (const LAS f32x4*)((buf) + OFF_U) + lane; \
            bf16x8 g0[8], g1[8]; f32x4 Uv[4]; \
            _Pragma("unroll") for (int f = 0; f < 8; ++f) g0[f] = Wf[((f >> 1) * 4 + (f & 1)) * 64];                \
            _Pragma("unroll") for (int f = 0; f < 8; ++f) g1[f] = Wf[((f >> 1) * 4 + 2 + (f & 1)) * 64];            \
            bf16x8 Sb[4]; \
            _Pragma("unroll") for (int kb = 0; kb < 4; ++kb) { u32x4 w; w.x = pk2(S[2 * kb][0], S[2 * kb][1]); w.y = pk2(S[2 * kb][2], S[2 * kb][3]); w.z = pk2(S[2 * kb + 1][0], S[2 * kb + 1][1]); w.w = pk2(S[2 * kb + 1][2], S[2 * kb + 1][3]); \
                Sb[kb] = __builtin_bit_cast(bf16x8, w); } \
            f32x4 Pv[4], O[4]; \
            _Pragma("unroll") for (int tb = 0; tb < 4; ++tb) { Pv[tb] = (f32x4){0.f, 0.f, 0.f, 0.f}; O[tb] = (f32x4){0.f, 0.f, 0.f, 0.f}; } \
            SB_; \
            _Pragma("unroll") for (int f = 0; f < 8; ++f) Pv[f >> 1] = MFMA16(g0[f], Sb[f & 1], Pv[f >> 1]); \
            _Pragma("unroll") for (int f = 0; f < 8; ++f) g0[f] = Qf[((f >> 1) * 4 + (f & 1)) * 64]; \
            SB_; \
            _Pragma("unroll") for (int f = 0; f < 8; ++f) Pv[f >> 1] = MFMA16(g1[f], Sb[2 + (f & 1)], Pv[f >> 1]); \
            _Pragma("unroll") for (int f = 0; f < 8; ++f) g1[f] = Qf[((f >> 1) * 4 + 2 + (f & 1)) * 64]; \
            _Pragma("unroll") for (int tb = 0; tb < 4; ++tb) Uv[tb] = Uf[tb * 64]; \
            SB_; \
            _Pragma("unroll") for (int f = 0; f < 8; ++f) O[f >> 1] = MFMA16(g0[f], Sb[f & 1], O[f >> 1]); \
            _Pragma("unroll") for (int f = 0; f < 8; ++f) g0[f] = Kf[(f * 2) * 64];                                  \
            SB_; \
            _Pragma("unroll") for (int f = 0; f < 8; ++f) O[f >> 1] = MFMA16(g1[f], Sb[2 + (f & 1)], O[f >> 1]); \
            _Pragma("unroll") for (int f = 0; f < 8; ++f) g1[f] = Kf[(f * 2 + 1) * 64];                              \
            _Pragma("unroll") for (int tb = 0; tb < 4; ++tb) Pv[tb] = Uv[tb] - Pv[tb]; \
            bf16x8 Vb[2]; \
            _Pragma("unroll") for (int kb = 0; kb < 2; ++kb) { u32x4 w; w.x = pk2(Pv[2 * kb][0], Pv[2 * kb][1]); w.y = pk2(Pv[2 * kb][2], Pv[2 * kb][3]); w.z = pk2(Pv[2 * kb + 1][0], Pv[2 * kb + 1][1]); w.w = pk2(Pv[2 * kb + 1][2], Pv[2 * kb + 1][3]); \
                Vb[kb] = __builtin_bit_cast(bf16x8, w); } \
            _Pragma("unroll") for (int db = 0; db < 8; ++db) S[db] = S[db] * al; \
            SB_; \
            _Pragma("unroll") for (int f = 0; f < 8; ++f) S[f] = MFMA16(g0[f], Vb[0], S[f]); \
            _Pragma("unroll") for (int f = 0; f < 8; ++f) g0[f] = QKf[f * 64];                                        \
            SB_; \
            _Pragma("unroll") for (int f = 0; f < 8; ++f) S[f] = MFMA16(g1[f], Vb[1], S[f]); \
            SB_; \
            _Pragma("unroll") for (int f = 0; f < 8; ++f) O[f >> 1] = MFMA16(g0[f], Vb[f & 1], O[f >> 1]); \
            float* op = obuf + (size_t)(b * SEQ + (n_) * 64 + 4 * q) * 512 + h * 128 + 16 * s + r; \
            _Pragma("unroll") for (int tb = 0; tb < 4; ++tb) \
                _Pragma("unroll") for (int j = 0; j < 4; ++j) op[(size_t)(16 * tb + j) * 512] = O[tb][j]; \
        } while (0)
#define SCAN_BAR() do { asm volatile("s_waitcnt lgkmcnt(0)" ::: "memory"); __builtin_amdgcn_s_barrier(); asm volatile("" ::: "memory"); } while (0)
    LAS unsigned char* buf0 = L; LAS unsigned char* buf1 = L + SCAN_BUF;
    if (wave == 0) {
        const float al_all = alast[(b * 64 + lane) * 4 + h];
        f32x4 S[8];
#pragma unroll
        for (int i = 0; i < 8; ++i) S[i] = (f32x4){0.f, 0.f, 0.f, 0.f};
        SCAN_BAR();
#pragma unroll 1
        for (int n = 0; n < 64; n += 2) {
            SCAN_COMPUTE(buf0, n);
            SCAN_BAR();
            SCAN_COMPUTE(buf1, n + 1);
            SCAN_BAR();
        }
    } else {
        const int ct = tid - 64;
        const int off8 = (ct < 256) ? (OFF_U + s * 4096 + ct * 16) : ((ct - 256) * 16);
        const unsigned char* dlb = dl + (size_t)((b * 64) * 4 + h) * ITEM_BYTES;
        u32x4 R0[9], R1[9], R2[9], R3[9];
#define SCAN_LOAD(regs, n_) do { const int nn_ = ((n_) < 64) ? (n_) : 63; const unsigned char* itp_ = dlb + (size_t)nn_ * (4 * ITEM_BYTES); \
        _Pragma("unroll") for (int i_ = 0; i_ < 8; ++i_) regs[i_] = *(const u32x4*)(itp_ + (ct + 448 * i_) * 16); \
        regs[8] = *(const u32x4*)(itp_ + off8); __builtin_amdgcn_sched_barrier(0); } while (0)
#define SCAN_STORE(regs, buf_) do { _Pragma("unroll") for (int i_ = 0; i_ < 9; ++i_) *(LAS u32x4*)((buf_) + (ct + 448 * i_) * 16) = regs[i_]; } while (0)
        SCAN_LOAD(R0, 0); SCAN_LOAD(R1, 1); SCAN_LOAD(R2, 2); SCAN_LOAD(R3, 3);
        SCAN_STORE(R0, buf0);
        SCAN_BAR();
#pragma unroll 1
        for (int n = 0; n < 64; n += 4) {
            SCAN_LOAD(R0, n + 4); SCAN_STORE(R1, buf1); SCAN_BAR();
            SCAN_LOAD(R1, n + 5); SCAN_STORE(R2, buf0); SCAN_BAR();
            SCAN_LOAD(R2, n + 6); SCAN_STORE(R3, buf1); SCAN_BAR();
            SCAN_LOAD(R3, n + 7); SCAN_STORE(R0, buf0); SCAN_BAR();
        }
    }
#undef SCAN_COMPUTE
#undef SB_
#undef SCAN_BAR
#undef SCAN_LOAD
#undef SCAN_STORE
}

__device__ __forceinline__ void phase_onorm(const int tidx, const P& p, int l) {
    const bf16_t* proj = (const bf16_t*)(p.ws + WS_PROJ); bf16_t* ycat = (bf16_t*)(p.ws + WS_YCAT); const float* obuf = (const float*)(p.ws + WS_H);
    const int sub = tidx & 15, d0 = sub * 8;
    const f32x4 g0 = *(const f32x4*)(p.dn_norm_g + l * 128 + d0), g1 = *(const f32x4*)(p.dn_norm_g + l * 128 + d0 + 4);
    for (int unit0 = (blockIdx.x * 32 + (tidx >> 4)) * 2; unit0 < MTOK * 4; unit0 += gridDim.x * 64) {
        f32x4 o0[2], o1[2]; u32x4 zr[2];
#pragma unroll
        for (int uu = 0; uu < 2; ++uu) { const int t = (unit0 + uu) >> 2, h = (unit0 + uu) & 3;
            o0[uu] = *(const f32x4*)(obuf + (size_t)t * 512 + h * 128 + d0); o1[uu] = *(const f32x4*)(obuf + (size_t)t * 512 + h * 128 + d0 + 4);
            zr[uu] = *(const u32x4*)(proj + (size_t)t * NINP + 2816 + h * 128 + d0); }
#pragma unroll
        for (int uu = 0; uu < 2; ++uu) { const int t = (unit0 + uu) >> 2, h = (unit0 + uu) & 3;
            float ss = o0[uu][0] * o0[uu][0] + o0[uu][1] * o0[uu][1] + o0[uu][2] * o0[uu][2] + o0[uu][3] * o0[uu][3] + o1[uu][0] * o1[uu][0] + o1[uu][1] * o1[uu][1] + o1[uu][2] * o1[uu][2] + o1[uu][3] * o1[uu][3];
            ss += __shfl_xor(ss, 1); ss += __shfl_xor(ss, 2); ss += __shfl_xor(ss, 4); ss += __shfl_xor(ss, 8);
            const float rinv = rsqrtf(ss * (1.f / 128.f) + 1e-6f);
            float z[8]; unpack8(zr[uu], z);
            float y[8];
#pragma unroll
            for (int i = 0; i < 4; ++i) { y[i] = o0[uu][i] * rinv * g0[i] * silu_f(z[i]); y[4 + i] = o1[uu][i] * rinv * g1[i] * silu_f(z[4 + i]); }
            *(u32x4*)(ycat + (size_t)t * DM + 512 + h * 128 + d0) = pack8(y); }
    }
}

#define XB_TMO      128
#define XB_XCNT(j)  (256  + 64 * (j))
#define XB_XSUB(j)  (1280 + 64 * (j))
#define XB_XGEN(j)  (2304 + 64 * (j))
#define XB_TOP      3328
#define XB_TOPGEN   3392
#define XCD_BAR_WORDS 3456
#define XB_SPIN_CAP (1u << 22)
__device__ __forceinline__ unsigned xb_ld(unsigned* p)              { return __hip_atomic_load(p, __ATOMIC_RELAXED, __HIP_MEMORY_SCOPE_AGENT); }
__device__ __forceinline__ unsigned xb_add(unsigned* p, unsigned v) { return __hip_atomic_fetch_add(p, v, __ATOMIC_RELAXED, __HIP_MEMORY_SCOPE_AGENT); }
__device__ __forceinline__ unsigned xb_xcc_id() { return (unsigned)__builtin_amdgcn_s_getreg((3 << 11) | 20) & 0xFu; }
#define XB_SPIN(cond, bar) do { unsigned _sp = 0; while (cond) { __builtin_amdgcn_s_sleep(1); \
    if ((++_sp & 255u) == 0u) { if (xb_ld(&(bar)[XB_TMO])) break; if (_sp > XB_SPIN_CAP) { atomicAdd(&(bar)[XB_TMO], 1u); break; } } } } while (0)
struct XcdBarrier { unsigned* bar; unsigned x; volatile LAS unsigned* st; };
__device__ __forceinline__ XcdBarrier xcd_barrier_post(unsigned* bar, volatile LAS unsigned* st) {
    XcdBarrier b; b.bar = bar; b.x = xb_xcc_id(); b.st = st;
    if (threadIdx.x == 0) (void)xb_add(&bar[XB_XCNT(b.x)], 1u);
    return b;
}
__device__ __forceinline__ void xcd_barrier_complete(unsigned* bar, unsigned x, unsigned& nloc, unsigned& nx) {
    const unsigned G = gridDim.x * gridDim.y * gridDim.z;
    unsigned sum, cnt, mine, sp = 0u;
    for (;;) {
        sum = 0u; cnt = 0u; mine = 0u;
#pragma unroll
        for (unsigned j = 0; j < 16; ++j) { const unsigned c = xb_ld(&bar[XB_XCNT(j)]); sum += c; cnt += (c > 0u) ? 1u : 0u; mine = (j == x) ? c : mine; }
        if (sum == G) break;
        __builtin_amdgcn_s_sleep(1);
        if ((++sp & 255u) == 0u) { if (xb_ld(&bar[XB_TMO])) break; if (sp > XB_SPIN_CAP) { atomicAdd(&bar[XB_TMO], 1u); break; } }
    }
    nloc = mine > 0u ? mine : 1u; nx = cnt > 0u ? cnt : 1u;
}
__device__ __forceinline__ void xcd_barrier(const XcdBarrier& b) {
    asm volatile("s_waitcnt vmcnt(0)" ::: "memory");
    __syncthreads();
    if (threadIdx.x == 0) {
        unsigned* bar = b.bar;
        __builtin_amdgcn_s_waitcnt(0);
        unsigned nloc = b.st[0], nx = b.st[1];
        if (nloc == 0u) { xcd_barrier_complete(bar, b.x, nloc, nx); b.st[0] = nloc; b.st[1] = nx; }
        const unsigned old = xb_add(&bar[XB_XSUB(b.x)], 1u);
        const unsigned gen = old / nloc;
        if (old + 1u == (gen + 1u) * nloc) {
            __builtin_amdgcn_fence(__ATOMIC_RELEASE, "agent");
            asm volatile("s_waitcnt vmcnt(0)" ::: "memory");
            const unsigned og = xb_add(&bar[XB_TOP], 1u);
            const unsigned tg = og / nx;
            if (og + 1u == (tg + 1u) * nx) xb_add(&bar[XB_TOPGEN], 1u);
            else XB_SPIN(xb_ld(&bar[XB_TOPGEN]) == tg, bar);
            __builtin_amdgcn_fence(__ATOMIC_ACQUIRE, "agent");
            xb_add(&bar[XB_XGEN(b.x)], 1u);
            asm volatile("s_waitcnt vmcnt(0)" ::: "memory");
        } else {
            XB_SPIN(xb_ld(&bar[XB_XGEN(b.x)]) == gen, bar);
            __builtin_amdgcn_fence(__ATOMIC_ACQUIRE, "agent");
            asm volatile("s_waitcnt vmcnt(0)" ::: "memory");
        }
    }
    __syncthreads();
}

template <int KIND>
__device__ __forceinline__ void run_kind(const int tidx, const P& p, int l, LAS unsigned char* L) {
    const float* modl = (const float*)(p.ws + WS_MOD) + (size_t)l * NB * NMOD;
    bf16_t* hbuf = (bf16_t*)(p.ws + WS_H); bf16_t* ycat = (bf16_t*)(p.ws + WS_YCAT); bf16_t* proj = (bf16_t*)(p.ws + WS_PROJ);
    const float* xin = (l == 0) ? p.x : p.out;
    if constexpr (KIND == 0) phase_prep(tidx, p, L);
    if constexpr (KIND == 1) phase_norm(tidx, xin, p.norm_mix_g + l * DM, modl, 0, DM, hbuf);
    if constexpr (KIND == 2) { pg8::Gemm g{hbuf, (const bf16_t*)(p.ws + WS_WIN) + (size_t)l * NINP * DM, MTOK, NINP, DM}; pg8::StaticOrder S; S.init(MTOK, NINP, gridDim.x, blockIdx.x);
        pg8::EpiProj E{proj, NINP}; pg8::gemm_phase<pg8::EpiProj>(tidx, L, g, S, E); }
    if constexpr (KIND == 3) phase_dprep(tidx, p, l, L);
    if constexpr (KIND == 4) phase_scan(tidx, p, l, L);
    if constexpr (KIND == 5) phase_onorm(tidx, p, l);
    if constexpr (KIND == 6) { pg8::Gemm g{ycat, (const bf16_t*)(p.ws + WS_WOUT) + (size_t)l * DM * DM, MTOK, DM, DM}; pg8::StaticOrder S; S.init(MTOK, DM, gridDim.x, blockIdx.x);
        pg8::EpiResid E{xin, p.out, modl + 2 * DM}; pg8::gemm_phase<pg8::EpiResid>(tidx, L, g, S, E);
        unsigned* cnt = (unsigned*)(p.ws + WS_BAR) + XCD_BAR_WORDS + (l * 2 + 0) * 64; pg8::Unit u;
        panel_post(tidx, cnt, S);
        for (int i = 0; S.next(i, u); ++i) {
            panel_wait(tidx, cnt + u.pm); norm_panel(tidx, p.out, p.norm_ffn_g + l * DM, modl, 3 * DM, 4 * DM, hbuf, u.pm * 256 + u.pn * 64, 64); } }
    if constexpr (KIND == 7) phase_norm(tidx, p.out, p.norm_ffn_g + l * DM, modl, 3 * DM, 4 * DM, hbuf);
    if constexpr (KIND == 8) { pg8::Gemm g{hbuf, (const bf16_t*)(p.ws + WS_WF1) + (size_t)l * NF1 * DM, MTOK, NF1, DM}; pg8::StaticOrder S; S.init(MTOK, NF1, gridDim.x, blockIdx.x);
        pg8::EpiSwiGLU E{proj}; pg8::gemm_phase<pg8::EpiSwiGLU>(tidx, L, g, S, E); }
    if constexpr (KIND == 9) { pg8::Gemm g{proj, (const bf16_t*)(p.ws + WS_WF2) + (size_t)l * DM * DFF, MTOK, DM, DFF}; pg8::StaticOrder S; S.init(MTOK, DM, gridDim.x, blockIdx.x);
        pg8::EpiResid E{p.out, p.out, modl + 5 * DM}; pg8::gemm_phase<pg8::EpiResid>(tidx, L, g, S, E);
        unsigned* cnt = (unsigned*)(p.ws + WS_BAR) + XCD_BAR_WORDS + (l * 2 + 1) * 64; pg8::Unit u;
        panel_post(tidx, cnt, S);
        for (int i = 0; S.next(i, u); ++i) {
            panel_wait(tidx, cnt + u.pm);
            if (l + 1 < NL) norm_panel(tidx, p.out, p.norm_mix_g + (l + 1) * DM, modl + (size_t)NB * NMOD, 0, DM, hbuf, u.pm * 256 + u.pn * 64, 64);
            else final_panel(tidx, p.out, p.final_norm_g, u.pm * 256 + u.pn * 64, 64);
        } }
    if constexpr (KIND == 10) phase_final(tidx, p.out, p.final_norm_g);
}
__host__ __device__ inline void phase_decode(int ph, int& kind, int& l) {
    if (ph == 0) { kind = 0; l = 0; } else if (ph == 1) { kind = 1; l = 0; }
    else { const int sp = (ph - 2) % 7; l = (ph - 2) / 7; kind = (sp < 5) ? 2 + sp : 3 + sp; }
}

#if ONE_LAUNCH
__global__ void __launch_bounds__(512, 2) hymba_fwd(P p) {
    extern __shared__ __attribute__((aligned(16))) unsigned char lds_raw[];
    LAS unsigned char* L = (LAS unsigned char*)lds_raw;
    cg::grid_group grid = cg::this_grid();
    if (threadIdx.x < 16) ((LAS unsigned*)(L + LDS_BAR_OFF))[threadIdx.x] = 0u;
    __syncthreads();
    const XcdBarrier bar = xcd_barrier_post((unsigned*)(p.ws + WS_BAR), (volatile LAS unsigned*)(L + LDS_BAR_OFF));
    for (int ph = p.ph_lo; ph < p.ph_hi; ++ph) {
        if (ph == p.ph_lo + 1) grid.sync();
        else if (ph > p.ph_lo + 1) xcd_barrier(bar);
        int kind, l; phase_decode(ph, kind, l);
        int tidx = threadIdx.x; asm volatile("" : "+v"(tidx));
#if REPEAT_MASK
        if ((REPEAT_MASK >> kind) & 1) {
            switch (kind) { case 1: run_kind<1>(tidx, p, l, L); break; case 2: run_kind<2>(tidx, p, l, L); break; case 3: run_kind<3>(tidx, p, l, L); break; case 4: run_kind<4>(tidx, p, l, L); break;
                case 5: run_kind<5>(tidx, p, l, L); break; case 7: run_kind<7>(tidx, p, l, L); break; case 8: run_kind<8>(tidx, p, l, L); break; default: break; }
            __syncthreads();
        }
#endif
        switch (kind) {
        case 0: run_kind<0>(tidx, p, l, L); break; case 1: run_kind<1>(tidx, p, l, L); break; case 2: run_kind<2>(tidx, p, l, L); break; case 3: run_kind<3>(tidx, p, l, L); break;
        case 4: run_kind<4>(tidx, p, l, L); break; case 5: run_kind<5>(tidx, p, l, L); break; case 6: run_kind<6>(tidx, p, l, L); break; case 7: run_kind<7>(tidx, p, l, L); break;
        case 8: run_kind<8>(tidx, p, l, L); break; case 9: run_kind<9>(tidx, p, l, L); break; default: run_kind<10>(tidx, p, l, L); break;
        }
    }
}
#define LAUNCH_FN(kind) ((const void*)hymba_fwd)
#else
template <int KIND> __global__ void __launch_bounds__(512, 2) hymba_ph(P p) {
    extern __shared__ __attribute__((aligned(16))) unsigned char lds_raw[];
    run_kind<KIND>((int)threadIdx.x, p, p.ph_hi, (LAS unsigned char*)lds_raw);
}
static const void* ph_fn(int kind) {
    switch (kind) { case 0: return (const void*)hymba_ph<0>; case 1: return (const void*)hymba_ph<1>; case 2: return (const void*)hymba_ph<2>; case 3: return (const void*)hymba_ph<3>;
        case 4: return (const void*)hymba_ph<4>; case 5: return (const void*)hymba_ph<5>; case 6: return (const void*)hymba_ph<6>; case 7: return (const void*)hymba_ph<7>;
        case 8: return (const void*)hymba_ph<8>; case 9: return (const void*)hymba_ph<9>; default: return (const void*)hymba_ph<10>; }
}
#define LAUNCH_FN(kind) ph_fn(kind)
#endif

extern "C" void kernel_launch(void* const* d_in, const int* in_sizes, int n_in, void* d_out, int out_size, void* d_ws, size_t ws_size, hipStream_t stream) {
    static int grid = 0;
    if (grid == 0) {
        if (n_in != 20 || out_size != MTOK * DM || ws_size < WS_END) { fprintf(stderr, "kernel_launch: unexpected problem (n_in %d out %d ws %zu need %zu)\n", n_in, out_size, ws_size, (size_t)WS_END); grid = -1; return; }
        int dev = 0, cus = 0, per_cu = 0;
        (void)hipGetDevice(&dev); (void)hipDeviceGetAttribute(&cus, hipDeviceAttributeMultiprocessorCount, dev);
        for (int k = 0; k <= 10; ++k)
            if (hipFuncSetAttribute(LAUNCH_FN(k), hipFuncAttributeMaxDynamicSharedMemorySize, LDS_BYTES) != hipSuccess) { fprintf(stderr, "kernel_launch: hipFuncSetAttribute failed\n"); grid = -1; return; }
#if ONE_LAUNCH
        if (hipOccupancyMaxActiveBlocksPerMultiprocessor(&per_cu, (const void*)hymba_fwd, 512, LDS_BYTES) != hipSuccess || per_cu < 1) { fprintf(stderr, "kernel_launch: occupancy query failed (%d)\n", per_cu); (void)hipGetLastError(); per_cu = 1; }
#else
        per_cu = 1;
#endif
        grid = cus * per_cu;
        if (grid < SCAN_BLOCKS + 32) { fprintf(stderr, "kernel_launch: grid %d too small\n", grid); grid = -1; return; }
    }
    if (grid < 0) return;
    P p{};
    const float** pp = (const float**)&p;
    for (int i = 0; i < 20; ++i) pp[i] = (const float*)d_in[i];
    p.out = (float*)d_out; p.ws = (unsigned char*)d_ws;
#if ONE_LAUNCH
    p.ph_lo = 0; p.ph_hi = NPH;
    if (hipMemsetAsync((unsigned char*)d_ws + WS_BAR, 0, 16384, stream) != hipSuccess) { fprintf(stderr, "kernel_launch: memset of the barrier words failed\n"); return; }
    void* args[] = {&p};
    hipError_t e = hipLaunchCooperativeKernel((const void*)hymba_fwd, dim3(grid), dim3(512), args, LDS_BYTES, stream);
    if (e != hipSuccess) fprintf(stderr, "cooperative launch failed: %s (grid %d)\n", hipGetErrorString(e), grid);
#else
    if (hipMemsetAsync((unsigned char*)d_ws + WS_BAR, 0, 16384, stream) != hipSuccess) return;
    for (int ph = 0; ph < NPH; ++ph) { int kind, l; phase_decode(ph, kind, l); p.ph_lo = kind; p.ph_hi = l; void* args[] = {&p};
        (void)hipLaunchKernel(ph_fn(kind), dim3(grid), dim3(512), args, LDS_BYTES, stream); }
#endif
}
```

```cpp
#include <hip/hip_runtime.h>
#include <hip/hip_cooperative_groups.h>
#include <cstdio>
namespace cg = cooperative_groups;

#ifndef ONE_LAUNCH
#define ONE_LAUNCH 1
#endif
#ifndef REPEAT_MASK
#define REPEAT_MASK 0
#endif

#define LAS __attribute__((address_space(3)))
typedef unsigned short bf16_t;
typedef short bf16x8 __attribute__((ext_vector_type(8)));
typedef float f32x4 __attribute__((ext_vector_type(4)));
typedef float f32x2 __attribute__((ext_vector_type(2)));
typedef unsigned u32x4 __attribute__((ext_vector_type(4)));
typedef unsigned u32x2 __attribute__((ext_vector_type(2)));
typedef __bf16 nbf16x2 __attribute__((ext_vector_type(2)));

constexpr int MTOK = 16384, DM = 1024, NL = 4, NB = 4, SEQ = 4096;
constexpr int NIN = 3336, NINP = 3584, DFF = 2816, NF1 = 2 * DFF, NMOD = 6 * DM;
constexpr int LDS_BYTES = 131072 + 64 + 6144 + 17408, LDS_BAR_OFF = 131072, LDS_CW_OFF = 131072 + 64, LDS_TF_OFF = LDS_CW_OFF + 6144;
constexpr int NPH = 1 + 9 * NL + 1;

constexpr size_t SZ_WIN = (size_t)NL * NINP * DM * 2, SZ_WOUT = (size_t)NL * DM * DM * 2, SZ_WF1 = (size_t)NL * NF1 * DM * 2, SZ_WF2 = (size_t)NL * DM * DFF * 2;
constexpr size_t WS_WIN = 0, WS_WOUT = WS_WIN + SZ_WIN, WS_WF1 = WS_WOUT + SZ_WOUT, WS_WF2 = WS_WF1 + SZ_WF1;
constexpr size_t WS_MOD = WS_WF2 + SZ_WF2;
constexpr size_t WS_ALAST = WS_MOD + (size_t)NL * NB * NMOD * 4;
constexpr size_t WS_H = WS_ALAST + 4096;
constexpr size_t WS_YCAT = WS_H + (size_t)MTOK * DM * 2;
constexpr size_t WS_PROJ = WS_YCAT + (size_t)MTOK * DM * 2;
constexpr int ITEM_BYTES = 90112, OFF_W = 0, OFF_Q = 16384, OFF_KT = 32768, OFF_QK = 49152, OFF_U = 57344;
constexpr size_t WS_DELTA = WS_PROJ + (size_t)MTOK * NINP * 2;
constexpr size_t WS_BAR = WS_DELTA + (size_t)1024 * ITEM_BYTES;
constexpr size_t WS_END = WS_BAR + 16384;

struct P {
    const float *x, *c, *w_ada, *b_ada, *norm_mix_g, *norm_ffn_g, *w_in, *conv_a_w, *conf_dw_w, *conf_dw_b, *conf_ln_g, *conf_ln_b,
        *dn_conv_w, *dn_a_log, *dn_dt_bias, *dn_norm_g, *w_out, *w_ffn_in, *w_ffn_out, *final_norm_g;
    float* out; unsigned char* ws; int ph_lo, ph_hi;
};

__device__ __forceinline__ float bf2f(bf16_t v) { return __uint_as_float(((unsigned)v) << 16); }
__device__ __forceinline__ unsigned pk2(float a, float b) { f32x2 v = {a, b}; nbf16x2 r = __builtin_convertvector(v, nbf16x2); return __builtin_bit_cast(unsigned, r); }
__device__ __forceinline__ bf16_t f2bf(float a) { return (bf16_t)(pk2(a, 0.f) & 0xffffu); }
__device__ __forceinline__ float lo16(unsigned w) { return __uint_as_float(w << 16); }
__device__ __forceinline__ float hi16(unsigned w) { return __uint_as_float(w & 0xffff0000u); }
__device__ __forceinline__ float sigmoid_f(float v) { return __builtin_amdgcn_rcpf(1.f + __expf(-v)); }
__device__ __forceinline__ float silu_f(float v) { return v * sigmoid_f(v); }
__device__ __forceinline__ float wave_sum(float v) {
#pragma unroll
    for (int o = 32; o; o >>= 1) v += __shfl_xor(v, o);
    return v;
}
__device__ __forceinline__ void unpack8(const u32x4 w, float (&f)[8]) {
    f[0] = lo16(w.x); f[1] = hi16(w.x); f[2] = lo16(w.y); f[3] = hi16(w.y); f[4] = lo16(w.z); f[5] = hi16(w.z); f[6] = lo16(w.w); f[7] = hi16(w.w);
}
__device__ __forceinline__ u32x4 pack8(const float (&f)[8]) { u32x4 w; w.x = pk2(f[0], f[1]); w.y = pk2(f[2], f[3]); w.z = pk2(f[4], f[5]); w.w = pk2(f[6], f[7]); return w; }
#define MFMA16(a, b, c) __builtin_amdgcn_mfma_f32_16x16x32_bf16((a), (b), (c), 0, 0, 0)

namespace pg8 {
constexpr int BM = 256, BK = 64, HALF = 128, HTB = HALF * BK * 2, STAGE_BYTES = 8 * HTB, NXCD = 8, WGM = 8;
__host__ __device__ __forceinline__ int lds_byte(int r, int c) { const int st = (r >> 4) * 2 + (c >> 5), rr = r & 15, cc = c & 31, ob = rr * 64 + cc * 2; return st * 1024 + (ob ^ (((ob >> 9) & 1) << 5)); }
__host__ __device__ __forceinline__ void stage_rc(int b, int& R, int& C) { const int st = b / 1024, sb = b % 1024, swz = sb ^ (((sb >> 9) & 1) << 5); R = (st >> 1) * 16 + swz / 64; C = (st & 1) * 32 + (swz % 64) / 2; }
__host__ __device__ __forceinline__ int perm32(int rho) { const int n = rho >> 4, i = rho & 15; return 8 * (i >> 2) + 4 * n + (i & 3); }
struct Unit { int pm, pn; };
struct Gemm { const bf16_t* A; const bf16_t* Bt; int M, N, K; };
struct StaticOrder {
    int nM, nN, nwg, G, c;
    __device__ void init(int M, int N, int G_, int c_) { nM = M / BM; nN = N / BM; nwg = nM * nN; G = G_; c = c_; }
    __device__ bool next(int i, Unit& u) const {
        const long L = (long)i * G + c; if (L >= nwg) return false;
        int wgid = (int)L; { const int q = nwg / NXCD, r = nwg % NXCD, xcd = wgid % NXCD, off = wgid / NXCD; wgid = (xcd < r ? xcd * (q + 1) : r * (q + 1) + (xcd - r) * q) + off; }
        const int nig = WGM * nN, gid = wgid / nig, fm = gid * WGM, gsz = (nM - fm) < WGM ? (nM - fm) : WGM;
        u.pm = fm + ((wgid % nig) % gsz); u.pn = (wgid % nig) / gsz; return true;
    }
};

struct EpiProj {
    static constexpr bool PERM = true;
    bf16_t* O; int ldc;
    __device__ __forceinline__ void operator()(const f32x4 (&acc)[2][2][4][2], const Unit& u, int wr, int wc, int fr, int fq) const {
        const int row0 = u.pm * BM + wr * 64 + fr, col0 = u.pn * BM + wc * 32 + 8 * fq;
#pragma unroll
        for (int ai = 0; ai < 2; ++ai)
#pragma unroll
            for (int m = 0; m < 4; ++m) { bf16_t* rowp = O + (size_t)(row0 + ai * HALF + m * 16) * ldc + col0;
#pragma unroll
                for (int bj = 0; bj < 2; ++bj) { const f32x4 v0 = acc[ai][bj][m][0], v1 = acc[ai][bj][m][1];
                    u32x4 w; w.x = pk2(v0[0], v0[1]); w.y = pk2(v0[2], v0[3]); w.z = pk2(v1[0], v1[1]); w.w = pk2(v1[2], v1[3]);
                    *(u32x4*)(rowp + bj * HALF) = w; } }
    }
};
struct EpiSwiGLU {
    static constexpr bool PERM = true;
    bf16_t* O;
    __device__ __forceinline__ void operator()(const f32x4 (&acc)[2][2][4][2], const Unit& u, int wr, int wc, int fr, int fq) const {
        const int row0 = u.pm * BM + wr * 64 + fr, col0 = u.pn * HALF + wc * 32 + 8 * fq;
#pragma unroll
        for (int ai = 0; ai < 2; ++ai)
#pragma unroll
            for (int m = 0; m < 4; ++m) {
                const f32x4 g0 = acc[ai][0][m][0], g1 = acc[ai][0][m][1], u0 = acc[ai][1][m][0], u1 = acc[ai][1][m][1];
                float v[8];
#pragma unroll
                for (int i = 0; i < 4; ++i) { v[i] = silu_f(g0[i]) * u0[i]; v[4 + i] = silu_f(g1[i]) * u1[i]; }
                *(u32x4*)(O + (size_t)(row0 + ai * HALF + m * 16) * DFF + col0) = pack8(v);
            }
    }
};
struct EpiResid {
    static constexpr bool PERM = false;
    const float* base; float* out; const float* gate;
    __device__ __forceinline__ void operator()(const f32x4 (&acc)[2][2][4][2], const Unit& u, int wr, int wc, int fr, int fq) const {
        const int row0 = u.pm * BM + wr * 64 + fr, col0 = u.pn * BM + wc * 32 + 4 * fq;
        const float* gp = gate + (size_t)(u.pm >> 4) * NMOD + col0;
        f32x4 gv[2][2];
#pragma unroll
        for (int bj = 0; bj < 2; ++bj)
#pragma unroll
            for (int n = 0; n < 2; ++n) gv[bj][n] = *(const f32x4*)(gp + bj * HALF + n * 16);
#pragma unroll
        for (int ai = 0; ai < 2; ++ai) {
            f32x4 bv[4][2][2];
#pragma unroll
            for (int m = 0; m < 4; ++m) { const size_t ro = (size_t)(row0 + ai * HALF + m * 16) * DM + col0;
#pragma unroll
                for (int bj = 0; bj < 2; ++bj)
#pragma unroll
                    for (int n = 0; n < 2; ++n) bv[m][bj][n] = *(const f32x4*)(base + ro + bj * HALF + n * 16); }
#pragma unroll
            for (int m = 0; m < 4; ++m) { const size_t ro = (size_t)(row0 + ai * HALF + m * 16) * DM + col0;
#pragma unroll
                for (int bj = 0; bj < 2; ++bj)
#pragma unroll
                    for (int n = 0; n < 2; ++n) *(f32x4*)(out + ro + bj * HALF + n * 16) = bv[m][bj][n] + gv[bj][n] * acc[ai][bj][m][n]; }
        }
    }
};

template <class Epi>
__device__ __forceinline__ void gemm_phase(const int tidx, LAS unsigned char* lds, const Gemm g, const StaticOrder& S, const Epi& E) {
    const int tid = tidx, wid = __builtin_amdgcn_readfirstlane(tid >> 6), lane = tid & 63, wr = wid >> 2, wc = wid & 3, fr = lane & 15, fq = lane >> 4;
    const int K = g.K, nt = K / BK;
    unsigned voffA[2], voffB[2];
#pragma unroll
    for (int i = 0; i < 2; ++i) { int R, C; stage_rc(tid * 16 + i * 8192, R, C); const int Rb = Epi::PERM ? ((R & ~31) + perm32(R & 31)) : R;
        voffA[i] = (unsigned)(R * K + C) * 2u; voffB[i] = (unsigned)(Rb * K + C) * 2u; }
    const size_t kstep = (size_t)(BK * 2);
    const size_t hstep = (size_t)HALF * K * 2;
    const size_t tstep = 2 * hstep;
    const unsigned ldsw = (unsigned)wid * 1024u;
    const int aoff = lds_byte(wr * 64 + fr, fq * 8), boff = lds_byte(wc * 32 + fr, fq * 8);
#define PG8_SA(b, h) (((b) * 2 + (h)) * HTB)
#define PG8_SB(b, h) ((4 + (b) * 2 + (h)) * HTB)
#define PG8_STAGE(bufoff, gbase, voff) do { _Pragma("unroll") for (int _i = 0; _i < 2; ++_i) \
        __builtin_amdgcn_global_load_lds((const unsigned*)((const char*)(gbase) + (voff)[_i]), (LAS unsigned*)(lds + (bufoff) + ldsw + _i * 8192), 16, 0, 0); } while (0)
#define PG8_LDA(dst, b, h) do { _Pragma("unroll") for (int m = 0; m < 4; ++m) _Pragma("unroll") for (int k = 0; k < 2; ++k) dst[m][k] = *(const LAS bf16x8*)(lds + PG8_SA(b, h) + aoff + m * 2048 + k * 1024); } while (0)
#define PG8_LDB(dst, b, h) do { _Pragma("unroll") for (int n = 0; n < 2; ++n) _Pragma("unroll") for (int k = 0; k < 2; ++k) dst[n][k] = *(const LAS bf16x8*)(lds + PG8_SB(b, h) + boff + n * 2048 + k * 1024); } while (0)
#define PG8_MMA(ai, bj, At, Bt) do { __builtin_amdgcn_s_setprio(1); _Pragma("unroll") for (int m = 0; m < 4; ++m) _Pragma("unroll") for (int n = 0; n < 2; ++n) _Pragma("unroll") for (int k = 0; k < 2; ++k) \
        acc[ai][bj][m][n] = __builtin_amdgcn_mfma_f32_16x16x32_bf16(Bt[n][k], At[m][k], acc[ai][bj][m][n], 0, 0, 0); __builtin_amdgcn_s_setprio(0); } while (0)
#define PG8_WAIT_V(n) asm volatile("s_waitcnt vmcnt(" #n ")" ::: "memory")
#define PG8_WAIT_L(n) asm volatile("s_waitcnt lgkmcnt(" #n ")" ::: "memory")
#define PG8_BAR __builtin_amdgcn_s_barrier()
#define PG8_SCHED __builtin_amdgcn_sched_barrier(0)
    Unit cur, nxt; int ui = 0;
    if (!S.next(0, cur)) return;
    f32x4 acc[2][2][4][2];
#pragma unroll
    for (int a = 0; a < 2; ++a)
#pragma unroll
        for (int b = 0; b < 2; ++b)
#pragma unroll
            for (int m = 0; m < 4; ++m)
#pragma unroll
                for (int n = 0; n < 2; ++n) acc[a][b][m][n] = (f32x4){0.f, 0.f, 0.f, 0.f};
    bf16x8 At[4][2], B0[2][2], B1[2][2];
    const char* cA = (const char*)g.A + (size_t)cur.pm * tstep; const char* cB = (const char*)g.Bt + (size_t)cur.pn * tstep;
    PG8_STAGE(PG8_SB(0, 0), cB, voffB); PG8_STAGE(PG8_SA(0, 0), cA, voffA); PG8_STAGE(PG8_SB(0, 1), cB + hstep, voffB); PG8_STAGE(PG8_SA(0, 1), cA + hstep, voffA);
    if (wr == 1) PG8_BAR;
    PG8_WAIT_V(4); PG8_BAR;
    PG8_STAGE(PG8_SB(1, 0), cB + kstep, voffB); PG8_STAGE(PG8_SA(1, 0), cA + kstep, voffA); PG8_STAGE(PG8_SB(1, 1), cB + hstep + kstep, voffB);
    PG8_WAIT_V(6); PG8_BAR;
    for (;;) {
        const bool has_next = S.next(ui + 1, nxt);
        const char* nA = has_next ? (const char*)g.A + (size_t)nxt.pm * tstep : cA; const char* nB = has_next ? (const char*)g.Bt + (size_t)nxt.pn * tstep : cB;
        for (int t = 0; t < nt; t += 2) {
            const bool last = (t == nt - 2);
            const char* a1 = cA + (size_t)(t + 1) * kstep;
            const char* a2 = last ? nA : cA + (size_t)(t + 2) * kstep; const char* b2 = last ? nB : cB + (size_t)(t + 2) * kstep;
            const char* a3 = a2 + kstep; const char* b3 = b2 + kstep;
            PG8_LDB(B0, 0, 0); PG8_SCHED; PG8_LDA(At, 0, 0); PG8_STAGE(PG8_SA(1, 1), a1 + hstep, voffA);
            PG8_WAIT_L(8); PG8_BAR; PG8_WAIT_L(0); PG8_MMA(0, 0, At, B0); PG8_BAR; PG8_SCHED;
            PG8_LDB(B1, 0, 1); PG8_STAGE(PG8_SB(0, 0), b2, voffB);
            PG8_BAR; PG8_WAIT_L(0); PG8_MMA(0, 1, At, B1); PG8_BAR;
            PG8_LDA(At, 0, 1); PG8_STAGE(PG8_SA(0, 0), a2, voffA);
            PG8_BAR; PG8_WAIT_L(0); PG8_MMA(1, 0, At, B0); PG8_BAR; PG8_SCHED;
            PG8_STAGE(PG8_SB(0, 1), b2 + hstep, voffB);
            PG8_WAIT_V(6); PG8_BAR; PG8_MMA(1, 1, At, B1); PG8_BAR;
            PG8_LDB(B0, 1, 0); PG8_SCHED; PG8_LDA(At, 1, 0); PG8_STAGE(PG8_SA(0, 1), a2 + hstep, voffA);
            PG8_WAIT_L(8); PG8_BAR; PG8_WAIT_L(0); PG8_MMA(0, 0, At, B0); PG8_BAR; PG8_SCHED;
            PG8_LDB(B1, 1, 1); PG8_STAGE(PG8_SB(1, 0), b3, voffB);
            PG8_BAR; PG8_WAIT_L(0); PG8_MMA(0, 1, At, B1); PG8_BAR;
            PG8_LDA(At, 1, 1); PG8_STAGE(PG8_SA(1, 0), a3, voffA);
            PG8_BAR; PG8_WAIT_L(0); PG8_MMA(1, 0, At, B0); PG8_BAR; PG8_SCHED;
            PG8_STAGE(PG8_SB(1, 1), b3 + hstep, voffB);
            PG8_WAIT_V(6); PG8_BAR; PG8_MMA(1, 1, At, B1); PG8_BAR;
        }
        E(acc, cur, wr, wc, fr, fq);
        if (!has_next) break;
#pragma unroll
        for (int a = 0; a < 2; ++a)
#pragma unroll
            for (int b = 0; b < 2; ++b)
#pragma unroll
                for (int m = 0; m < 4; ++m)
#pragma unroll
                    for (int n = 0; n < 2; ++n) acc[a][b][m][n] = (f32x4){0.f, 0.f, 0.f, 0.f};
        cur = nxt; cA = nA; cB = nB; ++ui;
    }
    PG8_WAIT_V(0);
    if (wr == 0) PG8_BAR;
    PG8_BAR;
#undef PG8_SA
#undef PG8_SB
#undef PG8_STAGE
#undef PG8_LDA
#undef PG8_LDB
#undef PG8_MMA
#undef PG8_WAIT_V
#undef PG8_WAIT_L
#undef PG8_BAR
#undef PG8_SCHED
}
}

__device__ __forceinline__ void phase_prep(const int tidx, const P& p, LAS unsigned char* L) {
    const int tid = tidx;
    constexpr int NADA = NL * 96, TPL = 3264, TOTAL = NADA + NL * TPL;
    float* mod = (float*)(p.ws + WS_MOD);
    for (int it = blockIdx.x; it < NADA; it += gridDim.x) {
        __syncthreads();
        {
            const int l = it / 96, n0 = (it % 96) * 64;
            LAS float* cact = (LAS float*)L;
            LAS float* red = cact + 4096;
            for (int i = tid; i < 4096; i += 512) cact[i] = silu_f(p.c[i]);
            __syncthreads();
            const int kg = tid >> 6, nn = tid & 63;
            const float* w = p.w_ada + ((size_t)l * DM + kg * 128) * NMOD + n0 + nn;
            float a0 = 0.f, a1 = 0.f, a2 = 0.f, a3 = 0.f;
#pragma unroll 8
            for (int k = 0; k < 128; ++k) { const float wv = w[(size_t)k * NMOD]; const int kk = kg * 128 + k;
                a0 += cact[kk] * wv; a1 += cact[1024 + kk] * wv; a2 += cact[2048 + kk] * wv; a3 += cact[3072 + kk] * wv; }
            red[(kg * 4 + 0) * 64 + nn] = a0; red[(kg * 4 + 1) * 64 + nn] = a1; red[(kg * 4 + 2) * 64 + nn] = a2; red[(kg * 4 + 3) * 64 + nn] = a3;
            __syncthreads();
            if (tid < 256) { const int b = tid >> 6; float s = p.b_ada[l * NMOD + n0 + nn];
#pragma unroll
                for (int k2 = 0; k2 < 8; ++k2) s += red[(k2 * 4 + b) * 64 + nn];
                mod[(size_t)(l * NB + b) * NMOD + n0 + nn] = s; }
        }
    }
    constexpr int NTT = NL * TPL;
    for (int it0 = blockIdx.x * 4; it0 < NTT; it0 += gridDim.x * 4) {
        __syncthreads();
        bf16_t* dstp[4]; int kd[4];
#pragma unroll
        for (int tt = 0; tt < 4; ++tt) {
            const int j = it0 + tt, l = j / TPL; int r = j % TPL;
            const float* src; bf16_t* dst; int Ns, Nvalid, Kd, k0, ns0, nd0;
            if (r < 896) { const int kt = r / 56, nt = r % 56; src = p.w_in + (size_t)l * DM * NIN; Ns = NIN; Nvalid = NIN; Kd = DM; k0 = kt * 64; nd0 = nt * 64; ns0 = nd0;
                dst = (bf16_t*)(p.ws + WS_WIN) + (size_t)l * NINP * DM; }
            else if (r < 1152) { r -= 896; const int kt = r / 16, nt = r % 16; src = p.w_out + (size_t)l * DM * DM; Ns = DM; Nvalid = DM; Kd = DM; k0 = kt * 64; nd0 = nt * 64; ns0 = nd0;
                dst = (bf16_t*)(p.ws + WS_WOUT) + (size_t)l * DM * DM; }
            else if (r < 2560) { r -= 1152; const int kt = r / 88, nt = r % 88; src = p.w_ffn_in + (size_t)l * DM * NF1; Ns = NF1; Nvalid = NF1; Kd = DM; k0 = kt * 64; nd0 = nt * 64;
                const int pn = nd0 >> 8, half = (nd0 >> 7) & 1, sub = nd0 & 127; ns0 = half * DFF + pn * 128 + sub;
                dst = (bf16_t*)(p.ws + WS_WF1) + (size_t)l * NF1 * DM; }
            else { r -= 2560; const int kt = r / 16, nt = r % 16; src = p.w_ffn_out + (size_t)l * DFF * DM; Ns = DM; Nvalid = DM; Kd = DFF; k0 = kt * 64; nd0 = nt * 64; ns0 = nd0;
                dst = (bf16_t*)(p.ws + WS_WF2) + (size_t)l * DM * DFF; }
            LAS float* tile = (LAS float*)L + tt * (64 * 65);
            const int kk = tid >> 4, c4 = (tid & 15) * 4;
            f32x4 v0 = {0.f, 0.f, 0.f, 0.f}, v1 = {0.f, 0.f, 0.f, 0.f};
            if (ns0 + c4 < Nvalid) { v0 = *(const f32x4*)(src + (size_t)(k0 + kk) * Ns + ns0 + c4); v1 = *(const f32x4*)(src + (size_t)(k0 + kk + 32) * Ns + ns0 + c4); }
            tile[kk * 65 + c4 + 0] = v0[0]; tile[kk * 65 + c4 + 1] = v0[1]; tile[kk * 65 + c4 + 2] = v0[2]; tile[kk * 65 + c4 + 3] = v0[3];
            tile[(kk + 32) * 65 + c4 + 0] = v1[0]; tile[(kk + 32) * 65 + c4 + 1] = v1[1]; tile[(kk + 32) * 65 + c4 + 2] = v1[2]; tile[(kk + 32) * 65 + c4 + 3] = v1[3];
            dstp[tt] = dst + (size_t)nd0 * Kd + k0; kd[tt] = Kd;
        }
        __syncthreads();
#pragma unroll
        for (int tt = 0; tt < 4; ++tt) {
            LAS float* tile = (LAS float*)L + tt * (64 * 65);
            const int nn = tid >> 3, k8 = (tid & 7) * 8; float f[8];
#pragma unroll
            for (int i = 0; i < 8; ++i) f[i] = tile[(k8 + i) * 65 + nn];
            *(u32x4*)(dstp[tt] + (size_t)nn * kd[tt] + k8) = pack8(f);
        }
    }
}

__device__ __forceinline__ void phase_norm(const int tidx, const float* xin, const float* g, const float* modl, int shoff, int scoff, bf16_t* hout) {
    const int wave = tidx >> 6, lane = tidx & 63;
    for (int row0 = (blockIdx.x * 8 + wave) * 2; row0 < MTOK; row0 += gridDim.x * 16) {
        const int b = row0 >> 12;
        f32x4 v[2][4], gg[4], sc[4], sh[4];
#pragma unroll
        for (int rr = 0; rr < 2; ++rr)
#pragma unroll
            for (int i = 0; i < 4; ++i) v[rr][i] = *(const f32x4*)(xin + (size_t)(row0 + rr) * DM + i * 256 + lane * 4);
#pragma unroll
        for (int i = 0; i < 4; ++i) { const int k = i * 256 + lane * 4;
            gg[i] = *(const f32x4*)(g + k); sc[i] = *(const f32x4*)(modl + (size_t)b * NMOD + scoff + k); sh[i] = *(const f32x4*)(modl + (size_t)b * NMOD + shoff + k); }
#pragma unroll
        for (int rr = 0; rr < 2; ++rr) {
            float ss = 0.f;
#pragma unroll
            for (int i = 0; i < 4; ++i) ss += v[rr][i][0] * v[rr][i][0] + v[rr][i][1] * v[rr][i][1] + v[rr][i][2] * v[rr][i][2] + v[rr][i][3] * v[rr][i][3];
            ss = wave_sum(ss);
            const float rinv = rsqrtf(ss * (1.f / DM) + 1e-6f);
#pragma unroll
            for (int i = 0; i < 4; ++i) { const int k = i * 256 + lane * 4;
                const f32x4 y = v[rr][i] * rinv * gg[i] * (sc[i] + 1.f) + sh[i];
                u32x2 w; w.x = pk2(y[0], y[1]); w.y = pk2(y[2], y[3]);
                *(u32x2*)(hout + (size_t)(row0 + rr) * DM + k) = w; }
        }
    }
}
__device__ __forceinline__ void phase_final(const int tidx, float* x, const float* g) {
    const int wave = tidx >> 6, lane = tidx & 63;
    for (int row0 = (blockIdx.x * 8 + wave) * 2; row0 < MTOK; row0 += gridDim.x * 16) {
        f32x4 v[2][4], gg[4];
#pragma unroll
        for (int rr = 0; rr < 2; ++rr)
#pragma unroll
            for (int i = 0; i < 4; ++i) v[rr][i] = *(const f32x4*)(x + (size_t)(row0 + rr) * DM + i * 256 + lane * 4);
#pragma unroll
        for (int i = 0; i < 4; ++i) gg[i] = *(const f32x4*)(g + i * 256 + lane * 4);
#pragma unroll
        for (int rr = 0; rr < 2; ++rr) {
            float ss = 0.f;
#pragma unroll
            for (int i = 0; i < 4; ++i) ss += v[rr][i][0] * v[rr][i][0] + v[rr][i][1] * v[rr][i][1] + v[rr][i][2] * v[rr][i][2] + v[rr][i][3] * v[rr][i][3];
            ss = wave_sum(ss);
            const float rinv = rsqrtf(ss * (1.f / DM) + 1e-6f);
#pragma unroll
            for (int i = 0; i < 4; ++i) *(f32x4*)(x + (size_t)(row0 + rr) * DM + i * 256 + lane * 4) = v[rr][i] * rinv * gg[i];
        }
    }
}

__device__ __forceinline__ void phase_dprep(const int tidx, const P& p, int l, LAS unsigned char* L) {
    LAS bf16_t* Qn = (LAS bf16_t*)(L + 0);
    LAS bf16_t* Kn = (LAS bf16_t*)(L + 17408);
    LAS bf16_t* KbgT = (LAS bf16_t*)(L + 34816);
    LAS bf16_t* KtlT = (LAS bf16_t*)(L + 53248);
    LAS bf16_t* VbT = (LAS bf16_t*)(L + 71680);
    LAS float* Lm = (LAS float*)(L + 90112);
    LAS bf16_t* Tm = (LAS bf16_t*)(L + 107520);
    LAS bf16_t* QKm = (LAS bf16_t*)(L + 116736);
    LAS float* gcs = (LAS float*)(L + 125952);
    LAS float* betas = gcs + 64;
    LAS float* cwl = (LAS float*)(L + LDS_CW_OFF);
    LAS float* Tf = (LAS float*)(L + LDS_TF_OFF);
    const bf16_t* proj = (const bf16_t*)(p.ws + WS_PROJ);
    float* alast = (float*)(p.ws + WS_ALAST);
    for (int item = blockIdx.x; item < 1024; item += gridDim.x) {
        __syncthreads();
        int tid = tidx; asm volatile("" : "+v"(tid));
        const int lane = tid & 63, wave = tid >> 6, r = lane & 15, q = lane >> 4;
        const int h = item & 3, n = (item >> 2) & 63, b = item >> 8;
        const int t0 = b * SEQ + n * 64;
        unsigned char* itp = p.ws + WS_DELTA + (size_t)item * ITEM_BYTES;
        const int run = (tid >> 4) & 15, d0 = (tid & 15) * 8, tk0 = run * 4, whichA = tid >> 8;
        u32x4 rawA[7], rawB[7];
#pragma unroll
        for (int rr = 0; rr < 7; ++rr) {
            const int pos = n * 64 + tk0 - 3 + rr;
            rawA[rr] = (u32x4){0u, 0u, 0u, 0u}; rawB[rr] = (u32x4){0u, 0u, 0u, 0u};
            if (pos >= 0) { const bf16_t* pr = proj + (size_t)(t0 + tk0 - 3 + rr) * NINP + 1280 + h * 128 + d0;
                rawA[rr] = *(const u32x4*)(pr + whichA * 512);
                if (tid < 256) rawB[rr] = *(const u32x4*)(pr + 1024); }
        }
        if (tid < 384) {
#pragma unroll
            for (int j = 0; j < 4; ++j) cwl[j * 384 + tid] = p.dn_conv_w[(size_t)(l * 4 + j) * 1536 + (tid >> 7) * 512 + h * 128 + (tid & 127)];
        }
        if (wave == 7) {
            const bf16_t* pr = proj + (size_t)(t0 + lane) * NINP;
            const float alpha = bf2f(pr[3328 + h]), braw = bf2f(pr[3332 + h]);
            const float xx = alpha + p.dn_dt_bias[l * 4 + h];
            const float sp = fmaxf(xx, 0.f) + log1pf(__expf(-fabsf(xx)));
            float gc = -__expf(p.dn_a_log[l * 4 + h]) * sp;
#pragma unroll
            for (int o = 1; o < 64; o <<= 1) { const float tv = __shfl_up(gc, o); if (lane >= o) gc += tv; }
            gcs[lane] = gc; betas[lane] = sigmoid_f(braw);
        }
        __syncthreads();
        const float gl = gcs[63];
#pragma unroll
        for (int pass = 0; pass < 2; ++pass) {
            if (pass == 1 && tid >= 256) break;
            const int which = pass ? 2 : whichA;
            const LAS float* cw = cwl + which * 128 + d0;
            float y[4][8];
#pragma unroll
            for (int i = 0; i < 4; ++i)
#pragma unroll
                for (int d = 0; d < 8; ++d) y[i][d] = 0.f;
#pragma unroll
            for (int j = 0; j < 4; ++j) {
                const f32x4 w0 = *(const LAS f32x4*)(cw + j * 384), w1 = *(const LAS f32x4*)(cw + j * 384 + 4);
#pragma unroll
                for (int i = 0; i < 4; ++i) { float rf[8]; unpack8(pass ? rawB[i + j] : rawA[i + j], rf);
#pragma unroll
                    for (int d = 0; d < 4; ++d) { y[i][d] += w0[d] * rf[d]; y[i][4 + d] += w1[d] * rf[4 + d]; } }
            }
#pragma unroll
            for (int i = 0; i < 4; ++i) {
#pragma unroll
                for (int d = 0; d < 8; ++d) y[i][d] = silu_f(y[i][d]);
                if (which < 2) {
                    float ss = 0.f;
#pragma unroll
                    for (int d = 0; d < 8; ++d) ss += y[i][d] * y[i][d];
                    ss += __shfl_xor(ss, 1); ss += __shfl_xor(ss, 2); ss += __shfl_xor(ss, 4); ss += __shfl_xor(ss, 8);
                    float rinv = rsqrtf(ss + 1e-6f);
                    if (which == 0) rinv *= 0.08838834764831845f;
#pragma unroll
                    for (int d = 0; d < 8; ++d) y[i][d] *= rinv;
                }
            }
            if (which == 0) {
#pragma unroll
                for (int i = 0; i < 4; ++i) *(LAS u32x4*)(Qn + (tk0 + i) * 136 + d0) = pack8(y[i]);
            } else if (which == 1) {
                float f1[4], f2[4];
#pragma unroll
                for (int i = 0; i < 4; ++i) { const float gc = gcs[tk0 + i]; f1[i] = betas[tk0 + i] * __expf(gc); f2[i] = __expf(gl - gc); }
#pragma unroll
                for (int i = 0; i < 4; ++i) *(LAS u32x4*)(Kn + (tk0 + i) * 136 + d0) = pack8(y[i]);
#pragma unroll
                for (int d = 0; d < 8; ++d) {
                    u32x2 a, c; a.x = pk2(y[0][d] * f1[0], y[1][d] * f1[1]); a.y = pk2(y[2][d] * f1[2], y[3][d] * f1[3]); c.x = pk2(y[0][d] * f2[0], y[1][d] * f2[1]); c.y = pk2(y[2][d] * f2[2], y[3][d] * f2[3]);
                    *(LAS u32x2*)(KbgT + (d0 + d) * 72 + tk0) = a; *(LAS u32x2*)(KtlT + (d0 + d) * 72 + tk0) = c; }
            } else {
                float bt[4];
#pragma unroll
                for (int i = 0; i < 4; ++i) bt[i] = betas[tk0 + i];
#pragma unroll
                for (int d = 0; d < 8; ++d) { u32x2 a; a.x = pk2(y[0][d] * bt[0], y[1][d] * bt[1]); a.y = pk2(y[2][d] * bt[2], y[3][d] * bt[3]);
                    *(LAS u32x2*)(VbT + (d0 + d) * 72 + tk0) = a; }
            }
        }
        __syncthreads();
        {
            const int mat = wave >> 2, cb = wave & 3;
            LAS bf16_t* Asrc = mat ? Qn : Kn;
            bf16x8 a[4];
#pragma unroll
            for (int kb = 0; kb < 4; ++kb) a[kb] = *(LAS bf16x8*)(Asrc + (16 * cb + r) * 136 + 32 * kb + 8 * q);
#pragma unroll
            for (int sb = 0; sb < 4; ++sb) {
                f32x4 acc = {0.f, 0.f, 0.f, 0.f};
                if (sb <= cb) {
#pragma unroll
                    for (int kb = 0; kb < 4; ++kb) { const bf16x8 bb = *(LAS bf16x8*)(Kn + (16 * sb + r) * 136 + 32 * kb + 8 * q); acc = MFMA16(a[kb], bb, acc); }
                }
                const int s = 16 * sb + r; const float gs = gcs[s];
#pragma unroll
                for (int j = 0; j < 4; ++j) { const int c = 16 * cb + 4 * q + j; const float dec = __expf(gcs[c] - gs);
                    if (mat == 0) Lm[c * 68 + s] = (s < c) ? acc[j] * betas[c] * dec : 0.f;
                    else QKm[c * 72 + s] = f2bf((s <= c) ? acc[j] * dec : 0.f); }
            }
        }
        __syncthreads();
        if (wave < 4) {
            const int blk = wave, c = lane & 15;
            int zoff; asm volatile("v_mov_b32 %0, 0" : "=v"(zoff));
            LAS float* Lb = Lm + (16 * blk) * 68 + 16 * blk + zoff;
            float t[16];
            f32x4 rb[2][4];
            t[0] = (c == 0) ? 1.f : 0.f;
            rb[1][0] = *(LAS f32x4*)(Lb + 1 * 68);
#pragma unroll
            for (int i = 1; i < 16; ++i) {
                if (i + 1 < 16) {
#pragma unroll
                    for (int j4 = 0; j4 < (i + 4) / 4; ++j4) rb[(i + 1) & 1][j4] = *(LAS f32x4*)(Lb + (i + 1) * 68 + 4 * j4);
                }
                __builtin_amdgcn_sched_barrier(0);
                float acc0 = (i == c) ? 1.f : 0.f, acc1 = 0.f;
#pragma unroll
                for (int j = 0; j < i; ++j) { if (j & 1) acc1 -= rb[i & 1][j >> 2][j & 3] * t[j]; else acc0 -= rb[i & 1][j >> 2][j & 3] * t[j]; }
                t[i] = acc0 + acc1;
                __builtin_amdgcn_sched_barrier(0);
            }
            if (q == 0) {
#pragma unroll
                for (int i = 0; i < 16; ++i) { Tf[(16 * blk + i) * 68 + 16 * blk + c] = t[i]; Tm[(16 * blk + i) * 72 + 16 * blk + c] = f2bf(t[i]); }
            }
            for (int cb = blk + 1; cb < 4; ++cb) {
#pragma unroll
                for (int jj = 0; jj < 4; ++jj) Tm[(16 * blk + 4 * q + jj) * 72 + 16 * cb + r] = (bf16_t)0;
            }
        } else {
            if (wave == 4 && lane == 0) alast[item] = __expf(gl);
            for (int jb = wave - 4; jb < 40; jb += 4) {
                if (jb < 16) {
                    const int tb = jb >> 2, kb = jb & 3, tok = 16 * tb + r;
                    const u32x2 lo = *(LAS u32x2*)(Qn + tok * 136 + 32 * kb + 4 * q), hi = *(LAS u32x2*)(Qn + tok * 136 + 32 * kb + 16 + 4 * q);
                    const float e = __expf(gcs[tok]);
                    u32x4 w; w.x = pk2(lo16(lo.x) * e, hi16(lo.x) * e); w.y = pk2(lo16(lo.y) * e, hi16(lo.y) * e); w.z = pk2(lo16(hi.x) * e, hi16(hi.x) * e); w.w = pk2(lo16(hi.y) * e, hi16(hi.y) * e);
                    *(u32x4*)(itp + OFF_Q + (size_t)(jb * 64 + lane) * 16) = w;
                } else if (jb < 32) {
                    const int f = jb - 16, db = f >> 1, kb = f & 1, dk = 16 * db + r;
                    const u32x2 lo = *(LAS u32x2*)(KtlT + dk * 72 + 32 * kb + 4 * q), hi = *(LAS u32x2*)(KtlT + dk * 72 + 32 * kb + 16 + 4 * q);
                    u32x4 w; w.x = lo.x; w.y = lo.y; w.z = hi.x; w.w = hi.y;
                    *(u32x4*)(itp + OFF_KT + (size_t)(f * 64 + lane) * 16) = w;
                } else {
                    const int f = jb - 32, tb = f >> 1, kb = f & 1, tok = 16 * tb + r;
                    const u32x2 lo = *(LAS u32x2*)(QKm + tok * 72 + 32 * kb + 4 * q), hi = *(LAS u32x2*)(QKm + tok * 72 + 32 * kb + 16 + 4 * q);
                    u32x4 w; w.x = lo.x; w.y = lo.y; w.z = hi.x; w.w = hi.y;
                    *(u32x4*)(itp + OFF_QK + (size_t)(f * 64 + lane) * 16) = w;
                }
            }
        }
        __syncthreads();
#pragma unroll
        for (int d = 1; d < 4; ++d) {
            if (wave < 4 - d) {
                const int bj = wave, bi = wave + d;
                f32x4 M = {0.f, 0.f, 0.f, 0.f};
#pragma unroll
                for (int kk = 0; kk < d; ++kk) { const int bk = bj + kk;
#pragma unroll
                    for (int s = 0; s < 4; ++s) M = __builtin_amdgcn_mfma_f32_16x16x4f32(Lm[(16 * bi + r) * 68 + 16 * bk + 4 * s + q], Tf[(16 * bk + 4 * s + q) * 68 + 16 * bj + r], M, 0, 0, 0);
                }
                f32x4 Tn = {0.f, 0.f, 0.f, 0.f};
#pragma unroll
                for (int s = 0; s < 4; ++s) Tn = __builtin_amdgcn_mfma_f32_16x16x4f32(Tf[(16 * bi + r) * 68 + 16 * bi + 4 * q + s], M[s], Tn, 0, 0, 0);
#pragma unroll
                for (int jj = 0; jj < 4; ++jj) { Tf[(16 * bi + 4 * q + jj) * 68 + 16 * bj + r] = -Tn[jj]; Tm[(16 * bi + 4 * q + jj) * 72 + 16 * bj + r] = f2bf(-Tn[jj]); }
            }
            __syncthreads();
        }
        {
            const int s = wave;
            bf16x8 vb[2];
#pragma unroll
            for (int kb = 0; kb < 2; ++kb) vb[kb] = *(LAS bf16x8*)(VbT + (16 * s + r) * 72 + 32 * kb + 8 * q);
#pragma unroll
            for (int tb = 0; tb < 4; ++tb) {
                f32x4 acc = {0.f, 0.f, 0.f, 0.f};
#pragma unroll
                for (int kb = 0; kb < 2; ++kb) { const bf16x8 a = *(LAS bf16x8*)(Tm + (16 * tb + r) * 72 + 32 * kb + 8 * q); acc = MFMA16(a, vb[kb], acc); }
                *(f32x4*)(itp + OFF_U + (size_t)((s * 4 + tb) * 64 + lane) * 16) = acc;
            }
            const int kbp = wave & 3, tbh = wave >> 2;
            bf16x8 ka[2][2];
#pragma unroll
            for (int d = 0; d < 2; ++d)
#pragma unroll
                for (int kb = 0; kb < 2; ++kb) ka[d][kb] = *(LAS bf16x8*)(KbgT + (16 * (2 * kbp + d) + r) * 72 + 32 * kb + 8 * q);
#pragma unroll
            for (int tt = 0; tt < 2; ++tt) {
                const int tb = 2 * tbh + tt;
                f32x4 a0 = {0.f, 0.f, 0.f, 0.f}, a1 = {0.f, 0.f, 0.f, 0.f};
#pragma unroll
                for (int kb = 0; kb < 2; ++kb) { const bf16x8 tf = *(LAS bf16x8*)(Tm + (16 * tb + r) * 72 + 32 * kb + 8 * q); a0 = MFMA16(ka[0][kb], tf, a0); a1 = MFMA16(ka[1][kb], tf, a1); }
                u32x4 w; w.x = pk2(a0[0], a0[1]); w.y = pk2(a0[2], a0[3]); w.z = pk2(a1[0], a1[1]); w.w = pk2(a1[2], a1[3]);
                *(u32x4*)(itp + OFF_W + (size_t)((tb * 4 + kbp) * 64 + lane) * 16) = w;
            }
        }
    }
}

__device__ __forceinline__ void mixer_a(const int tidx, const P& p, int l, int blk, int nblk) {
    const bf16_t* proj = (const bf16_t*)(p.ws + WS_PROJ); bf16_t* ycat = (bf16_t*)(p.ws + WS_YCAT);
    for (int unit = blk * 512 + tidx; unit < MTOK * 32; unit += nblk * 512) {
        const int t = unit >> 5, c0 = (unit & 31) * 8, pos = t & (SEQ - 1);
        float acc[8];
#pragma unroll
        for (int i = 0; i < 8; ++i) acc[i] = 0.f;
#pragma unroll
        for (int j = 0; j < 3; ++j) {
            if (pos - 2 + j >= 0) {
                const bf16_t* pr = proj + (size_t)(t - 2 + j) * NINP;
                float fc[8], fv[8]; unpack8(*(const u32x4*)(pr + 256 + c0), fc); unpack8(*(const u32x4*)(pr + 512 + c0), fv);
                const float* wp = p.conv_a_w + (size_t)(l * 3 + j) * 256 + c0;
                const f32x4 w0 = *(const f32x4*)wp, w1 = *(const f32x4*)(wp + 4);
#pragma unroll
                for (int i = 0; i < 4; ++i) { acc[i] += w0[i] * fc[i] * fv[i]; acc[4 + i] += w1[i] * fc[4 + i] * fv[4 + i]; }
            }
        }
        float fb[8]; unpack8(*(const u32x4*)(proj + (size_t)t * NINP + c0), fb);
#pragma unroll
        for (int i = 0; i < 8; ++i) acc[i] *= fb[i];
        *(u32x4*)(ycat + (size_t)t * DM + c0) = pack8(acc);
    }
}
__device__ __forceinline__ void mixer_b(const int tidx, const P& p, int l, int blk, int nblk, LAS unsigned char* L) {
    const bf16_t* proj = (const bf16_t*)(p.ws + WS_PROJ); bf16_t* ycat = (bf16_t*)(p.ws + WS_YCAT);
    LAS float* ut = (LAS float*)L;
    LAS float* co = (LAS float*)(L + 63488);
    const int tid = tidx, wave = tid >> 6, lane = tid & 63;
    for (int run = blk; run < MTOK / 32; run += nblk) {
        __syncthreads();
        const int t0 = run * 32, pos0 = t0 & (SEQ - 1);
        {
            u32x4 ra[4], rg[4];
#pragma unroll
            for (int it = 0; it < 4; ++it) { const int idx = tid + 512 * it, rr = idx >> 5, c0 = (idx & 31) * 8;
                ra[it] = (u32x4){0u, 0u, 0u, 0u}; rg[it] = (u32x4){0u, 0u, 0u, 0u};
                if (idx < 62 * 32 && pos0 - 30 + rr >= 0) { const bf16_t* pr = proj + (size_t)(t0 - 30 + rr) * NINP; ra[it] = *(const u32x4*)(pr + 768 + c0); rg[it] = *(const u32x4*)(pr + 1024 + c0); } }
#pragma unroll
            for (int it = 0; it < 4; ++it) { const int idx = tid + 512 * it, rr = idx >> 5, c0 = (idx & 31) * 8;
                if (idx < 62 * 32) { float fa[8], fg[8], u[8]; unpack8(ra[it], fa); unpack8(rg[it], fg);
#pragma unroll
                    for (int i = 0; i < 8; ++i) u[i] = fa[i] * sigmoid_f(fg[i]);
                    *(LAS f32x4*)(ut + rr * 256 + c0) = (f32x4){u[0], u[1], u[2], u[3]}; *(LAS f32x4*)(ut + rr * 256 + c0 + 4) = (f32x4){u[4], u[5], u[6], u[7]}; } }
        }
        __syncthreads();
        {
            const int c = tid & 255, half = tid >> 8;
            float w[31], win[46];
#pragma unroll
            for (int j = 0; j < 31; ++j) w[j] = p.conf_dw_w[(size_t)(l * 31 + j) * 256 + c];
            const float bias = p.conf_dw_b[l * 256 + c];
#pragma unroll
            for (int k = 0; k < 46; ++k) win[k] = ut[(half * 16 + k) * 256 + c];
#pragma unroll
            for (int tt = 0; tt < 16; ++tt) { float acc = bias;
#pragma unroll
                for (int j = 0; j < 31; ++j) acc += w[j] * win[tt + j];
                co[(half * 16 + tt) * 256 + c] = acc; }
        }
        __syncthreads();
#pragma unroll
        for (int i = 0; i < 4; ++i) {
            const int tl = wave * 4 + i;
            const f32x4 v = *(LAS f32x4*)(co + tl * 256 + lane * 4);
            const float mean = wave_sum(v[0] + v[1] + v[2] + v[3]) * (1.f / 256.f);
            const f32x4 d = v - mean;
            const float var = wave_sum(d[0] * d[0] + d[1] * d[1] + d[2] * d[2] + d[3] * d[3]) * (1.f / 256.f);
            const float rs = rsqrtf(var + 1e-5f);
            const f32x4 gg = *(const f32x4*)(p.conf_ln_g + l * 256 + lane * 4), bb = *(const f32x4*)(p.conf_ln_b + l * 256 + lane * 4);
            const f32x4 y = d * rs * gg + bb;
            u32x2 wv; wv.x = pk2(silu_f(y[0]), silu_f(y[1])); wv.y = pk2(silu_f(y[2]), silu_f(y[3]));
            *(u32x2*)(ycat + (size_t)(t0 + tl) * DM + 256 + lane * 4) = wv;
        }
    }
}

constexpr int SCAN_BLOCKS = 128, SCAN_BUF = 64512;
__device__ __forceinline__ void phase_scan(const int tidx, const P& p, int l, LAS unsigned char* L) {
    const int tid = tidx, lane = tid & 63, wave = tid >> 6, r = lane & 15, q = lane >> 4;
    if ((int)blockIdx.x >= SCAN_BLOCKS) {
        const int blk = blockIdx.x - SCAN_BLOCKS, nblk = gridDim.x - SCAN_BLOCKS;
        mixer_a(tidx, p, l, blk, nblk);
        mixer_b(tidx, p, l, blk, nblk, L);
        return;
    }
    const int item = blockIdx.x, xcd = item & 7, jj = item >> 3, s = jj & 7, bh = xcd * 2 + (jj >> 3), b = bh >> 2, h = bh & 3;
    const unsigned char* dl = p.ws + WS_DELTA;
    const float* alast = (const float*)(p.ws + WS_ALAST);
    float* obuf = (float*)(p.ws + WS_H);
#define SB_ __builtin_amdgcn_sched_barrier(0)
#define SCAN_COMPUTE(buf, n_) do { \
            const float al = __builtin_bit_cast(float, __builtin_amdgcn_readlane(__builtin_bit_cast(int, al_all), (n_))); \
            const LAS bf16x8* Wf = (const LAS bf16x8*)((buf) + OFF_W) + lane; const LAS bf16x8* Qf = (const LAS bf16x8*)((buf) + OFF_Q) + lane; \
            const LAS bf16x8* Kf = (const LAS bf16x8*)((buf) + OFF_KT) + lane; const LAS bf16x8* QKf = (const LAS bf16x8*)((buf) + OFF_QK) + lane; \
            const LAS f32x4* Uf = (const LAS f32x4*)((buf) + OFF_U) + lane; \
            bf16x8 g0[8], g1[8]; f32x4 Uv[4]; \
            _Pragma("unroll") for (int f = 0; f < 8; ++f) g0[f] = Wf[((f >> 1) * 4 + (f & 1)) * 64];                \
            _Pragma("unroll") for (int f = 0; f < 8; ++f) g1[f] = Wf[((f >> 1) * 4 + 2 + (f & 1)) * 64];            \
            bf16x8 Sb[4]; \
            _Pragma("unroll") for (int kb = 0; kb < 4; ++kb) { u32x4 w; w.x = pk2(S[2 * kb][0], S[2 * kb][1]); w.y = pk2(S[2 * kb][2], S[2 * kb][3]); w.z = pk2(S[2 * kb + 1][0], S[2 * kb + 1][1]); w.w = pk2(S[2 * kb + 1][2], S[2 * kb + 1][3]); \
                Sb[kb] = __builtin_bit_cast(bf16x8, w); } \
            f32x4 Pv[4], O[4]; \
            _Pragma("unroll") for (int tb = 0; tb < 4; ++tb) { Pv[tb] = (f32x4){0.f, 0.f, 0.f, 0.f}; O[tb] = (f32x4){0.f, 0.f, 0.f, 0.f}; } \
            SB_; \
            _Pragma("unroll") for (int f = 0; f < 8; ++f) Pv[f >> 1] = MFMA16(g0[f], Sb[f & 1], Pv[f >> 1]); \
            _Pragma("unroll") for (int f = 0; f < 8; ++f) g0[f] = Qf[((f >> 1) * 4 + (f & 1)) * 64]; \
            SB_; \
            _Pragma("unroll") for (int f = 0; f < 8; ++f) Pv[f >> 1] = MFMA16(g1[f], Sb[2 + (f & 1)], Pv[f >> 1]); \
            _Pragma("unroll") for (int f = 0; f < 8; ++f) g1[f] = Qf[((f >> 1) * 4 + 2 + (f & 1)) * 64]; \
            _Pragma("unroll") for (int tb = 0; tb < 4; ++tb) Uv[tb] = Uf[tb * 64]; \
            SB_; \
            _Pragma("unroll") for (int f = 0; f < 8; ++f) O[f >> 1] = MFMA16(g0[f], Sb[f & 1], O[f >> 1]); \
            _Pragma("unroll") for (int f = 0; f < 8; ++f) g0[f] = Kf[(f * 2) * 64];                                  \
            SB_; \
            _Pragma("unroll") for (int f = 0; f < 8; ++f) O[f >> 1] = MFMA16(g1[f], Sb[2 + (f & 1)], O[f >> 1]); \
            _Pragma("unroll") for (int f = 0; f < 8; ++f) g1[f] = Kf[(f * 2 + 1) * 64];                              \
            _Pragma("unroll") for (int tb = 0; tb < 4; ++tb) Pv[tb] = Uv[tb] - Pv[tb]; \
            bf16x8 Vb[2]; \
            _Pragma("unroll") for (int kb = 0; kb < 2; ++kb) { u32x4 w; w.x = pk2(Pv[2 * kb][0], Pv[2 * kb][1]); w.y = pk2(Pv[2 * kb][2], Pv[2 * kb][3]); w.z = pk2(Pv[2 * kb + 1][0], Pv[2 * kb + 1][1]); w.w = pk2(Pv[2 * kb + 1][2], Pv[2 * kb + 1][3]); \
                Vb[kb] = __builtin_bit_cast(bf16x8, w); } \
            _Pragma("unroll") for (int db = 0; db < 8; ++db) S[db] = S[db] * al; \
            SB_; \
            _Pragma("unroll") for (int f = 0; f < 8; ++f) S[f] = MFMA16(g0[f], Vb[0], S[f]); \
            _Pragma("unroll") for (int f = 0; f < 8; ++f) g0[f] = QKf[f * 64];                                        \
            SB_; \
            _Pragma("unroll") for (int f = 0; f < 8; ++f) S[f] = MFMA16(g1[f], Vb[1], S[f]); \
            SB_; \
            _Pragma("unroll") for (int f = 0; f < 8; ++f) O[f >> 1] = MFMA16(g0[f], Vb[f & 1], O[f >> 1]); \
            float* op = obuf + (size_t)(b * SEQ + (n_) * 64 + 4 * q) * 512 + h * 128 + 16 * s + r; \
            _Pragma("unroll") for (int tb = 0; tb < 4; ++tb) \
                _Pragma("unroll") for (int j = 0; j < 4; ++j) op[(size_t)(16 * tb + j) * 512] = O[tb][j]; \
        } while (0)
#define SCAN_BAR() do { asm volatile("s_waitcnt lgkmcnt(0)" ::: "memory"); __builtin_amdgcn_s_barrier(); asm volatile("" ::: "memory"); } while (0)
    LAS unsigned char* buf0 = L; LAS unsigned char* buf1 = L + SCAN_BUF;
    if (wave == 0) {
        const float al_all = alast[(b * 64 + lane) * 4 + h];
        f32x4 S[8];
#pragma unroll
        for (int i = 0; i < 8; ++i) S[i] = (f32x4){0.f, 0.f, 0.f, 0.f};
        SCAN_BAR();
#pragma unroll 1
        for (int n = 0; n < 64; n += 2) {
            SCAN_COMPUTE(buf0, n);
            SCAN_BAR();
            SCAN_COMPUTE(buf1, n + 1);
            SCAN_BAR();
        }
    } else {
        const int ct = tid - 64;
        const int off8 = (ct < 256) ? (OFF_U + s * 4096 + ct * 16) : ((ct - 256) * 16);
        const unsigned char* dlb = dl + (size_t)((b * 64) * 4 + h) * ITEM_BYTES;
        u32x4 R0[9], R1[9], R2[9], R3[9];
#define SCAN_LOAD(regs, n_) do { const int nn_ = ((n_) < 64) ? (n_) : 63; const unsigned char* itp_ = dlb + (size_t)nn_ * (4 * ITEM_BYTES); \
        _Pragma("unroll") for (int i_ = 0; i_ < 8; ++i_) regs[i_] = *(const u32x4*)(itp_ + (ct + 448 * i_) * 16); \
        regs[8] = *(const u32x4*)(itp_ + off8); __builtin_amdgcn_sched_barrier(0); } while (0)
#define SCAN_STORE(regs, buf_) do { _Pragma("unroll") for (int i_ = 0; i_ < 9; ++i_) *(LAS u32x4*)((buf_) + (ct + 448 * i_) * 16) = regs[i_]; } while (0)
        SCAN_LOAD(R0, 0); SCAN_LOAD(R1, 1); SCAN_LOAD(R2, 2); SCAN_LOAD(R3, 3);
        SCAN_STORE(R0, buf0);
        SCAN_BAR();
#pragma unroll 1
        for (int n = 0; n < 64; n += 4) {
            SCAN_LOAD(R0, n + 4); SCAN_STORE(R1, buf1); SCAN_BAR();
            SCAN_LOAD(R1, n + 5); SCAN_STORE(R2, buf0); SCAN_BAR();
            SCAN_LOAD(R2, n + 6); SCAN_STORE(R3, buf1); SCAN_BAR();
            SCAN_LOAD(R3, n + 7); SCAN_STORE(R0, buf0); SCAN_BAR();
        }
    }
#undef SCAN_COMPUTE
#undef SB_
#undef SCAN_BAR
#undef SCAN_LOAD
#undef SCAN_STORE
}

__device__ __forceinline__ void phase_onorm(const int tidx, const P& p, int l) {
    const bf16_t* proj = (const bf16_t*)(p.ws + WS_PROJ); bf16_t* ycat = (bf16_t*)(p.ws + WS_YCAT); const float* obuf = (const float*)(p.ws + WS_H);
    const int sub = tidx & 15, d0 = sub * 8;
    const f32x4 g0 = *(const f32x4*)(p.dn_norm_g + l * 128 + d0), g1 = *(const f32x4*)(p.dn_norm_g + l * 128 + d0 + 4);
    for (int unit0 = (blockIdx.x * 32 + (tidx >> 4)) * 2; unit0 < MTOK * 4; unit0 += gridDim.x * 64) {
        f32x4 o0[2], o1[2]; u32x4 zr[2];
#pragma unroll
        for (int uu = 0; uu < 2; ++uu) { const int t = (unit0 + uu) >> 2, h = (unit0 + uu) & 3;
            o0[uu] = *(const f32x4*)(obuf + (size_t)t * 512 + h * 128 + d0); o1[uu] = *(const f32x4*)(obuf + (size_t)t * 512 + h * 128 + d0 + 4);
            zr[uu] = *(const u32x4*)(proj + (size_t)t * NINP + 2816 + h * 128 + d0); }
#pragma unroll
        for (int uu = 0; uu < 2; ++uu) { const int t = (unit0 + uu) >> 2, h = (unit0 + uu) & 3;
            float ss = o0[uu][0] * o0[uu][0] + o0[uu][1] * o0[uu][1] + o0[uu][2] * o0[uu][2] + o0[uu][3] * o0[uu][3] + o1[uu][0] * o1[uu][0] + o1[uu][1] * o1[uu][1] + o1[uu][2] * o1[uu][2] + o1[uu][3] * o1[uu][3];
            ss += __shfl_xor(ss, 1); ss += __shfl_xor(ss, 2); ss += __shfl_xor(ss, 4); ss += __shfl_xor(ss, 8);
            const float rinv = rsqrtf(ss * (1.f / 128.f) + 1e-6f);
            float z[8]; unpack8(zr[uu], z);
            float y[8];
#pragma unroll
            for (int i = 0; i < 4; ++i) { y[i] = o0[uu][i] * rinv * g0[i] * silu_f(z[i]); y[4 + i] = o1[uu][i] * rinv * g1[i] * silu_f(z[4 + i]); }
            *(u32x4*)(ycat + (size_t)t * DM + 512 + h * 128 + d0) = pack8(y); }
    }
}

#define XB_TMO      128
#define XB_XCNT(j)  (256  + 64 * (j))
#define XB_XSUB(j)  (1280 + 64 * (j))
#define XB_XGEN(j)  (2304 + 64 * (j))
#define XB_TOP      3328
#define XB_TOPGEN   3392
#define XCD_BAR_WORDS 3456
#define XB_SPIN_CAP (1u << 22)
__device__ __forceinline__ unsigned xb_ld(unsigned* p)              { return __hip_atomic_load(p, __ATOMIC_RELAXED, __HIP_MEMORY_SCOPE_AGENT); }
__device__ __forceinline__ unsigned xb_add(unsigned* p, unsigned v) { return __hip_atomic_fetch_add(p, v, __ATOMIC_RELAXED, __HIP_MEMORY_SCOPE_AGENT); }
__device__ __forceinline__ unsigned xb_xcc_id() { return (unsigned)__builtin_amdgcn_s_getreg((3 << 11) | 20) & 0xFu; }
#define XB_SPIN(cond, bar) do { unsigned _sp = 0; while (cond) { __builtin_amdgcn_s_sleep(1); \
    if ((++_sp & 255u) == 0u) { if (xb_ld(&(bar)[XB_TMO])) break; if (_sp > XB_SPIN_CAP) { atomicAdd(&(bar)[XB_TMO], 1u); break; } } } } while (0)
struct XcdBarrier { unsigned* bar; unsigned x; volatile LAS unsigned* st; };
__device__ __forceinline__ XcdBarrier xcd_barrier_post(unsigned* bar, volatile LAS unsigned* st) {
    XcdBarrier b; b.bar = bar; b.x = xb_xcc_id(); b.st = st;
    if (threadIdx.x == 0) (void)xb_add(&bar[XB_XCNT(b.x)], 1u);
    return b;
}
__device__ __forceinline__ void xcd_barrier_complete(unsigned* bar, unsigned x, unsigned& nloc, unsigned& nx) {
    const unsigned G = gridDim.x * gridDim.y * gridDim.z;
    unsigned sum, cnt, mine, sp = 0u;
    for (;;) {
        sum = 0u; cnt = 0u; mine = 0u;
#pragma unroll
        for (unsigned j = 0; j < 16; ++j) { const unsigned c = xb_ld(&bar[XB_XCNT(j)]); sum += c; cnt += (c > 0u) ? 1u : 0u; mine = (j == x) ? c : mine; }
        if (sum == G) break;
        __builtin_amdgcn_s_sleep(1);
        if ((++sp & 255u) == 0u) { if (xb_ld(&bar[XB_TMO])) break; if (sp > XB_SPIN_CAP) { atomicAdd(&bar[XB_TMO], 1u); break; } }
    }
    nloc = mine > 0u ? mine : 1u; nx = cnt > 0u ? cnt : 1u;
}
__device__ __forceinline__ void xcd_barrier(const XcdBarrier& b) {
    asm volatile("s_waitcnt vmcnt(0)" ::: "memory");
    __syncthreads();
    if (threadIdx.x == 0) {
        unsigned* bar = b.bar;
        __builtin_amdgcn_s_waitcnt(0);
        unsigned nloc = b.st[0], nx = b.st[1];
        if (nloc == 0u) { xcd_barrier_complete(bar, b.x, nloc, nx); b.st[0] = nloc; b.st[1] = nx; }
        const unsigned old = xb_add(&bar[XB_XSUB(b.x)], 1u);
        const unsigned gen = old / nloc;
        if (old + 1u == (gen + 1u) * nloc) {
            __builtin_amdgcn_fence(__ATOMIC_RELEASE, "agent");
            asm volatile("s_waitcnt vmcnt(0)" ::: "memory");
            const unsigned og = xb_add(&bar[XB_TOP], 1u);
            const unsigned tg = og / nx;
            if (og + 1u == (tg + 1u) * nx) xb_add(&bar[XB_TOPGEN], 1u);
            else XB_SPIN(xb_ld(&bar[XB_TOPGEN]) == tg, bar);
            __builtin_amdgcn_fence(__ATOMIC_ACQUIRE, "agent");
            xb_add(&bar[XB_XGEN(b.x)], 1u);
            asm volatile("s_waitcnt vmcnt(0)" ::: "memory");
        } else {
            XB_SPIN(xb_ld(&bar[XB_XGEN(b.x)]) == gen, bar);
            __builtin_amdgcn_fence(__ATOMIC_ACQUIRE, "agent");
            asm volatile("s_waitcnt vmcnt(0)" ::: "memory");
        }
    }
    __syncthreads();
}

template <int KIND>
__device__ __forceinline__ void run_kind(const int tidx, const P& p, int l, LAS unsigned char* L) {
    const float* modl = (const float*)(p.ws + WS_MOD) + (size_t)l * NB * NMOD;
    bf16_t* hbuf = (bf16_t*)(p.ws + WS_H); bf16_t* ycat = (bf16_t*)(p.ws + WS_YCAT); bf16_t* proj = (bf16_t*)(p.ws + WS_PROJ);
    const float* xin = (l == 0) ? p.x : p.out;
    if constexpr (KIND == 0) phase_prep(tidx, p, L);
    if constexpr (KIND == 1) phase_norm(tidx, xin, p.norm_mix_g + l * DM, modl, 0, DM, hbuf);
    if constexpr (KIND == 2) { pg8::Gemm g{hbuf, (const bf16_t*)(p.ws + WS_WIN) + (size_t)l * NINP * DM, MTOK, NINP, DM}; pg8::StaticOrder S; S.init(MTOK, NINP, gridDim.x, blockIdx.x);
        pg8::EpiProj E{proj, NINP}; pg8::gemm_phase<pg8::EpiProj>(tidx, L, g, S, E); }
    if constexpr (KIND == 3) phase_dprep(tidx, p, l, L);
    if constexpr (KIND == 4) phase_scan(tidx, p, l, L);
    if constexpr (KIND == 5) phase_onorm(tidx, p, l);
    if constexpr (KIND == 6) { pg8::Gemm g{ycat, (const bf16_t*)(p.ws + WS_WOUT) + (size_t)l * DM * DM, MTOK, DM, DM}; pg8::StaticOrder S; S.init(MTOK, DM, gridDim.x, blockIdx.x);
        pg8::EpiResid E{xin, p.out, modl + 2 * DM}; pg8::gemm_phase<pg8::EpiResid>(tidx, L, g, S, E); }
    if constexpr (KIND == 7) phase_norm(tidx, p.out, p.norm_ffn_g + l * DM, modl, 3 * DM, 4 * DM, hbuf);
    if constexpr (KIND == 8) { pg8::Gemm g{hbuf, (const bf16_t*)(p.ws + WS_WF1) + (size_t)l * NF1 * DM, MTOK, NF1, DM}; pg8::StaticOrder S; S.init(MTOK, NF1, gridDim.x, blockIdx.x);
        pg8::EpiSwiGLU E{proj}; pg8::gemm_phase<pg8::EpiSwiGLU>(tidx, L, g, S, E); }
    if constexpr (KIND == 9) { pg8::Gemm g{proj, (const bf16_t*)(p.ws + WS_WF2) + (size_t)l * DM * DFF, MTOK, DM, DFF}; pg8::StaticOrder S; S.init(MTOK, DM, gridDim.x, blockIdx.x);
        pg8::EpiResid E{p.out, p.out, modl + 5 * DM}; pg8::gemm_phase<pg8::EpiResid>(tidx, L, g, S, E); }
    if constexpr (KIND == 10) phase_final(tidx, p.out, p.final_norm_g);
}
__host__ __device__ inline void phase_decode(int ph, int& kind, int& l) {
    if (ph == 0) { kind = 0; l = 0; } else if (ph == NPH - 1) { kind = 10; l = 0; } else { l = (ph - 1) / 9; kind = 1 + (ph - 1) % 9; }
}

#if ONE_LAUNCH
__global__ void __launch_bounds__(512, 2) hymba_fwd(P p) {
    extern __shared__ __attribute__((aligned(16))) unsigned char lds_raw[];
    LAS unsigned char* L = (LAS unsigned char*)lds_raw;
    cg::grid_group grid = cg::this_grid();
    if (threadIdx.x < 16) ((LAS unsigned*)(L + LDS_BAR_OFF))[threadIdx.x] = 0u;
    __syncthreads();
    const XcdBarrier bar = xcd_barrier_post((unsigned*)(p.ws + WS_BAR), (volatile LAS unsigned*)(L + LDS_BAR_OFF));
    for (int ph = p.ph_lo; ph < p.ph_hi; ++ph) {
        if (ph == p.ph_lo + 1) grid.sync();
        else if (ph > p.ph_lo + 1) xcd_barrier(bar);
        int kind, l; phase_decode(ph, kind, l);
        int tidx = threadIdx.x; asm volatile("" : "+v"(tidx));
#if REPEAT_MASK
        if ((REPEAT_MASK >> kind) & 1) {
            switch (kind) { case 1: run_kind<1>(tidx, p, l, L); break; case 2: run_kind<2>(tidx, p, l, L); break; case 3: run_kind<3>(tidx, p, l, L); break; case 4: run_kind<4>(tidx, p, l, L); break;
                case 5: run_kind<5>(tidx, p, l, L); break; case 7: run_kind<7>(tidx, p, l, L); break; case 8: run_kind<8>(tidx, p, l, L); break; default: break; }
            __syncthreads();
        }
#endif
        switch (kind) {
        case 0: run_kind<0>(tidx, p, l, L); break; case 1: run_kind<1>(tidx, p, l, L); break; case 2: run_kind<2>(tidx, p, l, L); break; case 3: run_kind<3>(tidx, p, l, L); break;
        case 4: run_kind<4>(tidx, p, l, L); break; case 5: run_kind<5>(tidx, p, l, L); break; case 6: run_kind<6>(tidx, p, l, L); break; case 7: run_kind<7>(tidx, p, l, L); break;
        case 8: run_kind<8>(tidx, p, l, L); break; case 9: run_kind<9>(tidx, p, l, L); break; default: run_kind<10>(tidx, p, l, L); break;
        }
    }
}
#define LAUNCH_FN(kind) ((const void*)hymba_fwd)
#else
template <int KIND> __global__ void __launch_bounds__(512, 2) hymba_ph(P p) {
    extern __shared__ __attribute__((aligned(16))) unsigned char lds_raw[];
    run_kind<KIND>((int)threadIdx.x, p, p.ph_hi, (LAS unsigned char*)lds_raw);
}
static const void* ph_fn(int kind) {
    switch (kind) { case 0: return (const void*)hymba_ph<0>; case 1: return (const void*)hymba_ph<1>; case 2: return (const void*)hymba_ph<2>; case 3: return (const void*)hymba_ph<3>;
        case 4: return (const void*)hymba_ph<4>; case 5: return (const void*)hymba_ph<5>; case 6: return (const void*)hymba_ph<6>; case 7: return (const void*)hymba_ph<7>;
        case 8: return (const void*)hymba_ph<8>; case 9: return (const void*)hymba_ph<9>; default: return (const void*)hymba_ph<10>; }
}
#define LAUNCH_FN(kind) ph_fn(kind)
#endif

extern "C" void kernel_launch(void* const* d_in, const int* in_sizes, int n_in, void* d_out, int out_size, void* d_ws, size_t ws_size, hipStream_t stream) {
    static int grid = 0;
    if (grid == 0) {
        if (n_in != 20 || out_size != MTOK * DM || ws_size < WS_END) { fprintf(stderr, "kernel_launch: unexpected problem (n_in %d out %d ws %zu need %zu)\n", n_in, out_size, ws_size, (size_t)WS_END); grid = -1; return; }
        int dev = 0, cus = 0, per_cu = 0;
        (void)hipGetDevice(&dev); (void)hipDeviceGetAttribute(&cus, hipDeviceAttributeMultiprocessorCount, dev);
        for (int k = 0; k <= 10; ++k)
            if (hipFuncSetAttribute(LAUNCH_FN(k), hipFuncAttributeMaxDynamicSharedMemorySize, LDS_BYTES) != hipSuccess) { fprintf(stderr, "kernel_launch: hipFuncSetAttribute failed\n"); grid = -1; return; }
#if ONE_LAUNCH
        if (hipOccupancyMaxActiveBlocksPerMultiprocessor(&per_cu, (const void*)hymba_fwd, 512, LDS_BYTES) != hipSuccess || per_cu < 1) { fprintf(stderr, "kernel_launch: occupancy query failed (%d)\n", per_cu); (void)hipGetLastError(); per_cu = 1; }
#else
        per_cu = 1;
#endif
        grid = cus * per_cu;
        if (grid < SCAN_BLOCKS + 32) { fprintf(stderr, "kernel_launch: grid %d too small\n", grid); grid = -1; return; }
    }
    if (grid < 0) return;
    P p{};
    const float** pp = (const float**)&p;
    for (int i = 0; i < 20; ++i) pp[i] = (const float*)d_in[i];
    p.out = (float*)d_out; p.ws = (unsigned char*)d_ws;
#if ONE_LAUNCH
    p.ph_lo = 0; p.ph_hi = NPH;
    if (hipMemsetAsync((unsigned char*)d_ws + WS_BAR, 0, 16384, stream) != hipSuccess) { fprintf(stderr, "kernel_launch: memset of the barrier words failed\n"); return; }
    void* args[] = {&p};
    hipError_t e = hipLaunchCooperativeKernel((const void*)hymba_fwd, dim3(grid), dim3(512), args, LDS_BYTES, stream);
    if (e != hipSuccess) fprintf(stderr, "cooperative launch failed: %s (grid %d)\n", hipGetErrorString(e), grid);
#else
    for (int ph = 0; ph < NPH; ++ph) { int kind, l; phase_decode(ph, kind, l); p.ph_lo = kind; p.ph_hi = l; void* args[] = {&p};
        (void)hipLaunchKernel(ph_fn(kind), dim3(grid), dim3(512), args, LDS_BYTES, stream); }
#endif
}
```

```cpp
#include <hip/hip_runtime.h>
#include <hip/hip_cooperative_groups.h>
#include <cstdio>
namespace cg = cooperative_groups;

#ifndef ONE_LAUNCH
#define ONE_LAUNCH 1
#endif
#ifndef REPEAT_MASK
#define REPEAT_MASK 0
#endif

#define LAS __attribute__((address_space(3)))
typedef unsigned short bf16_t;
typedef short bf16x8 __attribute__((ext_vector_type(8)));
typedef float f32x4 __attribute__((ext_vector_type(4)));
typedef float f32x2 __attribute__((ext_vector_type(2)));
typedef unsigned u32x4 __attribute__((ext_vector_type(4)));
typedef unsigned u32x2 __attribute__((ext_vector_type(2)));
typedef __bf16 nbf16x2 __attribute__((ext_vector_type(2)));

constexpr int MTOK = 16384, DM = 1024, NL = 4, NB = 4, SEQ = 4096;
constexpr int NIN = 3336, NINP = 3584, DFF = 2816, NF1 = 2 * DFF, NMOD = 6 * DM;
constexpr int LDS_BYTES = 131072 + 64 + 6144 + 17408, LDS_BAR_OFF = 131072, LDS_CW_OFF = 131072 + 64, LDS_TF_OFF = LDS_CW_OFF + 6144;
constexpr int NPH = 1 + 9 * NL + 1;

constexpr size_t SZ_WIN = (size_t)NL * NINP * DM * 2, SZ_WOUT = (size_t)NL * DM * DM * 2, SZ_WF1 = (size_t)NL * NF1 * DM * 2, SZ_WF2 = (size_t)NL * DM * DFF * 2;
constexpr size_t WS_WIN = 0, WS_WOUT = WS_WIN + SZ_WIN, WS_WF1 = WS_WOUT + SZ_WOUT, WS_WF2 = WS_WF1 + SZ_WF1;
constexpr size_t WS_MOD = WS_WF2 + SZ_WF2;
constexpr size_t WS_ALAST = WS_MOD + (size_t)NL * NB * NMOD * 4;
constexpr size_t WS_H = WS_ALAST + 4096;
constexpr size_t WS_YCAT = WS_H + (size_t)MTOK * DM * 2;
constexpr size_t WS_PROJ = WS_YCAT + (size_t)MTOK * DM * 2;
constexpr int ITEM_BYTES = 90112, OFF_W = 0, OFF_Q = 16384, OFF_KT = 32768, OFF_QK = 49152, OFF_U = 57344;
constexpr size_t WS_DELTA = WS_PROJ + (size_t)MTOK * NINP * 2;
constexpr size_t WS_BAR = WS_DELTA + (size_t)1024 * ITEM_BYTES;
constexpr size_t WS_END = WS_BAR + 16384;

struct P {
    const float *x, *c, *w_ada, *b_ada, *norm_mix_g, *norm_ffn_g, *w_in, *conv_a_w, *conf_dw_w, *conf_dw_b, *conf_ln_g, *conf_ln_b,
        *dn_conv_w, *dn_a_log, *dn_dt_bias, *dn_norm_g, *w_out, *w_ffn_in, *w_ffn_out, *final_norm_g;
    float* out; unsigned char* ws; int ph_lo, ph_hi;
};

__device__ __forceinline__ float bf2f(bf16_t v) { return __uint_as_float(((unsigned)v) << 16); }
__device__ __forceinline__ unsigned pk2(float a, float b) { f32x2 v = {a, b}; nbf16x2 r = __builtin_convertvector(v, nbf16x2); return __builtin_bit_cast(unsigned, r); }
__device__ __forceinline__ bf16_t f2bf(float a) { return (bf16_t)(pk2(a, 0.f) & 0xffffu); }
__device__ __forceinline__ float lo16(unsigned w) { return __uint_as_float(w << 16); }
__device__ __forceinline__ float hi16(unsigned w) { return __uint_as_float(w & 0xffff0000u); }
__device__ __forceinline__ float sigmoid_f(float v) { return __builtin_amdgcn_rcpf(1.f + __expf(-v)); }
__device__ __forceinline__ float silu_f(float v) { return v * sigmoid_f(v); }
__device__ __forceinline__ float wave_sum(float v) {
#pragma unroll
    for (int o = 32; o; o >>= 1) v += __shfl_xor(v, o);
    return v;
}
__device__ __forceinline__ void unpack8(const u32x4 w, float (&f)[8]) {
    f[0] = lo16(w.x); f[1] = hi16(w.x); f[2] = lo16(w.y); f[3] = hi16(w.y); f[4] = lo16(w.z); f[5] = hi16(w.z); f[6] = lo16(w.w); f[7] = hi16(w.w);
}
__device__ __forceinline__ u32x4 pack8(const float (&f)[8]) { u32x4 w; w.x = pk2(f[0], f[1]); w.y = pk2(f[2], f[3]); w.z = pk2(f[4], f[5]); w.w = pk2(f[6], f[7]); return w; }
#define MFMA16(a, b, c) __builtin_amdgcn_mfma_f32_16x16x32_bf16((a), (b), (c), 0, 0, 0)

namespace pg8 {
constexpr int BM = 256, BK = 64, HALF = 128, HTB = HALF * BK * 2, STAGE_BYTES = 8 * HTB, NXCD = 8, WGM = 8;
__host__ __device__ __forceinline__ int lds_byte(int r, int c) { const int st = (r >> 4) * 2 + (c >> 5), rr = r & 15, cc = c & 31, ob = rr * 64 + cc * 2; return st * 1024 + (ob ^ (((ob >> 9) & 1) << 5)); }
__host__ __device__ __forceinline__ void stage_rc(int b, int& R, int& C) { const int st = b / 1024, sb = b % 1024, swz = sb ^ (((sb >> 9) & 1) << 5); R = (st >> 1) * 16 + swz / 64; C = (st & 1) * 32 + (swz % 64) / 2; }
__host__ __device__ __forceinline__ int perm32(int rho) { const int n = rho >> 4, i = rho & 15; return 8 * (i >> 2) + 4 * n + (i & 3); }
struct Unit { int pm, pn; };
struct Gemm { const bf16_t* A; const bf16_t* Bt; int M, N, K; };
struct StaticOrder {
    int nM, nN, nwg, G, c;
    __device__ void init(int M, int N, int G_, int c_) { nM = M / BM; nN = N / BM; nwg = nM * nN; G = G_; c = c_; }
    __device__ bool next(int i, Unit& u) const {
        const long L = (long)i * G + c; if (L >= nwg) return false;
        int wgid = (int)L; { const int q = nwg / NXCD, r = nwg % NXCD, xcd = wgid % NXCD, off = wgid / NXCD; wgid = (xcd < r ? xcd * (q + 1) : r * (q + 1) + (xcd - r) * q) + off; }
        const int nig = WGM * nN, gid = wgid / nig, fm = gid * WGM, gsz = (nM - fm) < WGM ? (nM - fm) : WGM;
        u.pm = fm + ((wgid % nig) % gsz); u.pn = (wgid % nig) / gsz; return true;
    }
};

struct EpiProj {
    static constexpr bool PERM = true;
    bf16_t* O; int ldc;
    __device__ __forceinline__ void operator()(const f32x4 (&acc)[2][2][4][2], const Unit& u, int wr, int wc, int fr, int fq) const {
        const int row0 = u.pm * BM + wr * 64 + fr, col0 = u.pn * BM + wc * 32 + 8 * fq;
#pragma unroll
        for (int ai = 0; ai < 2; ++ai)
#pragma unroll
            for (int m = 0; m < 4; ++m) { bf16_t* rowp = O + (size_t)(row0 + ai * HALF + m * 16) * ldc + col0;
#pragma unroll
                for (int bj = 0; bj < 2; ++bj) { const f32x4 v0 = acc[ai][bj][m][0], v1 = acc[ai][bj][m][1];
                    u32x4 w; w.x = pk2(v0[0], v0[1]); w.y = pk2(v0[2], v0[3]); w.z = pk2(v1[0], v1[1]); w.w = pk2(v1[2], v1[3]);
                    *(u32x4*)(rowp + bj * HALF) = w; } }
    }
};
struct EpiSwiGLU {
    static constexpr bool PERM = true;
    bf16_t* O;
    __device__ __forceinline__ void operator()(const f32x4 (&acc)[2][2][4][2], const Unit& u, int wr, int wc, int fr, int fq) const {
        const int row0 = u.pm * BM + wr * 64 + fr, col0 = u.pn * HALF + wc * 32 + 8 * fq;
#pragma unroll
        for (int ai = 0; ai < 2; ++ai)
#pragma unroll
            for (int m = 0; m < 4; ++m) {
                const f32x4 g0 = acc[ai][0][m][0], g1 = acc[ai][0][m][1], u0 = acc[ai][1][m][0], u1 = acc[ai][1][m][1];
                float v[8];
#pragma unroll
                for (int i = 0; i < 4; ++i) { v[i] = silu_f(g0[i]) * u0[i]; v[4 + i] = silu_f(g1[i]) * u1[i]; }
                *(u32x4*)(O + (size_t)(row0 + ai * HALF + m * 16) * DFF + col0) = pack8(v);
            }
    }
};
struct EpiResid {
    static constexpr bool PERM = false;
    const float* base; float* out; const float* gate;
    __device__ __forceinline__ void operator()(const f32x4 (&acc)[2][2][4][2], const Unit& u, int wr, int wc, int fr, int fq) const {
        const int row0 = u.pm * BM + wr * 64 + fr, col0 = u.pn * BM + wc * 32 + 4 * fq;
        const float* gp = gate + (size_t)(u.pm >> 4) * NMOD + col0;
        f32x4 gv[2][2];
#pragma unroll
        for (int bj = 0; bj < 2; ++bj)
#pragma unroll
            for (int n = 0; n < 2; ++n) gv[bj][n] = *(const f32x4*)(gp + bj * HALF + n * 16);
#pragma unroll
        for (int ai = 0; ai < 2; ++ai) {
            f32x4 bv[4][2][2];
#pragma unroll
            for (int m = 0; m < 4; ++m) { const size_t ro = (size_t)(row0 + ai * HALF + m * 16) * DM + col0;
#pragma unroll
                for (int bj = 0; bj < 2; ++bj)
#pragma unroll
                    for (int n = 0; n < 2; ++n) bv[m][bj][n] = *(const f32x4*)(base + ro + bj * HALF + n * 16); }
#pragma unroll
            for (int m = 0; m < 4; ++m) { const size_t ro = (size_t)(row0 + ai * HALF + m * 16) * DM + col0;
#pragma unroll
                for (int bj = 0; bj < 2; ++bj)
#pragma unroll
                    for (int n = 0; n < 2; ++n) *(f32x4*)(out + ro + bj * HALF + n * 16) = bv[m][bj][n] + gv[bj][n] * acc[ai][bj][m][n]; }
        }
    }
};

template <class Epi>
__device__ __forceinline__ void gemm_phase(const int tidx, LAS unsigned char* lds, const Gemm g, const StaticOrder& S, const Epi& E) {
    const int tid = tidx, wid = __builtin_amdgcn_readfirstlane(tid >> 6), lane = tid & 63, wr = wid >> 2, wc = wid & 3, fr = lane & 15, fq = lane >> 4;
    const int K = g.K, nt = K / BK;
    unsigned voffA[2], voffB[2];
#pragma unroll
    for (int i = 0; i < 2; ++i) { int R, C; stage_rc(tid * 16 + i * 8192, R, C); const int Rb = Epi::PERM ? ((R & ~31) + perm32(R & 31)) : R;
        voffA[i] = (unsigned)(R * K + C) * 2u; voffB[i] = (unsigned)(Rb * K + C) * 2u; }
    const size_t kstep = (size_t)(BK * 2);
    const size_t hstep = (size_t)HALF * K * 2;
    const size_t tstep = 2 * hstep;
    const unsigned ldsw = (unsigned)wid * 1024u;
    const int aoff = lds_byte(wr * 64 + fr, fq * 8), boff = lds_byte(wc * 32 + fr, fq * 8);
#define PG8_SA(b, h) (((b) * 2 + (h)) * HTB)
#define PG8_SB(b, h) ((4 + (b) * 2 + (h)) * HTB)
#define PG8_STAGE(bufoff, gbase, voff) do { _Pragma("unroll") for (int _i = 0; _i < 2; ++_i) \
        __builtin_amdgcn_global_load_lds((const unsigned*)((const char*)(gbase) + (voff)[_i]), (LAS unsigned*)(lds + (bufoff) + ldsw + _i * 8192), 16, 0, 0); } while (0)
#define PG8_LDA(dst, b, h) do { _Pragma("unroll") for (int m = 0; m < 4; ++m) _Pragma("unroll") for (int k = 0; k < 2; ++k) dst[m][k] = *(const LAS bf16x8*)(lds + PG8_SA(b, h) + aoff + m * 2048 + k * 1024); } while (0)
#define PG8_LDB(dst, b, h) do { _Pragma("unroll") for (int n = 0; n < 2; ++n) _Pragma("unroll") for (int k = 0; k < 2; ++k) dst[n][k] = *(const LAS bf16x8*)(lds + PG8_SB(b, h) + boff + n * 2048 + k * 1024); } while (0)
#define PG8_MMA(ai, bj, At, Bt) do { __builtin_amdgcn_s_setprio(1); _Pragma("unroll") for (int m = 0; m < 4; ++m) _Pragma("unroll") for (int n = 0; n < 2; ++n) _Pragma("unroll") for (int k = 0; k < 2; ++k) \
        acc[ai][bj][m][n] = __builtin_amdgcn_mfma_f32_16x16x32_bf16(Bt[n][k], At[m][k], acc[ai][bj][m][n], 0, 0, 0); __builtin_amdgcn_s_setprio(0); } while (0)
#define PG8_WAIT_V(n) asm volatile("s_waitcnt vmcnt(" #n ")" ::: "memory")
#define PG8_WAIT_L(n) asm volatile("s_waitcnt lgkmcnt(" #n ")" ::: "memory")
#define PG8_BAR __builtin_amdgcn_s_barrier()
#define PG8_SCHED __builtin_amdgcn_sched_barrier(0)
    Unit cur, nxt; int ui = 0;
    if (!S.next(0, cur)) return;
    f32x4 acc[2][2][4][2];
#pragma unroll
    for (int a = 0; a < 2; ++a)
#pragma unroll
        for (int b = 0; b < 2; ++b)
#pragma unroll
            for (int m = 0; m < 4; ++m)
#pragma unroll
                for (int n = 0; n < 2; ++n) acc[a][b][m][n] = (f32x4){0.f, 0.f, 0.f, 0.f};
    bf16x8 At[4][2], B0[2][2], B1[2][2];
    const char* cA = (const char*)g.A + (size_t)cur.pm * tstep; const char* cB = (const char*)g.Bt + (size_t)cur.pn * tstep;
    PG8_STAGE(PG8_SB(0, 0), cB, voffB); PG8_STAGE(PG8_SA(0, 0), cA, voffA); PG8_STAGE(PG8_SB(0, 1), cB + hstep, voffB); PG8_STAGE(PG8_SA(0, 1), cA + hstep, voffA);
    if (wr == 1) PG8_BAR;
    PG8_WAIT_V(4); PG8_BAR;
    PG8_STAGE(PG8_SB(1, 0), cB + kstep, voffB); PG8_STAGE(PG8_SA(1, 0), cA + kstep, voffA); PG8_STAGE(PG8_SB(1, 1), cB + hstep + kstep, voffB);
    PG8_WAIT_V(6); PG8_BAR;
    for (;;) {
        const bool has_next = S.next(ui + 1, nxt);
        const char* nA = has_next ? (const char*)g.A + (size_t)nxt.pm * tstep : cA; const char* nB = has_next ? (const char*)g.Bt + (size_t)nxt.pn * tstep : cB;
        for (int t = 0; t < nt; t += 2) {
            const bool last = (t == nt - 2);
            const char* a1 = cA + (size_t)(t + 1) * kstep;
            const char* a2 = last ? nA : cA + (size_t)(t + 2) * kstep; const char* b2 = last ? nB : cB + (size_t)(t + 2) * kstep;
            const char* a3 = a2 + kstep; const char* b3 = b2 + kstep;
            PG8_LDB(B0, 0, 0); PG8_SCHED; PG8_LDA(At, 0, 0); PG8_STAGE(PG8_SA(1, 1), a1 + hstep, voffA);
            PG8_WAIT_L(8); PG8_BAR; PG8_WAIT_L(0); PG8_MMA(0, 0, At, B0); PG8_BAR; PG8_SCHED;
            PG8_LDB(B1, 0, 1); PG8_STAGE(PG8_SB(0, 0), b2, voffB);
            PG8_BAR; PG8_WAIT_L(0); PG8_MMA(0, 1, At, B1); PG8_BAR;
            PG8_LDA(At, 0, 1); PG8_STAGE(PG8_SA(0, 0), a2, voffA);
            PG8_BAR; PG8_WAIT_L(0); PG8_MMA(1, 0, At, B0); PG8_BAR; PG8_SCHED;
            PG8_STAGE(PG8_SB(0, 1), b2 + hstep, voffB);
            PG8_WAIT_V(6); PG8_BAR; PG8_MMA(1, 1, At, B1); PG8_BAR;
            PG8_LDB(B0, 1, 0); PG8_SCHED; PG8_LDA(At, 1, 0); PG8_STAGE(PG8_SA(0, 1), a2 + hstep, voffA);
            PG8_WAIT_L(8); PG8_BAR; PG8_WAIT_L(0); PG8_MMA(0, 0, At, B0); PG8_BAR; PG8_SCHED;
            PG8_LDB(B1, 1, 1); PG8_STAGE(PG8_SB(1, 0), b3, voffB);
            PG8_BAR; PG8_WAIT_L(0); PG8_MMA(0, 1, At, B1); PG8_BAR;
            PG8_LDA(At, 1, 1); PG8_STAGE(PG8_SA(1, 0), a3, voffA);
            PG8_BAR; PG8_WAIT_L(0); PG8_MMA(1, 0, At, B0); PG8_BAR; PG8_SCHED;
            PG8_STAGE(PG8_SB(1, 1), b3 + hstep, voffB);
            PG8_WAIT_V(6); PG8_BAR; PG8_MMA(1, 1, At, B1); PG8_BAR;
        }
        E(acc, cur, wr, wc, fr, fq);
        if (!has_next) break;
#pragma unroll
        for (int a = 0; a < 2; ++a)
#pragma unroll
            for (int b = 0; b < 2; ++b)
#pragma unroll
                for (int m = 0; m < 4; ++m)
#pragma unroll
                    for (int n = 0; n < 2; ++n) acc[a][b][m][n] = (f32x4){0.f, 0.f, 0.f, 0.f};
        cur = nxt; cA = nA; cB = nB; ++ui;
    }
    PG8_WAIT_V(0);
    if (wr == 0) PG8_BAR;
    PG8_BAR;
#undef PG8_SA
#undef PG8_SB
#undef PG8_STAGE
#undef PG8_LDA
#undef PG8_LDB
#undef PG8_MMA
#undef PG8_WAIT_V
#undef PG8_WAIT_L
#undef PG8_BAR
#undef PG8_SCHED
}
}

__device__ __forceinline__ void phase_prep(const int tidx, const P& p, LAS unsigned char* L) {
    const int tid = tidx;
    constexpr int NADA = NL * 96, TPL = 3264, TOTAL = NADA + NL * TPL;
    float* mod = (float*)(p.ws + WS_MOD);
    for (int it = blockIdx.x; it < NADA; it += gridDim.x) {
        __syncthreads();
        {
            const int l = it / 96, n0 = (it % 96) * 64;
            LAS float* cact = (LAS float*)L;
            LAS float* red = cact + 4096;
            for (int i = tid; i < 4096; i += 512) cact[i] = silu_f(p.c[i]);
            __syncthreads();
            const int kg = tid >> 6, nn = tid & 63;
            const float* w = p.w_ada + ((size_t)l * DM + kg * 128) * NMOD + n0 + nn;
            float a0 = 0.f, a1 = 0.f, a2 = 0.f, a3 = 0.f;
#pragma unroll 8
            for (int k = 0; k < 128; ++k) { const float wv = w[(size_t)k * NMOD]; const int kk = kg * 128 + k;
                a0 += cact[kk] * wv; a1 += cact[1024 + kk] * wv; a2 += cact[2048 + kk] * wv; a3 += cact[3072 + kk] * wv; }
            red[(kg * 4 + 0) * 64 + nn] = a0; red[(kg * 4 + 1) * 64 + nn] = a1; red[(kg * 4 + 2) * 64 + nn] = a2; red[(kg * 4 + 3) * 64 + nn] = a3;
            __syncthreads();
            if (tid < 256) { const int b = tid >> 6; float s = p.b_ada[l * NMOD + n0 + nn];
#pragma unroll
                for (int k2 = 0; k2 < 8; ++k2) s += red[(k2 * 4 + b) * 64 + nn];
                mod[(size_t)(l * NB + b) * NMOD + n0 + nn] = s; }
        }
    }
    constexpr int NTT = NL * TPL;
    for (int it0 = blockIdx.x * 4; it0 < NTT; it0 += gridDim.x * 4) {
        __syncthreads();
        bf16_t* dstp[4]; int kd[4];
#pragma unroll
        for (int tt = 0; tt < 4; ++tt) {
            const int j = it0 + tt, l = j / TPL; int r = j % TPL;
            const float* src; bf16_t* dst; int Ns, Nvalid, Kd, k0, ns0, nd0;
            if (r < 896) { const int kt = r / 56, nt = r % 56; src = p.w_in + (size_t)l * DM * NIN; Ns = NIN; Nvalid = NIN; Kd = DM; k0 = kt * 64; nd0 = nt * 64; ns0 = nd0;
                dst = (bf16_t*)(p.ws + WS_WIN) + (size_t)l * NINP * DM; }
            else if (r < 1152) { r -= 896; const int kt = r / 16, nt = r % 16; src = p.w_out + (size_t)l * DM * DM; Ns = DM; Nvalid = DM; Kd = DM; k0 = kt * 64; nd0 = nt * 64; ns0 = nd0;
                dst = (bf16_t*)(p.ws + WS_WOUT) + (size_t)l * DM * DM; }
            else if (r < 2560) { r -= 1152; const int kt = r / 88, nt = r % 88; src = p.w_ffn_in + (size_t)l * DM * NF1; Ns = NF1; Nvalid = NF1; Kd = DM; k0 = kt * 64; nd0 = nt * 64;
                const int pn = nd0 >> 8, half = (nd0 >> 7) & 1, sub = nd0 & 127; ns0 = half * DFF + pn * 128 + sub;
                dst = (bf16_t*)(p.ws + WS_WF1) + (size_t)l * NF1 * DM; }
            else { r -= 2560; const int kt = r / 16, nt = r % 16; src = p.w_ffn_out + (size_t)l * DFF * DM; Ns = DM; Nvalid = DM; Kd = DFF; k0 = kt * 64; nd0 = nt * 64; ns0 = nd0;
                dst = (bf16_t*)(p.ws + WS_WF2) + (size_t)l * DM * DFF; }
            LAS float* tile = (LAS float*)L + tt * (64 * 65);
            const int kk = tid >> 4, c4 = (tid & 15) * 4;
            f32x4 v0 = {0.f, 0.f, 0.f, 0.f}, v1 = {0.f, 0.f, 0.f, 0.f};
            if (ns0 + c4 < Nvalid) { v0 = *(const f32x4*)(src + (size_t)(k0 + kk) * Ns + ns0 + c4); v1 = *(const f32x4*)(src + (size_t)(k0 + kk + 32) * Ns + ns0 + c4); }
            tile[kk * 65 + c4 + 0] = v0[0]; tile[kk * 65 + c4 + 1] = v0[1]; tile[kk * 65 + c4 + 2] = v0[2]; tile[kk * 65 + c4 + 3] = v0[3];
            tile[(kk + 32) * 65 + c4 + 0] = v1[0]; tile[(kk + 32) * 65 + c4 + 1] = v1[1]; tile[(kk + 32) * 65 + c4 + 2] = v1[2]; tile[(kk + 32) * 65 + c4 + 3] = v1[3];
            dstp[tt] = dst + (size_t)nd0 * Kd + k0; kd[tt] = Kd;
        }
        __syncthreads();
#pragma unroll
        for (int tt = 0; tt < 4; ++tt) {
            LAS float* tile = (LAS float*)L + tt * (64 * 65);
            const int nn = tid >> 3, k8 = (tid & 7) * 8; float f[8];
#pragma unroll
            for (int i = 0; i < 8; ++i) f[i] = tile[(k8 + i) * 65 + nn];
            *(u32x4*)(dstp[tt] + (size_t)nn * kd[tt] + k8) = pack8(f);
        }
    }
}

__device__ __forceinline__ void phase_norm(const int tidx, const float* xin, const float* g, const float* modl, int shoff, int scoff, bf16_t* hout) {
    const int wave = tidx >> 6, lane = tidx & 63;
    for (int row0 = (blockIdx.x * 8 + wave) * 2; row0 < MTOK; row0 += gridDim.x * 16) {
        const int b = row0 >> 12;
        f32x4 v[2][4], gg[4], sc[4], sh[4];
#pragma unroll
        for (int rr = 0; rr < 2; ++rr)
#pragma unroll
            for (int i = 0; i < 4; ++i) v[rr][i] = *(const f32x4*)(xin + (size_t)(row0 + rr) * DM + i * 256 + lane * 4);
#pragma unroll
        for (int i = 0; i < 4; ++i) { const int k = i * 256 + lane * 4;
            gg[i] = *(const f32x4*)(g + k); sc[i] = *(const f32x4*)(modl + (size_t)b * NMOD + scoff + k); sh[i] = *(const f32x4*)(modl + (size_t)b * NMOD + shoff + k); }
#pragma unroll
        for (int rr = 0; rr < 2; ++rr) {
            float ss = 0.f;
#pragma unroll
            for (int i = 0; i < 4; ++i) ss += v[rr][i][0] * v[rr][i][0] + v[rr][i][1] * v[rr][i][1] + v[rr][i][2] * v[rr][i][2] + v[rr][i][3] * v[rr][i][3];
            ss = wave_sum(ss);
            const float rinv = rsqrtf(ss * (1.f / DM) + 1e-6f);
#pragma unroll
            for (int i = 0; i < 4; ++i) { const int k = i * 256 + lane * 4;
                const f32x4 y = v[rr][i] * rinv * gg[i] * (sc[i] + 1.f) + sh[i];
                u32x2 w; w.x = pk2(y[0], y[1]); w.y = pk2(y[2], y[3]);
                *(u32x2*)(hout + (size_t)(row0 + rr) * DM + k) = w; }
        }
    }
}
__device__ __forceinline__ void phase_final(const int tidx, float* x, const float* g) {
    const int wave = tidx >> 6, lane = tidx & 63;
    for (int row0 = (blockIdx.x * 8 + wave) * 2; row0 < MTOK; row0 += gridDim.x * 16) {
        f32x4 v[2][4], gg[4];
#pragma unroll
        for (int rr = 0; rr < 2; ++rr)
#pragma unroll
            for (int i = 0; i < 4; ++i) v[rr][i] = *(const f32x4*)(x + (size_t)(row0 + rr) * DM + i * 256 + lane * 4);
#pragma unroll
        for (int i = 0; i < 4; ++i) gg[i] = *(const f32x4*)(g + i * 256 + lane * 4);
#pragma unroll
        for (int rr = 0; rr < 2; ++rr) {
            float ss = 0.f;
#pragma unroll
            for (int i = 0; i < 4; ++i) ss += v[rr][i][0] * v[rr][i][0] + v[rr][i][1] * v[rr][i][1] + v[rr][i][2] * v[rr][i][2] + v[rr][i][3] * v[rr][i][3];
            ss = wave_sum(ss);
            const float rinv = rsqrtf(ss * (1.f / DM) + 1e-6f);
#pragma unroll
            for (int i = 0; i < 4; ++i) *(f32x4*)(x + (size_t)(row0 + rr) * DM + i * 256 + lane * 4) = v[rr][i] * rinv * gg[i];
        }
    }
}

__device__ __forceinline__ void phase_dprep(const int tidx, const P& p, int l, LAS unsigned char* L) {
    LAS bf16_t* Qn = (LAS bf16_t*)(L + 0);
    LAS bf16_t* Kn = (LAS bf16_t*)(L + 17408);
    LAS bf16_t* KbgT = (LAS bf16_t*)(L + 34816);
    LAS bf16_t* KtlT = (LAS bf16_t*)(L + 53248);
    LAS bf16_t* VbT = (LAS bf16_t*)(L + 71680);
    LAS float* Lm = (LAS float*)(L + 90112);
    LAS bf16_t* Tm = (LAS bf16_t*)(L + 107520);
    LAS bf16_t* QKm = (LAS bf16_t*)(L + 116736);
    LAS float* gcs = (LAS float*)(L + 125952);
    LAS float* betas = gcs + 64;
    LAS float* cwl = (LAS float*)(L + LDS_CW_OFF);
    LAS float* Tf = (LAS float*)(L + LDS_TF_OFF);
    const bf16_t* proj = (const bf16_t*)(p.ws + WS_PROJ);
    float* alast = (float*)(p.ws + WS_ALAST);
    u32x4 rawA[7], rawB[7]; float cwreg[4], alpha_r = 0.f, beta_r = 0.f;
#define DP_ISSUE(it_, tid_) do { const int h_ = (it_) & 3, n_ = ((it_) >> 2) & 63, t0_ = ((it_) >> 8) * SEQ + n_ * 64; \
        const int tk0_ = (((tid_) >> 4) & 15) * 4, d0_ = ((tid_) & 15) * 8; \
        _Pragma("unroll") for (int rr = 0; rr < 7; ++rr) { const int pos = n_ * 64 + tk0_ - 3 + rr; \
            rawA[rr] = (u32x4){0u, 0u, 0u, 0u}; rawB[rr] = (u32x4){0u, 0u, 0u, 0u}; \
            if (pos >= 0) { const bf16_t* pr = proj + (size_t)(t0_ + tk0_ - 3 + rr) * NINP + 1280 + h_ * 128 + d0_; \
                rawA[rr] = *(const u32x4*)(pr + ((tid_) >> 8) * 512); \
                if ((tid_) < 256) rawB[rr] = *(const u32x4*)(pr + 1024); } } \
        if ((tid_) < 384) { _Pragma("unroll") for (int j = 0; j < 4; ++j) cwreg[j] = p.dn_conv_w[(size_t)(l * 4 + j) * 1536 + ((tid_) >> 7) * 512 + h_ * 128 + ((tid_) & 127)]; } \
        if (((tid_) >> 6) == 7) { const bf16_t* pr = proj + (size_t)(t0_ + ((tid_) & 63)) * NINP; alpha_r = bf2f(pr[3328 + h_]); beta_r = bf2f(pr[3332 + h_]); } } while (0)
    if ((int)blockIdx.x < 1024) DP_ISSUE((int)blockIdx.x, tidx);
    for (int item = blockIdx.x; item < 1024; item += gridDim.x) {
        __syncthreads();
        int tid = tidx; asm volatile("" : "+v"(tid));
        const int lane = tid & 63, wave = tid >> 6, r = lane & 15, q = lane >> 4;
        const int h = item & 3, n = (item >> 2) & 63, b = item >> 8;
        const int t0 = b * SEQ + n * 64;
        unsigned char* itp = p.ws + WS_DELTA + (size_t)item * ITEM_BYTES;
        const int run = (tid >> 4) & 15, d0 = (tid & 15) * 8, tk0 = run * 4, whichA = tid >> 8;
        if (tid < 384) {
#pragma unroll
            for (int j = 0; j < 4; ++j) cwl[j * 384 + tid] = cwreg[j];
        }
        if (wave == 7) {
            const float xx = alpha_r + p.dn_dt_bias[l * 4 + h];
            const float sp = fmaxf(xx, 0.f) + log1pf(__expf(-fabsf(xx)));
            float gc = -__expf(p.dn_a_log[l * 4 + h]) * sp;
#pragma unroll
            for (int o = 1; o < 64; o <<= 1) { const float tv = __shfl_up(gc, o); if (lane >= o) gc += tv; }
            gcs[lane] = gc; betas[lane] = sigmoid_f(beta_r);
        }
        __syncthreads();
        const float gl = gcs[63];
#pragma unroll
        for (int pass = 0; pass < 2; ++pass) {
            if (pass == 1 && tid >= 256) break;
            const int which = pass ? 2 : whichA;
            const LAS float* cw = cwl + which * 128 + d0;
            float y[4][8];
#pragma unroll
            for (int i = 0; i < 4; ++i)
#pragma unroll
                for (int d = 0; d < 8; ++d) y[i][d] = 0.f;
#pragma unroll
            for (int j = 0; j < 4; ++j) {
                const f32x4 w0 = *(const LAS f32x4*)(cw + j * 384), w1 = *(const LAS f32x4*)(cw + j * 384 + 4);
#pragma unroll
                for (int i = 0; i < 4; ++i) { float rf[8]; unpack8(pass ? rawB[i + j] : rawA[i + j], rf);
#pragma unroll
                    for (int d = 0; d < 4; ++d) { y[i][d] += w0[d] * rf[d]; y[i][4 + d] += w1[d] * rf[4 + d]; } }
            }
#pragma unroll
            for (int i = 0; i < 4; ++i) {
#pragma unroll
                for (int d = 0; d < 8; ++d) y[i][d] = silu_f(y[i][d]);
                if (which < 2) {
                    float ss = 0.f;
#pragma unroll
                    for (int d = 0; d < 8; ++d) ss += y[i][d] * y[i][d];
                    ss += __shfl_xor(ss, 1); ss += __shfl_xor(ss, 2); ss += __shfl_xor(ss, 4); ss += __shfl_xor(ss, 8);
                    float rinv = rsqrtf(ss + 1e-6f);
                    if (which == 0) rinv *= 0.08838834764831845f;
#pragma unroll
                    for (int d = 0; d < 8; ++d) y[i][d] *= rinv;
                }
            }
            if (which == 0) {
#pragma unroll
                for (int i = 0; i < 4; ++i) *(LAS u32x4*)(Qn + (tk0 + i) * 136 + d0) = pack8(y[i]);
            } else if (which == 1) {
                float f1[4], f2[4];
#pragma unroll
                for (int i = 0; i < 4; ++i) { const float gc = gcs[tk0 + i]; f1[i] = betas[tk0 + i] * __expf(gc); f2[i] = __expf(gl - gc); }
#pragma unroll
                for (int i = 0; i < 4; ++i) *(LAS u32x4*)(Kn + (tk0 + i) * 136 + d0) = pack8(y[i]);
#pragma unroll
                for (int d = 0; d < 8; ++d) {
                    u32x2 a, c; a.x = pk2(y[0][d] * f1[0], y[1][d] * f1[1]); a.y = pk2(y[2][d] * f1[2], y[3][d] * f1[3]); c.x = pk2(y[0][d] * f2[0], y[1][d] * f2[1]); c.y = pk2(y[2][d] * f2[2], y[3][d] * f2[3]);
                    *(LAS u32x2*)(KbgT + (d0 + d) * 72 + tk0) = a; *(LAS u32x2*)(KtlT + (d0 + d) * 72 + tk0) = c; }
            } else {
                float bt[4];
#pragma unroll
                for (int i = 0; i < 4; ++i) bt[i] = betas[tk0 + i];
#pragma unroll
                for (int d = 0; d < 8; ++d) { u32x2 a; a.x = pk2(y[0][d] * bt[0], y[1][d] * bt[1]); a.y = pk2(y[2][d] * bt[2], y[3][d] * bt[3]);
                    *(LAS u32x2*)(VbT + (d0 + d) * 72 + tk0) = a; }
            }
        }
        if (item + (int)gridDim.x < 1024) DP_ISSUE(item + (int)gridDim.x, tid);
        __syncthreads();
        {
            const int mat = wave >> 2, cb = wave & 3;
            LAS bf16_t* Asrc = mat ? Qn : Kn;
            bf16x8 a[4];
#pragma unroll
            for (int kb = 0; kb < 4; ++kb) a[kb] = *(LAS bf16x8*)(Asrc + (16 * cb + r) * 136 + 32 * kb + 8 * q);
#pragma unroll
            for (int sb = 0; sb < 4; ++sb) {
                f32x4 acc = {0.f, 0.f, 0.f, 0.f};
                if (sb <= cb) {
#pragma unroll
                    for (int kb = 0; kb < 4; ++kb) { const bf16x8 bb = *(LAS bf16x8*)(Kn + (16 * sb + r) * 136 + 32 * kb + 8 * q); acc = MFMA16(a[kb], bb, acc); }
                }
                const int s = 16 * sb + r; const float gs = gcs[s];
#pragma unroll
                for (int j = 0; j < 4; ++j) { const int c = 16 * cb + 4 * q + j; const float dec = __expf(gcs[c] - gs);
                    if (mat == 0) Lm[c * 68 + s] = (s < c) ? acc[j] * betas[c] * dec : 0.f;
                    else QKm[c * 72 + s] = f2bf((s <= c) ? acc[j] * dec : 0.f); }
            }
        }
        __syncthreads();
        if (wave < 4) {
            const int blk = wave, c = lane & 15;
            int zoff; asm volatile("v_mov_b32 %0, 0" : "=v"(zoff));
            LAS float* Lb = Lm + (16 * blk) * 68 + 16 * blk + zoff;
            float t[16];
            f32x4 rb[2][4];
            t[0] = (c == 0) ? 1.f : 0.f;
            rb[1][0] = *(LAS f32x4*)(Lb + 1 * 68);
#pragma unroll
            for (int i = 1; i < 16; ++i) {
                if (i + 1 < 16) {
#pragma unroll
                    for (int j4 = 0; j4 < (i + 4) / 4; ++j4) rb[(i + 1) & 1][j4] = *(LAS f32x4*)(Lb + (i + 1) * 68 + 4 * j4);
                }
                __builtin_amdgcn_sched_barrier(0);
                float acc0 = (i == c) ? 1.f : 0.f, acc1 = 0.f;
#pragma unroll
                for (int j = 0; j < i; ++j) { if (j & 1) acc1 -= rb[i & 1][j >> 2][j & 3] * t[j]; else acc0 -= rb[i & 1][j >> 2][j & 3] * t[j]; }
                t[i] = acc0 + acc1;
                __builtin_amdgcn_sched_barrier(0);
            }
            if (q == 0) {
#pragma unroll
                for (int i = 0; i < 16; ++i) { Tf[(16 * blk + i) * 68 + 16 * blk + c] = t[i]; Tm[(16 * blk + i) * 72 + 16 * blk + c] = f2bf(t[i]); }
            }
            for (int cb = blk + 1; cb < 4; ++cb) {
#pragma unroll
                for (int jj = 0; jj < 4; ++jj) Tm[(16 * blk + 4 * q + jj) * 72 + 16 * cb + r] = (bf16_t)0;
            }
        } else {
            if (wave == 4 && lane == 0) alast[item] = __expf(gl);
            for (int jb = wave - 4; jb < 40; jb += 4) {
                if (jb < 16) {
                    const int tb = jb >> 2, kb = jb & 3, tok = 16 * tb + r;
                    const u32x2 lo = *(LAS u32x2*)(Qn + tok * 136 + 32 * kb + 4 * q), hi = *(LAS u32x2*)(Qn + tok * 136 + 32 * kb + 16 + 4 * q);
                    const float e = __expf(gcs[tok]);
                    u32x4 w; w.x = pk2(lo16(lo.x) * e, hi16(lo.x) * e); w.y = pk2(lo16(lo.y) * e, hi16(lo.y) * e); w.z = pk2(lo16(hi.x) * e, hi16(hi.x) * e); w.w = pk2(lo16(hi.y) * e, hi16(hi.y) * e);
                    *(u32x4*)(itp + OFF_Q + (size_t)(jb * 64 + lane) * 16) = w;
                } else if (jb < 32) {
                    const int f = jb - 16, db = f >> 1, kb = f & 1, dk = 16 * db + r;
                    const u32x2 lo = *(LAS u32x2*)(KtlT + dk * 72 + 32 * kb + 4 * q), hi = *(LAS u32x2*)(KtlT + dk * 72 + 32 * kb + 16 + 4 * q);
                    u32x4 w; w.x = lo.x; w.y = lo.y; w.z = hi.x; w.w = hi.y;
                    *(u32x4*)(itp + OFF_KT + (size_t)(f * 64 + lane) * 16) = w;
                } else {
                    const int f = jb - 32, tb = f >> 1, kb = f & 1, tok = 16 * tb + r;
                    const u32x2 lo = *(LAS u32x2*)(QKm + tok * 72 + 32 * kb + 4 * q), hi = *(LAS u32x2*)(QKm + tok * 72 + 32 * kb + 16 + 4 * q);
                    u32x4 w; w.x = lo.x; w.y = lo.y; w.z = hi.x; w.w = hi.y;
                    *(u32x4*)(itp + OFF_QK + (size_t)(f * 64 + lane) * 16) = w;
                }
            }
        }
        __syncthreads();
#pragma unroll
        for (int d = 1; d < 4; ++d) {
            if (wave < 4 - d) {
                const int bj = wave, bi = wave + d;
                f32x4 M = {0.f, 0.f, 0.f, 0.f};
#pragma unroll
                for (int kk = 0; kk < d; ++kk) { const int bk = bj + kk;
#pragma unroll
                    for (int s = 0; s < 4; ++s) M = __builtin_amdgcn_mfma_f32_16x16x4f32(Lm[(16 * bi + r) * 68 + 16 * bk + 4 * s + q], Tf[(16 * bk + 4 * s + q) * 68 + 16 * bj + r], M, 0, 0, 0);
                }
                f32x4 Tn = {0.f, 0.f, 0.f, 0.f};
#pragma unroll
                for (int s = 0; s < 4; ++s) Tn = __builtin_amdgcn_mfma_f32_16x16x4f32(Tf[(16 * bi + r) * 68 + 16 * bi + 4 * q + s], M[s], Tn, 0, 0, 0);
#pragma unroll
                for (int jj = 0; jj < 4; ++jj) { Tf[(16 * bi + 4 * q + jj) * 68 + 16 * bj + r] = -Tn[jj]; Tm[(16 * bi + 4 * q + jj) * 72 + 16 * bj + r] = f2bf(-Tn[jj]); }
            }
            __syncthreads();
        }
        {
            const int s = wave;
            bf16x8 vb[2];
#pragma unroll
            for (int kb = 0; kb < 2; ++kb) vb[kb] = *(LAS bf16x8*)(VbT + (16 * s + r) * 72 + 32 * kb + 8 * q);
#pragma unroll
            for (int tb = 0; tb < 4; ++tb) {
                f32x4 acc = {0.f, 0.f, 0.f, 0.f};
#pragma unroll
                for (int kb = 0; kb < 2; ++kb) { const bf16x8 a = *(LAS bf16x8*)(Tm + (16 * tb + r) * 72 + 32 * kb + 8 * q); acc = MFMA16(a, vb[kb], acc); }
                *(f32x4*)(itp + OFF_U + (size_t)((s * 4 + tb) * 64 + lane) * 16) = acc;
            }
            const int kbp = wave & 3, tbh = wave >> 2;
            bf16x8 ka[2][2];
#pragma unroll
            for (int d = 0; d < 2; ++d)
#pragma unroll
                for (int kb = 0; kb < 2; ++kb) ka[d][kb] = *(LAS bf16x8*)(KbgT + (16 * (2 * kbp + d) + r) * 72 + 32 * kb + 8 * q);
#pragma unroll
            for (int tt = 0; tt < 2; ++tt) {
                const int tb = 2 * tbh + tt;
                f32x4 a0 = {0.f, 0.f, 0.f, 0.f}, a1 = {0.f, 0.f, 0.f, 0.f};
#pragma unroll
                for (int kb = 0; kb < 2; ++kb) { const bf16x8 tf = *(LAS bf16x8*)(Tm + (16 * tb + r) * 72 + 32 * kb + 8 * q); a0 = MFMA16(ka[0][kb], tf, a0); a1 = MFMA16(ka[1][kb], tf, a1); }
                u32x4 w; w.x = pk2(a0[0], a0[1]); w.y = pk2(a0[2], a0[3]); w.z = pk2(a1[0], a1[1]); w.w = pk2(a1[2], a1[3]);
                *(u32x4*)(itp + OFF_W + (size_t)((tb * 4 + kbp) * 64 + lane) * 16) = w;
            }
        }
    }
}

__device__ __forceinline__ void mixer_a(const int tidx, const P& p, int l, int blk, int nblk) {
    const bf16_t* proj = (const bf16_t*)(p.ws + WS_PROJ); bf16_t* ycat = (bf16_t*)(p.ws + WS_YCAT);
    for (int unit = blk * 512 + tidx; unit < MTOK * 32; unit += nblk * 512) {
        const int t = unit >> 5, c0 = (unit & 31) * 8, pos = t & (SEQ - 1);
        float acc[8];
#pragma unroll
        for (int i = 0; i < 8; ++i) acc[i] = 0.f;
#pragma unroll
        for (int j = 0; j < 3; ++j) {
            if (pos - 2 + j >= 0) {
                const bf16_t* pr = proj + (size_t)(t - 2 + j) * NINP;
                float fc[8], fv[8]; unpack8(*(const u32x4*)(pr + 256 + c0), fc); unpack8(*(const u32x4*)(pr + 512 + c0), fv);
                const float* wp = p.conv_a_w + (size_t)(l * 3 + j) * 256 + c0;
                const f32x4 w0 = *(const f32x4*)wp, w1 = *(const f32x4*)(wp + 4);
#pragma unroll
                for (int i = 0; i < 4; ++i) { acc[i] += w0[i] * fc[i] * fv[i]; acc[4 + i] += w1[i] * fc[4 + i] * fv[4 + i]; }
            }
        }
        float fb[8]; unpack8(*(const u32x4*)(proj + (size_t)t * NINP + c0), fb);
#pragma unroll
        for (int i = 0; i < 8; ++i) acc[i] *= fb[i];
        *(u32x4*)(ycat + (size_t)t * DM + c0) = pack8(acc);
    }
}
__device__ __forceinline__ void mixer_b(const int tidx, const P& p, int l, int blk, int nblk, LAS unsigned char* L) {
    const bf16_t* proj = (const bf16_t*)(p.ws + WS_PROJ); bf16_t* ycat = (bf16_t*)(p.ws + WS_YCAT);
    LAS float* ut = (LAS float*)L;
    LAS float* co = (LAS float*)(L + 63488);
    const int tid = tidx, wave = tid >> 6, lane = tid & 63;
    for (int run = blk; run < MTOK / 32; run += nblk) {
        __syncthreads();
        const int t0 = run * 32, pos0 = t0 & (SEQ - 1);
        {
            u32x4 ra[4], rg[4];
#pragma unroll
            for (int it = 0; it < 4; ++it) { const int idx = tid + 512 * it, rr = idx >> 5, c0 = (idx & 31) * 8;
                ra[it] = (u32x4){0u, 0u, 0u, 0u}; rg[it] = (u32x4){0u, 0u, 0u, 0u};
                if (idx < 62 * 32 && pos0 - 30 + rr >= 0) { const bf16_t* pr = proj + (size_t)(t0 - 30 + rr) * NINP; ra[it] = *(const u32x4*)(pr + 768 + c0); rg[it] = *(const u32x4*)(pr + 1024 + c0); } }
#pragma unroll
            for (int it = 0; it < 4; ++it) { const int idx = tid + 512 * it, rr = idx >> 5, c0 = (idx & 31) * 8;
                if (idx < 62 * 32) { float fa[8], fg[8], u[8]; unpack8(ra[it], fa); unpack8(rg[it], fg);
#pragma unroll
                    for (int i = 0; i < 8; ++i) u[i] = fa[i] * sigmoid_f(fg[i]);
                    *(LAS f32x4*)(ut + rr * 256 + c0) = (f32x4){u[0], u[1], u[2], u[3]}; *(LAS f32x4*)(ut + rr * 256 + c0 + 4) = (f32x4){u[4], u[5], u[6], u[7]}; } }
        }
        __syncthreads();
        {
            const int c = tid & 255, half = tid >> 8;
            float w[31], win[46];
#pragma unroll
            for (int j = 0; j < 31; ++j) w[j] = p.conf_dw_w[(size_t)(l * 31 + j) * 256 + c];
            const float bias = p.conf_dw_b[l * 256 + c];
#pragma unroll
            for (int k = 0; k < 46; ++k) win[k] = ut[(half * 16 + k) * 256 + c];
#pragma unroll
            for (int tt = 0; tt < 16; ++tt) { float acc = bias;
#pragma unroll
                for (int j = 0; j < 31; ++j) acc += w[j] * win[tt + j];
                co[(half * 16 + tt) * 256 + c] = acc; }
        }
        __syncthreads();
#pragma unroll
        for (int i = 0; i < 4; ++i) {
            const int tl = wave * 4 + i;
            const f32x4 v = *(LAS f32x4*)(co + tl * 256 + lane * 4);
            const float mean = wave_sum(v[0] + v[1] + v[2] + v[3]) * (1.f / 256.f);
            const f32x4 d = v - mean;
            const float var = wave_sum(d[0] * d[0] + d[1] * d[1] + d[2] * d[2] + d[3] * d[3]) * (1.f / 256.f);
            const float rs = rsqrtf(var + 1e-5f);
            const f32x4 gg = *(const f32x4*)(p.conf_ln_g + l * 256 + lane * 4), bb = *(const f32x4*)(p.conf_ln_b + l * 256 + lane * 4);
            const f32x4 y = d * rs * gg + bb;
            u32x2 wv; wv.x = pk2(silu_f(y[0]), silu_f(y[1])); wv.y = pk2(silu_f(y[2]), silu_f(y[3]));
            *(u32x2*)(ycat + (size_t)(t0 + tl) * DM + 256 + lane * 4) = wv;
        }
    }
}

constexpr int SCAN_BLOCKS = 128, SCAN_BUF = 64512;
__device__ __forceinline__ void phase_scan(const int tidx, const P& p, int l, LAS unsigned char* L) {
    const int tid = tidx, lane = tid & 63, wave = tid >> 6, r = lane & 15, q = lane >> 4;
    if ((int)blockIdx.x >= SCAN_BLOCKS) {
        const int blk = blockIdx.x - SCAN_BLOCKS, nblk = gridDim.x - SCAN_BLOCKS;
        mixer_a(tidx, p, l, blk, nblk);
        mixer_b(tidx, p, l, blk, nblk, L);
        return;
    }
    const int item = blockIdx.x, xcd = item & 7, jj = item >> 3, s = jj & 7, bh = xcd * 2 + (jj >> 3), b = bh >> 2, h = bh & 3;
    const unsigned char* dl = p.ws + WS_DELTA;
    const float* alast = (const float*)(p.ws + WS_ALAST);
    float* obuf = (float*)(p.ws + WS_H);
#define SB_ __builtin_amdgcn_sched_barrier(0)
#define SCAN_COMPUTE(buf, n_) do { \
            const float al = __builtin_bit_cast(float, __builtin_amdgcn_readlane(__builtin_bit_cast(int, al_all), (n_))); \
            const LAS bf16x8* Wf = (const LAS bf16x8*)((buf) + OFF_W) + lane; const LAS bf16x8* Qf = (const LAS bf16x8*)((buf) + OFF_Q) + lane; \
            const LAS bf16x8* Kf = (const LAS bf16x8*)((buf) + OFF_KT) + lane; const LAS bf16x8* QKf = (const LAS bf16x8*)((buf) + OFF_QK) + lane; \
            const LAS f32x4* Uf = (const LAS f32x4*)((buf) + OFF_U) + lane; \
            bf16x8 g0[8], g1[8]; f32x4 Uv[4]; \
            _Pragma("unroll") for (int f = 0; f < 8; ++f) g0[f] = Wf[((f >> 1) * 4 + (f & 1)) * 64];                \
            _Pragma("unroll") for (int f = 0; f < 8; ++f) g1[f] = Wf[((f >> 1) * 4 + 2 + (f & 1)) * 64];            \
            bf16x8 Sb[4]; \
            _Pragma("unroll") for (int kb = 0; kb < 4; ++kb) { u32x4 w; w.x = pk2(S[2 * kb][0], S[2 * kb][1]); w.y = pk2(S[2 * kb][2], S[2 * kb][3]); w.z = pk2(S[2 * kb + 1][0], S[2 * kb + 1][1]); w.w = pk2(S[2 * kb + 1][2], S[2 * kb + 1][3]); \
                Sb[kb] = __builtin_bit_cast(bf16x8, w); } \
            f32x4 Pv[4], O[4]; \
            _Pragma("unroll") for (int tb = 0; tb < 4; ++tb) { Pv[tb] = (f32x4){0.f, 0.f, 0.f, 0.f}; O[tb] = (f32x4){0.f, 0.f, 0.f, 0.f}; } \
            SB_; \
            _Pragma("unroll") for (int f = 0; f < 8; ++f) Pv[f >> 1] = MFMA16(g0[f], Sb[f & 1], Pv[f >> 1]); \
            _Pragma("unroll") for (int f = 0; f < 8; ++f) g0[f] = Qf[((f >> 1) * 4 + (f & 1)) * 64]; \
            SB_; \
            _Pragma("unroll") for (int f = 0; f < 8; ++f) Pv[f >> 1] = MFMA16(g1[f], Sb[2 + (f & 1)], Pv[f >> 1]); \
            _Pragma("unroll") for (int f = 0; f < 8; ++f) g1[f] = Qf[((f >> 1) * 4 + 2 + (f & 1)) * 64]; \
            _Pragma("unroll") for (int tb = 0; tb < 4; ++tb) Uv[tb] = Uf[tb * 64]; \
            SB_; \
            _Pragma("unroll") for (int f = 0; f < 8; ++f) O[f >> 1] = MFMA16(g0[f], Sb[f & 1], O[f >> 1]); \
            _Pragma("unroll") for (int f = 0; f < 8; ++f) g0[f] = Kf[(f * 2) * 64];                                  \
            SB_; \
            _Pragma("unroll") for (int f = 0; f < 8; ++f) O[f >> 1] = MFMA16(g1[f], Sb[2 + (f & 1)], O[f >> 1]); \
            _Pragma("unroll") for (int f = 0; f < 8; ++f) g1[f] = Kf[(f * 2 + 1) * 64];                              \
            _Pragma("unroll") for (int tb = 0; tb < 4; ++tb) Pv[tb] = Uv[tb] - Pv[tb]; \
            bf16x8 Vb[2]; \
            _Pragma("unroll") for (int kb = 0; kb < 2; ++kb) { u32x4 w; w.x = pk2(Pv[2 * kb][0], Pv[2 * kb][1]); w.y = pk2(Pv[2 * kb][2], Pv[2 * kb][3]); w.z = pk2(Pv[2 * kb + 1][0], Pv[2 * kb + 1][1]); w.w = pk2(Pv[2 * kb + 1][2], Pv[2 * kb + 1][3]); \
                Vb[kb] = __builtin_bit_cast(bf16x8, w); } \
            _Pragma("unroll") for (int db = 0; db < 8; ++db) S[db] = S[db] * al; \
            SB_; \
            _Pragma("unroll") for (int f = 0; f < 8; ++f) S[f] = MFMA16(g0[f], Vb[0], S[f]); \
            _Pragma("unroll") for (int f = 0; f < 8; ++f) g0[f] = QKf[f * 64];                                        \
            SB_; \
            _Pragma("unroll") for (int f = 0; f < 8; ++f) S[f] = MFMA16(g1[f], Vb[1], S[f]); \
            SB_; \
            _Pragma("unroll") for (int f = 0; f < 8; ++f) O[f >> 1] = MFMA16(g0[f], Vb[f & 1], O[f >> 1]); \
            float* op = obuf + (size_t)(b * SEQ + (n_) * 64 + 4 * q) * 512 + h * 128 + 16 * s + r; \
            _Pragma("unroll") for (int tb = 0; tb < 4; ++tb) \
                _Pragma("unroll") for (int j = 0; j < 4; ++j) op[(size_t)(16 * tb + j) * 512] = O[tb][j]; \
        } while (0)
#define SCAN_BAR() do { asm volatile("s_waitcnt lgkmcnt(0)" ::: "memory"); __builtin_amdgcn_s_barrier(); asm volatile("" ::: "memory"); } while (0)
    LAS unsigned char* buf0 = L; LAS unsigned char* buf1 = L + SCAN_BUF;
    if (wave == 0) {
        const float al_all = alast[(b * 64 + lane) * 4 + h];
        f32x4 S[8];
#pragma unroll
        for (int i = 0; i < 8; ++i) S[i] = (f32x4){0.f, 0.f, 0.f, 0.f};
        SCAN_BAR();
#pragma unroll 1
        for (int n = 0; n < 64; n += 2) {
            SCAN_COMPUTE(buf0, n);
            SCAN_BAR();
            SCAN_COMPUTE(buf1, n + 1);
            SCAN_BAR();
        }
    } else {
        const int ct = tid - 64;
        const int off8 = (ct < 256) ? (OFF_U + s * 4096 + ct * 16) : ((ct - 256) * 16);
        const unsigned char* dlb = dl + (size_t)((b * 64) * 4 + h) * ITEM_BYTES;
        u32x4 R0[9], R1[9], R2[9], R3[9];
#define SCAN_LOAD(regs, n_) do { const int nn_ = ((n_) < 64) ? (n_) : 63; const unsigned char* itp_ = dlb + (size_t)nn_ * (4 * ITEM_BYTES); \
        _Pragma("unroll") for (int i_ = 0; i_ < 8; ++i_) regs[i_] = *(const u32x4*)(itp_ + (ct + 448 * i_) * 16); \
        regs[8] = *(const u32x4*)(itp_ + off8); __builtin_amdgcn_sched_barrier(0); } while (0)
#define SCAN_STORE(regs, buf_) do { _Pragma("unroll") for (int i_ = 0; i_ < 9; ++i_) *(LAS u32x4*)((buf_) + (ct + 448 * i_) * 16) = regs[i_]; } while (0)
        SCAN_LOAD(R0, 0); SCAN_LOAD(R1, 1); SCAN_LOAD(R2, 2); SCAN_LOAD(R3, 3);
        SCAN_STORE(R0, buf0);
        SCAN_BAR();
#pragma unroll 1
        for (int n = 0; n < 64; n += 4) {
            SCAN_LOAD(R0, n + 4); SCAN_STORE(R1, buf1); SCAN_BAR();
            SCAN_LOAD(R1, n + 5); SCAN_STORE(R2, buf0); SCAN_BAR();
            SCAN_LOAD(R2, n + 6); SCAN_STORE(R3, buf1); SCAN_BAR();
            SCAN_LOAD(R3, n + 7); SCAN_STORE(R0, buf0); SCAN_BAR();
        }
    }
#undef SCAN_COMPUTE
#undef SB_
#undef SCAN_BAR
#undef SCAN_LOAD
#undef SCAN_STORE
}

__device__ __forceinline__ void phase_onorm(const int tidx, const P& p, int l) {
    const bf16_t* proj = (const bf16_t*)(p.ws + WS_PROJ); bf16_t* ycat = (bf16_t*)(p.ws + WS_YCAT); const float* obuf = (const float*)(p.ws + WS_H);
    const int sub = tidx & 15, d0 = sub * 8;
    const f32x4 g0 = *(const f32x4*)(p.dn_norm_g + l * 128 + d0), g1 = *(const f32x4*)(p.dn_norm_g + l * 128 + d0 + 4);
    for (int unit0 = (blockIdx.x * 32 + (tidx >> 4)) * 2; unit0 < MTOK * 4; unit0 += gridDim.x * 64) {
        f32x4 o0[2], o1[2]; u32x4 zr[2];
#pragma unroll
        for (int uu = 0; uu < 2; ++uu) { const int t = (unit0 + uu) >> 2, h = (unit0 + uu) & 3;
            o0[uu] = *(const f32x4*)(obuf + (size_t)t * 512 + h * 128 + d0); o1[uu] = *(const f32x4*)(obuf + (size_t)t * 512 + h * 128 + d0 + 4);
            zr[uu] = *(const u32x4*)(proj + (size_t)t * NINP + 2816 + h * 128 + d0); }
#pragma unroll
        for (int uu = 0; uu < 2; ++uu) { const int t = (unit0 + uu) >> 2, h = (unit0 + uu) & 3;
            float ss = o0[uu][0] * o0[uu][0] + o0[uu][1] * o0[uu][1] + o0[uu][2] * o0[uu][2] + o0[uu][3] * o0[uu][3] + o1[uu][0] * o1[uu][0] + o1[uu][1] * o1[uu][1] + o1[uu][2] * o1[uu][2] + o1[uu][3] * o1[uu][3];
            ss += __shfl_xor(ss, 1); ss += __shfl_xor(ss, 2); ss += __shfl_xor(ss, 4); ss += __shfl_xor(ss, 8);
            const float rinv = rsqrtf(ss * (1.f / 128.f) + 1e-6f);
            float z[8]; unpack8(zr[uu], z);
            float y[8];
#pragma unroll
            for (int i = 0; i < 4; ++i) { y[i] = o0[uu][i] * rinv * g0[i] * silu_f(z[i]); y[4 + i] = o1[uu][i] * rinv * g1[i] * silu_f(z[4 + i]); }
            *(u32x4*)(ycat + (size_t)t * DM + 512 + h * 128 + d0) = pack8(y); }
    }
}

#define XB_TMO      128
#define XB_XCNT(j)  (256  + 64 * (j))
#define XB_XSUB(j)  (1280 + 64 * (j))
#define XB_XGEN(j)  (2304 + 64 * (j))
#define XB_TOP      3328
#define XB_TOPGEN   3392
#define XCD_BAR_WORDS 3456
#define XB_SPIN_CAP (1u << 22)
__device__ __forceinline__ unsigned xb_ld(unsigned* p)              { return __hip_atomic_load(p, __ATOMIC_RELAXED, __HIP_MEMORY_SCOPE_AGENT); }
__device__ __forceinline__ unsigned xb_add(unsigned* p, unsigned v) { return __hip_atomic_fetch_add(p, v, __ATOMIC_RELAXED, __HIP_MEMORY_SCOPE_AGENT); }
__device__ __forceinline__ unsigned xb_xcc_id() { return (unsigned)__builtin_amdgcn_s_getreg((3 << 11) | 20) & 0xFu; }
#define XB_SPIN(cond, bar) do { unsigned _sp = 0; while (cond) { __builtin_amdgcn_s_sleep(1); \
    if ((++_sp & 255u) == 0u) { if (xb_ld(&(bar)[XB_TMO])) break; if (_sp > XB_SPIN_CAP) { atomicAdd(&(bar)[XB_TMO], 1u); break; } } } } while (0)
struct XcdBarrier { unsigned* bar; unsigned x; volatile LAS unsigned* st; };
__device__ __forceinline__ XcdBarrier xcd_barrier_post(unsigned* bar, volatile LAS unsigned* st) {
    XcdBarrier b; b.bar = bar; b.x = xb_xcc_id(); b.st = st;
    if (threadIdx.x == 0) (void)xb_add(&bar[XB_XCNT(b.x)], 1u);
    return b;
}
__device__ __forceinline__ void xcd_barrier_complete(unsigned* bar, unsigned x, unsigned& nloc, unsigned& nx) {
    const unsigned G = gridDim.x * gridDim.y * gridDim.z;
    unsigned sum, cnt, mine, sp = 0u;
    for (;;) {
        sum = 0u; cnt = 0u; mine = 0u;
#pragma unroll
        for (unsigned j = 0; j < 16; ++j) { const unsigned c = xb_ld(&bar[XB_XCNT(j)]); sum += c; cnt += (c > 0u) ? 1u : 0u; mine = (j == x) ? c : mine; }
        if (sum == G) break;
        __builtin_amdgcn_s_sleep(1);
        if ((++sp & 255u) == 0u) { if (xb_ld(&bar[XB_TMO])) break; if (sp > XB_SPIN_CAP) { atomicAdd(&bar[XB_TMO], 1u); break; } }
    }
    nloc = mine > 0u ? mine : 1u; nx = cnt > 0u ? cnt : 1u;
}
__device__ __forceinline__ void xcd_barrier(const XcdBarrier& b) {
    asm volatile("s_waitcnt vmcnt(0)" ::: "memory");
    __syncthreads();
    if (threadIdx.x == 0) {
        unsigned* bar = b.bar;
        __builtin_amdgcn_s_waitcnt(0);
        unsigned nloc = b.st[0], nx = b.st[1];
        if (nloc == 0u) { xcd_barrier_complete(bar, b.x, nloc, nx); b.st[0] = nloc; b.st[1] = nx; }
        const unsigned old = xb_add(&bar[XB_XSUB(b.x)], 1u);
        const unsigned gen = old / nloc;
        if (old + 1u == (gen + 1u) * nloc) {
            __builtin_amdgcn_fence(__ATOMIC_RELEASE, "agent");
            asm volatile("s_waitcnt vmcnt(0)" ::: "memory");
            const unsigned og = xb_add(&bar[XB_TOP], 1u);
            const unsigned tg = og / nx;
            if (og + 1u == (tg + 1u) * nx) xb_add(&bar[XB_TOPGEN], 1u);
            else XB_SPIN(xb_ld(&bar[XB_TOPGEN]) == tg, bar);
            __builtin_amdgcn_fence(__ATOMIC_ACQUIRE, "agent");
            xb_add(&bar[XB_XGEN(b.x)], 1u);
            asm volatile("s_waitcnt vmcnt(0)" ::: "memory");
        } else {
            XB_SPIN(xb_ld(&bar[XB_XGEN(b.x)]) == gen, bar);
            __builtin_amdgcn_fence(__ATOMIC_ACQUIRE, "agent");
            asm volatile("s_waitcnt vmcnt(0)" ::: "memory");
        }
    }
    __syncthreads();
}

template <int KIND>
__device__ __forceinline__ void run_kind(const int tidx, const P& p, int l, LAS unsigned char* L) {
    const float* modl = (const float*)(p.ws + WS_MOD) + (size_t)l * NB * NMOD;
    bf16_t* hbuf = (bf16_t*)(p.ws + WS_H); bf16_t* ycat = (bf16_t*)(p.ws + WS_YCAT); bf16_t* proj = (bf16_t*)(p.ws + WS_PROJ);
    const float* xin = (l == 0) ? p.x : p.out;
    if constexpr (KIND == 0) phase_prep(tidx, p, L);
    if constexpr (KIND == 1) phase_norm(tidx, xin, p.norm_mix_g + l * DM, modl, 0, DM, hbuf);
    if constexpr (KIND == 2) { pg8::Gemm g{hbuf, (const bf16_t*)(p.ws + WS_WIN) + (size_t)l * NINP * DM, MTOK, NINP, DM}; pg8::StaticOrder S; S.init(MTOK, NINP, gridDim.x, blockIdx.x);
        pg8::EpiProj E{proj, NINP}; pg8::gemm_phase<pg8::EpiProj>(tidx, L, g, S, E); }
    if constexpr (KIND == 3) phase_dprep(tidx, p, l, L);
    if constexpr (KIND == 4) phase_scan(tidx, p, l, L);
    if constexpr (KIND == 5) phase_onorm(tidx, p, l);
    if constexpr (KIND == 6) { pg8::Gemm g{ycat, (const bf16_t*)(p.ws + WS_WOUT) + (size_t)l * DM * DM, MTOK, DM, DM}; pg8::StaticOrder S; S.init(MTOK, DM, gridDim.x, blockIdx.x);
        pg8::EpiResid E{xin, p.out, modl + 2 * DM}; pg8::gemm_phase<pg8::EpiResid>(tidx, L, g, S, E); }
    if constexpr (KIND == 7) phase_norm(tidx, p.out, p.norm_ffn_g + l * DM, modl, 3 * DM, 4 * DM, hbuf);
    if constexpr (KIND == 8) { pg8::Gemm g{hbuf, (const bf16_t*)(p.ws + WS_WF1) + (size_t)l * NF1 * DM, MTOK, NF1, DM}; pg8::StaticOrder S; S.init(MTOK, NF1, gridDim.x, blockIdx.x);
        pg8::EpiSwiGLU E{proj}; pg8::gemm_phase<pg8::EpiSwiGLU>(tidx, L, g, S, E); }
    if constexpr (KIND == 9) { pg8::Gemm g{proj, (const bf16_t*)(p.ws + WS_WF2) + (size_t)l * DM * DFF, MTOK, DM, DFF}; pg8::StaticOrder S; S.init(MTOK, DM, gridDim.x, blockIdx.x);
        pg8::EpiResid E{p.out, p.out, modl + 5 * DM}; pg8::gemm_phase<pg8::EpiResid>(tidx, L, g, S, E); }
    if constexpr (KIND == 10) phase_final(tidx, p.out, p.final_norm_g);
}
__host__ __device__ inline void phase_decode(int ph, int& kind, int& l) {
    if (ph == 0) { kind = 0; l = 0; } else if (ph == NPH - 1) { kind = 10; l = 0; } else { l = (ph - 1) / 9; kind = 1 + (ph - 1) % 9; }
}

#if ONE_LAUNCH
__global__ void __launch_bounds__(512, 2) hymba_fwd(P p) {
    extern __shared__ __attribute__((aligned(16))) unsigned char lds_raw[];
    LAS unsigned char* L = (LAS unsigned char*)lds_raw;
    cg::grid_group grid = cg::this_grid();
    if (threadIdx.x < 16) ((LAS unsigned*)(L + LDS_BAR_OFF))[threadIdx.x] = 0u;
    __syncthreads();
    const XcdBarrier bar = xcd_barrier_post((unsigned*)(p.ws + WS_BAR), (volatile LAS unsigned*)(L + LDS_BAR_OFF));
    for (int ph = p.ph_lo; ph < p.ph_hi; ++ph) {
        if (ph == p.ph_lo + 1) grid.sync();
        else if (ph > p.ph_lo + 1) xcd_barrier(bar);
        int kind, l; phase_decode(ph, kind, l);
        int tidx = threadIdx.x; asm volatile("" : "+v"(tidx));
#if REPEAT_MASK
        if ((REPEAT_MASK >> kind) & 1) {
            switch (kind) { case 1: run_kind<1>(tidx, p, l, L); break; case 2: run_kind<2>(tidx, p, l, L); break; case 3: run_kind<3>(tidx, p, l, L); break; case 4: run_kind<4>(tidx, p, l, L); break;
                case 5: run_kind<5>(tidx, p, l, L); break; case 7: run_kind<7>(tidx, p, l, L); break; case 8: run_kind<8>(tidx, p, l, L); break; default: break; }
            __syncthreads();
        }
#endif
        switch (kind) {
        case 0: run_kind<0>(tidx, p, l, L); break; case 1: run_kind<1>(tidx, p, l, L); break; case 2: run_kind<2>(tidx, p, l, L); break; case 3: run_kind<3>(tidx, p, l, L); break;
        case 4: run_kind<4>(tidx, p, l, L); break; case 5: run_kind<5>(tidx, p, l, L); break; case 6: run_kind<6>(tidx, p, l, L); break; case 7: run_kind<7>(tidx, p, l, L); break;
        case 8: run_kind<8>(tidx, p, l, L); break; case 9: run_kind<9>(tidx, p, l, L); break; default: run_kind<10>(tidx, p, l, L); break;
        }
    }
}
#define LAUNCH_FN(kind) ((const void*)hymba_fwd)
#else
template <int KIND> __global__ void __launch_bounds__(512, 2) hymba_ph(P p) {
    extern __shared__ __attribute__((aligned(16))) unsigned char lds_raw[];
    run_kind<KIND>((int)threadIdx.x, p, p.ph_hi, (LAS unsigned char*)lds_raw);
}
static const void* ph_fn(int kind) {
    switch (kind) { case 0: return (const void*)hymba_ph<0>; case 1: return (const void*)hymba_ph<1>; case 2: return (const void*)hymba_ph<2>; case 3: return (const void*)hymba_ph<3>;
        case 4: return (const void*)hymba_ph<4>; case 5: return (const void*)hymba_ph<5>; case 6: return (const void*)hymba_ph<6>; case 7: return (const void*)hymba_ph<7>;
        case 8: return (const void*)hymba_ph<8>; case 9: return (const void*)hymba_ph<9>; default: return (const void*)hymba_ph<10>; }
}
#define LAUNCH_FN(kind) ph_fn(kind)
#endif

extern "C" void kernel_launch(void* const* d_in, const int* in_sizes, int n_in, void* d_out, int out_size, void* d_ws, size_t ws_size, hipStream_t stream) {
    static int grid = 0;
    if (grid == 0) {
        if (n_in != 20 || out_size != MTOK * DM || ws_size < WS_END) { fprintf(stderr, "kernel_launch: unexpected problem (n_in %d out %d ws %zu need %zu)\n", n_in, out_size, ws_size, (size_t)WS_END); grid = -1; return; }
        int dev = 0, cus = 0, per_cu = 0;
        (void)hipGetDevice(&dev); (void)hipDeviceGetAttribute(&cus, hipDeviceAttributeMultiprocessorCount, dev);
        for (int k = 0; k <= 10; ++k)
            if (hipFuncSetAttribute(LAUNCH_FN(k), hipFuncAttributeMaxDynamicSharedMemorySize, LDS_BYTES) != hipSuccess) { fprintf(stderr, "kernel_launch: hipFuncSetAttribute failed\n"); grid = -1; return; }
#if ONE_LAUNCH
        if (hipOccupancyMaxActiveBlocksPerMultiprocessor(&per_cu, (const void*)hymba_fwd, 512, LDS_BYTES) != hipSuccess || per_cu < 1) { fprintf(stderr, "kernel_launch: occupancy query failed (%d)\n", per_cu); (void)hipGetLastError(); per_cu = 1; }
#else
        per_cu = 1;
#endif
        grid = cus * per_cu;
        if (grid < SCAN_BLOCKS + 32) { fprintf(stderr, "kernel_launch: grid %d too small\n", grid); grid = -1; return; }
    }
    if (grid < 0) return;
    P p{};
    const float** pp = (const float**)&p;
    for (int i = 0; i < 20; ++i) pp[i] = (const float*)d_in[i];
    p.out = (float*)d_out; p.ws = (unsigned char*)d_ws;
#if ONE_LAUNCH
    p.ph_lo = 0; p.ph_hi = NPH;
    if (hipMemsetAsync((unsigned char*)d_ws + WS_BAR, 0, 16384, stream) != hipSuccess) { fprintf(stderr, "kernel_launch: memset of the barrier words failed\n"); return; }
    void* args[] = {&p};
    hipError_t e = hipLaunchCooperativeKernel((const void*)hymba_fwd, dim3(grid), dim3(512), args, LDS_BYTES, stream);
    if (e != hipSuccess) fprintf(stderr, "cooperative launch failed: %s (grid %d)\n", hipGetErrorString(e), grid);
#else
    for (int ph = 0; ph < NPH; ++ph) { int kind, l; phase_decode(ph, kind, l); p.ph_lo = kind; p.ph_hi = l; void* args[] = {&p};
        (void)hipLaunchKernel(ph_fn(kind), dim3(grid), dim3(512), args, LDS_BYTES, stream); }
#endif
}
```

```cpp
#include <hip/hip_runtime.h>
#include <hip/hip_cooperative_groups.h>
#include <cstdio>
namespace cg = cooperative_groups;

#ifndef ONE_LAUNCH
#define ONE_LAUNCH 1
#endif
#ifndef REPEAT_MASK
#define REPEAT_MASK 0
#endif

#define LAS __attribute__((address_space(3)))
typedef unsigned short bf16_t;
typedef short bf16x8 __attribute__((ext_vector_type(8)));
typedef float f32x4 __attribute__((ext_vector_type(4)));
typedef float f32x2 __attribute__((ext_vector_type(2)));
typedef unsigned u32x4 __attribute__((ext_vector_type(4)));
typedef unsigned u32x2 __attribute__((ext_vector_type(2)));
typedef __bf16 nbf16x2 __attribute__((ext_vector_type(2)));

constexpr int MTOK = 16384, DM = 1024, NL = 4, NB = 4, SEQ = 4096;
constexpr int NIN = 3336, NINP = 3584, DFF = 2816, NF1 = 2 * DFF, NMOD = 6 * DM;
constexpr int LDS_BYTES = 131072 + 64 + 6144 + 17408, LDS_BAR_OFF = 131072, LDS_CW_OFF = 131072 + 64, LDS_TF_OFF = LDS_CW_OFF + 6144;
constexpr int NPH = 1 + 9 * NL + 1;

constexpr size_t SZ_WIN = (size_t)NL * NINP * DM * 2, SZ_WOUT = (size_t)NL * DM * DM * 2, SZ_WF1 = (size_t)NL * NF1 * DM * 2, SZ_WF2 = (size_t)NL * DM * DFF * 2;
constexpr size_t WS_WIN = 0, WS_WOUT = WS_WIN + SZ_WIN, WS_WF1 = WS_WOUT + SZ_WOUT, WS_WF2 = WS_WF1 + SZ_WF1;
constexpr size_t WS_MOD = WS_WF2 + SZ_WF2;
constexpr size_t WS_ALAST = WS_MOD + (size_t)NL * NB * NMOD * 4;
constexpr size_t WS_H = WS_ALAST + 4096;
constexpr size_t WS_YCAT = WS_H + (size_t)MTOK * DM * 2;
constexpr size_t WS_PROJ = WS_YCAT + (size_t)MTOK * DM * 2;
constexpr int ITEM_BYTES = 90112, OFF_W = 0, OFF_Q = 16384, OFF_KT = 32768, OFF_QK = 49152, OFF_U = 57344;
constexpr size_t WS_DELTA = WS_PROJ + (size_t)MTOK * NINP * 2;
constexpr size_t WS_BAR = WS_DELTA + (size_t)1024 * ITEM_BYTES;
constexpr size_t WS_END = WS_BAR + 16384;

struct P {
    const float *x, *c, *w_ada, *b_ada, *norm_mix_g, *norm_ffn_g, *w_in, *conv_a_w, *conf_dw_w, *conf_dw_b, *conf_ln_g, *conf_ln_b,
        *dn_conv_w, *dn_a_log, *dn_dt_bias, *dn_norm_g, *w_out, *w_ffn_in, *w_ffn_out, *final_norm_g;
    float* out; unsigned char* ws; int ph_lo, ph_hi;
};

__device__ __forceinline__ float bf2f(bf16_t v) { return __uint_as_float(((unsigned)v) << 16); }
__device__ __forceinline__ unsigned pk2(float a, float b) { f32x2 v = {a, b}; nbf16x2 r = __builtin_convertvector(v, nbf16x2); return __builtin_bit_cast(unsigned, r); }
__device__ __forceinline__ bf16_t f2bf(float a) { return (bf16_t)(pk2(a, 0.f) & 0xffffu); }
__device__ __forceinline__ float lo16(unsigned w) { return __uint_as_float(w << 16); }
__device__ __forceinline__ float hi16(unsigned w) { return __uint_as_float(w & 0xffff0000u); }
__device__ __forceinline__ float sigmoid_f(float v) { return __builtin_amdgcn_rcpf(1.f + __expf(-v)); }
__device__ __forceinline__ float silu_f(float v) { return v * sigmoid_f(v); }
__device__ __forceinline__ float wave_sum(float v) {
#pragma unroll
    for (int o = 32; o; o >>= 1) v += __shfl_xor(v, o);
    return v;
}
__device__ __forceinline__ void unpack8(const u32x4 w, float (&f)[8]) {
    f[0] = lo16(w.x); f[1] = hi16(w.x); f[2] = lo16(w.y); f[3] = hi16(w.y); f[4] = lo16(w.z); f[5] = hi16(w.z); f[6] = lo16(w.w); f[7] = hi16(w.w);
}
__device__ __forceinline__ u32x4 pack8(const float (&f)[8]) { u32x4 w; w.x = pk2(f[0], f[1]); w.y = pk2(f[2], f[3]); w.z = pk2(f[4], f[5]); w.w = pk2(f[6], f[7]); return w; }
#define MFMA16(a, b, c) __builtin_amdgcn_mfma_f32_16x16x32_bf16((a), (b), (c), 0, 0, 0)

namespace pg8 {
constexpr int BM = 256, BK = 64, HALF = 128, HTB = HALF * BK * 2, STAGE_BYTES = 8 * HTB, NXCD = 8, WGM = 8;
__host__ __device__ __forceinline__ int lds_byte(int r, int c) { const int st = (r >> 4) * 2 + (c >> 5), rr = r & 15, cc = c & 31, ob = rr * 64 + cc * 2; return st * 1024 + (ob ^ (((ob >> 9) & 1) << 5)); }
__host__ __device__ __forceinline__ void stage_rc(int b, int& R, int& C) { const int st = b / 1024, sb = b % 1024, swz = sb ^ (((sb >> 9) & 1) << 5); R = (st >> 1) * 16 + swz / 64; C = (st & 1) * 32 + (swz % 64) / 2; }
__host__ __device__ __forceinline__ int perm32(int rho) { const int n = rho >> 4, i = rho & 15; return 8 * (i >> 2) + 4 * n + (i & 3); }
struct Unit { int pm, pn; };
struct Gemm { const bf16_t* A; const bf16_t* Bt; int M, N, K; };
struct StaticOrder {
    int nM, nN, nwg, G, c;
    __device__ void init(int M, int N, int G_, int c_) { nM = M / BM; nN = N / BM; nwg = nM * nN; G = G_; c = c_; }
    __device__ bool next(int i, Unit& u) const {
        const long L = (long)i * G + c; if (L >= nwg) return false;
        int wgid = (int)L; { const int q = nwg / NXCD, r = nwg % NXCD, xcd = wgid % NXCD, off = wgid / NXCD; wgid = (xcd < r ? xcd * (q + 1) : r * (q + 1) + (xcd - r) * q) + off; }
        const int nig = WGM * nN, gid = wgid / nig, fm = gid * WGM, gsz = (nM - fm) < WGM ? (nM - fm) : WGM;
        u.pm = fm + ((wgid % nig) % gsz); u.pn = (wgid % nig) / gsz; return true;
    }
};

struct EpiProj {
    static constexpr bool PERM = true;
    bf16_t* O; int ldc;
    __device__ __forceinline__ void operator()(const f32x4 (&acc)[2][2][4][2], const Unit& u, int wr, int wc, int fr, int fq) const {
        const int row0 = u.pm * BM + wr * 64 + fr, col0 = u.pn * BM + wc * 32 + 8 * fq;
#pragma unroll
        for (int ai = 0; ai < 2; ++ai)
#pragma unroll
            for (int m = 0; m < 4; ++m) { bf16_t* rowp = O + (size_t)(row0 + ai * HALF + m * 16) * ldc + col0;
#pragma unroll
                for (int bj = 0; bj < 2; ++bj) { const f32x4 v0 = acc[ai][bj][m][0], v1 = acc[ai][bj][m][1];
                    u32x4 w; w.x = pk2(v0[0], v0[1]); w.y = pk2(v0[2], v0[3]); w.z = pk2(v1[0], v1[1]); w.w = pk2(v1[2], v1[3]);
                    *(u32x4*)(rowp + bj * HALF) = w; } }
    }
};
struct EpiSwiGLU {
    static constexpr bool PERM = true;
    bf16_t* O;
    __device__ __forceinline__ void operator()(const f32x4 (&acc)[2][2][4][2], const Unit& u, int wr, int wc, int fr, int fq) const {
        const int row0 = u.pm * BM + wr * 64 + fr, col0 = u.pn * HALF + wc * 32 + 8 * fq;
#pragma unroll
        for (int ai = 0; ai < 2; ++ai)
#pragma unroll
            for (int m = 0; m < 4; ++m) {
                const f32x4 g0 = acc[ai][0][m][0], g1 = acc[ai][0][m][1], u0 = acc[ai][1][m][0], u1 = acc[ai][1][m][1];
                float v[8];
#pragma unroll
                for (int i = 0; i < 4; ++i) { v[i] = silu_f(g0[i]) * u0[i]; v[4 + i] = silu_f(g1[i]) * u1[i]; }
                *(u32x4*)(O + (size_t)(row0 + ai * HALF + m * 16) * DFF + col0) = pack8(v);
            }
    }
};
struct EpiResid {
    static constexpr bool PERM = false;
    const float* base; float* out; const float* gate;
    __device__ __forceinline__ void operator()(const f32x4 (&acc)[2][2][4][2], const Unit& u, int wr, int wc, int fr, int fq) const {
        const int row0 = u.pm * BM + wr * 64 + fr, col0 = u.pn * BM + wc * 32 + 4 * fq;
        const float* gp = gate + (size_t)(u.pm >> 4) * NMOD + col0;
        f32x4 gv[2][2];
#pragma unroll
        for (int bj = 0; bj < 2; ++bj)
#pragma unroll
            for (int n = 0; n < 2; ++n) gv[bj][n] = *(const f32x4*)(gp + bj * HALF + n * 16);
#pragma unroll
        for (int ai = 0; ai < 2; ++ai) {
            f32x4 bv[4][2][2];
#pragma unroll
            for (int m = 0; m < 4; ++m) { const size_t ro = (size_t)(row0 + ai * HALF + m * 16) * DM + col0;
#pragma unroll
                for (int bj = 0; bj < 2; ++bj)
#pragma unroll
                    for (int n = 0; n < 2; ++n) bv[m][bj][n] = *(const f32x4*)(base + ro + bj * HALF + n * 16); }
#pragma unroll
            for (int m = 0; m < 4; ++m) { const size_t ro = (size_t)(row0 + ai * HALF + m * 16) * DM + col0;
#pragma unroll
                for (int bj = 0; bj < 2; ++bj)
#pragma unroll
                    for (int n = 0; n < 2; ++n) *(f32x4*)(out + ro + bj * HALF + n * 16) = bv[m][bj][n] + gv[bj][n] * acc[ai][bj][m][n]; }
        }
    }
};

template <class Epi>
__device__ __forceinline__ void gemm_phase(const int tidx, LAS unsigned char* lds, const Gemm g, const StaticOrder& S, const Epi& E) {
    const int tid = tidx, wid = __builtin_amdgcn_readfirstlane(tid >> 6), lane = tid & 63, wr = wid >> 2, wc = wid & 3, fr = lane & 15, fq = lane >> 4;
    const int K = g.K, nt = K / BK;
    unsigned voffA[2], voffB[2];
#pragma unroll
    for (int i = 0; i < 2; ++i) { int R, C; stage_rc(tid * 16 + i * 8192, R, C); const int Rb = Epi::PERM ? ((R & ~31) + perm32(R & 31)) : R;
        voffA[i] = (unsigned)(R * K + C) * 2u; voffB[i] = (unsigned)(Rb * K + C) * 2u; }
    const size_t kstep = (size_t)(BK * 2);
    const size_t hstep = (size_t)HALF * K * 2;
    const size_t tstep = 2 * hstep;
    const unsigned ldsw = (unsigned)wid * 1024u;
    const int aoff = lds_byte(wr * 64 + fr, fq * 8), boff = lds_byte(wc * 32 + fr, fq * 8);
#define PG8_SA(b, h) (((b) * 2 + (h)) * HTB)
#define PG8_SB(b, h) ((4 + (b) * 2 + (h)) * HTB)
#define PG8_STAGE(bufoff, gbase, voff) do { _Pragma("unroll") for (int _i = 0; _i < 2; ++_i) \
        __builtin_amdgcn_global_load_lds((const unsigned*)((const char*)(gbase) + (voff)[_i]), (LAS unsigned*)(lds + (bufoff) + ldsw + _i * 8192), 16, 0, 0); } while (0)
#define PG8_LDA(dst, b, h) do { _Pragma("unroll") for (int m = 0; m < 4; ++m) _Pragma("unroll") for (int k = 0; k < 2; ++k) dst[m][k] = *(const LAS bf16x8*)(lds + PG8_SA(b, h) + aoff + m * 2048 + k * 1024); } while (0)
#define PG8_LDB(dst, b, h) do { _Pragma("unroll") for (int n = 0; n < 2; ++n) _Pragma("unroll") for (int k = 0; k < 2; ++k) dst[n][k] = *(const LAS bf16x8*)(lds + PG8_SB(b, h) + boff + n * 2048 + k * 1024); } while (0)
#define PG8_MMA(ai, bj, At, Bt) do { __builtin_amdgcn_s_setprio(1); _Pragma("unroll") for (int m = 0; m < 4; ++m) _Pragma("unroll") for (int n = 0; n < 2; ++n) _Pragma("unroll") for (int k = 0; k < 2; ++k) \
        acc[ai][bj][m][n] = __builtin_amdgcn_mfma_f32_16x16x32_bf16(Bt[n][k], At[m][k], acc[ai][bj][m][n], 0, 0, 0); __builtin_amdgcn_s_setprio(0); } while (0)
#define PG8_WAIT_V(n) asm volatile("s_waitcnt vmcnt(" #n ")" ::: "memory")
#define PG8_WAIT_L(n) asm volatile("s_waitcnt lgkmcnt(" #n ")" ::: "memory")
#define PG8_BAR __builtin_amdgcn_s_barrier()
#define PG8_SCHED __builtin_amdgcn_sched_barrier(0)
    Unit cur, nxt; int ui = 0;
    if (!S.next(0, cur)) return;
    f32x4 acc[2][2][4][2];
#pragma unroll
    for (int a = 0; a < 2; ++a)
#pragma unroll
        for (int b = 0; b < 2; ++b)
#pragma unroll
            for (int m = 0; m < 4; ++m)
#pragma unroll
                for (int n = 0; n < 2; ++n) acc[a][b][m][n] = (f32x4){0.f, 0.f, 0.f, 0.f};
    bf16x8 At[4][2], B0[2][2], B1[2][2];
    const char* cA = (const char*)g.A + (size_t)cur.pm * tstep; const char* cB = (const char*)g.Bt + (size_t)cur.pn * tstep;
    PG8_STAGE(PG8_SB(0, 0), cB, voffB); PG8_STAGE(PG8_SA(0, 0), cA, voffA); PG8_STAGE(PG8_SB(0, 1), cB + hstep, voffB); PG8_STAGE(PG8_SA(0, 1), cA + hstep, voffA);
    if (wr == 1) PG8_BAR;
    PG8_WAIT_V(4); PG8_BAR;
    PG8_STAGE(PG8_SB(1, 0), cB + kstep, voffB); PG8_STAGE(PG8_SA(1, 0), cA + kstep, voffA); PG8_STAGE(PG8_SB(1, 1), cB + hstep + kstep, voffB);
    PG8_WAIT_V(6); PG8_BAR;
    for (;;) {
        const bool has_next = S.next(ui + 1, nxt);
        const char* nA = has_next ? (const char*)g.A + (size_t)nxt.pm * tstep : cA; const char* nB = has_next ? (const char*)g.Bt + (size_t)nxt.pn * tstep : cB;
        for (int t = 0; t < nt; t += 2) {
            const bool last = (t == nt - 2);
            const char* a1 = cA + (size_t)(t + 1) * kstep;
            const char* a2 = last ? nA : cA + (size_t)(t + 2) * kstep; const char* b2 = last ? nB : cB + (size_t)(t + 2) * kstep;
            const char* a3 = a2 + kstep; const char* b3 = b2 + kstep;
            PG8_LDB(B0, 0, 0); PG8_SCHED; PG8_LDA(At, 0, 0); PG8_STAGE(PG8_SA(1, 1), a1 + hstep, voffA);
            PG8_WAIT_L(8); PG8_BAR; PG8_WAIT_L(0); PG8_MMA(0, 0, At, B0); PG8_BAR; PG8_SCHED;
            PG8_LDB(B1, 0, 1); PG8_STAGE(PG8_SB(0, 0), b2, voffB);
            PG8_BAR; PG8_WAIT_L(0); PG8_MMA(0, 1, At, B1); PG8_BAR;
            PG8_LDA(At, 0, 1); PG8_STAGE(PG8_SA(0, 0), a2, voffA);
            PG8_BAR; PG8_WAIT_L(0); PG8_MMA(1, 0, At, B0); PG8_BAR; PG8_SCHED;
            PG8_STAGE(PG8_SB(0, 1), b2 + hstep, voffB);
            PG8_WAIT_V(6); PG8_BAR; PG8_MMA(1, 1, At, B1); PG8_BAR;
            PG8_LDB(B0, 1, 0); PG8_SCHED; PG8_LDA(At, 1, 0); PG8_STAGE(PG8_SA(0, 1), a2 + hstep, voffA);
            PG8_WAIT_L(8); PG8_BAR; PG8_WAIT_L(0); PG8_MMA(0, 0, At, B0); PG8_BAR; PG8_SCHED;
            PG8_LDB(B1, 1, 1); PG8_STAGE(PG8_SB(1, 0), b3, voffB);
            PG8_BAR; PG8_WAIT_L(0); PG8_MMA(0, 1, At, B1); PG8_BAR;
            PG8_LDA(At, 1, 1); PG8_STAGE(PG8_SA(1, 0), a3, voffA);
            PG8_BAR; PG8_WAIT_L(0); PG8_MMA(1, 0, At, B0); PG8_BAR; PG8_SCHED;
            PG8_STAGE(PG8_SB(1, 1), b3 + hstep, voffB);
            PG8_WAIT_V(6); PG8_BAR; PG8_MMA(1, 1, At, B1); PG8_BAR;
        }
        E(acc, cur, wr, wc, fr, fq);
        if (!has_next) break;
#pragma unroll
        for (int a = 0; a < 2; ++a)
#pragma unroll
            for (int b = 0; b < 2; ++b)
#pragma unroll
                for (int m = 0; m < 4; ++m)
#pragma unroll
                    for (int n = 0; n < 2; ++n) acc[a][b][m][n] = (f32x4){0.f, 0.f, 0.f, 0.f};
        cur = nxt; cA = nA; cB = nB; ++ui;
    }
    PG8_WAIT_V(0);
    if (wr == 0) PG8_BAR;
    PG8_BAR;
#undef PG8_SA
#undef PG8_SB
#undef PG8_STAGE
#undef PG8_LDA
#undef PG8_LDB
#undef PG8_MMA
#undef PG8_WAIT_V
#undef PG8_WAIT_L
#undef PG8_BAR
#undef PG8_SCHED
}
}

__device__ __forceinline__ void prep_transposes(const int tidx, const P& p, LAS unsigned char* L, int l0, int l1, int blk, int nblk);
__device__ __forceinline__ void phase_prep(const int tidx, const P& p, LAS unsigned char* L) {
    const int tid = tidx;
    constexpr int NADA = NL * 96, TPL = 3264, TOTAL = NADA + NL * TPL;
    float* mod = (float*)(p.ws + WS_MOD);
    for (int it = blockIdx.x; it < NADA; it += gridDim.x) {
        __syncthreads();
        {
            const int l = it / 96, n0 = (it % 96) * 64;
            LAS float* cact = (LAS float*)L;
            LAS float* red = cact + 4096;
            for (int i = tid; i < 4096; i += 512) cact[i] = silu_f(p.c[i]);
            __syncthreads();
            const int kg = tid >> 6, nn = tid & 63;
            const float* w = p.w_ada + ((size_t)l * DM + kg * 128) * NMOD + n0 + nn;
            float a0 = 0.f, a1 = 0.f, a2 = 0.f, a3 = 0.f;
#pragma unroll 8
            for (int k = 0; k < 128; ++k) { const float wv = w[(size_t)k * NMOD]; const int kk = kg * 128 + k;
                a0 += cact[kk] * wv; a1 += cact[1024 + kk] * wv; a2 += cact[2048 + kk] * wv; a3 += cact[3072 + kk] * wv; }
            red[(kg * 4 + 0) * 64 + nn] = a0; red[(kg * 4 + 1) * 64 + nn] = a1; red[(kg * 4 + 2) * 64 + nn] = a2; red[(kg * 4 + 3) * 64 + nn] = a3;
            __syncthreads();
            if (tid < 256) { const int b = tid >> 6; float s = p.b_ada[l * NMOD + n0 + nn];
#pragma unroll
                for (int k2 = 0; k2 < 8; ++k2) s += red[(k2 * 4 + b) * 64 + nn];
                mod[(size_t)(l * NB + b) * NMOD + n0 + nn] = s; }
        }
    }
    prep_transposes(tidx, p, L, 0, 1, blockIdx.x, gridDim.x);
}
__device__ __forceinline__ void prep_transposes(const int tidx, const P& p, LAS unsigned char* L, int l0, int l1, int blk, int nblk) {
    const int tid = tidx;
    constexpr int TPL = 3264;
    for (int it0 = l0 * TPL + blk * 4; it0 < l1 * TPL; it0 += nblk * 4) {
        __syncthreads();
        bf16_t* dstp[4]; int kd[4];
#pragma unroll
        for (int tt = 0; tt < 4; ++tt) {
            const int j = it0 + tt, l = j / TPL; int r = j % TPL;
            const float* src; bf16_t* dst; int Ns, Nvalid, Kd, k0, ns0, nd0;
            if (r < 896) { const int kt = r / 56, nt = r % 56; src = p.w_in + (size_t)l * DM * NIN; Ns = NIN; Nvalid = NIN; Kd = DM; k0 = kt * 64; nd0 = nt * 64; ns0 = nd0;
                dst = (bf16_t*)(p.ws + WS_WIN) + (size_t)l * NINP * DM; }
            else if (r < 1152) { r -= 896; const int kt = r / 16, nt = r % 16; src = p.w_out + (size_t)l * DM * DM; Ns = DM; Nvalid = DM; Kd = DM; k0 = kt * 64; nd0 = nt * 64; ns0 = nd0;
                dst = (bf16_t*)(p.ws + WS_WOUT) + (size_t)l * DM * DM; }
            else if (r < 2560) { r -= 1152; const int kt = r / 88, nt = r % 88; src = p.w_ffn_in + (size_t)l * DM * NF1; Ns = NF1; Nvalid = NF1; Kd = DM; k0 = kt * 64; nd0 = nt * 64;
                const int pn = nd0 >> 8, half = (nd0 >> 7) & 1, sub = nd0 & 127; ns0 = half * DFF + pn * 128 + sub;
                dst = (bf16_t*)(p.ws + WS_WF1) + (size_t)l * NF1 * DM; }
            else { r -= 2560; const int kt = r / 16, nt = r % 16; src = p.w_ffn_out + (size_t)l * DFF * DM; Ns = DM; Nvalid = DM; Kd = DFF; k0 = kt * 64; nd0 = nt * 64; ns0 = nd0;
                dst = (bf16_t*)(p.ws + WS_WF2) + (size_t)l * DM * DFF; }
            LAS float* tile = (LAS float*)L + tt * (64 * 65);
            const int kk = tid >> 4, c4 = (tid & 15) * 4;
            f32x4 v0 = {0.f, 0.f, 0.f, 0.f}, v1 = {0.f, 0.f, 0.f, 0.f};
            if (ns0 + c4 < Nvalid) { v0 = *(const f32x4*)(src + (size_t)(k0 + kk) * Ns + ns0 + c4); v1 = *(const f32x4*)(src + (size_t)(k0 + kk + 32) * Ns + ns0 + c4); }
            tile[kk * 65 + c4 + 0] = v0[0]; tile[kk * 65 + c4 + 1] = v0[1]; tile[kk * 65 + c4 + 2] = v0[2]; tile[kk * 65 + c4 + 3] = v0[3];
            tile[(kk + 32) * 65 + c4 + 0] = v1[0]; tile[(kk + 32) * 65 + c4 + 1] = v1[1]; tile[(kk + 32) * 65 + c4 + 2] = v1[2]; tile[(kk + 32) * 65 + c4 + 3] = v1[3];
            dstp[tt] = dst + (size_t)nd0 * Kd + k0; kd[tt] = Kd;
        }
        __syncthreads();
#pragma unroll
        for (int tt = 0; tt < 4; ++tt) {
            LAS float* tile = (LAS float*)L + tt * (64 * 65);
            const int nn = tid >> 3, k8 = (tid & 7) * 8; float f[8];
#pragma unroll
            for (int i = 0; i < 8; ++i) f[i] = tile[(k8 + i) * 65 + nn];
            *(u32x4*)(dstp[tt] + (size_t)nn * kd[tt] + k8) = pack8(f);
        }
    }
}

__device__ __forceinline__ void phase_norm(const int tidx, const float* xin, const float* g, const float* modl, int shoff, int scoff, bf16_t* hout) {
    const int wave = tidx >> 6, lane = tidx & 63;
    for (int row0 = (blockIdx.x * 8 + wave) * 2; row0 < MTOK; row0 += gridDim.x * 16) {
        const int b = row0 >> 12;
        f32x4 v[2][4], gg[4], sc[4], sh[4];
#pragma unroll
        for (int rr = 0; rr < 2; ++rr)
#pragma unroll
            for (int i = 0; i < 4; ++i) v[rr][i] = *(const f32x4*)(xin + (size_t)(row0 + rr) * DM + i * 256 + lane * 4);
#pragma unroll
        for (int i = 0; i < 4; ++i) { const int k = i * 256 + lane * 4;
            gg[i] = *(const f32x4*)(g + k); sc[i] = *(const f32x4*)(modl + (size_t)b * NMOD + scoff + k); sh[i] = *(const f32x4*)(modl + (size_t)b * NMOD + shoff + k); }
#pragma unroll
        for (int rr = 0; rr < 2; ++rr) {
            float ss = 0.f;
#pragma unroll
            for (int i = 0; i < 4; ++i) ss += v[rr][i][0] * v[rr][i][0] + v[rr][i][1] * v[rr][i][1] + v[rr][i][2] * v[rr][i][2] + v[rr][i][3] * v[rr][i][3];
            ss = wave_sum(ss);
            const float rinv = rsqrtf(ss * (1.f / DM) + 1e-6f);
#pragma unroll
            for (int i = 0; i < 4; ++i) { const int k = i * 256 + lane * 4;
                const f32x4 y = v[rr][i] * rinv * gg[i] * (sc[i] + 1.f) + sh[i];
                u32x2 w; w.x = pk2(y[0], y[1]); w.y = pk2(y[2], y[3]);
                *(u32x2*)(hout + (size_t)(row0 + rr) * DM + k) = w; }
        }
    }
}
__device__ __forceinline__ void phase_final(const int tidx, float* x, const float* g) {
    const int wave = tidx >> 6, lane = tidx & 63;
    for (int row0 = (blockIdx.x * 8 + wave) * 2; row0 < MTOK; row0 += gridDim.x * 16) {
        f32x4 v[2][4], gg[4];
#pragma unroll
        for (int rr = 0; rr < 2; ++rr)
#pragma unroll
            for (int i = 0; i < 4; ++i) v[rr][i] = *(const f32x4*)(x + (size_t)(row0 + rr) * DM + i * 256 + lane * 4);
#pragma unroll
        for (int i = 0; i < 4; ++i) gg[i] = *(const f32x4*)(g + i * 256 + lane * 4);
#pragma unroll
        for (int rr = 0; rr < 2; ++rr) {
            float ss = 0.f;
#pragma unroll
            for (int i = 0; i < 4; ++i) ss += v[rr][i][0] * v[rr][i][0] + v[rr][i][1] * v[rr][i][1] + v[rr][i][2] * v[rr][i][2] + v[rr][i][3] * v[rr][i][3];
            ss = wave_sum(ss);
            const float rinv = rsqrtf(ss * (1.f / DM) + 1e-6f);
#pragma unroll
            for (int i = 0; i < 4; ++i) *(f32x4*)(x + (size_t)(row0 + rr) * DM + i * 256 + lane * 4) = v[rr][i] * rinv * gg[i];
        }
    }
}

__device__ __forceinline__ void phase_dprep(const int tidx, const P& p, int l, LAS unsigned char* L) {
    LAS bf16_t* Qn = (LAS bf16_t*)(L + 0);
    LAS bf16_t* Kn = (LAS bf16_t*)(L + 17408);
    LAS bf16_t* KbgT = (LAS bf16_t*)(L + 34816);
    LAS bf16_t* KtlT = (LAS bf16_t*)(L + 53248);
    LAS bf16_t* VbT = (LAS bf16_t*)(L + 71680);
    LAS float* Lm = (LAS float*)(L + 90112);
    LAS bf16_t* Tm = (LAS bf16_t*)(L + 107520);
    LAS bf16_t* QKm = (LAS bf16_t*)(L + 116736);
    LAS float* gcs = (LAS float*)(L + 125952);
    LAS float* betas = gcs + 64;
    LAS float* cwl = (LAS float*)(L + LDS_CW_OFF);
    LAS float* Tf = (LAS float*)(L + LDS_TF_OFF);
    const bf16_t* proj = (const bf16_t*)(p.ws + WS_PROJ);
    float* alast = (float*)(p.ws + WS_ALAST);
    u32x4 rawA[7], rawB[7]; float cwreg[4], alpha_r = 0.f, beta_r = 0.f;
#define DP_ISSUE(it_, tid_) do { const int h_ = (it_) & 3, n_ = ((it_) >> 2) & 63, t0_ = ((it_) >> 8) * SEQ + n_ * 64; \
        const int tk0_ = (((tid_) >> 4) & 15) * 4, d0_ = ((tid_) & 15) * 8; \
        _Pragma("unroll") for (int rr = 0; rr < 7; ++rr) { const int pos = n_ * 64 + tk0_ - 3 + rr; \
            rawA[rr] = (u32x4){0u, 0u, 0u, 0u}; rawB[rr] = (u32x4){0u, 0u, 0u, 0u}; \
            if (pos >= 0) { const bf16_t* pr = proj + (size_t)(t0_ + tk0_ - 3 + rr) * NINP + 1280 + h_ * 128 + d0_; \
                rawA[rr] = *(const u32x4*)(pr + ((tid_) >> 8) * 512); \
                if ((tid_) < 256) rawB[rr] = *(const u32x4*)(pr + 1024); } } \
        if ((tid_) < 384) { _Pragma("unroll") for (int j = 0; j < 4; ++j) cwreg[j] = p.dn_conv_w[(size_t)(l * 4 + j) * 1536 + ((tid_) >> 7) * 512 + h_ * 128 + ((tid_) & 127)]; } \
        if (((tid_) >> 6) == 7) { const bf16_t* pr = proj + (size_t)(t0_ + ((tid_) & 63)) * NINP; alpha_r = bf2f(pr[3328 + h_]); beta_r = bf2f(pr[3332 + h_]); } } while (0)
    if ((int)blockIdx.x < 1024) DP_ISSUE((int)blockIdx.x, tidx);
    for (int item = blockIdx.x; item < 1024; item += gridDim.x) {
        __syncthreads();
        int tid = tidx; asm volatile("" : "+v"(tid));
        const int lane = tid & 63, wave = tid >> 6, r = lane & 15, q = lane >> 4;
        const int h = item & 3, n = (item >> 2) & 63, b = item >> 8;
        const int t0 = b * SEQ + n * 64;
        unsigned char* itp = p.ws + WS_DELTA + (size_t)item * ITEM_BYTES;
        const int run = (tid >> 4) & 15, d0 = (tid & 15) * 8, tk0 = run * 4, whichA = tid >> 8;
        if (tid < 384) {
#pragma unroll
            for (int j = 0; j < 4; ++j) cwl[j * 384 + tid] = cwreg[j];
        }
        if (wave == 7) {
            const float xx = alpha_r + p.dn_dt_bias[l * 4 + h];
            const float sp = fmaxf(xx, 0.f) + log1pf(__expf(-fabsf(xx)));
            float gc = -__expf(p.dn_a_log[l * 4 + h]) * sp;
#pragma unroll
            for (int o = 1; o < 64; o <<= 1) { const float tv = __shfl_up(gc, o); if (lane >= o) gc += tv; }
            gcs[lane] = gc; betas[lane] = sigmoid_f(beta_r);
        }
        __syncthreads();
        const float gl = gcs[63];
#pragma unroll
        for (int pass = 0; pass < 2; ++pass) {
            if (pass == 1 && tid >= 256) break;
            const int which = pass ? 2 : whichA;
            const LAS float* cw = cwl + which * 128 + d0;
            float y[4][8];
#pragma unroll
            for (int i = 0; i < 4; ++i)
#pragma unroll
                for (int d = 0; d < 8; ++d) y[i][d] = 0.f;
#pragma unroll
            for (int j = 0; j < 4; ++j) {
                const f32x4 w0 = *(const LAS f32x4*)(cw + j * 384), w1 = *(const LAS f32x4*)(cw + j * 384 + 4);
#pragma unroll
                for (int i = 0; i < 4; ++i) { float rf[8]; unpack8(pass ? rawB[i + j] : rawA[i + j], rf);
#pragma unroll
                    for (int d = 0; d < 4; ++d) { y[i][d] += w0[d] * rf[d]; y[i][4 + d] += w1[d] * rf[4 + d]; } }
            }
#pragma unroll
            for (int i = 0; i < 4; ++i) {
#pragma unroll
                for (int d = 0; d < 8; ++d) y[i][d] = silu_f(y[i][d]);
                if (which < 2) {
                    float ss = 0.f;
#pragma unroll
                    for (int d = 0; d < 8; ++d) ss += y[i][d] * y[i][d];
                    ss += __shfl_xor(ss, 1); ss += __shfl_xor(ss, 2); ss += __shfl_xor(ss, 4); ss += __shfl_xor(ss, 8);
                    float rinv = rsqrtf(ss + 1e-6f);
                    if (which == 0) rinv *= 0.08838834764831845f;
#pragma unroll
                    for (int d = 0; d < 8; ++d) y[i][d] *= rinv;
                }
            }
            if (which == 0) {
#pragma unroll
                for (int i = 0; i < 4; ++i) *(LAS u32x4*)(Qn + (tk0 + i) * 136 + d0) = pack8(y[i]);
            } else if (which == 1) {
                float f1[4], f2[4];
#pragma unroll
                for (int i = 0; i < 4; ++i) { const float gc = gcs[tk0 + i]; f1[i] = betas[tk0 + i] * __expf(gc); f2[i] = __expf(gl - gc); }
#pragma unroll
                for (int i = 0; i < 4; ++i) *(LAS u32x4*)(Kn + (tk0 + i) * 136 + d0) = pack8(y[i]);
#pragma unroll
                for (int d = 0; d < 8; ++d) {
                    u32x2 a, c; a.x = pk2(y[0][d] * f1[0], y[1][d] * f1[1]); a.y = pk2(y[2][d] * f1[2], y[3][d] * f1[3]); c.x = pk2(y[0][d] * f2[0], y[1][d] * f2[1]); c.y = pk2(y[2][d] * f2[2], y[3][d] * f2[3]);
                    *(LAS u32x2*)(KbgT + (d0 + d) * 72 + tk0) = a; *(LAS u32x2*)(KtlT + (d0 + d) * 72 + tk0) = c; }
            } else {
                float bt[4];
#pragma unroll
                for (int i = 0; i < 4; ++i) bt[i] = betas[tk0 + i];
#pragma unroll
                for (int d = 0; d < 8; ++d) { u32x2 a; a.x = pk2(y[0][d] * bt[0], y[1][d] * bt[1]); a.y = pk2(y[2][d] * bt[2], y[3][d] * bt[3]);
                    *(LAS u32x2*)(VbT + (d0 + d) * 72 + tk0) = a; }
            }
        }
        if (item + (int)gridDim.x < 1024) DP_ISSUE(item + (int)gridDim.x, tid);
        __syncthreads();
        {
            const int mat = wave >> 2, cb = wave & 3;
            LAS bf16_t* Asrc = mat ? Qn : Kn;
            bf16x8 a[4];
#pragma unroll
            for (int kb = 0; kb < 4; ++kb) a[kb] = *(LAS bf16x8*)(Asrc + (16 * cb + r) * 136 + 32 * kb + 8 * q);
#pragma unroll
            for (int sb = 0; sb < 4; ++sb) {
                f32x4 acc = {0.f, 0.f, 0.f, 0.f};
                if (sb <= cb) {
#pragma unroll
                    for (int kb = 0; kb < 4; ++kb) { const bf16x8 bb = *(LAS bf16x8*)(Kn + (16 * sb + r) * 136 + 32 * kb + 8 * q); acc = MFMA16(a[kb], bb, acc); }
                }
                const int s = 16 * sb + r; const float gs = gcs[s];
#pragma unroll
                for (int j = 0; j < 4; ++j) { const int c = 16 * cb + 4 * q + j; const float dec = __expf(gcs[c] - gs);
                    if (mat == 0) Lm[c * 68 + s] = (s < c) ? acc[j] * betas[c] * dec : 0.f;
                    else QKm[c * 72 + s] = f2bf((s <= c) ? acc[j] * dec : 0.f); }
            }
        }
        __syncthreads();
        if (wave < 4) {
            const int blk = wave, c = lane & 15;
            int zoff; asm volatile("v_mov_b32 %0, 0" : "=v"(zoff));
            LAS float* Lb = Lm + (16 * blk) * 68 + 16 * blk + zoff;
            float t[16];
            f32x4 rb[2][4];
            t[0] = (c == 0) ? 1.f : 0.f;
            rb[1][0] = *(LAS f32x4*)(Lb + 1 * 68);
#pragma unroll
            for (int i = 1; i < 16; ++i) {
                if (i + 1 < 16) {
#pragma unroll
                    for (int j4 = 0; j4 < (i + 4) / 4; ++j4) rb[(i + 1) & 1][j4] = *(LAS f32x4*)(Lb + (i + 1) * 68 + 4 * j4);
                }
                __builtin_amdgcn_sched_barrier(0);
                float acc0 = (i == c) ? 1.f : 0.f, acc1 = 0.f;
#pragma unroll
                for (int j = 0; j < i; ++j) { if (j & 1) acc1 -= rb[i & 1][j >> 2][j & 3] * t[j]; else acc0 -= rb[i & 1][j >> 2][j & 3] * t[j]; }
                t[i] = acc0 + acc1;
                __builtin_amdgcn_sched_barrier(0);
            }
            if (q == 0) {
#pragma unroll
                for (int i = 0; i < 16; ++i) { Tf[(16 * blk + i) * 68 + 16 * blk + c] = t[i]; Tm[(16 * blk + i) * 72 + 16 * blk + c] = f2bf(t[i]); }
            }
            for (int cb = blk + 1; cb < 4; ++cb) {
#pragma unroll
                for (int jj = 0; jj < 4; ++jj) Tm[(16 * blk + 4 * q + jj) * 72 + 16 * cb + r] = (bf16_t)0;
            }
        } else {
            if (wave == 4 && lane == 0) alast[item] = __expf(gl);
            for (int jb = wave - 4; jb < 40; jb += 4) {
                if (jb < 16) {
                    const int tb = jb >> 2, kb = jb & 3, tok = 16 * tb + r;
                    const u32x2 lo = *(LAS u32x2*)(Qn + tok * 136 + 32 * kb + 4 * q), hi = *(LAS u32x2*)(Qn + tok * 136 + 32 * kb + 16 + 4 * q);
                    const float e = __expf(gcs[tok]);
                    u32x4 w; w.x = pk2(lo16(lo.x) * e, hi16(lo.x) * e); w.y = pk2(lo16(lo.y) * e, hi16(lo.y) * e); w.z = pk2(lo16(hi.x) * e, hi16(hi.x) * e); w.w = pk2(lo16(hi.y) * e, hi16(hi.y) * e);
                    *(u32x4*)(itp + OFF_Q + (size_t)(jb * 64 + lane) * 16) = w;
                } else if (jb < 32) {
                    const int f = jb - 16, db = f >> 1, kb = f & 1, dk = 16 * db + r;
                    const u32x2 lo = *(LAS u32x2*)(KtlT + dk * 72 + 32 * kb + 4 * q), hi = *(LAS u32x2*)(KtlT + dk * 72 + 32 * kb + 16 + 4 * q);
                    u32x4 w; w.x = lo.x; w.y = lo.y; w.z = hi.x; w.w = hi.y;
                    *(u32x4*)(itp + OFF_KT + (size_t)(f * 64 + lane) * 16) = w;
                } else {
                    const int f = jb - 32, tb = f >> 1, kb = f & 1, tok = 16 * tb + r;
                    const u32x2 lo = *(LAS u32x2*)(QKm + tok * 72 + 32 * kb + 4 * q), hi = *(LAS u32x2*)(QKm + tok * 72 + 32 * kb + 16 + 4 * q);
                    u32x4 w; w.x = lo.x; w.y = lo.y; w.z = hi.x; w.w = hi.y;
                    *(u32x4*)(itp + OFF_QK + (size_t)(f * 64 + lane) * 16) = w;
                }
            }
        }
        __syncthreads();
#pragma unroll
        for (int d = 1; d < 4; ++d) {
            if (wave < 4 - d) {
                const int bj = wave, bi = wave + d;
                f32x4 M = {0.f, 0.f, 0.f, 0.f};
#pragma unroll
                for (int kk = 0; kk < d; ++kk) { const int bk = bj + kk;
#pragma unroll
                    for (int s = 0; s < 4; ++s) M = __builtin_amdgcn_mfma_f32_16x16x4f32(Lm[(16 * bi + r) * 68 + 16 * bk + 4 * s + q], Tf[(16 * bk + 4 * s + q) * 68 + 16 * bj + r], M, 0, 0, 0);
                }
                f32x4 Tn = {0.f, 0.f, 0.f, 0.f};
#pragma unroll
                for (int s = 0; s < 4; ++s) Tn = __builtin_amdgcn_mfma_f32_16x16x4f32(Tf[(16 * bi + r) * 68 + 16 * bi + 4 * q + s], M[s], Tn, 0, 0, 0);
#pragma unroll
                for (int jj = 0; jj < 4; ++jj) { Tf[(16 * bi + 4 * q + jj) * 68 + 16 * bj + r] = -Tn[jj]; Tm[(16 * bi + 4 * q + jj) * 72 + 16 * bj + r] = f2bf(-Tn[jj]); }
            }
            __syncthreads();
        }
        {
            const int s = wave;
            bf16x8 vb[2];
#pragma unroll
            for (int kb = 0; kb < 2; ++kb) vb[kb] = *(LAS bf16x8*)(VbT + (16 * s + r) * 72 + 32 * kb + 8 * q);
#pragma unroll
            for (int tb = 0; tb < 4; ++tb) {
                f32x4 acc = {0.f, 0.f, 0.f, 0.f};
#pragma unroll
                for (int kb = 0; kb < 2; ++kb) { const bf16x8 a = *(LAS bf16x8*)(Tm + (16 * tb + r) * 72 + 32 * kb + 8 * q); acc = MFMA16(a, vb[kb], acc); }
                *(f32x4*)(itp + OFF_U + (size_t)((s * 4 + tb) * 64 + lane) * 16) = acc;
            }
            const int kbp = wave & 3, tbh = wave >> 2;
            bf16x8 ka[2][2];
#pragma unroll
            for (int d = 0; d < 2; ++d)
#pragma unroll
                for (int kb = 0; kb < 2; ++kb) ka[d][kb] = *(LAS bf16x8*)(KbgT + (16 * (2 * kbp + d) + r) * 72 + 32 * kb + 8 * q);
#pragma unroll
            for (int tt = 0; tt < 2; ++tt) {
                const int tb = 2 * tbh + tt;
                f32x4 a0 = {0.f, 0.f, 0.f, 0.f}, a1 = {0.f, 0.f, 0.f, 0.f};
#pragma unroll
                for (int kb = 0; kb < 2; ++kb) { const bf16x8 tf = *(LAS bf16x8*)(Tm + (16 * tb + r) * 72 + 32 * kb + 8 * q); a0 = MFMA16(ka[0][kb], tf, a0); a1 = MFMA16(ka[1][kb], tf, a1); }
                u32x4 w; w.x = pk2(a0[0], a0[1]); w.y = pk2(a0[2], a0[3]); w.z = pk2(a1[0], a1[1]); w.w = pk2(a1[2], a1[3]);
                *(u32x4*)(itp + OFF_W + (size_t)((tb * 4 + kbp) * 64 + lane) * 16) = w;
            }
        }
    }
}

__device__ __forceinline__ void mixer_a(const int tidx, const P& p, int l, int blk, int nblk) {
    const bf16_t* proj = (const bf16_t*)(p.ws + WS_PROJ); bf16_t* ycat = (bf16_t*)(p.ws + WS_YCAT);
    for (int unit = blk * 512 + tidx; unit < MTOK * 32; unit += nblk * 512) {
        const int t = unit >> 5, c0 = (unit & 31) * 8, pos = t & (SEQ - 1);
        float acc[8];
#pragma unroll
        for (int i = 0; i < 8; ++i) acc[i] = 0.f;
#pragma unroll
        for (int j = 0; j < 3; ++j) {
            if (pos - 2 + j >= 0) {
                const bf16_t* pr = proj + (size_t)(t - 2 + j) * NINP;
                float fc[8], fv[8]; unpack8(*(const u32x4*)(pr + 256 + c0), fc); unpack8(*(const u32x4*)(pr + 512 + c0), fv);
                const float* wp = p.conv_a_w + (size_t)(l * 3 + j) * 256 + c0;
                const f32x4 w0 = *(const f32x4*)wp, w1 = *(const f32x4*)(wp + 4);
#pragma unroll
                for (int i = 0; i < 4; ++i) { acc[i] += w0[i] * fc[i] * fv[i]; acc[4 + i] += w1[i] * fc[4 + i] * fv[4 + i]; }
            }
        }
        float fb[8]; unpack8(*(const u32x4*)(proj + (size_t)t * NINP + c0), fb);
#pragma unroll
        for (int i = 0; i < 8; ++i) acc[i] *= fb[i];
        *(u32x4*)(ycat + (size_t)t * DM + c0) = pack8(acc);
    }
}
__device__ __forceinline__ void mixer_b(const int tidx, const P& p, int l, int blk, int nblk, LAS unsigned char* L) {
    const bf16_t* proj = (const bf16_t*)(p.ws + WS_PROJ); bf16_t* ycat = (bf16_t*)(p.ws + WS_YCAT);
    LAS float* ut = (LAS float*)L;
    LAS float* co = (LAS float*)(L + 63488);
    const int tid = tidx, wave = tid >> 6, lane = tid & 63;
    for (int run = blk; run < MTOK / 32; run += nblk) {
        __syncthreads();
        const int t0 = run * 32, pos0 = t0 & (SEQ - 1);
        {
            u32x4 ra[4], rg[4];
#pragma unroll
            for (int it = 0; it < 4; ++it) { const int idx = tid + 512 * it, rr = idx >> 5, c0 = (idx & 31) * 8;
                ra[it] = (u32x4){0u, 0u, 0u, 0u}; rg[it] = (u32x4){0u, 0u, 0u, 0u};
                if (idx < 62 * 32 && pos0 - 30 + rr >= 0) { const bf16_t* pr = proj + (size_t)(t0 - 30 + rr) * NINP; ra[it] = *(const u32x4*)(pr + 768 + c0); rg[it] = *(const u32x4*)(pr + 1024 + c0); } }
#pragma unroll
            for (int it = 0; it < 4; ++it) { const int idx = tid + 512 * it, rr = idx >> 5, c0 = (idx & 31) * 8;
                if (idx < 62 * 32) { float fa[8], fg[8], u[8]; unpack8(ra[it], fa); unpack8(rg[it], fg);
#pragma unroll
                    for (int i = 0; i < 8; ++i) u[i] = fa[i] * sigmoid_f(fg[i]);
                    *(LAS f32x4*)(ut + rr * 256 + c0) = (f32x4){u[0], u[1], u[2], u[3]}; *(LAS f32x4*)(ut + rr * 256 + c0 + 4) = (f32x4){u[4], u[5], u[6], u[7]}; } }
        }
        __syncthreads();
        {
            const int c = tid & 255, half = tid >> 8;
            float w[31], win[46];
#pragma unroll
            for (int j = 0; j < 31; ++j) w[j] = p.conf_dw_w[(size_t)(l * 31 + j) * 256 + c];
            const float bias = p.conf_dw_b[l * 256 + c];
#pragma unroll
            for (int k = 0; k < 46; ++k) win[k] = ut[(half * 16 + k) * 256 + c];
#pragma unroll
            for (int tt = 0; tt < 16; ++tt) { float acc = bias;
#pragma unroll
                for (int j = 0; j < 31; ++j) acc += w[j] * win[tt + j];
                co[(half * 16 + tt) * 256 + c] = acc; }
        }
        __syncthreads();
#pragma unroll
        for (int i = 0; i < 4; ++i) {
            const int tl = wave * 4 + i;
            const f32x4 v = *(LAS f32x4*)(co + tl * 256 + lane * 4);
            const float mean = wave_sum(v[0] + v[1] + v[2] + v[3]) * (1.f / 256.f);
            const f32x4 d = v - mean;
            const float var = wave_sum(d[0] * d[0] + d[1] * d[1] + d[2] * d[2] + d[3] * d[3]) * (1.f / 256.f);
            const float rs = rsqrtf(var + 1e-5f);
            const f32x4 gg = *(const f32x4*)(p.conf_ln_g + l * 256 + lane * 4), bb = *(const f32x4*)(p.conf_ln_b + l * 256 + lane * 4);
            const f32x4 y = d * rs * gg + bb;
            u32x2 wv; wv.x = pk2(silu_f(y[0]), silu_f(y[1])); wv.y = pk2(silu_f(y[2]), silu_f(y[3]));
            *(u32x2*)(ycat + (size_t)(t0 + tl) * DM + 256 + lane * 4) = wv;
        }
    }
}

constexpr int SCAN_BLOCKS = 128, SCAN_BUF = 64512;
__device__ __forceinline__ void phase_scan(const int tidx, const P& p, int l, LAS unsigned char* L) {
    const int tid = tidx, lane = tid & 63, wave = tid >> 6, r = lane & 15, q = lane >> 4;
    if ((int)blockIdx.x >= SCAN_BLOCKS) {
        const int blk = blockIdx.x - SCAN_BLOCKS, nblk = gridDim.x - SCAN_BLOCKS;
        mixer_a(tidx, p, l, blk, nblk);
        mixer_b(tidx, p, l, blk, nblk, L);
        if (l + 1 < NL) prep_transposes(tidx, p, L, l + 1, l + 2, blk, nblk);
        return;
    }
    const int item = blockIdx.x, xcd = item & 7, jj = item >> 3, s = jj & 7, bh = xcd * 2 + (jj >> 3), b = bh >> 2, h = bh & 3;
    const unsigned char* dl = p.ws + WS_DELTA;
    const float* alast = (const float*)(p.ws + WS_ALAST);
    float* obuf = (float*)(p.ws + WS_H);
#define SB_ __builtin_amdgcn_sched_barrier(0)
#define SCAN_COMPUTE(buf, n_) do { \
            const float al = __builtin_bit_cast(float, __builtin_amdgcn_readlane(__builtin_bit_cast(int, al_all), (n_))); \
            const LAS bf16x8* Wf = (const LAS bf16x8*)((buf) + OFF_W) + lane; const LAS bf16x8* Qf = (const LAS bf16x8*)((buf) + OFF_Q) + lane; \
            const LAS bf16x8* Kf = (const LAS bf16x8*)((buf) + OFF_KT) + lane; const LAS bf16x8* QKf = (const LAS bf16x8*)((buf) + OFF_QK) + lane; \
            const LAS f32x4* Uf = (const LAS f32x4*)((buf) + OFF_U) + lane; \
            bf16x8 g0[8], g1[8]; f32x4 Uv[4]; \
            _Pragma("unroll") for (int f = 0; f < 8; ++f) g0[f] = Wf[((f >> 1) * 4 + (f & 1)) * 64];                \
            _Pragma("unroll") for (int f = 0; f < 8; ++f) g1[f] = Wf[((f >> 1) * 4 + 2 + (f & 1)) * 64];            \
            bf16x8 Sb[4]; \
            _Pragma("unroll") for (int kb = 0; kb < 4; ++kb) { u32x4 w; w.x = pk2(S[2 * kb][0], S[2 * kb][1]); w.y = pk2(S[2 * kb][2], S[2 * kb][3]); w.z = pk2(S[2 * kb + 1][0], S[2 * kb + 1][1]); w.w = pk2(S[2 * kb + 1][2], S[2 * kb + 1][3]); \
                Sb[kb] = __builtin_bit_cast(bf16x8, w); } \
            f32x4 Pv[4], O[4]; \
            _Pragma("unroll") for (int tb = 0; tb < 4; ++tb) { Pv[tb] = (f32x4){0.f, 0.f, 0.f, 0.f}; O[tb] = (f32x4){0.f, 0.f, 0.f, 0.f}; } \
            SB_; \
            _Pragma("unroll") for (int f = 0; f < 8; ++f) Pv[f >> 1] = MFMA16(g0[f], Sb[f & 1], Pv[f >> 1]); \
            _Pragma("unroll") for (int f = 0; f < 8; ++f) g0[f] = Qf[((f >> 1) * 4 + (f & 1)) * 64]; \
            SB_; \
            _Pragma("unroll") for (int f = 0; f < 8; ++f) Pv[f >> 1] = MFMA16(g1[f], Sb[2 + (f & 1)], Pv[f >> 1]); \
            _Pragma("unroll") for (int f = 0; f < 8; ++f) g1[f] = Qf[((f >> 1) * 4 + 2 + (f & 1)) * 64]; \
            _Pragma("unroll") for (int tb = 0; tb < 4; ++tb) Uv[tb] = Uf[tb * 64]; \
            SB_; \
            _Pragma("unroll") for (int f = 0; f < 8; ++f) O[f >> 1] = MFMA16(g0[f], Sb[f & 1], O[f >> 1]); \
            _Pragma("unroll") for (int f = 0; f < 8; ++f) g0[f] = Kf[(f * 2) * 64];                                  \
            SB_; \
            _Pragma("unroll") for (int f = 0; f < 8; ++f) O[f >> 1] = MFMA16(g1[f], Sb[2 + (f & 1)], O[f >> 1]); \
            _Pragma("unroll") for (int f = 0; f < 8; ++f) g1[f] = Kf[(f * 2 + 1) * 64];                              \
            _Pragma("unroll") for (int tb = 0; tb < 4; ++tb) Pv[tb] = Uv[tb] - Pv[tb]; \
            bf16x8 Vb[2]; \
            _Pragma("unroll") for (int kb = 0; kb < 2; ++kb) { u32x4 w; w.x = pk2(Pv[2 * kb][0], Pv[2 * kb][1]); w.y = pk2(Pv[2 * kb][2], Pv[2 * kb][3]); w.z = pk2(Pv[2 * kb + 1][0], Pv[2 * kb + 1][1]); w.w = pk2(Pv[2 * kb + 1][2], Pv[2 * kb + 1][3]); \
                Vb[kb] = __builtin_bit_cast(bf16x8, w); } \
            _Pragma("unroll") for (int db = 0; db < 8; ++db) S[db] = S[db] * al; \
            SB_; \
            _Pragma("unroll") for (int f = 0; f < 8; ++f) S[f] = MFMA16(g0[f], Vb[0], S[f]); \
            _Pragma("unroll") for (int f = 0; f < 8; ++f) g0[f] = QKf[f * 64];                                        \
            SB_; \
            _Pragma("unroll") for (int f = 0; f < 8; ++f) S[f] = MFMA16(g1[f], Vb[1], S[f]); \
            SB_; \
            _Pragma("unroll") for (int f = 0; f < 8; ++f) O[f >> 1] = MFMA16(g0[f], Vb[f & 1], O[f >> 1]); \
            float* op = obuf + (size_t)(b * SEQ + (n_) * 64 + 4 * q) * 512 + h * 128 + 16 * s + r; \
            _Pragma("unroll") for (int tb = 0; tb < 4; ++tb) \
                _Pragma("unroll") for (int j = 0; j < 4; ++j) op[(size_t)(16 * tb + j) * 512] = O[tb][j]; \
        } while (0)
#define SCAN_BAR() do { asm volatile("s_waitcnt lgkmcnt(0)" ::: "memory"); __builtin_amdgcn_s_barrier(); asm volatile("" ::: "memory"); } while (0)
    LAS unsigned char* buf0 = L; LAS unsigned char* buf1 = L + SCAN_BUF;
    if (wave == 0) {
        const float al_all = alast[(b * 64 + lane) * 4 + h];
        f32x4 S[8];
#pragma unroll
        for (int i = 0; i < 8; ++i) S[i] = (f32x4){0.f, 0.f, 0.f, 0.f};
        SCAN_BAR();
#pragma unroll 1
        for (int n = 0; n < 64; n += 2) {
            SCAN_COMPUTE(buf0, n);
            SCAN_BAR();
            SCAN_COMPUTE(buf1, n + 1);
            SCAN_BAR();
        }
    } else {
        const int ct = tid - 64;
        const int off8 = (ct < 256) ? (OFF_U + s * 4096 + ct * 16) : ((ct - 256) * 16);
        const unsigned char* dlb = dl + (size_t)((b * 64) * 4 + h) * ITEM_BYTES;
        u32x4 R0[9], R1[9], R2[9], R3[9];
#define SCAN_LOAD(regs, n_) do { const int nn_ = ((n_) < 64) ? (n_) : 63; const unsigned char* itp_ = dlb + (size_t)nn_ * (4 * ITEM_BYTES); \
        _Pragma("unroll") for (int i_ = 0; i_ < 8; ++i_) regs[i_] = *(const u32x4*)(itp_ + (ct + 448 * i_) * 16); \
        regs[8] = *(const u32x4*)(itp_ + off8); __builtin_amdgcn_sched_barrier(0); } while (0)
#define SCAN_STORE(regs, buf_) do { _Pragma("unroll") for (int i_ = 0; i_ < 9; ++i_) *(LAS u32x4*)((buf_) + (ct + 448 * i_) * 16) = regs[i_]; } while (0)
        SCAN_LOAD(R0, 0); SCAN_LOAD(R1, 1); SCAN_LOAD(R2, 2); SCAN_LOAD(R3, 3);
        SCAN_STORE(R0, buf0);
        SCAN_BAR();
#pragma unroll 1
        for (int n = 0; n < 64; n += 4) {
            SCAN_LOAD(R0, n + 4); SCAN_STORE(R1, buf1); SCAN_BAR();
            SCAN_LOAD(R1, n + 5); SCAN_STORE(R2, buf0); SCAN_BAR();
            SCAN_LOAD(R2, n + 6); SCAN_STORE(R3, buf1); SCAN_BAR();
            SCAN_LOAD(R3, n + 7); SCAN_STORE(R0, buf0); SCAN_BAR();
        }
    }
#undef SCAN_COMPUTE
#undef SB_
#undef SCAN_BAR
#undef SCAN_LOAD
#undef SCAN_STORE
}

__device__ __forceinline__ void phase_onorm(const int tidx, const P& p, int l) {
    const bf16_t* proj = (const bf16_t*)(p.ws + WS_PROJ); bf16_t* ycat = (bf16_t*)(p.ws + WS_YCAT); const float* obuf = (const float*)(p.ws + WS_H);
    const int sub = tidx & 15, d0 = sub * 8;
    const f32x4 g0 = *(const f32x4*)(p.dn_norm_g + l * 128 + d0), g1 = *(const f32x4*)(p.dn_norm_g + l * 128 + d0 + 4);
    for (int unit0 = (blockIdx.x * 32 + (tidx >> 4)) * 2; unit0 < MTOK * 4; unit0 += gridDim.x * 64) {
        f32x4 o0[2], o1[2]; u32x4 zr[2];
#pragma unroll
        for (int uu = 0; uu < 2; ++uu) { const int t = (unit0 + uu) >> 2, h = (unit0 + uu) & 3;
            o0[uu] = *(const f32x4*)(obuf + (size_t)t * 512 + h * 128 + d0); o1[uu] = *(const f32x4*)(obuf + (size_t)t * 512 + h * 128 + d0 + 4);
            zr[uu] = *(const u32x4*)(proj + (size_t)t * NINP + 2816 + h * 128 + d0); }
#pragma unroll
        for (int uu = 0; uu < 2; ++uu) { const int t = (unit0 + uu) >> 2, h = (unit0 + uu) & 3;
            float ss = o0[uu][0] * o0[uu][0] + o0[uu][1] * o0[uu][1] + o0[uu][2] * o0[uu][2] + o0[uu][3] * o0[uu][3] + o1[uu][0] * o1[uu][0] + o1[uu][1] * o1[uu][1] + o1[uu][2] * o1[uu][2] + o1[uu][3] * o1[uu][3];
            ss += __shfl_xor(ss, 1); ss += __shfl_xor(ss, 2); ss += __shfl_xor(ss, 4); ss += __shfl_xor(ss, 8);
            const float rinv = rsqrtf(ss * (1.f / 128.f) + 1e-6f);
            float z[8]; unpack8(zr[uu], z);
            float y[8];
#pragma unroll
            for (int i = 0; i < 4; ++i) { y[i] = o0[uu][i] * rinv * g0[i] * silu_f(z[i]); y[4 + i] = o1[uu][i] * rinv * g1[i] * silu_f(z[4 + i]); }
            *(u32x4*)(ycat + (size_t)t * DM + 512 + h * 128 + d0) = pack8(y); }
    }
}

#define XB_TMO      128
#define XB_XCNT(j)  (256  + 64 * (j))
#define XB_XSUB(j)  (1280 + 64 * (j))
#define XB_XGEN(j)  (2304 + 64 * (j))
#define XB_TOP      3328
#define XB_TOPGEN   3392
#define XCD_BAR_WORDS 3456
#define XB_SPIN_CAP (1u << 22)
__device__ __forceinline__ unsigned xb_ld(unsigned* p)              { return __hip_atomic_load(p, __ATOMIC_RELAXED, __HIP_MEMORY_SCOPE_AGENT); }
__device__ __forceinline__ unsigned xb_add(unsigned* p, unsigned v) { return __hip_atomic_fetch_add(p, v, __ATOMIC_RELAXED, __HIP_MEMORY_SCOPE_AGENT); }
__device__ __forceinline__ unsigned xb_xcc_id() { return (unsigned)__builtin_amdgcn_s_getreg((3 << 11) | 20) & 0xFu; }
#define XB_SPIN(cond, bar) do { unsigned _sp = 0; while (cond) { __builtin_amdgcn_s_sleep(1); \
    if ((++_sp & 255u) == 0u) { if (xb_ld(&(bar)[XB_TMO])) break; if (_sp > XB_SPIN_CAP) { atomicAdd(&(bar)[XB_TMO], 1u); break; } } } } while (0)
struct XcdBarrier { unsigned* bar; unsigned x; volatile LAS unsigned* st; };
__device__ __forceinline__ XcdBarrier xcd_barrier_post(unsigned* bar, volatile LAS unsigned* st) {
    XcdBarrier b; b.bar = bar; b.x = xb_xcc_id(); b.st = st;
    if (threadIdx.x == 0) (void)xb_add(&bar[XB_XCNT(b.x)], 1u);
    return b;
}
__device__ __forceinline__ void xcd_barrier_complete(unsigned* bar, unsigned x, unsigned& nloc, unsigned& nx) {
    const unsigned G = gridDim.x * gridDim.y * gridDim.z;
    unsigned sum, cnt, mine, sp = 0u;
    for (;;) {
        sum = 0u; cnt = 0u; mine = 0u;
#pragma unroll
        for (unsigned j = 0; j < 16; ++j) { const unsigned c = xb_ld(&bar[XB_XCNT(j)]); sum += c; cnt += (c > 0u) ? 1u : 0u; mine = (j == x) ? c : mine; }
        if (sum == G) break;
        __builtin_amdgcn_s_sleep(1);
        if ((++sp & 255u) == 0u) { if (xb_ld(&bar[XB_TMO])) break; if (sp > XB_SPIN_CAP) { atomicAdd(&bar[XB_TMO], 1u); break; } }
    }
    nloc = mine > 0u ? mine : 1u; nx = cnt > 0u ? cnt : 1u;
}
__device__ __forceinline__ void xcd_barrier(const XcdBarrier& b) {
    asm volatile("s_waitcnt vmcnt(0)" ::: "memory");
    __syncthreads();
    if (threadIdx.x == 0) {
        unsigned* bar = b.bar;
        __builtin_amdgcn_s_waitcnt(0);
        unsigned nloc = b.st[0], nx = b.st[1];
        if (nloc == 0u) { xcd_barrier_complete(bar, b.x, nloc, nx); b.st[0] = nloc; b.st[1] = nx; }
        const unsigned old = xb_add(&bar[XB_XSUB(b.x)], 1u);
        const unsigned gen = old / nloc;
        if (old + 1u == (gen + 1u) * nloc) {
            __builtin_amdgcn_fence(__ATOMIC_RELEASE, "agent");
            asm volatile("s_waitcnt vmcnt(0)" ::: "memory");
            const unsigned og = xb_add(&bar[XB_TOP], 1u);
            const unsigned tg = og / nx;
            if (og + 1u == (tg + 1u) * nx) xb_add(&bar[XB_TOPGEN], 1u);
            else XB_SPIN(xb_ld(&bar[XB_TOPGEN]) == tg, bar);
            __builtin_amdgcn_fence(__ATOMIC_ACQUIRE, "agent");
            xb_add(&bar[XB_XGEN(b.x)], 1u);
            asm volatile("s_waitcnt vmcnt(0)" ::: "memory");
        } else {
            XB_SPIN(xb_ld(&bar[XB_XGEN(b.x)]) == gen, bar);
            __builtin_amdgcn_fence(__ATOMIC_ACQUIRE, "agent");
            asm volatile("s_waitcnt vmcnt(0)" ::: "memory");
        }
    }
    __syncthreads();
}

template <int KIND>
__device__ __forceinline__ void run_kind(const int tidx, const P& p, int l, LAS unsigned char* L) {
    const float* modl = (const float*)(p.ws + WS_MOD) + (size_t)l * NB * NMOD;
    bf16_t* hbuf = (bf16_t*)(p.ws + WS_H); bf16_t* ycat = (bf16_t*)(p.ws + WS_YCAT); bf16_t* proj = (bf16_t*)(p.ws + WS_PROJ);
    const float* xin = (l == 0) ? p.x : p.out;
    if constexpr (KIND == 0) phase_prep(tidx, p, L);
    if constexpr (KIND == 1) phase_norm(tidx, xin, p.norm_mix_g + l * DM, modl, 0, DM, hbuf);
    if constexpr (KIND == 2) { pg8::Gemm g{hbuf, (const bf16_t*)(p.ws + WS_WIN) + (size_t)l * NINP * DM, MTOK, NINP, DM}; pg8::StaticOrder S; S.init(MTOK, NINP, gridDim.x, blockIdx.x);
        pg8::EpiProj E{proj, NINP}; pg8::gemm_phase<pg8::EpiProj>(tidx, L, g, S, E); }
    if constexpr (KIND == 3) phase_dprep(tidx, p, l, L);
    if constexpr (KIND == 4) phase_scan(tidx, p, l, L);
    if constexpr (KIND == 5) phase_onorm(tidx, p, l);
    if constexpr (KIND == 6) { pg8::Gemm g{ycat, (const bf16_t*)(p.ws + WS_WOUT) + (size_t)l * DM * DM, MTOK, DM, DM}; pg8::StaticOrder S; S.init(MTOK, DM, gridDim.x, blockIdx.x);
        pg8::EpiResid E{xin, p.out, modl + 2 * DM}; pg8::gemm_phase<pg8::EpiResid>(tidx, L, g, S, E); }
    if constexpr (KIND == 7) phase_norm(tidx, p.out, p.norm_ffn_g + l * DM, modl, 3 * DM, 4 * DM, hbuf);
    if constexpr (KIND == 8) { pg8::Gemm g{hbuf, (const bf16_t*)(p.ws + WS_WF1) + (size_t)l * NF1 * DM, MTOK, NF1, DM}; pg8::StaticOrder S; S.init(MTOK, NF1, gridDim.x, blockIdx.x);
        pg8::EpiSwiGLU E{proj}; pg8::gemm_phase<pg8::EpiSwiGLU>(tidx, L, g, S, E); }
    if constexpr (KIND == 9) { pg8::Gemm g{proj, (const bf16_t*)(p.ws + WS_WF2) + (size_t)l * DM * DFF, MTOK, DM, DFF}; pg8::StaticOrder S; S.init(MTOK, DM, gridDim.x, blockIdx.x);
        pg8::EpiResid E{p.out, p.out, modl + 5 * DM}; pg8::gemm_phase<pg8::EpiResid>(tidx, L, g, S, E); }
    if constexpr (KIND == 10) phase_final(tidx, p.out, p.final_norm_g);
}
__host__ __device__ inline void phase_decode(int ph, int& kind, int& l) {
    if (ph == 0) { kind = 0; l = 0; } else if (ph == NPH - 1) { kind = 10; l = 0; } else { l = (ph - 1) / 9; kind = 1 + (ph - 1) % 9; }
}

#if ONE_LAUNCH
__global__ void __launch_bounds__(512, 2) hymba_fwd(P p) {
    extern __shared__ __attribute__((aligned(16))) unsigned char lds_raw[];
    LAS unsigned char* L = (LAS unsigned char*)lds_raw;
    cg::grid_group grid = cg::this_grid();
    if (threadIdx.x < 16) ((LAS unsigned*)(L + LDS_BAR_OFF))[threadIdx.x] = 0u;
    __syncthreads();
    const XcdBarrier bar = xcd_barrier_post((unsigned*)(p.ws + WS_BAR), (volatile LAS unsigned*)(L + LDS_BAR_OFF));
    for (int ph = p.ph_lo; ph < p.ph_hi; ++ph) {
        if (ph == p.ph_lo + 1) grid.sync();
        else if (ph > p.ph_lo + 1) xcd_barrier(bar);
        int kind, l; phase_decode(ph, kind, l);
        int tidx = threadIdx.x; asm volatile("" : "+v"(tidx));
#if REPEAT_MASK
        if ((REPEAT_MASK >> kind) & 1) {
            switch (kind) { case 1: run_kind<1>(tidx, p, l, L); break; case 2: run_kind<2>(tidx, p, l, L); break; case 3: run_kind<3>(tidx, p, l, L); break; case 4: run_kind<4>(tidx, p, l, L); break;
                case 5: run_kind<5>(tidx, p, l, L); break; case 7: run_kind<7>(tidx, p, l, L); break; case 8: run_kind<8>(tidx, p, l, L); break; default: break; }
            __syncthreads();
        }
#endif
        switch (kind) {
        case 0: run_kind<0>(tidx, p, l, L); break; case 1: run_kind<1>(tidx, p, l, L); break; case 2: run_kind<2>(tidx, p, l, L); break; case 3: run_kind<3>(tidx, p, l, L); break;
        case 4: run_kind<4>(tidx, p, l, L); break; case 5: run_kind<5>(tidx, p, l, L); break; case 6: run_kind<6>(tidx, p, l, L); break; case 7: run_kind<7>(tidx, p, l, L); break;
        case 8: run_kind<8>(tidx, p, l, L); break; case 9: run_kind<9>(tidx, p, l, L); break; default: run_kind<10>(tidx, p, l, L); break;
        }
    }
}
#define LAUNCH_FN(kind) ((const void*)hymba_fwd)
#else
template <int KIND> __global__ void __launch_bounds__(512, 2) hymba_ph(P p) {
    extern __shared__ __attribute__((aligned(16))) unsigned char lds_raw[];
    run_kind<KIND>((int)threadIdx.x, p, p.ph_hi, (LAS unsigned char*)lds_raw);
}
static const void* ph_fn(int kind) {
    switch (kind) { case 0: return (const void*)hymba_ph<0>; case 1: return (const void*)hymba_ph<1>; case 2: return (const void*)hymba_ph<2>; case 3: return (const void*)hymba_ph<3>;
        case 4: return (const void*)hymba_ph<4>; case 5: return (const void*)hymba_ph<5>; case 6: return (const void*)hymba_ph<6>; case 7: return (const void*)hymba_ph<7>;
        case 8: return (const void*)hymba_ph<8>; case 9: return (const void*)hymba_ph<9>; default: return (const void*)hymba_ph<10>; }
}
#define LAUNCH_FN(kind) ph_fn(kind)
#endif

extern "C" void kernel_launch(void* const* d_in, const int* in_sizes, int n_in, void* d_out, int out_size, void* d_ws, size_t ws_size, hipStream_t stream) {
    static int grid = 0;
    if (grid == 0) {
        if (n_in != 20 || out_size != MTOK * DM || ws_size < WS_END) { fprintf(stderr, "kernel_launch: unexpected problem (n_in %d out %d ws %zu need %zu)\n", n_in, out_size, ws_size, (size_t)WS_END); grid = -1; return; }
        int dev = 0, cus = 0, per_cu = 0;
        (void)hipGetDevice(&dev); (void)hipDeviceGetAttribute(&cus, hipDeviceAttributeMultiprocessorCount, dev);
        for (int k = 0; k <= 10; ++k)
            if (hipFuncSetAttribute(LAUNCH_FN(k), hipFuncAttributeMaxDynamicSharedMemorySize, LDS_BYTES) != hipSuccess) { fprintf(stderr, "kernel_launch: hipFuncSetAttribute failed\n"); grid = -1; return; }
#if ONE_LAUNCH
        if (hipOccupancyMaxActiveBlocksPerMultiprocessor(&per_cu, (const void*)hymba_fwd, 512, LDS_BYTES) != hipSuccess || per_cu < 1) { fprintf(stderr, "kernel_launch: occupancy query failed (%d)\n", per_cu); (void)hipGetLastError(); per_cu = 1; }
#else
        per_cu = 1;
#endif
        grid = cus * per_cu;
        if (grid < SCAN_BLOCKS + 32) { fprintf(stderr, "kernel_launch: grid %d too small\n", grid); grid = -1; return; }
    }
    if (grid < 0) return;
    P p{};
    const float** pp = (const float**)&p;
    for (int i = 0; i < 20; ++i) pp[i] = (const float*)d_in[i];
    p.out = (float*)d_out; p.ws = (unsigned char*)d_ws;
#if ONE_LAUNCH
    p.ph_lo = 0; p.ph_hi = NPH;
    if (hipMemsetAsync((unsigned char*)d_ws + WS_BAR, 0, 16384, stream) != hipSuccess) { fprintf(stderr, "kernel_launch: memset of the barrier words failed\n"); return; }
    void* args[] = {&p};
    hipError_t e = hipLaunchCooperativeKernel((const void*)hymba_fwd, dim3(grid), dim3(512), args, LDS_BYTES, stream);
    if (e != hipSuccess) fprintf(stderr, "cooperative launch failed: %s (grid %d)\n", hipGetErrorString(e), grid);
#else
    for (int ph = 0; ph < NPH; ++ph) { int kind, l; phase_decode(ph, kind, l); p.ph_lo = kind; p.ph_hi = l; void* args[] = {&p};
        (void)hipLaunchKernel(ph_fn(kind), dim3(grid), dim3(512), args, LDS_BYTES, stream); }
#endif
}
```

```cpp
#include <hip/hip_runtime.h>
#include <hip/hip_cooperative_groups.h>
#include <cstdio>
namespace cg = cooperative_groups;

#ifndef ONE_LAUNCH
#define ONE_LAUNCH 1
#endif
#ifndef REPEAT_MASK
#define REPEAT_MASK 0
#endif

#define LAS __attribute__((address_space(3)))
typedef unsigned short bf16_t;
typedef short bf16x8 __attribute__((ext_vector_type(8)));
typedef float f32x4 __attribute__((ext_vector_type(4)));
typedef float f32x2 __attribute__((ext_vector_type(2)));
typedef unsigned u32x4 __attribute__((ext_vector_type(4)));
typedef unsigned u32x2 __attribute__((ext_vector_type(2)));
typedef __bf16 nbf16x2 __attribute__((ext_vector_type(2)));

constexpr int MTOK = 16384, DM = 1024, NL = 4, NB = 4, SEQ = 4096;
constexpr int NIN = 3336, NINP = 3584, DFF = 2816, NF1 = 2 * DFF, NMOD = 6 * DM;
constexpr int LDS_BYTES = 131072 + 64 + 6144 + 17408, LDS_BAR_OFF = 131072, LDS_CW_OFF = 131072 + 64, LDS_TF_OFF = LDS_CW_OFF + 6144;
constexpr int NPH = 1 + 9 * NL + 1;

constexpr size_t SZ_WIN = (size_t)NL * NINP * DM * 2, SZ_WOUT = (size_t)NL * DM * DM * 2, SZ_WF1 = (size_t)NL * NF1 * DM * 2, SZ_WF2 = (size_t)NL * DM * DFF * 2;
constexpr size_t WS_WIN = 0, WS_WOUT = WS_WIN + SZ_WIN, WS_WF1 = WS_WOUT + SZ_WOUT, WS_WF2 = WS_WF1 + SZ_WF1;
constexpr size_t WS_MOD = WS_WF2 + SZ_WF2;
constexpr size_t WS_ALAST = WS_MOD + (size_t)NL * NB * NMOD * 4;
constexpr size_t WS_H = WS_ALAST + 4096;
constexpr size_t WS_YCAT = WS_H + (size_t)MTOK * DM * 2;
constexpr size_t WS_PROJ = WS_YCAT + (size_t)MTOK * DM * 2;
constexpr int ITEM_BYTES = 90112, OFF_W = 0, OFF_Q = 16384, OFF_KT = 32768, OFF_QK = 49152, OFF_U = 57344;
constexpr size_t WS_DELTA = WS_PROJ + (size_t)MTOK * NINP * 2;
constexpr size_t WS_BAR = WS_DELTA + (size_t)1024 * ITEM_BYTES;
constexpr size_t WS_END = WS_BAR + 16384;

struct P {
    const float *x, *c, *w_ada, *b_ada, *norm_mix_g, *norm_ffn_g, *w_in, *conv_a_w, *conf_dw_w, *conf_dw_b, *conf_ln_g, *conf_ln_b,
        *dn_conv_w, *dn_a_log, *dn_dt_bias, *dn_norm_g, *w_out, *w_ffn_in, *w_ffn_out, *final_norm_g;
    float* out; unsigned char* ws; int ph_lo, ph_hi;
};

__device__ __forceinline__ float bf2f(bf16_t v) { return __uint_as_float(((unsigned)v) << 16); }
__device__ __forceinline__ unsigned pk2(float a, float b) { f32x2 v = {a, b}; nbf16x2 r = __builtin_convertvector(v, nbf16x2); return __builtin_bit_cast(unsigned, r); }
__device__ __forceinline__ bf16_t f2bf(float a) { return (bf16_t)(pk2(a, 0.f) & 0xffffu); }
__device__ __forceinline__ float lo16(unsigned w) { return __uint_as_float(w << 16); }
__device__ __forceinline__ float hi16(unsigned w) { return __uint_as_float(w & 0xffff0000u); }
__device__ __forceinline__ float sigmoid_f(float v) { return __builtin_amdgcn_rcpf(1.f + __expf(-v)); }
__device__ __forceinline__ float silu_f(float v) { return v * sigmoid_f(v); }
__device__ __forceinline__ float wave_sum(float v) {
#pragma unroll
    for (int o = 32; o; o >>= 1) v += __shfl_xor(v, o);
    return v;
}
__device__ __forceinline__ void unpack8(const u32x4 w, float (&f)[8]) {
    f[0] = lo16(w.x); f[1] = hi16(w.x); f[2] = lo16(w.y); f[3] = hi16(w.y); f[4] = lo16(w.z); f[5] = hi16(w.z); f[6] = lo16(w.w); f[7] = hi16(w.w);
}
__device__ __forceinline__ u32x4 pack8(const float (&f)[8]) { u32x4 w; w.x = pk2(f[0], f[1]); w.y = pk2(f[2], f[3]); w.z = pk2(f[4], f[5]); w.w = pk2(f[6], f[7]); return w; }
#define MFMA16(a, b, c) __builtin_amdgcn_mfma_f32_16x16x32_bf16((a), (b), (c), 0, 0, 0)

namespace pg8 {
constexpr int BM = 256, BK = 64, HALF = 128, HTB = HALF * BK * 2, STAGE_BYTES = 8 * HTB, NXCD = 8, WGM = 8;
__host__ __device__ __forceinline__ int lds_byte(int r, int c) { const int st = (r >> 4) * 2 + (c >> 5), rr = r & 15, cc = c & 31, ob = rr * 64 + cc * 2; return st * 1024 + (ob ^ (((ob >> 9) & 1) << 5)); }
__host__ __device__ __forceinline__ void stage_rc(int b, int& R, int& C) { const int st = b / 1024, sb = b % 1024, swz = sb ^ (((sb >> 9) & 1) << 5); R = (st >> 1) * 16 + swz / 64; C = (st & 1) * 32 + (swz % 64) / 2; }
__host__ __device__ __forceinline__ int perm32(int rho) { const int n = rho >> 4, i = rho & 15; return 8 * (i >> 2) + 4 * n + (i & 3); }
struct Unit { int pm, pn; };
struct Gemm { const bf16_t* A; const bf16_t* Bt; int M, N, K; };
struct StaticOrder {
    int nM, nN, nwg, G, c;
    __device__ void init(int M, int N, int G_, int c_) { nM = M / BM; nN = N / BM; nwg = nM * nN; G = G_; c = c_; }
    __device__ bool next(int i, Unit& u) const {
        const long L = (long)i * G + c; if (L >= nwg) return false;
        int wgid = (int)L; { const int q = nwg / NXCD, r = nwg % NXCD, xcd = wgid % NXCD, off = wgid / NXCD; wgid = (xcd < r ? xcd * (q + 1) : r * (q + 1) + (xcd - r) * q) + off; }
        const int nig = WGM * nN, gid = wgid / nig, fm = gid * WGM, gsz = (nM - fm) < WGM ? (nM - fm) : WGM;
        u.pm = fm + ((wgid % nig) % gsz); u.pn = (wgid % nig) / gsz; return true;
    }
};

struct EpiProj {
    static constexpr bool PERM = true;
    bf16_t* O; int ldc;
    __device__ __forceinline__ void operator()(const f32x4 (&acc)[2][2][4][2], const Unit& u, int wr, int wc, int fr, int fq) const {
        const int row0 = u.pm * BM + wr * 64 + fr, col0 = u.pn * BM + wc * 32 + 8 * fq;
#pragma unroll
        for (int ai = 0; ai < 2; ++ai)
#pragma unroll
            for (int m = 0; m < 4; ++m) { bf16_t* rowp = O + (size_t)(row0 + ai * HALF + m * 16) * ldc + col0;
#pragma unroll
                for (int bj = 0; bj < 2; ++bj) { const f32x4 v0 = acc[ai][bj][m][0], v1 = acc[ai][bj][m][1];
                    u32x4 w; w.x = pk2(v0[0], v0[1]); w.y = pk2(v0[2], v0[3]); w.z = pk2(v1[0], v1[1]); w.w = pk2(v1[2], v1[3]);
                    *(u32x4*)(rowp + bj * HALF) = w; } }
    }
};
struct EpiSwiGLU {
    static constexpr bool PERM = true;
    bf16_t* O;
    __device__ __forceinline__ void operator()(const f32x4 (&acc)[2][2][4][2], const Unit& u, int wr, int wc, int fr, int fq) const {
        const int row0 = u.pm * BM + wr * 64 + fr, col0 = u.pn * HALF + wc * 32 + 8 * fq;
#pragma unroll
        for (int ai = 0; ai < 2; ++ai)
#pragma unroll
            for (int m = 0; m < 4; ++m) {
                const f32x4 g0 = acc[ai][0][m][0], g1 = acc[ai][0][m][1], u0 = acc[ai][1][m][0], u1 = acc[ai][1][m][1];
                float v[8];
#pragma unroll
                for (int i = 0; i < 4; ++i) { v[i] = silu_f(g0[i]) * u0[i]; v[4 + i] = silu_f(g1[i]) * u1[i]; }
                *(u32x4*)(O + (size_t)(row0 + ai * HALF + m * 16) * DFF + col0) = pack8(v);
            }
    }
};
struct EpiResid {
    static constexpr bool PERM = false;
    const float* base; float* out; const float* gate;
    __device__ __forceinline__ void operator()(const f32x4 (&acc)[2][2][4][2], const Unit& u, int wr, int wc, int fr, int fq) const {
        const int row0 = u.pm * BM + wr * 64 + fr, col0 = u.pn * BM + wc * 32 + 4 * fq;
        const float* gp = gate + (size_t)(u.pm >> 4) * NMOD + col0;
        f32x4 gv[2][2];
#pragma unroll
        for (int bj = 0; bj < 2; ++bj)
#pragma unroll
            for (int n = 0; n < 2; ++n) gv[bj][n] = *(const f32x4*)(gp + bj * HALF + n * 16);
#pragma unroll
        for (int ai = 0; ai < 2; ++ai) {
            f32x4 bv[4][2][2];
#pragma unroll
            for (int m = 0; m < 4; ++m) { const size_t ro = (size_t)(row0 + ai * HALF + m * 16) * DM + col0;
#pragma unroll
                for (int bj = 0; bj < 2; ++bj)
#pragma unroll
                    for (int n = 0; n < 2; ++n) bv[m][bj][n] = *(const f32x4*)(base + ro + bj * HALF + n * 16); }
#pragma unroll
            for (int m = 0; m < 4; ++m) { const size_t ro = (size_t)(row0 + ai * HALF + m * 16) * DM + col0;
#pragma unroll
                for (int bj = 0; bj < 2; ++bj)
#pragma unroll
                    for (int n = 0; n < 2; ++n) *(f32x4*)(out + ro + bj * HALF + n * 16) = bv[m][bj][n] + gv[bj][n] * acc[ai][bj][m][n]; }
        }
    }
};

template <class Epi>
__device__ __forceinline__ void gemm_phase(const int tidx, LAS unsigned char* lds, const Gemm g, const StaticOrder& S, const Epi& E) {
    const int tid = tidx, wid = __builtin_amdgcn_readfirstlane(tid >> 6), lane = tid & 63, wr = wid >> 2, wc = wid & 3, fr = lane & 15, fq = lane >> 4;
    const int K = g.K, nt = K / BK;
    unsigned voffA[2], voffB[2];
#pragma unroll
    for (int i = 0; i < 2; ++i) { int R, C; stage_rc(tid * 16 + i * 8192, R, C); const int Rb = Epi::PERM ? ((R & ~31) + perm32(R & 31)) : R;
        voffA[i] = (unsigned)(R * K + C) * 2u; voffB[i] = (unsigned)(Rb * K + C) * 2u; }
    const size_t kstep = (size_t)(BK * 2);
    const size_t hstep = (size_t)HALF * K * 2;
    const size_t tstep = 2 * hstep;
    const unsigned ldsw = (unsigned)wid * 1024u;
    const int aoff = lds_byte(wr * 64 + fr, fq * 8), boff = lds_byte(wc * 32 + fr, fq * 8);
#define PG8_SA(b, h) (((b) * 2 + (h)) * HTB)
#define PG8_SB(b, h) ((4 + (b) * 2 + (h)) * HTB)
#define PG8_STAGE(bufoff, gbase, voff) do { _Pragma("unroll") for (int _i = 0; _i < 2; ++_i) \
        __builtin_amdgcn_global_load_lds((const unsigned*)((const char*)(gbase) + (voff)[_i]), (LAS unsigned*)(lds + (bufoff) + ldsw + _i * 8192), 16, 0, 0); } while (0)
#define PG8_LDA(dst, b, h) do { _Pragma("unroll") for (int m = 0; m < 4; ++m) _Pragma("unroll") for (int k = 0; k < 2; ++k) dst[m][k] = *(const LAS bf16x8*)(lds + PG8_SA(b, h) + aoff + m * 2048 + k * 1024); } while (0)
#define PG8_LDB(dst, b, h) do { _Pragma("unroll") for (int n = 0; n < 2; ++n) _Pragma("unroll") for (int k = 0; k < 2; ++k) dst[n][k] = *(const LAS bf16x8*)(lds + PG8_SB(b, h) + boff + n * 2048 + k * 1024); } while (0)
#define PG8_MMA(ai, bj, At, Bt) do { __builtin_amdgcn_s_setprio(1); _Pragma("unroll") for (int m = 0; m < 4; ++m) _Pragma("unroll") for (int n = 0; n < 2; ++n) _Pragma("unroll") for (int k = 0; k < 2; ++k) \
        acc[ai][bj][m][n] = __builtin_amdgcn_mfma_f32_16x16x32_bf16(Bt[n][k], At[m][k], acc[ai][bj][m][n], 0, 0, 0); __builtin_amdgcn_s_setprio(0); } while (0)
#define PG8_WAIT_V(n) asm volatile("s_waitcnt vmcnt(" #n ")" ::: "memory")
#define PG8_WAIT_L(n) asm volatile("s_waitcnt lgkmcnt(" #n ")" ::: "memory")
#define PG8_BAR __builtin_amdgcn_s_barrier()
#define PG8_SCHED __builtin_amdgcn_sched_barrier(0)
    Unit cur, nxt; int ui = 0;
    if (!S.next(0, cur)) return;
    f32x4 acc[2][2][4][2];
#pragma unroll
    for (int a = 0; a < 2; ++a)
#pragma unroll
        for (int b = 0; b < 2; ++b)
#pragma unroll
            for (int m = 0; m < 4; ++m)
#pragma unroll
                for (int n = 0; n < 2; ++n) acc[a][b][m][n] = (f32x4){0.f, 0.f, 0.f, 0.f};
    bf16x8 At[4][2], B0[2][2], B1[2][2];
    const char* cA = (const char*)g.A + (size_t)cur.pm * tstep; const char* cB = (const char*)g.Bt + (size_t)cur.pn * tstep;
    PG8_STAGE(PG8_SB(0, 0), cB, voffB); PG8_STAGE(PG8_SA(0, 0), cA, voffA); PG8_STAGE(PG8_SB(0, 1), cB + hstep, voffB); PG8_STAGE(PG8_SA(0, 1), cA + hstep, voffA);
    if (wr == 1) PG8_BAR;
    PG8_WAIT_V(4); PG8_BAR;
    PG8_STAGE(PG8_SB(1, 0), cB + kstep, voffB); PG8_STAGE(PG8_SA(1, 0), cA + kstep, voffA); PG8_STAGE(PG8_SB(1, 1), cB + hstep + kstep, voffB);
    PG8_WAIT_V(6); PG8_BAR;
    for (;;) {
        const bool has_next = S.next(ui + 1, nxt);
        const char* nA = has_next ? (const char*)g.A + (size_t)nxt.pm * tstep : cA; const char* nB = has_next ? (const char*)g.Bt + (size_t)nxt.pn * tstep : cB;
        for (int t = 0; t < nt; t += 2) {
            const bool last = (t == nt - 2);
            const char* a1 = cA + (size_t)(t + 1) * kstep;
            const char* a2 = last ? nA : cA + (size_t)(t + 2) * kstep; const char* b2 = last ? nB : cB + (size_t)(t + 2) * kstep;
            const char* a3 = a2 + kstep; const char* b3 = b2 + kstep;
            PG8_LDB(B0, 0, 0); PG8_SCHED; PG8_LDA(At, 0, 0); PG8_STAGE(PG8_SA(1, 1), a1 + hstep, voffA);
            PG8_WAIT_L(8); PG8_BAR; PG8_WAIT_L(0); PG8_MMA(0, 0, At, B0); PG8_BAR; PG8_SCHED;
            PG8_LDB(B1, 0, 1); PG8_STAGE(PG8_SB(0, 0), b2, voffB);
            PG8_BAR; PG8_WAIT_L(0); PG8_MMA(0, 1, At, B1); PG8_BAR;
            PG8_LDA(At, 0, 1); PG8_STAGE(PG8_SA(0, 0), a2, voffA);
            PG8_BAR; PG8_WAIT_L(0); PG8_MMA(1, 0, At, B0); PG8_BAR; PG8_SCHED;
            PG8_STAGE(PG8_SB(0, 1), b2 + hstep, voffB);
            PG8_WAIT_V(6); PG8_BAR; PG8_MMA(1, 1, At, B1); PG8_BAR;
            PG8_LDB(B0, 1, 0); PG8_SCHED; PG8_LDA(At, 1, 0); PG8_STAGE(PG8_SA(0, 1), a2 + hstep, voffA);
            PG8_WAIT_L(8); PG8_BAR; PG8_WAIT_L(0); PG8_MMA(0, 0, At, B0); PG8_BAR; PG8_SCHED;
            PG8_LDB(B1, 1, 1); PG8_STAGE(PG8_SB(1, 0), b3, voffB);
            PG8_BAR; PG8_WAIT_L(0); PG8_MMA(0, 1, At, B1); PG8_BAR;
            PG8_LDA(At, 1, 1); PG8_STAGE(PG8_SA(1, 0), a3, voffA);
            PG8_BAR; PG8_WAIT_L(0); PG8_MMA(1, 0, At, B0); PG8_BAR; PG8_SCHED;
            PG8_STAGE(PG8_SB(1, 1), b3 + hstep, voffB);
            PG8_WAIT_V(6); PG8_BAR; PG8_MMA(1, 1, At, B1); PG8_BAR;
        }
        E(acc, cur, wr, wc, fr, fq);
        if (!has_next) break;
#pragma unroll
        for (int a = 0; a < 2; ++a)
#pragma unroll
            for (int b = 0; b < 2; ++b)
#pragma unroll
                for (int m = 0; m < 4; ++m)
#pragma unroll
                    for (int n = 0; n < 2; ++n) acc[a][b][m][n] = (f32x4){0.f, 0.f, 0.f, 0.f};
        cur = nxt; cA = nA; cB = nB; ++ui;
    }
    PG8_WAIT_V(0);
    if (wr == 0) PG8_BAR;
    PG8_BAR;
#undef PG8_SA
#undef PG8_SB
#undef PG8_STAGE
#undef PG8_LDA
#undef PG8_LDB
#undef PG8_MMA
#undef PG8_WAIT_V
#undef PG8_WAIT_L
#undef PG8_BAR
#undef PG8_SCHED
}
}

__device__ __forceinline__ void prep_transposes(const int tidx, const P& p, LAS unsigned char* L, int l0, int l1, int blk, int nblk);
__device__ __forceinline__ void phase_prep(const int tidx, const P& p, LAS unsigned char* L) {
    const int tid = tidx;
    constexpr int NADA = NL * 96, TPL = 3264, TOTAL = NADA + NL * TPL;
    float* mod = (float*)(p.ws + WS_MOD);
    for (int it = blockIdx.x; it < NADA; it += gridDim.x) {
        __syncthreads();
        {
            const int l = it / 96, n0 = (it % 96) * 64;
            LAS float* cact = (LAS float*)L;
            LAS float* red = cact + 4096;
            for (int i = tid; i < 4096; i += 512) cact[i] = silu_f(p.c[i]);
            __syncthreads();
            const int kg = tid >> 6, nn = tid & 63;
            const float* w = p.w_ada + ((size_t)l * DM + kg * 128) * NMOD + n0 + nn;
            float a0 = 0.f, a1 = 0.f, a2 = 0.f, a3 = 0.f;
#pragma unroll 8
            for (int k = 0; k < 128; ++k) { const float wv = w[(size_t)k * NMOD]; const int kk = kg * 128 + k;
                a0 += cact[kk] * wv; a1 += cact[1024 + kk] * wv; a2 += cact[2048 + kk] * wv; a3 += cact[3072 + kk] * wv; }
            red[(kg * 4 + 0) * 64 + nn] = a0; red[(kg * 4 + 1) * 64 + nn] = a1; red[(kg * 4 + 2) * 64 + nn] = a2; red[(kg * 4 + 3) * 64 + nn] = a3;
            __syncthreads();
            if (tid < 256) { const int b = tid >> 6; float s = p.b_ada[l * NMOD + n0 + nn];
#pragma unroll
                for (int k2 = 0; k2 < 8; ++k2) s += red[(k2 * 4 + b) * 64 + nn];
                mod[(size_t)(l * NB + b) * NMOD + n0 + nn] = s; }
        }
    }
    prep_transposes(tidx, p, L, 0, 1, blockIdx.x, gridDim.x);
}
__device__ __forceinline__ void prep_transposes(const int tidx, const P& p, LAS unsigned char* L, int l0, int l1, int blk, int nblk) {
    const int tid = tidx;
    constexpr int TPL = 3264;
    for (int it0 = l0 * TPL + blk * 4; it0 < l1 * TPL; it0 += nblk * 4) {
        __syncthreads();
        bf16_t* dstp[4]; int kd[4];
#pragma unroll
        for (int tt = 0; tt < 4; ++tt) {
            const int j = it0 + tt, l = j / TPL; int r = j % TPL;
            const float* src; bf16_t* dst; int Ns, Nvalid, Kd, k0, ns0, nd0;
            if (r < 896) { const int kt = r / 56, nt = r % 56; src = p.w_in + (size_t)l * DM * NIN; Ns = NIN; Nvalid = NIN; Kd = DM; k0 = kt * 64; nd0 = nt * 64; ns0 = nd0;
                dst = (bf16_t*)(p.ws + WS_WIN) + (size_t)l * NINP * DM; }
            else if (r < 1152) { r -= 896; const int kt = r / 16, nt = r % 16; src = p.w_out + (size_t)l * DM * DM; Ns = DM; Nvalid = DM; Kd = DM; k0 = kt * 64; nd0 = nt * 64; ns0 = nd0;
                dst = (bf16_t*)(p.ws + WS_WOUT) + (size_t)l * DM * DM; }
            else if (r < 2560) { r -= 1152; const int kt = r / 88, nt = r % 88; src = p.w_ffn_in + (size_t)l * DM * NF1; Ns = NF1; Nvalid = NF1; Kd = DM; k0 = kt * 64; nd0 = nt * 64;
                const int pn = nd0 >> 8, half = (nd0 >> 7) & 1, sub = nd0 & 127; ns0 = half * DFF + pn * 128 + sub;
                dst = (bf16_t*)(p.ws + WS_WF1) + (size_t)l * NF1 * DM; }
            else { r -= 2560; const int kt = r / 16, nt = r % 16; src = p.w_ffn_out + (size_t)l * DFF * DM; Ns = DM; Nvalid = DM; Kd = DFF; k0 = kt * 64; nd0 = nt * 64; ns0 = nd0;
                dst = (bf16_t*)(p.ws + WS_WF2) + (size_t)l * DM * DFF; }
            LAS float* tile = (LAS float*)L + tt * (64 * 65);
            const int kk = tid >> 4, c4 = (tid & 15) * 4;
            f32x4 v0 = {0.f, 0.f, 0.f, 0.f}, v1 = {0.f, 0.f, 0.f, 0.f};
            if (ns0 + c4 < Nvalid) { v0 = *(const f32x4*)(src + (size_t)(k0 + kk) * Ns + ns0 + c4); v1 = *(const f32x4*)(src + (size_t)(k0 + kk + 32) * Ns + ns0 + c4); }
            tile[kk * 65 + c4 + 0] = v0[0]; tile[kk * 65 + c4 + 1] = v0[1]; tile[kk * 65 + c4 + 2] = v0[2]; tile[kk * 65 + c4 + 3] = v0[3];
            tile[(kk + 32) * 65 + c4 + 0] = v1[0]; tile[(kk + 32) * 65 + c4 + 1] = v1[1]; tile[(kk + 32) * 65 + c4 + 2] = v1[2]; tile[(kk + 32) * 65 + c4 + 3] = v1[3];
            dstp[tt] = dst + (size_t)nd0 * Kd + k0; kd[tt] = Kd;
        }
        __syncthreads();
#pragma unroll
        for (int tt = 0; tt < 4; ++tt) {
            LAS float* tile = (LAS float*)L + tt * (64 * 65);
            const int nn = tid >> 3, k8 = (tid & 7) * 8; float f[8];
#pragma unroll
            for (int i = 0; i < 8; ++i) f[i] = tile[(k8 + i) * 65 + nn];
            *(u32x4*)(dstp[tt] + (size_t)nn * kd[tt] + k8) = pack8(f);
        }
    }
}

__device__ __forceinline__ void phase_norm(const int tidx, const float* xin, const float* g, const float* modl, int shoff, int scoff, bf16_t* hout) {
    const int wave = tidx >> 6, lane = tidx & 63;
    for (int row0 = (blockIdx.x * 8 + wave) * 2; row0 < MTOK; row0 += gridDim.x * 16) {
        const int b = row0 >> 12;
        f32x4 v[2][4], gg[4], sc[4], sh[4];
#pragma unroll
        for (int rr = 0; rr < 2; ++rr)
#pragma unroll
            for (int i = 0; i < 4; ++i) v[rr][i] = *(const f32x4*)(xin + (size_t)(row0 + rr) * DM + i * 256 + lane * 4);
#pragma unroll
        for (int i = 0; i < 4; ++i) { const int k = i * 256 + lane * 4;
            gg[i] = *(const f32x4*)(g + k); sc[i] = *(const f32x4*)(modl + (size_t)b * NMOD + scoff + k); sh[i] = *(const f32x4*)(modl + (size_t)b * NMOD + shoff + k); }
#pragma unroll
        for (int rr = 0; rr < 2; ++rr) {
            float ss = 0.f;
#pragma unroll
            for (int i = 0; i < 4; ++i) ss += v[rr][i][0] * v[rr][i][0] + v[rr][i][1] * v[rr][i][1] + v[rr][i][2] * v[rr][i][2] + v[rr][i][3] * v[rr][i][3];
            ss = wave_sum(ss);
            const float rinv = rsqrtf(ss * (1.f / DM) + 1e-6f);
#pragma unroll
            for (int i = 0; i < 4; ++i) { const int k = i * 256 + lane * 4;
                const f32x4 y = v[rr][i] * rinv * gg[i] * (sc[i] + 1.f) + sh[i];
                u32x2 w; w.x = pk2(y[0], y[1]); w.y = pk2(y[2], y[3]);
                *(u32x2*)(hout + (size_t)(row0 + rr) * DM + k) = w; }
        }
    }
}
__device__ __forceinline__ void phase_final(const int tidx, float* x, const float* g) {
    const int wave = tidx >> 6, lane = tidx & 63;
    for (int row0 = (blockIdx.x * 8 + wave) * 2; row0 < MTOK; row0 += gridDim.x * 16) {
        f32x4 v[2][4], gg[4];
#pragma unroll
        for (int rr = 0; rr < 2; ++rr)
#pragma unroll
            for (int i = 0; i < 4; ++i) v[rr][i] = *(const f32x4*)(x + (size_t)(row0 + rr) * DM + i * 256 + lane * 4);
#pragma unroll
        for (int i = 0; i < 4; ++i) gg[i] = *(const f32x4*)(g + i * 256 + lane * 4);
#pragma unroll
        for (int rr = 0; rr < 2; ++rr) {
            float ss = 0.f;
#pragma unroll
            for (int i = 0; i < 4; ++i) ss += v[rr][i][0] * v[rr][i][0] + v[rr][i][1] * v[rr][i][1] + v[rr][i][2] * v[rr][i][2] + v[rr][i][3] * v[rr][i][3];
            ss = wave_sum(ss);
            const float rinv = rsqrtf(ss * (1.f / DM) + 1e-6f);
#pragma unroll
            for (int i = 0; i < 4; ++i) *(f32x4*)(x + (size_t)(row0 + rr) * DM + i * 256 + lane * 4) = v[rr][i] * rinv * gg[i];
        }
    }
}

__device__ __forceinline__ void phase_dprep(const int tidx, const P& p, int l, LAS unsigned char* L) {
    LAS bf16_t* Qn = (LAS bf16_t*)(L + 0);
    LAS bf16_t* Kn = (LAS bf16_t*)(L + 17408);
    LAS bf16_t* KbgT = (LAS bf16_t*)(L + 34816);
    LAS bf16_t* KtlT = (LAS bf16_t*)(L + 53248);
    LAS bf16_t* VbT = (LAS bf16_t*)(L + 71680);
    LAS float* Lm = (LAS float*)(L + 90112);
    LAS bf16_t* Tm = (LAS bf16_t*)(L + 107520);
    LAS bf16_t* QKm = (LAS bf16_t*)(L + 116736);
    LAS float* gcs = (LAS float*)(L + 125952);
    LAS float* betas = gcs + 64;
    LAS float* cwl = (LAS float*)(L + LDS_CW_OFF);
    LAS float* Tf = (LAS float*)(L + LDS_TF_OFF);
    const bf16_t* proj = (const bf16_t*)(p.ws + WS_PROJ);
    float* alast = (float*)(p.ws + WS_ALAST);
    u32x4 rawA[7], rawB[7]; float cwreg[4], alpha_r = 0.f, beta_r = 0.f;
#define DP_ISSUE(it_, tid_) do { const int h_ = (it_) & 3, n_ = ((it_) >> 2) & 63, t0_ = ((it_) >> 8) * SEQ + n_ * 64; \
        const int tk0_ = (((tid_) >> 4) & 15) * 4, d0_ = ((tid_) & 15) * 8; \
        _Pragma("unroll") for (int rr = 0; rr < 7; ++rr) { const int pos = n_ * 64 + tk0_ - 3 + rr; \
            rawA[rr] = (u32x4){0u, 0u, 0u, 0u}; rawB[rr] = (u32x4){0u, 0u, 0u, 0u}; \
            if (pos >= 0) { const bf16_t* pr = proj + (size_t)(t0_ + tk0_ - 3 + rr) * NINP + 1280 + h_ * 128 + d0_; \
                rawA[rr] = *(const u32x4*)(pr + ((tid_) >> 8) * 512); \
                if ((tid_) < 256) rawB[rr] = *(const u32x4*)(pr + 1024); } } \
        if ((tid_) < 384) { _Pragma("unroll") for (int j = 0; j < 4; ++j) cwreg[j] = p.dn_conv_w[(size_t)(l * 4 + j) * 1536 + ((tid_) >> 7) * 512 + h_ * 128 + ((tid_) & 127)]; } \
        if (((tid_) >> 6) == 7) { const bf16_t* pr = proj + (size_t)(t0_ + ((tid_) & 63)) * NINP; alpha_r = bf2f(pr[3328 + h_]); beta_r = bf2f(pr[3332 + h_]); } } while (0)
    if ((int)blockIdx.x < 1024) DP_ISSUE((int)blockIdx.x, tidx);
    for (int item = blockIdx.x; item < 1024; item += gridDim.x) {
        __syncthreads();
        int tid = tidx; asm volatile("" : "+v"(tid));
        const int lane = tid & 63, wave = tid >> 6, r = lane & 15, q = lane >> 4;
        const int h = item & 3, n = (item >> 2) & 63, b = item >> 8;
        const int t0 = b * SEQ + n * 64;
        unsigned char* itp = p.ws + WS_DELTA + (size_t)item * ITEM_BYTES;
        const int run = (tid >> 4) & 15, d0 = (tid & 15) * 8, tk0 = run * 4, whichA = tid >> 8;
        if (tid < 384) {
#pragma unroll
            for (int j = 0; j < 4; ++j) cwl[j * 384 + tid] = cwreg[j];
        }
        if (wave == 7) {
            const float xx = alpha_r + p.dn_dt_bias[l * 4 + h];
            const float sp = fmaxf(xx, 0.f) + log1pf(__expf(-fabsf(xx)));
            float gc = -__expf(p.dn_a_log[l * 4 + h]) * sp;
#pragma unroll
            for (int o = 1; o < 64; o <<= 1) { const float tv = __shfl_up(gc, o); if (lane >= o) gc += tv; }
            gcs[lane] = gc; betas[lane] = sigmoid_f(beta_r);
        }
        __syncthreads();
        const float gl = gcs[63];
#pragma unroll
        for (int pass = 0; pass < 2; ++pass) {
            if (pass == 1 && tid >= 256) break;
            const int which = pass ? 2 : whichA;
            const LAS float* cw = cwl + which * 128 + d0;
            float y[4][8];
#pragma unroll
            for (int i = 0; i < 4; ++i)
#pragma unroll
                for (int d = 0; d < 8; ++d) y[i][d] = 0.f;
#pragma unroll
            for (int j = 0; j < 4; ++j) {
                const f32x4 w0 = *(const LAS f32x4*)(cw + j * 384), w1 = *(const LAS f32x4*)(cw + j * 384 + 4);
#pragma unroll
                for (int i = 0; i < 4; ++i) { float rf[8]; unpack8(pass ? rawB[i + j] : rawA[i + j], rf);
#pragma unroll
                    for (int d = 0; d < 4; ++d) { y[i][d] += w0[d] * rf[d]; y[i][4 + d] += w1[d] * rf[4 + d]; } }
            }
#pragma unroll
            for (int i = 0; i < 4; ++i) {
#pragma unroll
                for (int d = 0; d < 8; ++d) y[i][d] = silu_f(y[i][d]);
                if (which < 2) {
                    float ss = 0.f;
#pragma unroll
                    for (int d = 0; d < 8; ++d) ss += y[i][d] * y[i][d];
                    ss += __shfl_xor(ss, 1); ss += __shfl_xor(ss, 2); ss += __shfl_xor(ss, 4); ss += __shfl_xor(ss, 8);
                    float rinv = rsqrtf(ss + 1e-6f);
                    if (which == 0) rinv *= 0.08838834764831845f;
#pragma unroll
                    for (int d = 0; d < 8; ++d) y[i][d] *= rinv;
                }
            }
            if (which == 0) {
#pragma unroll
                for (int i = 0; i < 4; ++i) *(LAS u32x4*)(Qn + (tk0 + i) * 136 + d0) = pack8(y[i]);
            } else if (which == 1) {
                float f1[4], f2[4];
#pragma unroll
                for (int i = 0; i < 4; ++i) { const float gc = gcs[tk0 + i]; f1[i] = betas[tk0 + i] * __expf(gc); f2[i] = __expf(gl - gc); }
#pragma unroll
                for (int i = 0; i < 4; ++i) *(LAS u32x4*)(Kn + (tk0 + i) * 136 + d0) = pack8(y[i]);
#pragma unroll
                for (int d = 0; d < 8; ++d) {
                    u32x2 a, c; a.x = pk2(y[0][d] * f1[0], y[1][d] * f1[1]); a.y = pk2(y[2][d] * f1[2], y[3][d] * f1[3]); c.x = pk2(y[0][d] * f2[0], y[1][d] * f2[1]); c.y = pk2(y[2][d] * f2[2], y[3][d] * f2[3]);
                    *(LAS u32x2*)(KbgT + (d0 + d) * 72 + tk0) = a; *(LAS u32x2*)(KtlT + (d0 + d) * 72 + tk0) = c; }
            } else {
                float bt[4];
#pragma unroll
                for (int i = 0; i < 4; ++i) bt[i] = betas[tk0 + i];
#pragma unroll
                for (int d = 0; d < 8; ++d) { u32x2 a; a.x = pk2(y[0][d] * bt[0], y[1][d] * bt[1]); a.y = pk2(y[2][d] * bt[2], y[3][d] * bt[3]);
                    *(LAS u32x2*)(VbT + (d0 + d) * 72 + tk0) = a; }
            }
        }
        if (item + (int)gridDim.x < 1024) DP_ISSUE(item + (int)gridDim.x, tid);
        __syncthreads();
        {
            const int mat = wave >> 2, cb = wave & 3;
            LAS bf16_t* Asrc = mat ? Qn : Kn;
            bf16x8 a[4];
#pragma unroll
            for (int kb = 0; kb < 4; ++kb) a[kb] = *(LAS bf16x8*)(Asrc + (16 * cb + r) * 136 + 32 * kb + 8 * q);
#pragma unroll
            for (int sb = 0; sb < 4; ++sb) {
                f32x4 acc = {0.f, 0.f, 0.f, 0.f};
                if (sb <= cb) {
#pragma unroll
                    for (int kb = 0; kb < 4; ++kb) { const bf16x8 bb = *(LAS bf16x8*)(Kn + (16 * sb + r) * 136 + 32 * kb + 8 * q); acc = MFMA16(a[kb], bb, acc); }
                }
                const int s = 16 * sb + r; const float gs = gcs[s];
#pragma unroll
                for (int j = 0; j < 4; ++j) { const int c = 16 * cb + 4 * q + j; const float dec = __expf(gcs[c] - gs);
                    if (mat == 0) Lm[c * 68 + s] = (s < c) ? acc[j] * betas[c] * dec : 0.f;
                    else QKm[c * 72 + s] = f2bf((s <= c) ? acc[j] * dec : 0.f); }
            }
        }
        __syncthreads();
        if (wave < 4) {
            const int blk = wave, c = lane & 15;
            int zoff; asm volatile("v_mov_b32 %0, 0" : "=v"(zoff));
            LAS float* Lb = Lm + (16 * blk) * 68 + 16 * blk + zoff;
            float t[16];
            f32x4 rb[2][4];
            t[0] = (c == 0) ? 1.f : 0.f;
            rb[1][0] = *(LAS f32x4*)(Lb + 1 * 68);
#pragma unroll
            for (int i = 1; i < 16; ++i) {
                if (i + 1 < 16) {
#pragma unroll
                    for (int j4 = 0; j4 < (i + 4) / 4; ++j4) rb[(i + 1) & 1][j4] = *(LAS f32x4*)(Lb + (i + 1) * 68 + 4 * j4);
                }
                __builtin_amdgcn_sched_barrier(0);
                float acc0 = (i == c) ? 1.f : 0.f, acc1 = 0.f;
#pragma unroll
                for (int j = 0; j < i; ++j) { if (j & 1) acc1 -= rb[i & 1][j >> 2][j & 3] * t[j]; else acc0 -= rb[i & 1][j >> 2][j & 3] * t[j]; }
                t[i] = acc0 + acc1;
                __builtin_amdgcn_sched_barrier(0);
            }
            if (q == 0) {
#pragma unroll
                for (int i = 0; i < 16; ++i) { Tf[(16 * blk + i) * 68 + 16 * blk + c] = t[i]; Tm[(16 * blk + i) * 72 + 16 * blk + c] = f2bf(t[i]); }
            }
            for (int cb = blk + 1; cb < 4; ++cb) {
#pragma unroll
                for (int jj = 0; jj < 4; ++jj) Tm[(16 * blk + 4 * q + jj) * 72 + 16 * cb + r] = (bf16_t)0;
            }
        } else {
            if (wave == 4 && lane == 0) alast[item] = __expf(gl);
            for (int jb = wave - 4; jb < 40; jb += 4) {
                if (jb < 16) {
                    const int tb = jb >> 2, kb = jb & 3, tok = 16 * tb + r;
                    const u32x2 lo = *(LAS u32x2*)(Qn + tok * 136 + 32 * kb + 4 * q), hi = *(LAS u32x2*)(Qn + tok * 136 + 32 * kb + 16 + 4 * q);
                    const float e = __expf(gcs[tok]);
                    u32x4 w; w.x = pk2(lo16(lo.x) * e, hi16(lo.x) * e); w.y = pk2(lo16(lo.y) * e, hi16(lo.y) * e); w.z = pk2(lo16(hi.x) * e, hi16(hi.x) * e); w.w = pk2(lo16(hi.y) * e, hi16(hi.y) * e);
                    *(u32x4*)(itp + OFF_Q + (size_t)(jb * 64 + lane) * 16) = w;
                } else if (jb < 32) {
                    const int f = jb - 16, db = f >> 1, kb = f & 1, dk = 16 * db + r;
                    const u32x2 lo = *(LAS u32x2*)(KtlT + dk * 72 + 32 * kb + 4 * q), hi = *(LAS u32x2*)(KtlT + dk * 72 + 32 * kb + 16 + 4 * q);
                    u32x4 w; w.x = lo.x; w.y = lo.y; w.z = hi.x; w.w = hi.y;
                    *(u32x4*)(itp + OFF_KT + (size_t)(f * 64 + lane) * 16) = w;
                } else {
                    const int f = jb - 32, tb = f >> 1, kb = f & 1, tok = 16 * tb + r;
                    const u32x2 lo = *(LAS u32x2*)(QKm + tok * 72 + 32 * kb + 4 * q), hi = *(LAS u32x2*)(QKm + tok * 72 + 32 * kb + 16 + 4 * q);
                    u32x4 w; w.x = lo.x; w.y = lo.y; w.z = hi.x; w.w = hi.y;
                    *(u32x4*)(itp + OFF_QK + (size_t)(f * 64 + lane) * 16) = w;
                }
            }
        }
        __syncthreads();
#pragma unroll
        for (int d = 1; d < 4; ++d) {
            if (wave < 4 - d) {
                const int bj = wave, bi = wave + d;
                f32x4 M = {0.f, 0.f, 0.f, 0.f};
#pragma unroll
                for (int kk = 0; kk < d; ++kk) { const int bk = bj + kk;
#pragma unroll
                    for (int s = 0; s < 4; ++s) M = __builtin_amdgcn_mfma_f32_16x16x4f32(Lm[(16 * bi + r) * 68 + 16 * bk + 4 * s + q], Tf[(16 * bk + 4 * s + q) * 68 + 16 * bj + r], M, 0, 0, 0);
                }
                f32x4 Tn = {0.f, 0.f, 0.f, 0.f};
#pragma unroll
                for (int s = 0; s < 4; ++s) Tn = __builtin_amdgcn_mfma_f32_16x16x4f32(Tf[(16 * bi + r) * 68 + 16 * bi + 4 * q + s], M[s], Tn, 0, 0, 0);
#pragma unroll
                for (int jj = 0; jj < 4; ++jj) { Tf[(16 * bi + 4 * q + jj) * 68 + 16 * bj + r] = -Tn[jj]; Tm[(16 * bi + 4 * q + jj) * 72 + 16 * bj + r] = f2bf(-Tn[jj]); }
            }
            __syncthreads();
        }
        {
            const int s = wave;
            bf16x8 vb[2];
#pragma unroll
            for (int kb = 0; kb < 2; ++kb) vb[kb] = *(LAS bf16x8*)(VbT + (16 * s + r) * 72 + 32 * kb + 8 * q);
#pragma unroll
            for (int tb = 0; tb < 4; ++tb) {
                f32x4 acc = {0.f, 0.f, 0.f, 0.f};
#pragma unroll
                for (int kb = 0; kb < 2; ++kb) { const bf16x8 a = *(LAS bf16x8*)(Tm + (16 * tb + r) * 72 + 32 * kb + 8 * q); acc = MFMA16(a, vb[kb], acc); }
                *(f32x4*)(itp + OFF_U + (size_t)((s * 4 + tb) * 64 + lane) * 16) = acc;
            }
            const int kbp = wave & 3, tbh = wave >> 2;
            bf16x8 ka[2][2];
#pragma unroll
            for (int d = 0; d < 2; ++d)
#pragma unroll
                for (int kb = 0; kb < 2; ++kb) ka[d][kb] = *(LAS bf16x8*)(KbgT + (16 * (2 * kbp + d) + r) * 72 + 32 * kb + 8 * q);
#pragma unroll
            for (int tt = 0; tt < 2; ++tt) {
                const int tb = 2 * tbh + tt;
                f32x4 a0 = {0.f, 0.f, 0.f, 0.f}, a1 = {0.f, 0.f, 0.f, 0.f};
#pragma unroll
                for (int kb = 0; kb < 2; ++kb) { const bf16x8 tf = *(LAS bf16x8*)(Tm + (16 * tb + r) * 72 + 32 * kb + 8 * q); a0 = MFMA16(ka[0][kb], tf, a0); a1 = MFMA16(ka[1][kb], tf, a1); }
                u32x4 w; w.x = pk2(a0[0], a0[1]); w.y = pk2(a0[2], a0[3]); w.z = pk2(a1[0], a1[1]); w.w = pk2(a1[2], a1[3]);
                *(u32x4*)(itp + OFF_W + (size_t)((tb * 4 + kbp) * 64 + lane) * 16) = w;
            }
        }
    }
}

__device__ __forceinline__ void mixer_a(const int tidx, const P& p, int l, int blk, int nblk) {
    const bf16_t* proj = (const bf16_t*)(p.ws + WS_PROJ); bf16_t* ycat = (bf16_t*)(p.ws + WS_YCAT);
    for (int unit = blk * 512 + tidx; unit < MTOK * 32; unit += nblk * 512) {
        const int t = unit >> 5, c0 = (unit & 31) * 8, pos = t & (SEQ - 1);
        float acc[8];
#pragma unroll
        for (int i = 0; i < 8; ++i) acc[i] = 0.f;
#pragma unroll
        for (int j = 0; j < 3; ++j) {
            if (pos - 2 + j >= 0) {
                const bf16_t* pr = proj + (size_t)(t - 2 + j) * NINP;
                float fc[8], fv[8]; unpack8(*(const u32x4*)(pr + 256 + c0), fc); unpack8(*(const u32x4*)(pr + 512 + c0), fv);
                const float* wp = p.conv_a_w + (size_t)(l * 3 + j) * 256 + c0;
                const f32x4 w0 = *(const f32x4*)wp, w1 = *(const f32x4*)(wp + 4);
#pragma unroll
                for (int i = 0; i < 4; ++i) { acc[i] += w0[i] * fc[i] * fv[i]; acc[4 + i] += w1[i] * fc[4 + i] * fv[4 + i]; }
            }
        }
        float fb[8]; unpack8(*(const u32x4*)(proj + (size_t)t * NINP + c0), fb);
#pragma unroll
        for (int i = 0; i < 8; ++i) acc[i] *= fb[i];
        *(u32x4*)(ycat + (size_t)t * DM + c0) = pack8(acc);
    }
}
__device__ __forceinline__ void mixer_b(const int tidx, const P& p, int l, int blk, int nblk, LAS unsigned char* L) {
    const bf16_t* proj = (const bf16_t*)(p.ws + WS_PROJ); bf16_t* ycat = (bf16_t*)(p.ws + WS_YCAT);
    LAS float* ut = (LAS float*)L;
    LAS float* co = (LAS float*)(L + 63488);
    const int tid = tidx, wave = tid >> 6, lane = tid & 63;
    for (int run = blk; run < MTOK / 32; run += nblk) {
        __syncthreads();
        const int t0 = run * 32, pos0 = t0 & (SEQ - 1);
        {
            u32x4 ra[4], rg[4];
#pragma unroll
            for (int it = 0; it < 4; ++it) { const int idx = tid + 512 * it, rr = idx >> 5, c0 = (idx & 31) * 8;
                ra[it] = (u32x4){0u, 0u, 0u, 0u}; rg[it] = (u32x4){0u, 0u, 0u, 0u};
                if (idx < 62 * 32 && pos0 - 30 + rr >= 0) { const bf16_t* pr = proj + (size_t)(t0 - 30 + rr) * NINP; ra[it] = *(const u32x4*)(pr + 768 + c0); rg[it] = *(const u32x4*)(pr + 1024 + c0); } }
#pragma unroll
            for (int it = 0; it < 4; ++it) { const int idx = tid + 512 * it, rr = idx >> 5, c0 = (idx & 31) * 8;
                if (idx < 62 * 32) { float fa[8], fg[8], u[8]; unpack8(ra[it], fa); unpack8(rg[it], fg);
#pragma unroll
                    for (int i = 0; i < 8; ++i) u[i] = fa[i] * sigmoid_f(fg[i]);
                    *(LAS f32x4*)(ut + rr * 256 + c0) = (f32x4){u[0], u[1], u[2], u[3]}; *(LAS f32x4*)(ut + rr * 256 + c0 + 4) = (f32x4){u[4], u[5], u[6], u[7]}; } }
        }
        __syncthreads();
        {
            const int c = tid & 255, half = tid >> 8;
            float w[31], win[46];
#pragma unroll
            for (int j = 0; j < 31; ++j) w[j] = p.conf_dw_w[(size_t)(l * 31 + j) * 256 + c];
            const float bias = p.conf_dw_b[l * 256 + c];
#pragma unroll
            for (int k = 0; k < 46; ++k) win[k] = ut[(half * 16 + k) * 256 + c];
#pragma unroll
            for (int tt = 0; tt < 16; ++tt) { float acc = bias;
#pragma unroll
                for (int j = 0; j < 31; ++j) acc += w[j] * win[tt + j];
                co[(half * 16 + tt) * 256 + c] = acc; }
        }
        __syncthreads();
#pragma unroll
        for (int i = 0; i < 4; ++i) {
            const int tl = wave * 4 + i;
            const f32x4 v = *(LAS f32x4*)(co + tl * 256 + lane * 4);
            const float mean = wave_sum(v[0] + v[1] + v[2] + v[3]) * (1.f / 256.f);
            const f32x4 d = v - mean;
            const float var = wave_sum(d[0] * d[0] + d[1] * d[1] + d[2] * d[2] + d[3] * d[3]) * (1.f / 256.f);
            const float rs = rsqrtf(var + 1e-5f);
            const f32x4 gg = *(const f32x4*)(p.conf_ln_g + l * 256 + lane * 4), bb = *(const f32x4*)(p.conf_ln_b + l * 256 + lane * 4);
            const f32x4 y = d * rs * gg + bb;
            u32x2 wv; wv.x = pk2(silu_f(y[0]), silu_f(y[1])); wv.y = pk2(silu_f(y[2]), silu_f(y[3]));
            *(u32x2*)(ycat + (size_t)(t0 + tl) * DM + 256 + lane * 4) = wv;
        }
    }
}

constexpr int SCAN_BLOCKS = 128, SCAN_BUF = 64512;
__device__ __forceinline__ void phase_scan(const int tidx, const P& p, int l, LAS unsigned char* L) {
    const int tid = tidx, lane = tid & 63, wave = tid >> 6, r = lane & 15, q = lane >> 4;
    if ((int)blockIdx.x >= SCAN_BLOCKS) {
        const int blk = blockIdx.x - SCAN_BLOCKS, nblk = gridDim.x - SCAN_BLOCKS;
        mixer_a(tidx, p, l, blk, nblk);
        mixer_b(tidx, p, l, blk, nblk, L);
        if (l + 1 < NL) prep_transposes(tidx, p, L, l + 1, l + 2, blk, nblk);
        return;
    }
    const int item = blockIdx.x, xcd = item & 7, jj = item >> 3, s = jj & 7, bh = xcd * 2 + (jj >> 3), b = bh >> 2, h = bh & 3;
    const unsigned char* dl = p.ws + WS_DELTA;
    const float* alast = (const float*)(p.ws + WS_ALAST);
    float* obuf = (float*)(p.ws + WS_H);
#define SB_ __builtin_amdgcn_sched_barrier(0)
#define SCAN_COMPUTE(buf, n_) do { \
            const float al = __builtin_bit_cast(float, __builtin_amdgcn_readlane(__builtin_bit_cast(int, al_all), (n_))); \
            const LAS bf16x8* Wf = (const LAS bf16x8*)((buf) + OFF_W) + lane; const LAS bf16x8* Qf = (const LAS bf16x8*)((buf) + OFF_Q) + lane; \
            const LAS bf16x8* Kf = (const LAS bf16x8*)((buf) + OFF_KT) + lane; const LAS bf16x8* QKf = (const LAS bf16x8*)((buf) + OFF_QK) + lane; \
            const LAS f32x4* Uf = (const LAS f32x4*)((buf) + OFF_U) + lane; \
            bf16x8 g0[8], g1[8]; f32x4 Uv[4]; \
            _Pragma("unroll") for (int f = 0; f < 8; ++f) g0[f] = Wf[((f >> 1) * 4 + (f & 1)) * 64];                \
            _Pragma("unroll") for (int f = 0; f < 8; ++f) g1[f] = Wf[((f >> 1) * 4 + 2 + (f & 1)) * 64];            \
            bf16x8 Sb[4]; \
            _Pragma("unroll") for (int kb = 0; kb < 4; ++kb) { u32x4 w; w.x = pk2(S[2 * kb][0], S[2 * kb][1]); w.y = pk2(S[2 * kb][2], S[2 * kb][3]); w.z = pk2(S[2 * kb + 1][0], S[2 * kb + 1][1]); w.w = pk2(S[2 * kb + 1][2], S[2 * kb + 1][3]); \
                Sb[kb] = __builtin_bit_cast(bf16x8, w); } \
            f32x4 Pv[4], O[4]; \
            _Pragma("unroll") for (int tb = 0; tb < 4; ++tb) { Pv[tb] = (f32x4){0.f, 0.f, 0.f, 0.f}; O[tb] = (f32x4){0.f, 0.f, 0.f, 0.f}; } \
            SB_; \
            _Pragma("unroll") for (int f = 0; f < 8; ++f) Pv[f >> 1] = MFMA16(g0[f], Sb[f & 1], Pv[f >> 1]); \
            _Pragma("unroll") for (int f = 0; f < 8; ++f) g0[f] = Qf[((f >> 1) * 4 + (f & 1)) * 64]; \
            SB_; \
            _Pragma("unroll") for (int f = 0; f < 8; ++f) Pv[f >> 1] = MFMA16(g1[f], Sb[2 + (f & 1)], Pv[f >> 1]); \
            _Pragma("unroll") for (int f = 0; f < 8; ++f) g1[f] = Qf[((f >> 1) * 4 + 2 + (f & 1)) * 64]; \
            _Pragma("unroll") for (int tb = 0; tb < 4; ++tb) Uv[tb] = Uf[tb * 64]; \
            SB_; \
            _Pragma("unroll") for (int f = 0; f < 8; ++f) O[f >> 1] = MFMA16(g0[f], Sb[f & 1], O[f >> 1]); \
            _Pragma("unroll") for (int f = 0; f < 8; ++f) g0[f] = Kf[(f * 2) * 64];                                  \
            SB_; \
            _Pragma("unroll") for (int f = 0; f < 8; ++f) O[f >> 1] = MFMA16(g1[f], Sb[2 + (f & 1)], O[f >> 1]); \
            _Pragma("unroll") for (int f = 0; f < 8; ++f) g1[f] = Kf[(f * 2 + 1) * 64];                              \
            _Pragma("unroll") for (int tb = 0; tb < 4; ++tb) Pv[tb] = Uv[tb] - Pv[tb]; \
            bf16x8 Vb[2]; \
            _Pragma("unroll") for (int kb = 0; kb < 2; ++kb) { u32x4 w; w.x = pk2(Pv[2 * kb][0], Pv[2 * kb][1]); w.y = pk2(Pv[2 * kb][2], Pv[2 * kb][3]); w.z = pk2(Pv[2 * kb + 1][0], Pv[2 * kb + 1][1]); w.w = pk2(Pv[2 * kb + 1][2], Pv[2 * kb + 1][3]); \
                Vb[kb] = __builtin_bit_cast(bf16x8, w); } \
            _Pragma("unroll") for (int db = 0; db < 8; ++db) S[db] = S[db] * al; \
            SB_; \
            _Pragma("unroll") for (int f = 0; f < 8; ++f) S[f] = MFMA16(g0[f], Vb[0], S[f]); \
            _Pragma("unroll") for (int f = 0; f < 8; ++f) if (f != 1 && f != 3) g0[f] = QKf[f * 64];                  \
            SB_; \
            _Pragma("unroll") for (int f = 0; f < 8; ++f) S[f] = MFMA16(g1[f], Vb[1], S[f]); \
            SB_; \
            _Pragma("unroll") for (int f = 0; f < 8; ++f) if (f != 1 && f != 3) O[f >> 1] = MFMA16(g0[f], Vb[f & 1], O[f >> 1]); \
            float* op = obuf + (size_t)(b * SEQ + (n_) * 64 + 4 * q) * 512 + h * 128 + 16 * s + r; \
            _Pragma("unroll") for (int tb = 0; tb < 4; ++tb) \
                _Pragma("unroll") for (int j = 0; j < 4; ++j) op[(size_t)(16 * tb + j) * 512] = O[tb][j]; \
        } while (0)
#define SCAN_BAR() do { asm volatile("s_waitcnt lgkmcnt(0)" ::: "memory"); __builtin_amdgcn_s_barrier(); asm volatile("" ::: "memory"); } while (0)
    LAS unsigned char* buf0 = L; LAS unsigned char* buf1 = L + SCAN_BUF;
    if (wave == 0) {
        const float al_all = alast[(b * 64 + lane) * 4 + h];
        f32x4 S[8];
#pragma unroll
        for (int i = 0; i < 8; ++i) S[i] = (f32x4){0.f, 0.f, 0.f, 0.f};
        SCAN_BAR();
#pragma unroll 1
        for (int n = 0; n < 64; n += 2) {
            SCAN_COMPUTE(buf0, n);
            SCAN_BAR();
            SCAN_COMPUTE(buf1, n + 1);
            SCAN_BAR();
        }
    } else {
        const int ct = tid - 64;
        const int off8 = (ct < 256) ? (OFF_U + s * 4096 + ct * 16) : ((ct - 256) * 16);
        const unsigned char* dlb = dl + (size_t)((b * 64) * 4 + h) * ITEM_BYTES;
        u32x4 R0[9], R1[9], R2[9], R3[9];
#define SCAN_LOAD(regs, n_) do { const int nn_ = ((n_) < 64) ? (n_) : 63; const unsigned char* itp_ = dlb + (size_t)nn_ * (4 * ITEM_BYTES); \
        _Pragma("unroll") for (int i_ = 0; i_ < 8; ++i_) regs[i_] = *(const u32x4*)(itp_ + (ct + 448 * i_) * 16); \
        regs[8] = *(const u32x4*)(itp_ + off8); __builtin_amdgcn_sched_barrier(0); } while (0)
#define SCAN_STORE(regs, buf_) do { _Pragma("unroll") for (int i_ = 0; i_ < 9; ++i_) *(LAS u32x4*)((buf_) + (ct + 448 * i_) * 16) = regs[i_]; } while (0)
        SCAN_LOAD(R0, 0); SCAN_LOAD(R1, 1); SCAN_LOAD(R2, 2); SCAN_LOAD(R3, 3);
        SCAN_STORE(R0, buf0);
        SCAN_BAR();
#pragma unroll 1
        for (int n = 0; n < 64; n += 4) {
            SCAN_LOAD(R0, n + 4); SCAN_STORE(R1, buf1); SCAN_BAR();
            SCAN_LOAD(R1, n + 5); SCAN_STORE(R2, buf0); SCAN_BAR();
            SCAN_LOAD(R2, n + 6); SCAN_STORE(R3, buf1); SCAN_BAR();
            SCAN_LOAD(R3, n + 7); SCAN_STORE(R0, buf0); SCAN_BAR();
        }
    }
#undef SCAN_COMPUTE
#undef SB_
#undef SCAN_BAR
#undef SCAN_LOAD
#undef SCAN_STORE
}

__device__ __forceinline__ void phase_onorm(const int tidx, const P& p, int l) {
    const bf16_t* proj = (const bf16_t*)(p.ws + WS_PROJ); bf16_t* ycat = (bf16_t*)(p.ws + WS_YCAT); const float* obuf = (const float*)(p.ws + WS_H);
    const int sub = tidx & 15, d0 = sub * 8;
    const f32x4 g0 = *(const f32x4*)(p.dn_norm_g + l * 128 + d0), g1 = *(const f32x4*)(p.dn_norm_g + l * 128 + d0 + 4);
    for (int unit0 = (blockIdx.x * 32 + (tidx >> 4)) * 2; unit0 < MTOK * 4; unit0 += gridDim.x * 64) {
        f32x4 o0[2], o1[2]; u32x4 zr[2];
#pragma unroll
        for (int uu = 0; uu < 2; ++uu) { const int t = (unit0 + uu) >> 2, h = (unit0 + uu) & 3;
            o0[uu] = *(const f32x4*)(obuf + (size_t)t * 512 + h * 128 + d0); o1[uu] = *(const f32x4*)(obuf + (size_t)t * 512 + h * 128 + d0 + 4);
            zr[uu] = *(const u32x4*)(proj + (size_t)t * NINP + 2816 + h * 128 + d0); }
#pragma unroll
        for (int uu = 0; uu < 2; ++uu) { const int t = (unit0 + uu) >> 2, h = (unit0 + uu) & 3;
            float ss = o0[uu][0] * o0[uu][0] + o0[uu][1] * o0[uu][1] + o0[uu][2] * o0[uu][2] + o0[uu][3] * o0[uu][3] + o1[uu][0] * o1[uu][0] + o1[uu][1] * o1[uu][1] + o1[uu][2] * o1[uu][2] + o1[uu][3] * o1[uu][3];
            ss += __shfl_xor(ss, 1); ss += __shfl_xor(ss, 2); ss += __shfl_xor(ss, 4); ss += __shfl_xor(ss, 8);
            const float rinv = rsqrtf(ss * (1.f / 128.f) + 1e-6f);
            float z[8]; unpack8(zr[uu], z);
            float y[8];
#pragma unroll
            for (int i = 0; i < 4; ++i) { y[i] = o0[uu][i] * rinv * g0[i] * silu_f(z[i]); y[4 + i] = o1[uu][i] * rinv * g1[i] * silu_f(z[4 + i]); }
            *(u32x4*)(ycat + (size_t)t * DM + 512 + h * 128 + d0) = pack8(y); }
    }
}

#define XB_TMO      128
#define XB_XCNT(j)  (256  + 64 * (j))
#define XB_XSUB(j)  (1280 + 64 * (j))
#define XB_XGEN(j)  (2304 + 64 * (j))
#define XB_TOP      3328
#define XB_TOPGEN   3392
#define XCD_BAR_WORDS 3456
#define XB_SPIN_CAP (1u << 22)
__device__ __forceinline__ unsigned xb_ld(unsigned* p)              { return __hip_atomic_load(p, __ATOMIC_RELAXED, __HIP_MEMORY_SCOPE_AGENT); }
__device__ __forceinline__ unsigned xb_add(unsigned* p, unsigned v) { return __hip_atomic_fetch_add(p, v, __ATOMIC_RELAXED, __HIP_MEMORY_SCOPE_AGENT); }
__device__ __forceinline__ unsigned xb_xcc_id() { return (unsigned)__builtin_amdgcn_s_getreg((3 << 11) | 20) & 0xFu; }
#define XB_SPIN(cond, bar) do { unsigned _sp = 0; while (cond) { __builtin_amdgcn_s_sleep(1); \
    if ((++_sp & 255u) == 0u) { if (xb_ld(&(bar)[XB_TMO])) break; if (_sp > XB_SPIN_CAP) { atomicAdd(&(bar)[XB_TMO], 1u); break; } } } } while (0)
struct XcdBarrier { unsigned* bar; unsigned x; volatile LAS unsigned* st; };
__device__ __forceinline__ XcdBarrier xcd_barrier_post(unsigned* bar, volatile LAS unsigned* st) {
    XcdBarrier b; b.bar = bar; b.x = xb_xcc_id(); b.st = st;
    if (threadIdx.x == 0) (void)xb_add(&bar[XB_XCNT(b.x)], 1u);
    return b;
}
__device__ __forceinline__ void xcd_barrier_complete(unsigned* bar, unsigned x, unsigned& nloc, unsigned& nx) {
    const unsigned G = gridDim.x * gridDim.y * gridDim.z;
    unsigned sum, cnt, mine, sp = 0u;
    for (;;) {
        sum = 0u; cnt = 0u; mine = 0u;
#pragma unroll
        for (unsigned j = 0; j < 16; ++j) { const unsigned c = xb_ld(&bar[XB_XCNT(j)]); sum += c; cnt += (c > 0u) ? 1u : 0u; mine = (j == x) ? c : mine; }
        if (sum == G) break;
        __builtin_amdgcn_s_sleep(1);
        if ((++sp & 255u) == 0u) { if (xb_ld(&bar[XB_TMO])) break; if (sp > XB_SPIN_CAP) { atomicAdd(&bar[XB_TMO], 1u); break; } }
    }
    nloc = mine > 0u ? mine : 1u; nx = cnt > 0u ? cnt : 1u;
}
__device__ __forceinline__ void xcd_barrier(const XcdBarrier& b) {
    asm volatile("s_waitcnt vmcnt(0)" ::: "memory");
    __syncthreads();
    if (threadIdx.x == 0) {
        unsigned* bar = b.bar;
        __builtin_amdgcn_s_waitcnt(0);
        unsigned nloc = b.st[0], nx = b.st[1];
        if (nloc == 0u) { xcd_barrier_complete(bar, b.x, nloc, nx); b.st[0] = nloc; b.st[1] = nx; }
        const unsigned old = xb_add(&bar[XB_XSUB(b.x)], 1u);
        const unsigned gen = old / nloc;
        if (old + 1u == (gen + 1u) * nloc) {
            __builtin_amdgcn_fence(__ATOMIC_RELEASE, "agent");
            asm volatile("s_waitcnt vmcnt(0)" ::: "memory");
            const unsigned og = xb_add(&bar[XB_TOP], 1u);
            const unsigned tg = og / nx;
            if (og + 1u == (tg + 1u) * nx) xb_add(&bar[XB_TOPGEN], 1u);
            else XB_SPIN(xb_ld(&bar[XB_TOPGEN]) == tg, bar);
            __builtin_amdgcn_fence(__ATOMIC_ACQUIRE, "agent");
            xb_add(&bar[XB_XGEN(b.x)], 1u);
            asm volatile("s_waitcnt vmcnt(0)" ::: "memory");
        } else {
            XB_SPIN(xb_ld(&bar[XB_XGEN(b.x)]) == gen, bar);
            __builtin_amdgcn_fence(__ATOMIC_ACQUIRE, "agent");
            asm volatile("s_waitcnt vmcnt(0)" ::: "memory");
        }
    }
    __syncthreads();
}

template <int KIND>
__device__ __forceinline__ void run_kind(const int tidx, const P& p, int l, LAS unsigned char* L) {
    const float* modl = (const float*)(p.ws + WS_MOD) + (size_t)l * NB * NMOD;
    bf16_t* hbuf = (bf16_t*)(p.ws + WS_H); bf16_t* ycat = (bf16_t*)(p.ws + WS_YCAT); bf16_t* proj = (bf16_t*)(p.ws + WS_PROJ);
    const float* xin = (l == 0) ? p.x : p.out;
    if constexpr (KIND == 0) phase_prep(tidx, p, L);
    if constexpr (KIND == 1) phase_norm(tidx, xin, p.norm_mix_g + l * DM, modl, 0, DM, hbuf);
    if constexpr (KIND == 2) { pg8::Gemm g{hbuf, (const bf16_t*)(p.ws + WS_WIN) + (size_t)l * NINP * DM, MTOK, NINP, DM}; pg8::StaticOrder S; S.init(MTOK, NINP, gridDim.x, blockIdx.x);
        pg8::EpiProj E{proj, NINP}; pg8::gemm_phase<pg8::EpiProj>(tidx, L, g, S, E); }
    if constexpr (KIND == 3) phase_dprep(tidx, p, l, L);
    if constexpr (KIND == 4) phase_scan(tidx, p, l, L);
    if constexpr (KIND == 5) phase_onorm(tidx, p, l);
    if constexpr (KIND == 6) { pg8::Gemm g{ycat, (const bf16_t*)(p.ws + WS_WOUT) + (size_t)l * DM * DM, MTOK, DM, DM}; pg8::StaticOrder S; S.init(MTOK, DM, gridDim.x, blockIdx.x);
        pg8::EpiResid E{xin, p.out, modl + 2 * DM}; pg8::gemm_phase<pg8::EpiResid>(tidx, L, g, S, E); }
    if constexpr (KIND == 7) phase_norm(tidx, p.out, p.norm_ffn_g + l * DM, modl, 3 * DM, 4 * DM, hbuf);
    if constexpr (KIND == 8) { pg8::Gemm g{hbuf, (const bf16_t*)(p.ws + WS_WF1) + (size_t)l * NF1 * DM, MTOK, NF1, DM}; pg8::StaticOrder S; S.init(MTOK, NF1, gridDim.x, blockIdx.x);
        pg8::EpiSwiGLU E{proj}; pg8::gemm_phase<pg8::EpiSwiGLU>(tidx, L, g, S, E); }
    if constexpr (KIND == 9) { pg8::Gemm g{proj, (const bf16_t*)(p.ws + WS_WF2) + (size_t)l * DM * DFF, MTOK, DM, DFF}; pg8::StaticOrder S; S.init(MTOK, DM, gridDim.x, blockIdx.x);
        pg8::EpiResid E{p.out, p.out, modl + 5 * DM}; pg8::gemm_phase<pg8::EpiResid>(tidx, L, g, S, E); }
    if constexpr (KIND == 10) phase_final(tidx, p.out, p.final_norm_g);
}
__host__ __device__ inline void phase_decode(int ph, int& kind, int& l) {
    if (ph == 0) { kind = 0; l = 0; } else if (ph == NPH - 1) { kind = 10; l = 0; } else { l = (ph - 1) / 9; kind = 1 + (ph - 1) % 9; }
}

#if ONE_LAUNCH
__global__ void __launch_bounds__(512, 2) hymba_fwd(P p) {
    extern __shared__ __attribute__((aligned(16))) unsigned char lds_raw[];
    LAS unsigned char* L = (LAS unsigned char*)lds_raw;
    cg::grid_group grid = cg::this_grid();
    if (threadIdx.x < 16) ((LAS unsigned*)(L + LDS_BAR_OFF))[threadIdx.x] = 0u;
    __syncthreads();
    const XcdBarrier bar = xcd_barrier_post((unsigned*)(p.ws + WS_BAR), (volatile LAS unsigned*)(L + LDS_BAR_OFF));
    for (int ph = p.ph_lo; ph < p.ph_hi; ++ph) {
        if (p.ph_hi > NPH) grid.sync();
        if (ph > p.ph_lo) xcd_barrier(bar);
        int kind, l; phase_decode(ph, kind, l);
        int tidx = threadIdx.x; asm volatile("" : "+v"(tidx));
#if REPEAT_MASK
        if ((REPEAT_MASK >> kind) & 1) {
            switch (kind) { case 1: run_kind<1>(tidx, p, l, L); break; case 2: run_kind<2>(tidx, p, l, L); break; case 3: run_kind<3>(tidx, p, l, L); break; case 4: run_kind<4>(tidx, p, l, L); break;
                case 5: run_kind<5>(tidx, p, l, L); break; case 7: run_kind<7>(tidx, p, l, L); break; case 8: run_kind<8>(tidx, p, l, L); break; default: break; }
            __syncthreads();
        }
#endif
        switch (kind) {
        case 0: run_kind<0>(tidx, p, l, L); break; case 1: run_kind<1>(tidx, p, l, L); break; case 2: run_kind<2>(tidx, p, l, L); break; case 3: run_kind<3>(tidx, p, l, L); break;
        case 4: run_kind<4>(tidx, p, l, L); break; case 5: run_kind<5>(tidx, p, l, L); break; case 6: run_kind<6>(tidx, p, l, L); break; case 7: run_kind<7>(tidx, p, l, L); break;
        case 8: run_kind<8>(tidx, p, l, L); break; case 9: run_kind<9>(tidx, p, l, L); break; default: run_kind<10>(tidx, p, l, L); break;
        }
    }
}
#define LAUNCH_FN(kind) ((const void*)hymba_fwd)
#else
template <int KIND> __global__ void __launch_bounds__(512, 2) hymba_ph(P p) {
    extern __shared__ __attribute__((aligned(16))) unsigned char lds_raw[];
    run_kind<KIND>((int)threadIdx.x, p, p.ph_hi, (LAS unsigned char*)lds_raw);
}
static const void* ph_fn(int kind) {
    switch (kind) { case 0: return (const void*)hymba_ph<0>; case 1: return (const void*)hymba_ph<1>; case 2: return (const void*)hymba_ph<2>; case 3: return (const void*)hymba_ph<3>;
        case 4: return (const void*)hymba_ph<4>; case 5: return (const void*)hymba_ph<5>; case 6: return (const void*)hymba_ph<6>; case 7: return (const void*)hymba_ph<7>;
        case 8: return (const void*)hymba_ph<8>; case 9: return (const void*)hymba_ph<9>; default: return (const void*)hymba_ph<10>; }
}
#define LAUNCH_FN(kind) ph_fn(kind)
#endif

extern "C" void kernel_launch(void* const* d_in, const int* in_sizes, int n_in, void* d_out, int out_size, void* d_ws, size_t ws_size, hipStream_t stream) {
    static int grid = 0;
    if (grid == 0) {
        if (n_in != 20 || out_size != MTOK * DM || ws_size < WS_END) { fprintf(stderr, "kernel_launch: unexpected problem (n_in %d out %d ws %zu need %zu)\n", n_in, out_size, ws_size, (size_t)WS_END); grid = -1; return; }
        int dev = 0, cus = 0, per_cu = 0;
        (void)hipGetDevice(&dev); (void)hipDeviceGetAttribute(&cus, hipDeviceAttributeMultiprocessorCount, dev);
        for (int k = 0; k <= 10; ++k)
            if (hipFuncSetAttribute(LAUNCH_FN(k), hipFuncAttributeMaxDynamicSharedMemorySize, LDS_BYTES) != hipSuccess) { fprintf(stderr, "kernel_launch: hipFuncSetAttribute failed\n"); grid = -1; return; }
#if ONE_LAUNCH
        if (hipOccupancyMaxActiveBlocksPerMultiprocessor(&per_cu, (const void*)hymba_fwd, 512, LDS_BYTES) != hipSuccess || per_cu < 1) { fprintf(stderr, "kernel_launch: occupancy query failed (%d)\n", per_cu); (void)hipGetLastError(); per_cu = 1; }
#else
        per_cu = 1;
#endif
        grid = cus * per_cu;
        if (grid < SCAN_BLOCKS + 32) { fprintf(stderr, "kernel_launch: grid %d too small\n", grid); grid = -1; return; }
    }
    if (grid < 0) return;
    P p{};
    const float** pp = (const float**)&p;
    for (int i = 0; i < 20; ++i) pp[i] = (const float*)d_in[i];
    p.out = (float*)d_out; p.ws = (unsigned char*)d_ws;
#if ONE_LAUNCH
    p.ph_lo = 0; p.ph_hi = NPH;
    if (hipMemsetAsync((unsigned char*)d_ws + WS_BAR, 0, 16384, stream) != hipSuccess) { fprintf(stderr, "kernel_launch: memset of the barrier words failed\n"); return; }
    void* args[] = {&p};
    hipError_t e = hipLaunchCooperativeKernel((const void*)hymba_fwd, dim3(grid), dim3(512), args, LDS_BYTES, stream);
    if (e != hipSuccess) fprintf(stderr, "cooperative launch failed: %s (grid %d)\n", hipGetErrorString(e), grid);
#else
    for (int ph = 0; ph < NPH; ++ph) { int kind, l; phase_decode(ph, kind, l); p.ph_lo = kind; p.ph_hi = l; void* args[] = {&p};
        (void)hipLaunchKernel(ph_fn(kind), dim3(grid), dim3(512), args, LDS_BYTES, stream); }
#endif
}
```

```cpp
#include <hip/hip_runtime.h>
#include <hip/hip_cooperative_groups.h>
#include <cstdio>
namespace cg = cooperative_groups;

#ifndef ONE_LAUNCH
#define ONE_LAUNCH 1
#endif
#ifndef REPEAT_MASK
#define REPEAT_MASK 0
#endif

#define LAS __attribute__((address_space(3)))
typedef unsigned short bf16_t;
typedef short bf16x8 __attribute__((ext_vector_type(8)));
typedef float f32x4 __attribute__((ext_vector_type(4)));
typedef float f32x2 __attribute__((ext_vector_type(2)));
typedef unsigned u32x4 __attribute__((ext_vector_type(4)));
typedef unsigned u32x2 __attribute__((ext_vector_type(2)));
typedef __bf16 nbf16x2 __attribute__((ext_vector_type(2)));

constexpr int MTOK = 16384, DM = 1024, NL = 4, NB = 4, SEQ = 4096;
constexpr int NIN = 3336, NINP = 3584, DFF = 2816, NF1 = 2 * DFF, NMOD = 6 * DM;
constexpr int LDS_BYTES = 131072 + 64 + 6144 + 17408, LDS_BAR_OFF = 131072, LDS_CW_OFF = 131072 + 64, LDS_TF_OFF = LDS_CW_OFF + 6144;
constexpr int NPH = 1 + 9 * NL + 1;

constexpr size_t SZ_WIN = (size_t)NL * NINP * DM * 2, SZ_WOUT = (size_t)NL * DM * DM * 2, SZ_WF1 = (size_t)NL * NF1 * DM * 2, SZ_WF2 = (size_t)NL * DM * DFF * 2;
constexpr size_t WS_WIN = 0, WS_WOUT = WS_WIN + SZ_WIN, WS_WF1 = WS_WOUT + SZ_WOUT, WS_WF2 = WS_WF1 + SZ_WF1;
constexpr size_t WS_MOD = WS_WF2 + SZ_WF2;
constexpr size_t WS_ALAST = WS_MOD + (size_t)NL * NB * NMOD * 4;
constexpr size_t WS_H = WS_ALAST + 4096;
constexpr size_t WS_YCAT = WS_H + (size_t)MTOK * DM * 2;
constexpr size_t WS_PROJ = WS_YCAT + (size_t)MTOK * DM * 2;
constexpr int ITEM_BYTES = 90112, OFF_W = 0, OFF_Q = 16384, OFF_KT = 32768, OFF_QK = 49152, OFF_U = 57344;
constexpr size_t WS_DELTA = WS_PROJ + (size_t)MTOK * NINP * 2;
constexpr size_t WS_BAR = WS_DELTA + (size_t)1024 * ITEM_BYTES;
constexpr size_t WS_END = WS_BAR + 16384;

struct P {
    const float *x, *c, *w_ada, *b_ada, *norm_mix_g, *norm_ffn_g, *w_in, *conv_a_w, *conf_dw_w, *conf_dw_b, *conf_ln_g, *conf_ln_b,
        *dn_conv_w, *dn_a_log, *dn_dt_bias, *dn_norm_g, *w_out, *w_ffn_in, *w_ffn_out, *final_norm_g;
    float* out; unsigned char* ws; int ph_lo, ph_hi;
};

__device__ __forceinline__ float bf2f(bf16_t v) { return __uint_as_float(((unsigned)v) << 16); }
__device__ __forceinline__ unsigned pk2(float a, float b) { f32x2 v = {a, b}; nbf16x2 r = __builtin_convertvector(v, nbf16x2); return __builtin_bit_cast(unsigned, r); }
__device__ __forceinline__ bf16_t f2bf(float a) { return (bf16_t)(pk2(a, 0.f) & 0xffffu); }
__device__ __forceinline__ float lo16(unsigned w) { return __uint_as_float(w << 16); }
__device__ __forceinline__ float hi16(unsigned w) { return __uint_as_float(w & 0xffff0000u); }
__device__ __forceinline__ float sigmoid_f(float v) { return __builtin_amdgcn_rcpf(1.f + __expf(-v)); }
__device__ __forceinline__ float silu_f(float v) { return v * sigmoid_f(v); }
__device__ __forceinline__ float wave_sum(float v) {
#pragma unroll
    for (int o = 32; o; o >>= 1) v += __shfl_xor(v, o);
    return v;
}
__device__ __forceinline__ void unpack8(const u32x4 w, float (&f)[8]) {
    f[0] = lo16(w.x); f[1] = hi16(w.x); f[2] = lo16(w.y); f[3] = hi16(w.y); f[4] = lo16(w.z); f[5] = hi16(w.z); f[6] = lo16(w.w); f[7] = hi16(w.w);
}
__device__ __forceinline__ u32x4 pack8(const float (&f)[8]) { u32x4 w; w.x = pk2(f[0], f[1]); w.y = pk2(f[2], f[3]); w.z = pk2(f[4], f[5]); w.w = pk2(f[6], f[7]); return w; }
#define MFMA16(a, b, c) __builtin_amdgcn_mfma_f32_16x16x32_bf16((a), (b), (c), 0, 0, 0)

namespace pg8 {
constexpr int BM = 256, BK = 64, HALF = 128, HTB = HALF * BK * 2, STAGE_BYTES = 8 * HTB, NXCD = 8, WGM = 8;
__host__ __device__ __forceinline__ int lds_byte(int r, int c) { const int st = (r >> 4) * 2 + (c >> 5), rr = r & 15, cc = c & 31, ob = rr * 64 + cc * 2; return st * 1024 + (ob ^ (((ob >> 9) & 1) << 5)); }
__host__ __device__ __forceinline__ void stage_rc(int b, int& R, int& C) { const int st = b / 1024, sb = b % 1024, swz = sb ^ (((sb >> 9) & 1) << 5); R = (st >> 1) * 16 + swz / 64; C = (st & 1) * 32 + (swz % 64) / 2; }
__host__ __device__ __forceinline__ int perm32(int rho) { const int n = rho >> 4, i = rho & 15; return 8 * (i >> 2) + 4 * n + (i & 3); }
struct Unit { int pm, pn; };
struct Gemm { const bf16_t* A; const bf16_t* Bt; int M, N, K; };
struct StaticOrder {
    int nM, nN, nwg, G, c;
    __device__ void init(int M, int N, int G_, int c_) { nM = M / BM; nN = N / BM; nwg = nM * nN; G = G_; c = c_; }
    __device__ bool next(int i, Unit& u) const {
        const long L = (long)i * G + c; if (L >= nwg) return false;
        int wgid = (int)L; { const int q = nwg / NXCD, r = nwg % NXCD, xcd = wgid % NXCD, off = wgid / NXCD; wgid = (xcd < r ? xcd * (q + 1) : r * (q + 1) + (xcd - r) * q) + off; }
        const int nig = WGM * nN, gid = wgid / nig, fm = gid * WGM, gsz = (nM - fm) < WGM ? (nM - fm) : WGM;
        u.pm = fm + ((wgid % nig) % gsz); u.pn = (wgid % nig) / gsz; return true;
    }
};

struct EpiProj {
    static constexpr bool PERM = true;
    bf16_t* O; int ldc;
    __device__ __forceinline__ void operator()(const f32x4 (&acc)[2][2][4][2], const Unit& u, int wr, int wc, int fr, int fq) const {
        const int row0 = u.pm * BM + wr * 64 + fr, col0 = u.pn * BM + wc * 32 + 8 * fq;
#pragma unroll
        for (int ai = 0; ai < 2; ++ai)
#pragma unroll
            for (int m = 0; m < 4; ++m) { bf16_t* rowp = O + (size_t)(row0 + ai * HALF + m * 16) * ldc + col0;
#pragma unroll
                for (int bj = 0; bj < 2; ++bj) { const f32x4 v0 = acc[ai][bj][m][0], v1 = acc[ai][bj][m][1];
                    u32x4 w; w.x = pk2(v0[0], v0[1]); w.y = pk2(v0[2], v0[3]); w.z = pk2(v1[0], v1[1]); w.w = pk2(v1[2], v1[3]);
                    *(u32x4*)(rowp + bj * HALF) = w; } }
    }
};
struct EpiSwiGLU {
    static constexpr bool PERM = true;
    bf16_t* O;
    __device__ __forceinline__ void operator()(const f32x4 (&acc)[2][2][4][2], const Unit& u, int wr, int wc, int fr, int fq) const {
        const int row0 = u.pm * BM + wr * 64 + fr, col0 = u.pn * HALF + wc * 32 + 8 * fq;
#pragma unroll
        for (int ai = 0; ai < 2; ++ai)
#pragma unroll
            for (int m = 0; m < 4; ++m) {
                const f32x4 g0 = acc[ai][0][m][0], g1 = acc[ai][0][m][1], u0 = acc[ai][1][m][0], u1 = acc[ai][1][m][1];
                float v[8];
#pragma unroll
                for (int i = 0; i < 4; ++i) { v[i] = silu_f(g0[i]) * u0[i]; v[4 + i] = silu_f(g1[i]) * u1[i]; }
                *(u32x4*)(O + (size_t)(row0 + ai * HALF + m * 16) * DFF + col0) = pack8(v);
            }
    }
};
struct EpiResid {
    static constexpr bool PERM = false;
    const float* base; float* out; const float* gate;
    __device__ __forceinline__ void operator()(const f32x4 (&acc)[2][2][4][2], const Unit& u, int wr, int wc, int fr, int fq) const {
        const int row0 = u.pm * BM + wr * 64 + fr, col0 = u.pn * BM + wc * 32 + 4 * fq;
        const float* gp = gate + (size_t)(u.pm >> 4) * NMOD + col0;
        f32x4 gv[2][2];
#pragma unroll
        for (int bj = 0; bj < 2; ++bj)
#pragma unroll
            for (int n = 0; n < 2; ++n) gv[bj][n] = *(const f32x4*)(gp + bj * HALF + n * 16);
#pragma unroll
        for (int ai = 0; ai < 2; ++ai) {
            f32x4 bv[4][2][2];
#pragma unroll
            for (int m = 0; m < 4; ++m) { const size_t ro = (size_t)(row0 + ai * HALF + m * 16) * DM + col0;
#pragma unroll
                for (int bj = 0; bj < 2; ++bj)
#pragma unroll
                    for (int n = 0; n < 2; ++n) bv[m][bj][n] = *(const f32x4*)(base + ro + bj * HALF + n * 16); }
#pragma unroll
            for (int m = 0; m < 4; ++m) { const size_t ro = (size_t)(row0 + ai * HALF + m * 16) * DM + col0;
#pragma unroll
                for (int bj = 0; bj < 2; ++bj)
#pragma unroll
                    for (int n = 0; n < 2; ++n) *(f32x4*)(out + ro + bj * HALF + n * 16) = bv[m][bj][n] + gv[bj][n] * acc[ai][bj][m][n]; }
        }
    }
};

template <class Epi>
__device__ __forceinline__ void gemm_phase(const int tidx, LAS unsigned char* lds, const Gemm g, const StaticOrder& S, const Epi& E) {
    const int tid = tidx, wid = __builtin_amdgcn_readfirstlane(tid >> 6), lane = tid & 63, wr = wid >> 2, wc = wid & 3, fr = lane & 15, fq = lane >> 4;
    const int K = g.K, nt = K / BK;
    unsigned voffA[2], voffB[2];
#pragma unroll
    for (int i = 0; i < 2; ++i) { int R, C; stage_rc(tid * 16 + i * 8192, R, C); const int Rb = Epi::PERM ? ((R & ~31) + perm32(R & 31)) : R;
        voffA[i] = (unsigned)(R * K + C) * 2u; voffB[i] = (unsigned)(Rb * K + C) * 2u; }
    const size_t kstep = (size_t)(BK * 2);
    const size_t hstep = (size_t)HALF * K * 2;
    const size_t tstep = 2 * hstep;
    const unsigned ldsw = (unsigned)wid * 1024u;
    const int aoff = lds_byte(wr * 64 + fr, fq * 8), boff = lds_byte(wc * 32 + fr, fq * 8);
#define PG8_SA(b, h) (((b) * 2 + (h)) * HTB)
#define PG8_SB(b, h) ((4 + (b) * 2 + (h)) * HTB)
#define PG8_STAGE(bufoff, gbase, voff) do { _Pragma("unroll") for (int _i = 0; _i < 2; ++_i) \
        __builtin_amdgcn_global_load_lds((const unsigned*)((const char*)(gbase) + (voff)[_i]), (LAS unsigned*)(lds + (bufoff) + ldsw + _i * 8192), 16, 0, 0); } while (0)
#define PG8_LDA(dst, b, h) do { _Pragma("unroll") for (int m = 0; m < 4; ++m) _Pragma("unroll") for (int k = 0; k < 2; ++k) dst[m][k] = *(const LAS bf16x8*)(lds + PG8_SA(b, h) + aoff + m * 2048 + k * 1024); } while (0)
#define PG8_LDB(dst, b, h) do { _Pragma("unroll") for (int n = 0; n < 2; ++n) _Pragma("unroll") for (int k = 0; k < 2; ++k) dst[n][k] = *(const LAS bf16x8*)(lds + PG8_SB(b, h) + boff + n * 2048 + k * 1024); } while (0)
#define PG8_MMA(ai, bj, At, Bt) do { __builtin_amdgcn_s_setprio(1); _Pragma("unroll") for (int m = 0; m < 4; ++m) _Pragma("unroll") for (int n = 0; n < 2; ++n) _Pragma("unroll") for (int k = 0; k < 2; ++k) \
        acc[ai][bj][m][n] = __builtin_amdgcn_mfma_f32_16x16x32_bf16(Bt[n][k], At[m][k], acc[ai][bj][m][n], 0, 0, 0); __builtin_amdgcn_s_setprio(0); } while (0)
#define PG8_WAIT_V(n) asm volatile("s_waitcnt vmcnt(" #n ")" ::: "memory")
#define PG8_WAIT_L(n) asm volatile("s_waitcnt lgkmcnt(" #n ")" ::: "memory")
#define PG8_BAR __builtin_amdgcn_s_barrier()
#define PG8_SCHED __builtin_amdgcn_sched_barrier(0)
    Unit cur, nxt; int ui = 0;
    if (!S.next(0, cur)) return;
    f32x4 acc[2][2][4][2];
#pragma unroll
    for (int a = 0; a < 2; ++a)
#pragma unroll
        for (int b = 0; b < 2; ++b)
#pragma unroll
            for (int m = 0; m < 4; ++m)
#pragma unroll
                for (int n = 0; n < 2; ++n) acc[a][b][m][n] = (f32x4){0.f, 0.f, 0.f, 0.f};
    bf16x8 At[4][2], B0[2][2], B1[2][2];
    const char* cA = (const char*)g.A + (size_t)cur.pm * tstep; const char* cB = (const char*)g.Bt + (size_t)cur.pn * tstep;
    PG8_STAGE(PG8_SB(0, 0), cB, voffB); PG8_STAGE(PG8_SA(0, 0), cA, voffA); PG8_STAGE(PG8_SB(0, 1), cB + hstep, voffB); PG8_STAGE(PG8_SA(0, 1), cA + hstep, voffA);
    if (wr == 1) PG8_BAR;
    PG8_WAIT_V(4); PG8_BAR;
    PG8_STAGE(PG8_SB(1, 0), cB + kstep, voffB); PG8_STAGE(PG8_SA(1, 0), cA + kstep, voffA); PG8_STAGE(PG8_SB(1, 1), cB + hstep + kstep, voffB);
    PG8_WAIT_V(6); PG8_BAR;
    for (;;) {
        const bool has_next = S.next(ui + 1, nxt);
        const char* nA = has_next ? (const char*)g.A + (size_t)nxt.pm * tstep : cA; const char* nB = has_next ? (const char*)g.Bt + (size_t)nxt.pn * tstep : cB;
        for (int t = 0; t < nt; t += 2) {
            const bool last = (t == nt - 2);
            const char* a1 = cA + (size_t)(t + 1) * kstep;
            const char* a2 = last ? nA : cA + (size_t)(t + 2) * kstep; const char* b2 = last ? nB : cB + (size_t)(t + 2) * kstep;
            const char* a3 = a2 + kstep; const char* b3 = b2 + kstep;
            PG8_LDB(B0, 0, 0); PG8_SCHED; PG8_LDA(At, 0, 0); PG8_STAGE(PG8_SA(1, 1), a1 + hstep, voffA);
            PG8_WAIT_L(8); PG8_BAR; PG8_WAIT_L(0); PG8_MMA(0, 0, At, B0); PG8_BAR; PG8_SCHED;
            PG8_LDB(B1, 0, 1); PG8_STAGE(PG8_SB(0, 0), b2, voffB);
            PG8_BAR; PG8_WAIT_L(0); PG8_MMA(0, 1, At, B1); PG8_BAR;
            PG8_LDA(At, 0, 1); PG8_STAGE(PG8_SA(0, 0), a2, voffA);
            PG8_BAR; PG8_WAIT_L(0); PG8_MMA(1, 0, At, B0); PG8_BAR; PG8_SCHED;
            PG8_STAGE(PG8_SB(0, 1), b2 + hstep, voffB);
            PG8_WAIT_V(6); PG8_BAR; PG8_MMA(1, 1, At, B1); PG8_BAR;
            PG8_LDB(B0, 1, 0); PG8_SCHED; PG8_LDA(At, 1, 0); PG8_STAGE(PG8_SA(0, 1), a2 + hstep, voffA);
            PG8_WAIT_L(8); PG8_BAR; PG8_WAIT_L(0); PG8_MMA(0, 0, At, B0); PG8_BAR; PG8_SCHED;
            PG8_LDB(B1, 1, 1); PG8_STAGE(PG8_SB(1, 0), b3, voffB);
            PG8_BAR; PG8_WAIT_L(0); PG8_MMA(0, 1, At, B1); PG8_BAR;
            PG8_LDA(At, 1, 1); PG8_STAGE(PG8_SA(1, 0), a3, voffA);
            PG8_BAR; PG8_WAIT_L(0); PG8_MMA(1, 0, At, B0); PG8_BAR; PG8_SCHED;
            PG8_STAGE(PG8_SB(1, 1), b3 + hstep, voffB);
            PG8_WAIT_V(6); PG8_BAR; PG8_MMA(1, 1, At, B1); PG8_BAR;
        }
        E(acc, cur, wr, wc, fr, fq);
        if (!has_next) break;
#pragma unroll
        for (int a = 0; a < 2; ++a)
#pragma unroll
            for (int b = 0; b < 2; ++b)
#pragma unroll
                for (int m = 0; m < 4; ++m)
#pragma unroll
                    for (int n = 0; n < 2; ++n) acc[a][b][m][n] = (f32x4){0.f, 0.f, 0.f, 0.f};
        cur = nxt; cA = nA; cB = nB; ++ui;
    }
    PG8_WAIT_V(0);
    if (wr == 0) PG8_BAR;
    PG8_BAR;
#undef PG8_SA
#undef PG8_SB
#undef PG8_STAGE
#undef PG8_LDA
#undef PG8_LDB
#undef PG8_MMA
#undef PG8_WAIT_V
#undef PG8_WAIT_L
#undef PG8_BAR
#undef PG8_SCHED
}
}

__device__ __forceinline__ void prep_transposes(const int tidx, const P& p, LAS unsigned char* L, int l0, int l1, int blk, int nblk);
__device__ __forceinline__ void phase_prep(const int tidx, const P& p, LAS unsigned char* L) {
    const int tid = tidx;
    constexpr int NADA = NL * 96, TPL = 3264, TOTAL = NADA + NL * TPL;
    float* mod = (float*)(p.ws + WS_MOD);
    for (int it = blockIdx.x; it < NADA; it += gridDim.x) {
        __syncthreads();
        {
            const int l = it / 96, n0 = (it % 96) * 64;
            LAS float* cact = (LAS float*)L;
            LAS float* red = cact + 4096;
            for (int i = tid; i < 4096; i += 512) cact[i] = silu_f(p.c[i]);
            __syncthreads();
            const int kg = tid >> 6, nn = tid & 63;
            const float* w = p.w_ada + ((size_t)l * DM + kg * 128) * NMOD + n0 + nn;
            float a0 = 0.f, a1 = 0.f, a2 = 0.f, a3 = 0.f;
#pragma unroll 8
            for (int k = 0; k < 128; ++k) { const float wv = w[(size_t)k * NMOD]; const int kk = kg * 128 + k;
                a0 += cact[kk] * wv; a1 += cact[1024 + kk] * wv; a2 += cact[2048 + kk] * wv; a3 += cact[3072 + kk] * wv; }
            red[(kg * 4 + 0) * 64 + nn] = a0; red[(kg * 4 + 1) * 64 + nn] = a1; red[(kg * 4 + 2) * 64 + nn] = a2; red[(kg * 4 + 3) * 64 + nn] = a3;
            __syncthreads();
            if (tid < 256) { const int b = tid >> 6; float s = p.b_ada[l * NMOD + n0 + nn];
#pragma unroll
                for (int k2 = 0; k2 < 8; ++k2) s += red[(k2 * 4 + b) * 64 + nn];
                mod[(size_t)(l * NB + b) * NMOD + n0 + nn] = s; }
        }
    }
    prep_transposes(tidx, p, L, 0, 1, blockIdx.x, gridDim.x);
}
__device__ __forceinline__ void prep_transposes(const int tidx, const P& p, LAS unsigned char* L, int l0, int l1, int blk, int nblk) {
    const int tid = tidx;
    constexpr int TPL = 3264;
    for (int it0 = l0 * TPL + blk * 4; it0 < l1 * TPL; it0 += nblk * 4) {
        __syncthreads();
        bf16_t* dstp[4]; int kd[4];
#pragma unroll
        for (int tt = 0; tt < 4; ++tt) {
            const int j = it0 + tt, l = j / TPL; int r = j % TPL;
            const float* src; bf16_t* dst; int Ns, Nvalid, Kd, k0, ns0, nd0;
            if (r < 896) { const int kt = r / 56, nt = r % 56; src = p.w_in + (size_t)l * DM * NIN; Ns = NIN; Nvalid = NIN; Kd = DM; k0 = kt * 64; nd0 = nt * 64; ns0 = nd0;
                dst = (bf16_t*)(p.ws + WS_WIN) + (size_t)l * NINP * DM; }
            else if (r < 1152) { r -= 896; const int kt = r / 16, nt = r % 16; src = p.w_out + (size_t)l * DM * DM; Ns = DM; Nvalid = DM; Kd = DM; k0 = kt * 64; nd0 = nt * 64; ns0 = nd0;
                dst = (bf16_t*)(p.ws + WS_WOUT) + (size_t)l * DM * DM; }
            else if (r < 2560) { r -= 1152; const int kt = r / 88, nt = r % 88; src = p.w_ffn_in + (size_t)l * DM * NF1; Ns = NF1; Nvalid = NF1; Kd = DM; k0 = kt * 64; nd0 = nt * 64;
                const int pn = nd0 >> 8, half = (nd0 >> 7) & 1, sub = nd0 & 127; ns0 = half * DFF + pn * 128 + sub;
                dst = (bf16_t*)(p.ws + WS_WF1) + (size_t)l * NF1 * DM; }
            else { r -= 2560; const int kt = r / 16, nt = r % 16; src = p.w_ffn_out + (size_t)l * DFF * DM; Ns = DM; Nvalid = DM; Kd = DFF; k0 = kt * 64; nd0 = nt * 64; ns0 = nd0;
                dst = (bf16_t*)(p.ws + WS_WF2) + (size_t)l * DM * DFF; }
            LAS float* tile = (LAS float*)L + tt * (64 * 65);
            const int kk = tid >> 4, c4 = (tid & 15) * 4;
            f32x4 v0 = {0.f, 0.f, 0.f, 0.f}, v1 = {0.f, 0.f, 0.f, 0.f};
            if (ns0 + c4 < Nvalid) { v0 = *(const f32x4*)(src + (size_t)(k0 + kk) * Ns + ns0 + c4); v1 = *(const f32x4*)(src + (size_t)(k0 + kk + 32) * Ns + ns0 + c4); }
            tile[kk * 65 + c4 + 0] = v0[0]; tile[kk * 65 + c4 + 1] = v0[1]; tile[kk * 65 + c4 + 2] = v0[2]; tile[kk * 65 + c4 + 3] = v0[3];
            tile[(kk + 32) * 65 + c4 + 0] = v1[0]; tile[(kk + 32) * 65 + c4 + 1] = v1[1]; tile[(kk + 32) * 65 + c4 + 2] = v1[2]; tile[(kk + 32) * 65 + c4 + 3] = v1[3];
            dstp[tt] = dst + (size_t)nd0 * Kd + k0; kd[tt] = Kd;
        }
        __syncthreads();
#pragma unroll
        for (int tt = 0; tt < 4; ++tt) {
            LAS float* tile = (LAS float*)L + tt * (64 * 65);
            const int nn = tid >> 3, k8 = (tid & 7) * 8; float f[8];
#pragma unroll
            for (int i = 0; i < 8; ++i) f[i] = tile[(k8 + i) * 65 + nn];
            *(u32x4*)(dstp[tt] + (size_t)nn * kd[tt] + k8) = pack8(f);
        }
    }
}

__device__ __forceinline__ void phase_norm(const int tidx, const float* xin, const float* g, const float* modl, int shoff, int scoff, bf16_t* hout) {
    const int wave = tidx >> 6, lane = tidx & 63;
    for (int row0 = (blockIdx.x * 8 + wave) * 2; row0 < MTOK; row0 += gridDim.x * 16) {
        const int b = row0 >> 12;
        f32x4 v[2][4], gg[4], sc[4], sh[4];
#pragma unroll
        for (int rr = 0; rr < 2; ++rr)
#pragma unroll
            for (int i = 0; i < 4; ++i) v[rr][i] = *(const f32x4*)(xin + (size_t)(row0 + rr) * DM + i * 256 + lane * 4);
#pragma unroll
        for (int i = 0; i < 4; ++i) { const int k = i * 256 + lane * 4;
            gg[i] = *(const f32x4*)(g + k); sc[i] = *(const f32x4*)(modl + (size_t)b * NMOD + scoff + k); sh[i] = *(const f32x4*)(modl + (size_t)b * NMOD + shoff + k); }
#pragma unroll
        for (int rr = 0; rr < 2; ++rr) {
            float ss = 0.f;
#pragma unroll
            for (int i = 0; i < 4; ++i) ss += v[rr][i][0] * v[rr][i][0] + v[rr][i][1] * v[rr][i][1] + v[rr][i][2] * v[rr][i][2] + v[rr][i][3] * v[rr][i][3];
            ss = wave_sum(ss);
            const float rinv = rsqrtf(ss * (1.f / DM) + 1e-6f);
#pragma unroll
            for (int i = 0; i < 4; ++i) { const int k = i * 256 + lane * 4;
                const f32x4 y = v[rr][i] * rinv * gg[i] * (sc[i] + 1.f) + sh[i];
                u32x2 w; w.x = pk2(y[0], y[1]); w.y = pk2(y[2], y[3]);
                *(u32x2*)(hout + (size_t)(row0 + rr) * DM + k) = w; }
        }
    }
}
__device__ __forceinline__ void phase_final(const int tidx, float* x, const float* g) {
    const int wave = tidx >> 6, lane = tidx & 63;
    for (int row0 = (blockIdx.x * 8 + wave) * 2; row0 < MTOK; row0 += gridDim.x * 16) {
        f32x4 v[2][4], gg[4];
#pragma unroll
        for (int rr = 0; rr < 2; ++rr)
#pragma unroll
            for (int i = 0; i < 4; ++i) v[rr][i] = *(const f32x4*)(x + (size_t)(row0 + rr) * DM + i * 256 + lane * 4);
#pragma unroll
        for (int i = 0; i < 4; ++i) gg[i] = *(const f32x4*)(g + i * 256 + lane * 4);
#pragma unroll
        for (int rr = 0; rr < 2; ++rr) {
            float ss = 0.f;
#pragma unroll
            for (int i = 0; i < 4; ++i) ss += v[rr][i][0] * v[rr][i][0] + v[rr][i][1] * v[rr][i][1] + v[rr][i][2] * v[rr][i][2] + v[rr][i][3] * v[rr][i][3];
            ss = wave_sum(ss);
            const float rinv = rsqrtf(ss * (1.f / DM) + 1e-6f);
#pragma unroll
            for (int i = 0; i < 4; ++i) *(f32x4*)(x + (size_t)(row0 + rr) * DM + i * 256 + lane * 4) = v[rr][i] * rinv * gg[i];
        }
    }
}

__device__ __forceinline__ void phase_dprep(const int tidx, const P& p, int l, LAS unsigned char* L) {
    LAS bf16_t* Qn = (LAS bf16_t*)(L + 0);
    LAS bf16_t* Kn = (LAS bf16_t*)(L + 17408);
    LAS bf16_t* KbgT = (LAS bf16_t*)(L + 34816);
    LAS bf16_t* KtlT = (LAS bf16_t*)(L + 53248);
    LAS bf16_t* VbT = (LAS bf16_t*)(L + 71680);
    LAS float* Lm = (LAS float*)(L + 90112);
    LAS bf16_t* Tm = (LAS bf16_t*)(L + 107520);
    LAS bf16_t* QKm = (LAS bf16_t*)(L + 116736);
    LAS float* gcs = (LAS float*)(L + 125952);
    LAS float* betas = gcs + 64;
    LAS float* cwl = (LAS float*)(L + LDS_CW_OFF);
    LAS float* Tf = (LAS float*)(L + LDS_TF_OFF);
    const bf16_t* proj = (const bf16_t*)(p.ws + WS_PROJ);
    float* alast = (float*)(p.ws + WS_ALAST);
    u32x4 rawA[7], rawB[7]; float cwreg[4], alpha_r = 0.f, beta_r = 0.f;
#define DP_ISSUE(it_, tid_) do { const int h_ = (it_) & 3, n_ = ((it_) >> 2) & 63, t0_ = ((it_) >> 8) * SEQ + n_ * 64; \
        const int tk0_ = (((tid_) >> 4) & 15) * 4, d0_ = ((tid_) & 15) * 8; \
        _Pragma("unroll") for (int rr = 0; rr < 7; ++rr) { const int pos = n_ * 64 + tk0_ - 3 + rr; \
            rawA[rr] = (u32x4){0u, 0u, 0u, 0u}; rawB[rr] = (u32x4){0u, 0u, 0u, 0u}; \
            if (pos >= 0) { const bf16_t* pr = proj + (size_t)(t0_ + tk0_ - 3 + rr) * NINP + 1280 + h_ * 128 + d0_; \
                rawA[rr] = *(const u32x4*)(pr + ((tid_) >> 8) * 512); \
                if ((tid_) < 256) rawB[rr] = *(const u32x4*)(pr + 1024); } } \
        if ((tid_) < 384) { _Pragma("unroll") for (int j = 0; j < 4; ++j) cwreg[j] = p.dn_conv_w[(size_t)(l * 4 + j) * 1536 + ((tid_) >> 7) * 512 + h_ * 128 + ((tid_) & 127)]; } \
        if (((tid_) >> 6) == 7) { const bf16_t* pr = proj + (size_t)(t0_ + ((tid_) & 63)) * NINP; alpha_r = bf2f(pr[3328 + h_]); beta_r = bf2f(pr[3332 + h_]); } } while (0)
    if ((int)blockIdx.x < 1024) DP_ISSUE((int)blockIdx.x, tidx);
    for (int item = blockIdx.x; item < 1024; item += gridDim.x) {
        __syncthreads();
        int tid = tidx; asm volatile("" : "+v"(tid));
        const int lane = tid & 63, wave = tid >> 6, r = lane & 15, q = lane >> 4;
        const int h = item & 3, n = (item >> 2) & 63, b = item >> 8;
        const int t0 = b * SEQ + n * 64;
        unsigned char* itp = p.ws + WS_DELTA + (size_t)item * ITEM_BYTES;
        const int run = (tid >> 4) & 15, d0 = (tid & 15) * 8, tk0 = run * 4, whichA = tid >> 8;
        if (tid < 384) {
#pragma unroll
            for (int j = 0; j < 4; ++j) cwl[j * 384 + tid] = cwreg[j];
        }
        if (wave == 7) {
            const float xx = alpha_r + p.dn_dt_bias[l * 4 + h];
            const float sp = fmaxf(xx, 0.f) + log1pf(__expf(-fabsf(xx)));
            float gc = -__expf(p.dn_a_log[l * 4 + h]) * sp;
#pragma unroll
            for (int o = 1; o < 64; o <<= 1) { const float tv = __shfl_up(gc, o); if (lane >= o) gc += tv; }
            gcs[lane] = gc; betas[lane] = sigmoid_f(beta_r);
        }
        __syncthreads();
        const float gl = gcs[63];
#pragma unroll
        for (int pass = 0; pass < 2; ++pass) {
            if (pass == 1 && tid >= 256) break;
            const int which = pass ? 2 : whichA;
            const LAS float* cw = cwl + which * 128 + d0;
            float y[4][8];
#pragma unroll
            for (int i = 0; i < 4; ++i)
#pragma unroll
                for (int d = 0; d < 8; ++d) y[i][d] = 0.f;
#pragma unroll
            for (int j = 0; j < 4; ++j) {
                const f32x4 w0 = *(const LAS f32x4*)(cw + j * 384), w1 = *(const LAS f32x4*)(cw + j * 384 + 4);
#pragma unroll
                for (int i = 0; i < 4; ++i) { float rf[8]; unpack8(pass ? rawB[i + j] : rawA[i + j], rf);
#pragma unroll
                    for (int d = 0; d < 4; ++d) { y[i][d] += w0[d] * rf[d]; y[i][4 + d] += w1[d] * rf[4 + d]; } }
            }
#pragma unroll
            for (int i = 0; i < 4; ++i) {
#pragma unroll
                for (int d = 0; d < 8; ++d) y[i][d] = silu_f(y[i][d]);
                if (which < 2) {
                    float ss = 0.f;
#pragma unroll
                    for (int d = 0; d < 8; ++d) ss += y[i][d] * y[i][d];
                    ss += __shfl_xor(ss, 1); ss += __shfl_xor(ss, 2); ss += __shfl_xor(ss, 4); ss += __shfl_xor(ss, 8);
                    float rinv = rsqrtf(ss + 1e-6f);
                    if (which == 0) rinv *= 0.08838834764831845f;
#pragma unroll
                    for (int d = 0; d < 8; ++d) y[i][d] *= rinv;
                }
            }
            if (which == 0) {
#pragma unroll
                for (int i = 0; i < 4; ++i) *(LAS u32x4*)(Qn + (tk0 + i) * 136 + d0) = pack8(y[i]);
            } else if (which == 1) {
                float f1[4], f2[4];
#pragma unroll
                for (int i = 0; i < 4; ++i) { const float gc = gcs[tk0 + i]; f1[i] = betas[tk0 + i] * __expf(gc); f2[i] = __expf(gl - gc); }
#pragma unroll
                for (int i = 0; i < 4; ++i) *(LAS u32x4*)(Kn + (tk0 + i) * 136 + d0) = pack8(y[i]);
#pragma unroll
                for (int d = 0; d < 8; ++d) {
                    u32x2 a, c; a.x = pk2(y[0][d] * f1[0], y[1][d] * f1[1]); a.y = pk2(y[2][d] * f1[2], y[3][d] * f1[3]); c.x = pk2(y[0][d] * f2[0], y[1][d] * f2[1]); c.y = pk2(y[2][d] * f2[2], y[3][d] * f2[3]);
                    *(LAS u32x2*)(KbgT + (d0 + d) * 72 + tk0) = a; *(LAS u32x2*)(KtlT + (d0 + d) * 72 + tk0) = c; }
            } else {
                float bt[4];
#pragma unroll
                for (int i = 0; i < 4; ++i) bt[i] = betas[tk0 + i];
#pragma unroll
                for (int d = 0; d < 8; ++d) { u32x2 a; a.x = pk2(y[0][d] * bt[0], y[1][d] * bt[1]); a.y = pk2(y[2][d] * bt[2], y[3][d] * bt[3]);
                    *(LAS u32x2*)(VbT + (d0 + d) * 72 + tk0) = a; }
            }
        }
        if (item + (int)gridDim.x < 1024) DP_ISSUE(item + (int)gridDim.x, tid);
        __syncthreads();
        {
            const int mat = wave >> 2, cb = wave & 3;
            LAS bf16_t* Asrc = mat ? Qn : Kn;
            bf16x8 a[4];
#pragma unroll
            for (int kb = 0; kb < 4; ++kb) a[kb] = *(LAS bf16x8*)(Asrc + (16 * cb + r) * 136 + 32 * kb + 8 * q);
#pragma unroll
            for (int sb = 0; sb < 4; ++sb) {
                f32x4 acc = {0.f, 0.f, 0.f, 0.f};
                if (sb <= cb) {
#pragma unroll
                    for (int kb = 0; kb < 4; ++kb) { const bf16x8 bb = *(LAS bf16x8*)(Kn + (16 * sb + r) * 136 + 32 * kb + 8 * q); acc = MFMA16(a[kb], bb, acc); }
                }
                const int s = 16 * sb + r; const float gs = gcs[s];
#pragma unroll
                for (int j = 0; j < 4; ++j) { const int c = 16 * cb + 4 * q + j; const float dec = __expf(gcs[c] - gs);
                    if (mat == 0) Lm[c * 68 + s] = (s < c) ? acc[j] * betas[c] * dec : 0.f;
                    else QKm[c * 72 + s] = f2bf((s <= c) ? acc[j] * dec : 0.f); }
            }
        }
        __syncthreads();
        if (wave < 4) {
            const int blk = wave, c = lane & 15;
            int zoff; asm volatile("v_mov_b32 %0, 0" : "=v"(zoff));
            LAS float* Lb = Lm + (16 * blk) * 68 + 16 * blk + zoff;
            float t[16];
            f32x4 rb[2][4];
            t[0] = (c == 0) ? 1.f : 0.f;
            rb[1][0] = *(LAS f32x4*)(Lb + 1 * 68);
#pragma unroll
            for (int i = 1; i < 16; ++i) {
                if (i + 1 < 16) {
#pragma unroll
                    for (int j4 = 0; j4 < (i + 4) / 4; ++j4) rb[(i + 1) & 1][j4] = *(LAS f32x4*)(Lb + (i + 1) * 68 + 4 * j4);
                }
                __builtin_amdgcn_sched_barrier(0);
                float acc0 = (i == c) ? 1.f : 0.f, acc1 = 0.f;
#pragma unroll
                for (int j = 0; j < i; ++j) { if (j & 1) acc1 -= rb[i & 1][j >> 2][j & 3] * t[j]; else acc0 -= rb[i & 1][j >> 2][j & 3] * t[j]; }
                t[i] = acc0 + acc1;
                __builtin_amdgcn_sched_barrier(0);
            }
            if (q == 0) {
#pragma unroll
                for (int i = 0; i < 16; ++i) { Tf[(16 * blk + i) * 68 + 16 * blk + c] = t[i]; Tm[(16 * blk + i) * 72 + 16 * blk + c] = f2bf(t[i]); }
            }
            for (int cb = blk + 1; cb < 4; ++cb) {
#pragma unroll
                for (int jj = 0; jj < 4; ++jj) Tm[(16 * blk + 4 * q + jj) * 72 + 16 * cb + r] = (bf16_t)0;
            }
        } else {
            if (wave == 4 && lane == 0) alast[item] = __expf(gl);
            for (int jb = wave - 4; jb < 40; jb += 4) {
                if (jb < 16) {
                    const int tb = jb >> 2, kb = jb & 3, tok = 16 * tb + r;
                    const u32x2 lo = *(LAS u32x2*)(Qn + tok * 136 + 32 * kb + 4 * q), hi = *(LAS u32x2*)(Qn + tok * 136 + 32 * kb + 16 + 4 * q);
                    const float e = __expf(gcs[tok]);
                    u32x4 w; w.x = pk2(lo16(lo.x) * e, hi16(lo.x) * e); w.y = pk2(lo16(lo.y) * e, hi16(lo.y) * e); w.z = pk2(lo16(hi.x) * e, hi16(hi.x) * e); w.w = pk2(lo16(hi.y) * e, hi16(hi.y) * e);
                    *(u32x4*)(itp + OFF_Q + (size_t)(jb * 64 + lane) * 16) = w;
                } else if (jb < 32) {
                    const int f = jb - 16, db = f >> 1, kb = f & 1, dk = 16 * db + r;
                    const u32x2 lo = *(LAS u32x2*)(KtlT + dk * 72 + 32 * kb + 4 * q), hi = *(LAS u32x2*)(KtlT + dk * 72 + 32 * kb + 16 + 4 * q);
                    u32x4 w; w.x = lo.x; w.y = lo.y; w.z = hi.x; w.w = hi.y;
                    *(u32x4*)(itp + OFF_KT + (size_t)(f * 64 + lane) * 16) = w;
                } else {
                    const int f = jb - 32, tb = f >> 1, kb = f & 1, tok = 16 * tb + r;
                    const u32x2 lo = *(LAS u32x2*)(QKm + tok * 72 + 32 * kb + 4 * q), hi = *(LAS u32x2*)(QKm + tok * 72 + 32 * kb + 16 + 4 * q);
                    u32x4 w; w.x = lo.x; w.y = lo.y; w.z = hi.x; w.w = hi.y;
                    *(u32x4*)(itp + OFF_QK + (size_t)(f * 64 + lane) * 16) = w;
                }
            }
        }
        __syncthreads();
#pragma unroll
        for (int d = 1; d < 4; ++d) {
            if (wave < 4 - d) {
                const int bj = wave, bi = wave + d;
                f32x4 M = {0.f, 0.f, 0.f, 0.f};
#pragma unroll
                for (int kk = 0; kk < d; ++kk) { const int bk = bj + kk;
#pragma unroll
                    for (int s = 0; s < 4; ++s) M = __builtin_amdgcn_mfma_f32_16x16x4f32(Lm[(16 * bi + r) * 68 + 16 * bk + 4 * s + q], Tf[(16 * bk + 4 * s + q) * 68 + 16 * bj + r], M, 0, 0, 0);
                }
                f32x4 Tn = {0.f, 0.f, 0.f, 0.f};
#pragma unroll
                for (int s = 0; s < 4; ++s) Tn = __builtin_amdgcn_mfma_f32_16x16x4f32(Tf[(16 * bi + r) * 68 + 16 * bi + 4 * q + s], M[s], Tn, 0, 0, 0);
#pragma unroll
                for (int jj = 0; jj < 4; ++jj) { Tf[(16 * bi + 4 * q + jj) * 68 + 16 * bj + r] = -Tn[jj]; Tm[(16 * bi + 4 * q + jj) * 72 + 16 * bj + r] = f2bf(-Tn[jj]); }
            }
            __syncthreads();
        }
        {
            const int s = wave;
            bf16x8 vb[2];
#pragma unroll
            for (int kb = 0; kb < 2; ++kb) vb[kb] = *(LAS bf16x8*)(VbT + (16 * s + r) * 72 + 32 * kb + 8 * q);
#pragma unroll
            for (int tb = 0; tb < 4; ++tb) {
                f32x4 acc = {0.f, 0.f, 0.f, 0.f};
#pragma unroll
                for (int kb = 0; kb < 2; ++kb) { const bf16x8 a = *(LAS bf16x8*)(Tm + (16 * tb + r) * 72 + 32 * kb + 8 * q); acc = MFMA16(a, vb[kb], acc); }
                *(f32x4*)(itp + OFF_U + (size_t)((s * 4 + tb) * 64 + lane) * 16) = acc;
            }
            const int kbp = wave & 3, tbh = wave >> 2;
            bf16x8 ka[2][2];
#pragma unroll
            for (int d = 0; d < 2; ++d)
#pragma unroll
                for (int kb = 0; kb < 2; ++kb) ka[d][kb] = *(LAS bf16x8*)(KbgT + (16 * (2 * kbp + d) + r) * 72 + 32 * kb + 8 * q);
#pragma unroll
            for (int tt = 0; tt < 2; ++tt) {
                const int tb = 2 * tbh + tt;
                f32x4 a0 = {0.f, 0.f, 0.f, 0.f}, a1 = {0.f, 0.f, 0.f, 0.f};
#pragma unroll
                for (int kb = 0; kb < 2; ++kb) { const bf16x8 tf = *(LAS bf16x8*)(Tm + (16 * tb + r) * 72 + 32 * kb + 8 * q); a0 = MFMA16(ka[0][kb], tf, a0); a1 = MFMA16(ka[1][kb], tf, a1); }
                u32x4 w; w.x = pk2(a0[0], a0[1]); w.y = pk2(a0[2], a0[3]); w.z = pk2(a1[0], a1[1]); w.w = pk2(a1[2], a1[3]);
                *(u32x4*)(itp + OFF_W + (size_t)((tb * 4 + kbp) * 64 + lane) * 16) = w;
            }
        }
    }
}

__device__ __forceinline__ void mixer_a(const int tidx, const P& p, int l, int blk, int nblk) {
    const bf16_t* proj = (const bf16_t*)(p.ws + WS_PROJ); bf16_t* ycat = (bf16_t*)(p.ws + WS_YCAT);
    for (int unit = blk * 512 + tidx; unit < MTOK * 32; unit += nblk * 512) {
        const int t = unit >> 5, c0 = (unit & 31) * 8, pos = t & (SEQ - 1);
        float acc[8];
#pragma unroll
        for (int i = 0; i < 8; ++i) acc[i] = 0.f;
#pragma unroll
        for (int j = 0; j < 3; ++j) {
            if (pos - 2 + j >= 0) {
                const bf16_t* pr = proj + (size_t)(t - 2 + j) * NINP;
                float fc[8], fv[8]; unpack8(*(const u32x4*)(pr + 256 + c0), fc); unpack8(*(const u32x4*)(pr + 512 + c0), fv);
                const float* wp = p.conv_a_w + (size_t)(l * 3 + j) * 256 + c0;
                const f32x4 w0 = *(const f32x4*)wp, w1 = *(const f32x4*)(wp + 4);
#pragma unroll
                for (int i = 0; i < 4; ++i) { acc[i] += w0[i] * fc[i] * fv[i]; acc[4 + i] += w1[i] * fc[4 + i] * fv[4 + i]; }
            }
        }
        float fb[8]; unpack8(*(const u32x4*)(proj + (size_t)t * NINP + c0), fb);
#pragma unroll
        for (int i = 0; i < 8; ++i) acc[i] *= fb[i];
        *(u32x4*)(ycat + (size_t)t * DM + c0) = pack8(acc);
    }
}
__device__ __forceinline__ void mixer_b(const int tidx, const P& p, int l, int blk, int nblk, LAS unsigned char* L) {
    const bf16_t* proj = (const bf16_t*)(p.ws + WS_PROJ); bf16_t* ycat = (bf16_t*)(p.ws + WS_YCAT);
    LAS float* ut = (LAS float*)L;
    LAS float* co = (LAS float*)(L + 63488);
    const int tid = tidx, wave = tid >> 6, lane = tid & 63;
    for (int run = blk; run < MTOK / 32; run += nblk) {
        __syncthreads();
        const int t0 = run * 32, pos0 = t0 & (SEQ - 1);
        {
            u32x4 ra[4], rg[4];
#pragma unroll
            for (int it = 0; it < 4; ++it) { const int idx = tid + 512 * it, rr = idx >> 5, c0 = (idx & 31) * 8;
                ra[it] = (u32x4){0u, 0u, 0u, 0u}; rg[it] = (u32x4){0u, 0u, 0u, 0u};
                if (idx < 62 * 32 && pos0 - 30 + rr >= 0) { const bf16_t* pr = proj + (size_t)(t0 - 30 + rr) * NINP; ra[it] = *(const u32x4*)(pr + 768 + c0); rg[it] = *(const u32x4*)(pr + 1024 + c0); } }
#pragma unroll
            for (int it = 0; it < 4; ++it) { const int idx = tid + 512 * it, rr = idx >> 5, c0 = (idx & 31) * 8;
                if (idx < 62 * 32) { float fa[8], fg[8], u[8]; unpack8(ra[it], fa); unpack8(rg[it], fg);
#pragma unroll
                    for (int i = 0; i < 8; ++i) u[i] = fa[i] * sigmoid_f(fg[i]);
                    *(LAS f32x4*)(ut + rr * 256 + c0) = (f32x4){u[0], u[1], u[2], u[3]}; *(LAS f32x4*)(ut + rr * 256 + c0 + 4) = (f32x4){u[4], u[5], u[6], u[7]}; } }
        }
        __syncthreads();
        {
            const int c = tid & 255, half = tid >> 8;
            float w[31], win[46];
#pragma unroll
            for (int j = 0; j < 31; ++j) w[j] = p.conf_dw_w[(size_t)(l * 31 + j) * 256 + c];
            const float bias = p.conf_dw_b[l * 256 + c];
#pragma unroll
            for (int k = 0; k < 46; ++k) win[k] = ut[(half * 16 + k) * 256 + c];
#pragma unroll
            for (int tt = 0; tt < 16; ++tt) { float acc = bias;
#pragma unroll
                for (int j = 0; j < 31; ++j) acc += w[j] * win[tt + j];
                co[(half * 16 + tt) * 256 + c] = acc; }
        }
        __syncthreads();
#pragma unroll
        for (int i = 0; i < 4; ++i) {
            const int tl = wave * 4 + i;
            const f32x4 v = *(LAS f32x4*)(co + tl * 256 + lane * 4);
            const float mean = wave_sum(v[0] + v[1] + v[2] + v[3]) * (1.f / 256.f);
            const f32x4 d = v - mean;
            const float var = wave_sum(d[0] * d[0] + d[1] * d[1] + d[2] * d[2] + d[3] * d[3]) * (1.f / 256.f);
            const float rs = rsqrtf(var + 1e-5f);
            const f32x4 gg = *(const f32x4*)(p.conf_ln_g + l * 256 + lane * 4), bb = *(const f32x4*)(p.conf_ln_b + l * 256 + lane * 4);
            const f32x4 y = d * rs * gg + bb;
            u32x2 wv; wv.x = pk2(silu_f(y[0]), silu_f(y[1])); wv.y = pk2(silu_f(y[2]), silu_f(y[3]));
            *(u32x2*)(ycat + (size_t)(t0 + tl) * DM + 256 + lane * 4) = wv;
        }
    }
}

constexpr int SCAN_BLOCKS = 128, SCAN_BUF = 64512;
__device__ __forceinline__ void phase_scan(const int tidx, const P& p, int l, LAS unsigned char* L) {
    const int tid = tidx, lane = tid & 63, wave = tid >> 6, r = lane & 15, q = lane >> 4;
    if ((int)blockIdx.x >= SCAN_BLOCKS) {
        const int blk = blockIdx.x - SCAN_BLOCKS, nblk = gridDim.x - SCAN_BLOCKS;
        mixer_a(tidx, p, l, blk, nblk);
        mixer_b(tidx, p, l, blk, nblk, L);
        if (l + 1 < NL) prep_transposes(tidx, p, L, l + 1, l + 2, blk, nblk);
        return;
    }
    const int item = blockIdx.x, xcd = item & 7, jj = item >> 3, s = jj & 7, bh = xcd * 2 + (jj >> 3), b = bh >> 2, h = bh & 3;
    const unsigned char* dl = p.ws + WS_DELTA;
    const float* alast = (const float*)(p.ws + WS_ALAST);
    float* obuf = (float*)(p.ws + WS_H);
#define SB_ __builtin_amdgcn_sched_barrier(0)
#define SCAN_COMPUTE(buf, n_) do { \
            const float al = __builtin_bit_cast(float, __builtin_amdgcn_readlane(__builtin_bit_cast(int, al_all), (n_))); \
            const LAS bf16x8* Wf = (const LAS bf16x8*)((buf) + OFF_W) + lane; const LAS bf16x8* Qf = (const LAS bf16x8*)((buf) + OFF_Q) + lane; \
            const LAS bf16x8* Kf = (const LAS bf16x8*)((buf) + OFF_KT) + lane; const LAS bf16x8* QKf = (const LAS bf16x8*)((buf) + OFF_QK) + lane; \
            const LAS f32x4* Uf = (const LAS f32x4*)((buf) + OFF_U) + lane; \
            bf16x8 g0[8], g1[8]; f32x4 Uv[4]; \
            _Pragma("unroll") for (int f = 0; f < 8; ++f) g0[f] = Wf[((f >> 1) * 4 + (f & 1)) * 64];                \
            _Pragma("unroll") for (int f = 0; f < 8; ++f) g1[f] = Wf[((f >> 1) * 4 + 2 + (f & 1)) * 64];            \
            bf16x8 Sb[4]; \
            _Pragma("unroll") for (int kb = 0; kb < 4; ++kb) { u32x4 w; w.x = pk2(S[2 * kb][0], S[2 * kb][1]); w.y = pk2(S[2 * kb][2], S[2 * kb][3]); w.z = pk2(S[2 * kb + 1][0], S[2 * kb + 1][1]); w.w = pk2(S[2 * kb + 1][2], S[2 * kb + 1][3]); \
                Sb[kb] = __builtin_bit_cast(bf16x8, w); } \
            f32x4 Pv[4], O[4]; \
            _Pragma("unroll") for (int tb = 0; tb < 4; ++tb) { Pv[tb] = (f32x4){0.f, 0.f, 0.f, 0.f}; O[tb] = (f32x4){0.f, 0.f, 0.f, 0.f}; } \
            SB_; \
            _Pragma("unroll") for (int f = 0; f < 8; ++f) Pv[f >> 1] = MFMA16(g0[f], Sb[f & 1], Pv[f >> 1]); \
            _Pragma("unroll") for (int f = 0; f < 8; ++f) g0[f] = Qf[((f >> 1) * 4 + (f & 1)) * 64]; \
            SB_; \
            _Pragma("unroll") for (int f = 0; f < 8; ++f) Pv[f >> 1] = MFMA16(g1[f], Sb[2 + (f & 1)], Pv[f >> 1]); \
            _Pragma("unroll") for (int f = 0; f < 8; ++f) g1[f] = Qf[((f >> 1) * 4 + 2 + (f & 1)) * 64]; \
            _Pragma("unroll") for (int tb = 0; tb < 4; ++tb) Uv[tb] = Uf[tb * 64]; \
            SB_; \
            _Pragma("unroll") for (int f = 0; f < 8; ++f) O[f >> 1] = MFMA16(g0[f], Sb[f & 1], O[f >> 1]); \
            _Pragma("unroll") for (int f = 0; f < 8; ++f) g0[f] = Kf[(f * 2) * 64];                                  \
            SB_; \
            _Pragma("unroll") for (int f = 0; f < 8; ++f) O[f >> 1] = MFMA16(g1[f], Sb[2 + (f & 1)], O[f >> 1]); \
            _Pragma("unroll") for (int f = 0; f < 8; ++f) g1[f] = Kf[(f * 2 + 1) * 64];                              \
            _Pragma("unroll") for (int tb = 0; tb < 4; ++tb) Pv[tb] = Uv[tb] - Pv[tb]; \
            bf16x8 Vb[2]; \
            _Pragma("unroll") for (int kb = 0; kb < 2; ++kb) { u32x4 w; w.x = pk2(Pv[2 * kb][0], Pv[2 * kb][1]); w.y = pk2(Pv[2 * kb][2], Pv[2 * kb][3]); w.z = pk2(Pv[2 * kb + 1][0], Pv[2 * kb + 1][1]); w.w = pk2(Pv[2 * kb + 1][2], Pv[2 * kb + 1][3]); \
                Vb[kb] = __builtin_bit_cast(bf16x8, w); } \
            _Pragma("unroll") for (int db = 0; db < 8; ++db) S[db] = S[db] * al; \
            SB_; \
            _Pragma("unroll") for (int f = 0; f < 8; ++f) S[f] = MFMA16(g0[f], Vb[0], S[f]); \
            _Pragma("unroll") for (int f = 0; f < 8; ++f) if (f != 1 && f != 3) g0[f] = QKf[f * 64];                  \
            SB_; \
            _Pragma("unroll") for (int f = 0; f < 8; ++f) S[f] = MFMA16(g1[f], Vb[1], S[f]); \
            SB_; \
            _Pragma("unroll") for (int f = 0; f < 8; ++f) if (f != 1 && f != 3) O[f >> 1] = MFMA16(g0[f], Vb[f & 1], O[f >> 1]); \
            float* op = obuf + (size_t)(b * SEQ + (n_) * 64 + 4 * q) * 512 + h * 128 + 16 * s + r; \
            _Pragma("unroll") for (int tb = 0; tb < 4; ++tb) \
                _Pragma("unroll") for (int j = 0; j < 4; ++j) op[(size_t)(16 * tb + j) * 512] = O[tb][j]; \
        } while (0)
#define SCAN_BAR() do { asm volatile("s_waitcnt lgkmcnt(0)" ::: "memory"); __builtin_amdgcn_s_barrier(); asm volatile("" ::: "memory"); } while (0)
    LAS unsigned char* buf0 = L; LAS unsigned char* buf1 = L + SCAN_BUF;
    if (wave == 0) {
        const float al_all = alast[(b * 64 + lane) * 4 + h];
        f32x4 S[8];
#pragma unroll
        for (int i = 0; i < 8; ++i) S[i] = (f32x4){0.f, 0.f, 0.f, 0.f};
        SCAN_BAR();
        __builtin_amdgcn_s_setprio(3);
#pragma unroll 1
        for (int n = 0; n < 64; n += 2) {
            SCAN_COMPUTE(buf0, n);
            SCAN_BAR();
            SCAN_COMPUTE(buf1, n + 1);
            SCAN_BAR();
        }
        __builtin_amdgcn_s_setprio(0);
    } else {
        const int ct = tid - 64;
        const int off8 = (ct < 256) ? (OFF_U + s * 4096 + ct * 16) : ((ct - 256) * 16);
        const unsigned char* dlb = dl + (size_t)((b * 64) * 4 + h) * ITEM_BYTES;
        u32x4 R0[9], R1[9], R2[9], R3[9];
#define SCAN_LOAD(regs, n_) do { const int nn_ = ((n_) < 64) ? (n_) : 63; const unsigned char* itp_ = dlb + (size_t)nn_ * (4 * ITEM_BYTES); \
        _Pragma("unroll") for (int i_ = 0; i_ < 8; ++i_) regs[i_] = *(const u32x4*)(itp_ + (ct + 448 * i_) * 16); \
        regs[8] = *(const u32x4*)(itp_ + off8); __builtin_amdgcn_sched_barrier(0); } while (0)
#define SCAN_STORE(regs, buf_) do { _Pragma("unroll") for (int i_ = 0; i_ < 9; ++i_) *(LAS u32x4*)((buf_) + (ct + 448 * i_) * 16) = regs[i_]; } while (0)
        SCAN_LOAD(R0, 0); SCAN_LOAD(R1, 1); SCAN_LOAD(R2, 2); SCAN_LOAD(R3, 3);
        SCAN_STORE(R0, buf0);
        SCAN_BAR();
#pragma unroll 1
        for (int n = 0; n < 64; n += 4) {
            SCAN_LOAD(R0, n + 4); SCAN_STORE(R1, buf1); SCAN_BAR();
            SCAN_LOAD(R1, n + 5); SCAN_STORE(R2, buf0); SCAN_BAR();
            SCAN_LOAD(R2, n + 6); SCAN_STORE(R3, buf1); SCAN_BAR();
            SCAN_LOAD(R3, n + 7); SCAN_STORE(R0, buf0); SCAN_BAR();
        }
    }
#undef SCAN_COMPUTE
#undef SB_
#undef SCAN_BAR
#undef SCAN_LOAD
#undef SCAN_STORE
}

__device__ __forceinline__ void phase_onorm(const int tidx, const P& p, int l) {
    const bf16_t* proj = (const bf16_t*)(p.ws + WS_PROJ); bf16_t* ycat = (bf16_t*)(p.ws + WS_YCAT); const float* obuf = (const float*)(p.ws + WS_H);
    const int sub = tidx & 15, d0 = sub * 8;
    const f32x4 g0 = *(const f32x4*)(p.dn_norm_g + l * 128 + d0), g1 = *(const f32x4*)(p.dn_norm_g + l * 128 + d0 + 4);
    for (int unit0 = (blockIdx.x * 32 + (tidx >> 4)) * 2; unit0 < MTOK * 4; unit0 += gridDim.x * 64) {
        f32x4 o0[2], o1[2]; u32x4 zr[2];
#pragma unroll
        for (int uu = 0; uu < 2; ++uu) { const int t = (unit0 + uu) >> 2, h = (unit0 + uu) & 3;
            o0[uu] = *(const f32x4*)(obuf + (size_t)t * 512 + h * 128 + d0); o1[uu] = *(const f32x4*)(obuf + (size_t)t * 512 + h * 128 + d0 + 4);
            zr[uu] = *(const u32x4*)(proj + (size_t)t * NINP + 2816 + h * 128 + d0); }
#pragma unroll
        for (int uu = 0; uu < 2; ++uu) { const int t = (unit0 + uu) >> 2, h = (unit0 + uu) & 3;
            float ss = o0[uu][0] * o0[uu][0] + o0[uu][1] * o0[uu][1] + o0[uu][2] * o0[uu][2] + o0[uu][3] * o0[uu][3] + o1[uu][0] * o1[uu][0] + o1[uu][1] * o1[uu][1] + o1[uu][2] * o1[uu][2] + o1[uu][3] * o1[uu][3];
            ss += __shfl_xor(ss, 1); ss += __shfl_xor(ss, 2); ss += __shfl_xor(ss, 4); ss += __shfl_xor(ss, 8);
            const float rinv = rsqrtf(ss * (1.f / 128.f) + 1e-6f);
            float z[8]; unpack8(zr[uu], z);
            float y[8];
#pragma unroll
            for (int i = 0; i < 4; ++i) { y[i] = o0[uu][i] * rinv * g0[i] * silu_f(z[i]); y[4 + i] = o1[uu][i] * rinv * g1[i] * silu_f(z[4 + i]); }
            *(u32x4*)(ycat + (size_t)t * DM + 512 + h * 128 + d0) = pack8(y); }
    }
}

#define XB_TMO      128
#define XB_XCNT(j)  (256  + 64 * (j))
#define XB_XSUB(j)  (1280 + 64 * (j))
#define XB_XGEN(j)  (2304 + 64 * (j))
#define XB_TOP      3328
#define XB_TOPGEN   3392
#define XCD_BAR_WORDS 3456
#define XB_SPIN_CAP (1u << 22)
__device__ __forceinline__ unsigned xb_ld(unsigned* p)              { return __hip_atomic_load(p, __ATOMIC_RELAXED, __HIP_MEMORY_SCOPE_AGENT); }
__device__ __forceinline__ unsigned xb_add(unsigned* p, unsigned v) { return __hip_atomic_fetch_add(p, v, __ATOMIC_RELAXED, __HIP_MEMORY_SCOPE_AGENT); }
__device__ __forceinline__ unsigned xb_xcc_id() { return (unsigned)__builtin_amdgcn_s_getreg((3 << 11) | 20) & 0xFu; }
#define XB_SPIN(cond, bar) do { unsigned _sp = 0; while (cond) { __builtin_amdgcn_s_sleep(1); \
    if ((++_sp & 255u) == 0u) { if (xb_ld(&(bar)[XB_TMO])) break; if (_sp > XB_SPIN_CAP) { atomicAdd(&(bar)[XB_TMO], 1u); break; } } } } while (0)
struct XcdBarrier { unsigned* bar; unsigned x; volatile LAS unsigned* st; };
__device__ __forceinline__ XcdBarrier xcd_barrier_post(unsigned* bar, volatile LAS unsigned* st) {
    XcdBarrier b; b.bar = bar; b.x = xb_xcc_id(); b.st = st;
    if (threadIdx.x == 0) (void)xb_add(&bar[XB_XCNT(b.x)], 1u);
    return b;
}
__device__ __forceinline__ void xcd_barrier_complete(unsigned* bar, unsigned x, unsigned& nloc, unsigned& nx) {
    const unsigned G = gridDim.x * gridDim.y * gridDim.z;
    unsigned sum, cnt, mine, sp = 0u;
    for (;;) {
        sum = 0u; cnt = 0u; mine = 0u;
#pragma unroll
        for (unsigned j = 0; j < 16; ++j) { const unsigned c = xb_ld(&bar[XB_XCNT(j)]); sum += c; cnt += (c > 0u) ? 1u : 0u; mine = (j == x) ? c : mine; }
        if (sum == G) break;
        __builtin_amdgcn_s_sleep(1);
        if ((++sp & 255u) == 0u) { if (xb_ld(&bar[XB_TMO])) break; if (sp > XB_SPIN_CAP) { atomicAdd(&bar[XB_TMO], 1u); break; } }
    }
    nloc = mine > 0u ? mine : 1u; nx = cnt > 0u ? cnt : 1u;
}
__device__ __forceinline__ void xcd_barrier(const XcdBarrier& b) {
    asm volatile("s_waitcnt vmcnt(0)" ::: "memory");
    __syncthreads();
    if (threadIdx.x == 0) {
        unsigned* bar = b.bar;
        __builtin_amdgcn_s_waitcnt(0);
        unsigned nloc = b.st[0], nx = b.st[1];
        if (nloc == 0u) { xcd_barrier_complete(bar, b.x, nloc, nx); b.st[0] = nloc; b.st[1] = nx; }
        const unsigned old = xb_add(&bar[XB_XSUB(b.x)], 1u);
        const unsigned gen = old / nloc;
        if (old + 1u == (gen + 1u) * nloc) {
            __builtin_amdgcn_fence(__ATOMIC_RELEASE, "agent");
            asm volatile("s_waitcnt vmcnt(0)" ::: "memory");
            const unsigned og = xb_add(&bar[XB_TOP], 1u);
            const unsigned tg = og / nx;
            if (og + 1u == (tg + 1u) * nx) xb_add(&bar[XB_TOPGEN], 1u);
            else XB_SPIN(xb_ld(&bar[XB_TOPGEN]) == tg, bar);
            __builtin_amdgcn_fence(__ATOMIC_ACQUIRE, "agent");
            xb_add(&bar[XB_XGEN(b.x)], 1u);
            asm volatile("s_waitcnt vmcnt(0)" ::: "memory");
        } else {
            XB_SPIN(xb_ld(&bar[XB_XGEN(b.x)]) == gen, bar);
            __builtin_amdgcn_fence(__ATOMIC_ACQUIRE, "agent");
            asm volatile("s_waitcnt vmcnt(0)" ::: "memory");
        }
    }
    __syncthreads();
}

template <int KIND>
__device__ __forceinline__ void run_kind(const int tidx, const P& p, int l, LAS unsigned char* L) {
    const float* modl = (const float*)(p.ws + WS_MOD) + (size_t)l * NB * NMOD;
    bf16_t* hbuf = (bf16_t*)(p.ws + WS_H); bf16_t* ycat = (bf16_t*)(p.ws + WS_YCAT); bf16_t* proj = (bf16_t*)(p.ws + WS_PROJ);
    const float* xin = (l == 0) ? p.x : p.out;
    if constexpr (KIND == 0) phase_prep(tidx, p, L);
    if constexpr (KIND == 1) phase_norm(tidx, xin, p.norm_mix_g + l * DM, modl, 0, DM, hbuf);
    if constexpr (KIND == 2) { pg8::Gemm g{hbuf, (const bf16_t*)(p.ws + WS_WIN) + (size_t)l * NINP * DM, MTOK, NINP, DM}; pg8::StaticOrder S; S.init(MTOK, NINP, gridDim.x, blockIdx.x);
        pg8::EpiProj E{proj, NINP}; pg8::gemm_phase<pg8::EpiProj>(tidx, L, g, S, E); }
    if constexpr (KIND == 3) phase_dprep(tidx, p, l, L);
    if constexpr (KIND == 4) phase_scan(tidx, p, l, L);
    if constexpr (KIND == 5) phase_onorm(tidx, p, l);
    if constexpr (KIND == 6) { pg8::Gemm g{ycat, (const bf16_t*)(p.ws + WS_WOUT) + (size_t)l * DM * DM, MTOK, DM, DM}; pg8::StaticOrder S; S.init(MTOK, DM, gridDim.x, blockIdx.x);
        pg8::EpiResid E{xin, p.out, modl + 2 * DM}; pg8::gemm_phase<pg8::EpiResid>(tidx, L, g, S, E); }
    if constexpr (KIND == 7) phase_norm(tidx, p.out, p.norm_ffn_g + l * DM, modl, 3 * DM, 4 * DM, hbuf);
    if constexpr (KIND == 8) { pg8::Gemm g{hbuf, (const bf16_t*)(p.ws + WS_WF1) + (size_t)l * NF1 * DM, MTOK, NF1, DM}; pg8::StaticOrder S; S.init(MTOK, NF1, gridDim.x, blockIdx.x);
        pg8::EpiSwiGLU E{proj}; pg8::gemm_phase<pg8::EpiSwiGLU>(tidx, L, g, S, E); }
    if constexpr (KIND == 9) { pg8::Gemm g{proj, (const bf16_t*)(p.ws + WS_WF2) + (size_t)l * DM * DFF, MTOK, DM, DFF}; pg8::StaticOrder S; S.init(MTOK, DM, gridDim.x, blockIdx.x);
        pg8::EpiResid E{p.out, p.out, modl + 5 * DM}; pg8::gemm_phase<pg8::EpiResid>(tidx, L, g, S, E); }
    if constexpr (KIND == 10) phase_final(tidx, p.out, p.final_norm_g);
}
__host__ __device__ inline void phase_decode(int ph, int& kind, int& l) {
    if (ph == 0) { kind = 0; l = 0; } else if (ph == NPH - 1) { kind = 10; l = 0; } else { l = (ph - 1) / 9; kind = 1 + (ph - 1) % 9; }
}

#if ONE_LAUNCH
__global__ void __launch_bounds__(512, 2) hymba_fwd(P p) {
    extern __shared__ __attribute__((aligned(16))) unsigned char lds_raw[];
    LAS unsigned char* L = (LAS unsigned char*)lds_raw;
    cg::grid_group grid = cg::this_grid();
    if (threadIdx.x < 16) ((LAS unsigned*)(L + LDS_BAR_OFF))[threadIdx.x] = 0u;
    __syncthreads();
    const XcdBarrier bar = xcd_barrier_post((unsigned*)(p.ws + WS_BAR), (volatile LAS unsigned*)(L + LDS_BAR_OFF));
    for (int ph = p.ph_lo; ph < p.ph_hi; ++ph) {
        if (p.ph_hi > NPH) grid.sync();
        if (ph > p.ph_lo) xcd_barrier(bar);
        int kind, l; phase_decode(ph, kind, l);
        int tidx = threadIdx.x; asm volatile("" : "+v"(tidx));
#if REPEAT_MASK
        if ((REPEAT_MASK >> kind) & 1) {
            switch (kind) { case 1: run_kind<1>(tidx, p, l, L); break; case 2: run_kind<2>(tidx, p, l, L); break; case 3: run_kind<3>(tidx, p, l, L); break; case 4: run_kind<4>(tidx, p, l, L); break;
                case 5: run_kind<5>(tidx, p, l, L); break; case 7: run_kind<7>(tidx, p, l, L); break; case 8: run_kind<8>(tidx, p, l, L); break; default: break; }
            __syncthreads();
        }
#endif
        switch (kind) {
        case 0: run_kind<0>(tidx, p, l, L); break; case 1: run_kind<1>(tidx, p, l, L); break; case 2: run_kind<2>(tidx, p, l, L); break; case 3: run_kind<3>(tidx, p, l, L); break;
        case 4: run_kind<4>(tidx, p, l, L); break; case 5: run_kind<5>(tidx, p, l, L); break; case 6: run_kind<6>(tidx, p, l, L); break; case 7: run_kind<7>(tidx, p, l, L); break;
        case 8: run_kind<8>(tidx, p, l, L); break; case 9: run_kind<9>(tidx, p, l, L); break; default: run_kind<10>(tidx, p, l, L); break;
        }
    }
}
#define LAUNCH_FN(kind) ((const void*)hymba_fwd)
#else
template <int KIND> __global__ void __launch_bounds__(512, 2) hymba_ph(P p) {
    extern __shared__ __attribute__((aligned(16))) unsigned char lds_raw[];
    run_kind<KIND>((int)threadIdx.x, p, p.ph_hi, (LAS unsigned char*)lds_raw);
}
static const void* ph_fn(int kind) {
    switch (kind) { case 0: return (const void*)hymba_ph<0>; case 1: return (const void*)hymba_ph<1>; case 2: return (const void*)hymba_ph<2>; case 3: return (const void*)hymba_ph<3>;
        case 4: return (const void*)hymba_ph<4>; case 5: return (const void*)hymba_ph<5>; case 6: return (const void*)hymba_ph<6>; case 7: return (const void*)hymba_ph<7>;
        case 8: return (const void*)hymba_ph<8>; case 9: return (const void*)hymba_ph<9>; default: return (const void*)hymba_ph<10>; }
}
#define LAUNCH_FN(kind) ph_fn(kind)
#endif

extern "C" void kernel_launch(void* const* d_in, const int* in_sizes, int n_in, void* d_out, int out_size, void* d_ws, size_t ws_size, hipStream_t stream) {
    static int grid = 0;
    if (grid == 0) {
        if (n_in != 20 || out_size != MTOK * DM || ws_size < WS_END) { fprintf(stderr, "kernel_launch: unexpected problem (n_in %d out %d ws %zu need %zu)\n", n_in, out_size, ws_size, (size_t)WS_END); grid = -1; return; }
        int dev = 0, cus = 0, per_cu = 0;
        (void)hipGetDevice(&dev); (void)hipDeviceGetAttribute(&cus, hipDeviceAttributeMultiprocessorCount, dev);
        for (int k = 0; k <= 10; ++k)
            if (hipFuncSetAttribute(LAUNCH_FN(k), hipFuncAttributeMaxDynamicSharedMemorySize, LDS_BYTES) != hipSuccess) { fprintf(stderr, "kernel_launch: hipFuncSetAttribute failed\n"); grid = -1; return; }
#if ONE_LAUNCH
        if (hipOccupancyMaxActiveBlocksPerMultiprocessor(&per_cu, (const void*)hymba_fwd, 512, LDS_BYTES) != hipSuccess || per_cu < 1) { fprintf(stderr, "kernel_launch: occupancy query failed (%d)\n", per_cu); (void)hipGetLastError(); per_cu = 1; }
#else
        per_cu = 1;
#endif
        grid = cus * per_cu;
        if (grid < SCAN_BLOCKS + 32) { fprintf(stderr, "kernel_launch: grid %d too small\n", grid); grid = -1; return; }
    }
    if (grid < 0) return;
    P p{};
    const float** pp = (const float**)&p;
    for (int i = 0; i < 20; ++i) pp[i] = (const float*)d_in[i];
    p.out = (float*)d_out; p.ws = (unsigned char*)d_ws;
#if ONE_LAUNCH
    p.ph_lo = 0; p.ph_hi = NPH;
    if (hipMemsetAsync((unsigned char*)d_ws + WS_BAR, 0, 16384, stream) != hipSuccess) { fprintf(stderr, "kernel_launch: memset of the barrier words failed\n"); return; }
    void* args[] = {&p};
    hipError_t e = hipLaunchCooperativeKernel((const void*)hymba_fwd, dim3(grid), dim3(512), args, LDS_BYTES, stream);
    if (e != hipSuccess) fprintf(stderr, "cooperative launch failed: %s (grid %d)\n", hipGetErrorString(e), grid);
#else
    for (int ph = 0; ph < NPH; ++ph) { int kind, l; phase_decode(ph, kind, l); p.ph_lo = kind; p.ph_hi = l; void* args[] = {&p};
        (void)hipLaunchKernel(ph_fn(kind), dim3(grid), dim3(512), args, LDS_BYTES, stream); }
#endif
}
```

```cpp
#include <hip/hip_runtime.h>
#include <hip/hip_cooperative_groups.h>
#include <cstdio>
namespace cg = cooperative_groups;

#ifndef ONE_LAUNCH
#define ONE_LAUNCH 1
#endif
#ifndef REPEAT_MASK
#define REPEAT_MASK 0
#endif

#define LAS __attribute__((address_space(3)))
typedef unsigned short bf16_t;
typedef short bf16x8 __attribute__((ext_vector_type(8)));
typedef float f32x4 __attribute__((ext_vector_type(4)));
typedef float f32x2 __attribute__((ext_vector_type(2)));
typedef unsigned u32x4 __attribute__((ext_vector_type(4)));
typedef unsigned u32x2 __attribute__((ext_vector_type(2)));
typedef __bf16 nbf16x2 __attribute__((ext_vector_type(2)));

constexpr int MTOK = 16384, DM = 1024, NL = 4, NB = 4, SEQ = 4096;
constexpr int NIN = 3336, NINP = 3584, DFF = 2816, NF1 = 2 * DFF, NMOD = 6 * DM;
constexpr int LDS_BYTES = 131072 + 64 + 6144 + 17408, LDS_BAR_OFF = 131072, LDS_CW_OFF = 131072 + 64, LDS_TF_OFF = LDS_CW_OFF + 6144;
constexpr int NPH = 1 + 9 * NL + 1;

constexpr size_t SZ_WIN = (size_t)NL * NINP * DM * 2, SZ_WOUT = (size_t)NL * DM * DM * 2, SZ_WF1 = (size_t)NL * NF1 * DM * 2, SZ_WF2 = (size_t)NL * DM * DFF * 2;
constexpr size_t WS_WIN = 0, WS_WOUT = WS_WIN + SZ_WIN, WS_WF1 = WS_WOUT + SZ_WOUT, WS_WF2 = WS_WF1 + SZ_WF1;
constexpr size_t WS_MOD = WS_WF2 + SZ_WF2;
constexpr size_t WS_ALAST = WS_MOD + (size_t)NL * NB * NMOD * 4;
constexpr size_t WS_H = WS_ALAST + 4096;
constexpr size_t WS_YCAT = WS_H + (size_t)MTOK * DM * 2;
constexpr size_t WS_PROJ = WS_YCAT + (size_t)MTOK * DM * 2;
constexpr int ITEM_BYTES = 90112, OFF_W = 0, OFF_Q = 16384, OFF_KT = 32768, OFF_QK = 49152, OFF_U = 57344;
constexpr size_t WS_DELTA = WS_PROJ + (size_t)MTOK * NINP * 2;
constexpr size_t WS_BAR = WS_DELTA + (size_t)1024 * ITEM_BYTES;
constexpr size_t WS_END = WS_BAR + 16384;

struct P {
    const float *x, *c, *w_ada, *b_ada, *norm_mix_g, *norm_ffn_g, *w_in, *conv_a_w, *conf_dw_w, *conf_dw_b, *conf_ln_g, *conf_ln_b,
        *dn_conv_w, *dn_a_log, *dn_dt_bias, *dn_norm_g, *w_out, *w_ffn_in, *w_ffn_out, *final_norm_g;
    float* out; unsigned char* ws; int ph_lo, ph_hi;
};

__device__ __forceinline__ float bf2f(bf16_t v) { return __uint_as_float(((unsigned)v) << 16); }
__device__ __forceinline__ unsigned pk2(float a, float b) { f32x2 v = {a, b}; nbf16x2 r = __builtin_convertvector(v, nbf16x2); return __builtin_bit_cast(unsigned, r); }
__device__ __forceinline__ bf16_t f2bf(float a) { return (bf16_t)(pk2(a, 0.f) & 0xffffu); }
__device__ __forceinline__ float lo16(unsigned w) { return __uint_as_float(w << 16); }
__device__ __forceinline__ float hi16(unsigned w) { return __uint_as_float(w & 0xffff0000u); }
__device__ __forceinline__ float sigmoid_f(float v) { return __builtin_amdgcn_rcpf(1.f + __expf(-v)); }
__device__ __forceinline__ float silu_f(float v) { return v * sigmoid_f(v); }
__device__ __forceinline__ float wave_sum(float v) {
#pragma unroll
    for (int o = 32; o; o >>= 1) v += __shfl_xor(v, o);
    return v;
}
__device__ __forceinline__ void unpack8(const u32x4 w, float (&f)[8]) {
    f[0] = lo16(w.x); f[1] = hi16(w.x); f[2] = lo16(w.y); f[3] = hi16(w.y); f[4] = lo16(w.z); f[5] = hi16(w.z); f[6] = lo16(w.w); f[7] = hi16(w.w);
}
__device__ __forceinline__ u32x4 pack8(const float (&f)[8]) { u32x4 w; w.x = pk2(f[0], f[1]); w.y = pk2(f[2], f[3]); w.z = pk2(f[4], f[5]); w.w = pk2(f[6], f[7]); return w; }
#define MFMA16(a, b, c) __builtin_amdgcn_mfma_f32_16x16x32_bf16((a), (b), (c), 0, 0, 0)

namespace pg8 {
constexpr int BM = 256, BK = 64, HALF = 128, HTB = HALF * BK * 2, STAGE_BYTES = 8 * HTB, NXCD = 8, WGM = 8;
__host__ __device__ __forceinline__ int lds_byte(int r, int c) { const int st = (r >> 4) * 2 + (c >> 5), rr = r & 15, cc = c & 31, ob = rr * 64 + cc * 2; return st * 1024 + (ob ^ (((ob >> 9) & 1) << 5)); }
__host__ __device__ __forceinline__ void stage_rc(int b, int& R, int& C) { const int st = b / 1024, sb = b % 1024, swz = sb ^ (((sb >> 9) & 1) << 5); R = (st >> 1) * 16 + swz / 64; C = (st & 1) * 32 + (swz % 64) / 2; }
__host__ __device__ __forceinline__ int perm32(int rho) { const int n = rho >> 4, i = rho & 15; return 8 * (i >> 2) + 4 * n + (i & 3); }
struct Unit { int pm, pn; };
struct Gemm { const bf16_t* A; const bf16_t* Bt; int M, N, K; };
struct StaticOrder {
    int nM, nN, nwg, G, c;
    __device__ void init(int M, int N, int G_, int c_) { nM = M / BM; nN = N / BM; nwg = nM * nN; G = G_; c = c_; }
    __device__ bool next(int i, Unit& u) const {
        const long L = (long)i * G + c; if (L >= nwg) return false;
        int wgid = (int)L; { const int q = nwg / NXCD, r = nwg % NXCD, xcd = wgid % NXCD, off = wgid / NXCD; wgid = (xcd < r ? xcd * (q + 1) : r * (q + 1) + (xcd - r) * q) + off; }
        const int nig = WGM * nN, gid = wgid / nig, fm = gid * WGM, gsz = (nM - fm) < WGM ? (nM - fm) : WGM;
        u.pm = fm + ((wgid % nig) % gsz); u.pn = (wgid % nig) / gsz; return true;
    }
};

struct EpiProj {
    static constexpr bool PERM = true;
    bf16_t* O; int ldc;
    __device__ __forceinline__ void operator()(const f32x4 (&acc)[2][2][4][2], const Unit& u, int wr, int wc, int fr, int fq) const {
        const int row0 = u.pm * BM + wr * 64 + fr, col0 = u.pn * BM + wc * 32 + 8 * fq;
#pragma unroll
        for (int ai = 0; ai < 2; ++ai)
#pragma unroll
            for (int m = 0; m < 4; ++m) { bf16_t* rowp = O + (size_t)(row0 + ai * HALF + m * 16) * ldc + col0;
#pragma unroll
                for (int bj = 0; bj < 2; ++bj) { const f32x4 v0 = acc[ai][bj][m][0], v1 = acc[ai][bj][m][1];
                    u32x4 w; w.x = pk2(v0[0], v0[1]); w.y = pk2(v0[2], v0[3]); w.z = pk2(v1[0], v1[1]); w.w = pk2(v1[2], v1[3]);
                    *(u32x4*)(rowp + bj * HALF) = w; } }
    }
};
struct EpiSwiGLU {
    static constexpr bool PERM = true;
    bf16_t* O;
    __device__ __forceinline__ void operator()(const f32x4 (&acc)[2][2][4][2], const Unit& u, int wr, int wc, int fr, int fq) const {
        const int row0 = u.pm * BM + wr * 64 + fr, col0 = u.pn * HALF + wc * 32 + 8 * fq;
#pragma unroll
        for (int ai = 0; ai < 2; ++ai)
#pragma unroll
            for (int m = 0; m < 4; ++m) {
                const f32x4 g0 = acc[ai][0][m][0], g1 = acc[ai][0][m][1], u0 = acc[ai][1][m][0], u1 = acc[ai][1][m][1];
                float v[8];
#pragma unroll
                for (int i = 0; i < 4; ++i) { v[i] = silu_f(g0[i]) * u0[i]; v[4 + i] = silu_f(g1[i]) * u1[i]; }
                *(u32x4*)(O + (size_t)(row0 + ai * HALF + m * 16) * DFF + col0) = pack8(v);
            }
    }
};
struct EpiResid {
    static constexpr bool PERM = false;
    const float* base; float* out; const float* gate;
    __device__ __forceinline__ void operator()(const f32x4 (&acc)[2][2][4][2], const Unit& u, int wr, int wc, int fr, int fq) const {
        const int row0 = u.pm * BM + wr * 64 + fr, col0 = u.pn * BM + wc * 32 + 4 * fq;
        const float* gp = gate + (size_t)(u.pm >> 4) * NMOD + col0;
        f32x4 gv[2][2];
#pragma unroll
        for (int bj = 0; bj < 2; ++bj)
#pragma unroll
            for (int n = 0; n < 2; ++n) gv[bj][n] = *(const f32x4*)(gp + bj * HALF + n * 16);
#pragma unroll
        for (int ai = 0; ai < 2; ++ai) {
            f32x4 bv[4][2][2];
#pragma unroll
            for (int m = 0; m < 4; ++m) { const size_t ro = (size_t)(row0 + ai * HALF + m * 16) * DM + col0;
#pragma unroll
                for (int bj = 0; bj < 2; ++bj)
#pragma unroll
                    for (int n = 0; n < 2; ++n) bv[m][bj][n] = *(const f32x4*)(base + ro + bj * HALF + n * 16); }
#pragma unroll
            for (int m = 0; m < 4; ++m) { const size_t ro = (size_t)(row0 + ai * HALF + m * 16) * DM + col0;
#pragma unroll
                for (int bj = 0; bj < 2; ++bj)
#pragma unroll
                    for (int n = 0; n < 2; ++n) *(f32x4*)(out + ro + bj * HALF + n * 16) = bv[m][bj][n] + gv[bj][n] * acc[ai][bj][m][n]; }
        }
    }
};

template <class Epi>
__device__ __forceinline__ void gemm_phase(const int tidx, LAS unsigned char* lds, const Gemm g, const StaticOrder& S, const Epi& E) {
    const int tid = tidx, wid = __builtin_amdgcn_readfirstlane(tid >> 6), lane = tid & 63, wr = wid >> 2, wc = wid & 3, fr = lane & 15, fq = lane >> 4;
    const int K = g.K, nt = K / BK;
    unsigned voffA[2], voffB[2];
#pragma unroll
    for (int i = 0; i < 2; ++i) { int R, C; stage_rc(tid * 16 + i * 8192, R, C); const int Rb = Epi::PERM ? ((R & ~31) + perm32(R & 31)) : R;
        voffA[i] = (unsigned)(R * K + C) * 2u; voffB[i] = (unsigned)(Rb * K + C) * 2u; }
    const size_t kstep = (size_t)(BK * 2);
    const size_t hstep = (size_t)HALF * K * 2;
    const size_t tstep = 2 * hstep;
    const unsigned ldsw = (unsigned)wid * 1024u;
    const int aoff = lds_byte(wr * 64 + fr, fq * 8), boff = lds_byte(wc * 32 + fr, fq * 8);
#define PG8_SA(b, h) (((b) * 2 + (h)) * HTB)
#define PG8_SB(b, h) ((4 + (b) * 2 + (h)) * HTB)
#define PG8_STAGE(bufoff, gbase, voff) do { _Pragma("unroll") for (int _i = 0; _i < 2; ++_i) \
        __builtin_amdgcn_global_load_lds((const unsigned*)((const char*)(gbase) + (voff)[_i]), (LAS unsigned*)(lds + (bufoff) + ldsw + _i * 8192), 16, 0, 0); } while (0)
#define PG8_LDA(dst, b, h) do { _Pragma("unroll") for (int m = 0; m < 4; ++m) _Pragma("unroll") for (int k = 0; k < 2; ++k) dst[m][k] = *(const LAS bf16x8*)(lds + PG8_SA(b, h) + aoff + m * 2048 + k * 1024); } while (0)
#define PG8_LDB(dst, b, h) do { _Pragma("unroll") for (int n = 0; n < 2; ++n) _Pragma("unroll") for (int k = 0; k < 2; ++k) dst[n][k] = *(const LAS bf16x8*)(lds + PG8_SB(b, h) + boff + n * 2048 + k * 1024); } while (0)
#define PG8_MMA(ai, bj, At, Bt) do { __builtin_amdgcn_s_setprio(1); _Pragma("unroll") for (int m = 0; m < 4; ++m) _Pragma("unroll") for (int n = 0; n < 2; ++n) _Pragma("unroll") for (int k = 0; k < 2; ++k) \
        acc[ai][bj][m][n] = __builtin_amdgcn_mfma_f32_16x16x32_bf16(Bt[n][k], At[m][k], acc[ai][bj][m][n], 0, 0, 0); __builtin_amdgcn_s_setprio(0); } while (0)
#define PG8_WAIT_V(n) asm volatile("s_waitcnt vmcnt(" #n ")" ::: "memory")
#define PG8_WAIT_L(n) asm volatile("s_waitcnt lgkmcnt(" #n ")" ::: "memory")
#define PG8_BAR __builtin_amdgcn_s_barrier()
#define PG8_SCHED __builtin_amdgcn_sched_barrier(0)
    Unit cur, nxt; int ui = 0;
    if (!S.next(0, cur)) return;
    f32x4 acc[2][2][4][2];
#pragma unroll
    for (int a = 0; a < 2; ++a)
#pragma unroll
        for (int b = 0; b < 2; ++b)
#pragma unroll
            for (int m = 0; m < 4; ++m)
#pragma unroll
                for (int n = 0; n < 2; ++n) acc[a][b][m][n] = (f32x4){0.f, 0.f, 0.f, 0.f};
    bf16x8 At[4][2], B0[2][2], B1[2][2];
    const char* cA = (const char*)g.A + (size_t)cur.pm * tstep; const char* cB = (const char*)g.Bt + (size_t)cur.pn * tstep;
    PG8_STAGE(PG8_SB(0, 0), cB, voffB); PG8_STAGE(PG8_SA(0, 0), cA, voffA); PG8_STAGE(PG8_SB(0, 1), cB + hstep, voffB); PG8_STAGE(PG8_SA(0, 1), cA + hstep, voffA);
    if (wr == 1) PG8_BAR;
    PG8_WAIT_V(4); PG8_BAR;
    PG8_STAGE(PG8_SB(1, 0), cB + kstep, voffB); PG8_STAGE(PG8_SA(1, 0), cA + kstep, voffA); PG8_STAGE(PG8_SB(1, 1), cB + hstep + kstep, voffB);
    PG8_WAIT_V(6); PG8_BAR;
    for (;;) {
        const bool has_next = S.next(ui + 1, nxt);
        const char* nA = has_next ? (const char*)g.A + (size_t)nxt.pm * tstep : cA; const char* nB = has_next ? (const char*)g.Bt + (size_t)nxt.pn * tstep : cB;
        for (int t = 0; t < nt; t += 2) {
            const bool last = (t == nt - 2);
            const char* a1 = cA + (size_t)(t + 1) * kstep;
            const char* a2 = last ? nA : cA + (size_t)(t + 2) * kstep; const char* b2 = last ? nB : cB + (size_t)(t + 2) * kstep;
            const char* a3 = a2 + kstep; const char* b3 = b2 + kstep;
            PG8_LDB(B0, 0, 0); PG8_SCHED; PG8_LDA(At, 0, 0); PG8_STAGE(PG8_SA(1, 1), a1 + hstep, voffA);
            PG8_WAIT_L(8); PG8_BAR; PG8_WAIT_L(0); PG8_MMA(0, 0, At, B0); PG8_BAR; PG8_SCHED;
            PG8_LDB(B1, 0, 1); PG8_STAGE(PG8_SB(0, 0), b2, voffB);
            PG8_BAR; PG8_WAIT_L(0); PG8_MMA(0, 1, At, B1); PG8_BAR;
            PG8_LDA(At, 0, 1); PG8_STAGE(PG8_SA(0, 0), a2, voffA);
            PG8_BAR; PG8_WAIT_L(0); PG8_MMA(1, 0, At, B0); PG8_BAR; PG8_SCHED;
            PG8_STAGE(PG8_SB(0, 1), b2 + hstep, voffB);
            PG8_WAIT_V(6); PG8_BAR; PG8_MMA(1, 1, At, B1); PG8_BAR;
            PG8_LDB(B0, 1, 0); PG8_SCHED; PG8_LDA(At, 1, 0); PG8_STAGE(PG8_SA(0, 1), a2 + hstep, voffA);
            PG8_WAIT_L(8); PG8_BAR; PG8_WAIT_L(0); PG8_MMA(0, 0, At, B0); PG8_BAR; PG8_SCHED;
            PG8_LDB(B1, 1, 1); PG8_STAGE(PG8_SB(1, 0), b3, voffB);
            PG8_BAR; PG8_WAIT_L(0); PG8_MMA(0, 1, At, B1); PG8_BAR;
            PG8_LDA(At, 1, 1); PG8_STAGE(PG8_SA(1, 0), a3, voffA);
            PG8_BAR; PG8_WAIT_L(0); PG8_MMA(1, 0, At, B0); PG8_BAR; PG8_SCHED;
            PG8_STAGE(PG8_SB(1, 1), b3 + hstep, voffB);
            PG8_WAIT_V(6); PG8_BAR; PG8_MMA(1, 1, At, B1); PG8_BAR;
        }
        E(acc, cur, wr, wc, fr, fq);
        if (!has_next) break;
#pragma unroll
        for (int a = 0; a < 2; ++a)
#pragma unroll
            for (int b = 0; b < 2; ++b)
#pragma unroll
                for (int m = 0; m < 4; ++m)
#pragma unroll
                    for (int n = 0; n < 2; ++n) acc[a][b][m][n] = (f32x4){0.f, 0.f, 0.f, 0.f};
        cur = nxt; cA = nA; cB = nB; ++ui;
    }
    PG8_WAIT_V(0);
    if (wr == 0) PG8_BAR;
    PG8_BAR;
#undef PG8_SA
#undef PG8_SB
#undef PG8_STAGE
#undef PG8_LDA
#undef PG8_LDB
#undef PG8_MMA
#undef PG8_WAIT_V
#undef PG8_WAIT_L
#undef PG8_BAR
#undef PG8_SCHED
}
}

__device__ __forceinline__ void prep_transposes(const int tidx, const P& p, LAS unsigned char* L, int l0, int l1, int blk, int nblk);
__device__ __forceinline__ void phase_prep(const int tidx, const P& p, LAS unsigned char* L) {
    const int tid = tidx;
    constexpr int NADA = NL * 96, TPL = 3264, TOTAL = NADA + NL * TPL;
    float* mod = (float*)(p.ws + WS_MOD);
    for (int it = blockIdx.x; it < NADA; it += gridDim.x) {
        __syncthreads();
        {
            const int l = it / 96, n0 = (it % 96) * 64;
            LAS float* cact = (LAS float*)L;
            LAS float* red = cact + 4096;
            for (int i = tid; i < 4096; i += 512) cact[i] = silu_f(p.c[i]);
            __syncthreads();
            const int kg = tid >> 6, nn = tid & 63;
            const float* w = p.w_ada + ((size_t)l * DM + kg * 128) * NMOD + n0 + nn;
            float a0 = 0.f, a1 = 0.f, a2 = 0.f, a3 = 0.f;
#pragma unroll 8
            for (int k = 0; k < 128; ++k) { const float wv = w[(size_t)k * NMOD]; const int kk = kg * 128 + k;
                a0 += cact[kk] * wv; a1 += cact[1024 + kk] * wv; a2 += cact[2048 + kk] * wv; a3 += cact[3072 + kk] * wv; }
            red[(kg * 4 + 0) * 64 + nn] = a0; red[(kg * 4 + 1) * 64 + nn] = a1; red[(kg * 4 + 2) * 64 + nn] = a2; red[(kg * 4 + 3) * 64 + nn] = a3;
            __syncthreads();
            if (tid < 256) { const int b = tid >> 6; float s = p.b_ada[l * NMOD + n0 + nn];
#pragma unroll
                for (int k2 = 0; k2 < 8; ++k2) s += red[(k2 * 4 + b) * 64 + nn];
                mod[(size_t)(l * NB + b) * NMOD + n0 + nn] = s; }
        }
    }
    prep_transposes(tidx, p, L, 0, 1, blockIdx.x, gridDim.x);
}
__device__ __forceinline__ void prep_transposes(const int tidx, const P& p, LAS unsigned char* L, int l0, int l1, int blk, int nblk) {
    const int tid = tidx;
    constexpr int TPL = 3264;
    for (int it0 = l0 * TPL + blk * 4; it0 < l1 * TPL; it0 += nblk * 4) {
        __syncthreads();
        bf16_t* dstp[4]; int kd[4];
#pragma unroll
        for (int tt = 0; tt < 4; ++tt) {
            const int j = it0 + tt, l = j / TPL; int r = j % TPL;
            const float* src; bf16_t* dst; int Ns, Nvalid, Kd, k0, ns0, nd0;
            if (r < 896) { const int kt = r / 56, nt = r % 56; src = p.w_in + (size_t)l * DM * NIN; Ns = NIN; Nvalid = NIN; Kd = DM; k0 = kt * 64; nd0 = nt * 64;
                ns0 = (nd0 < 2816) ? nd0 : ((nd0 < 3072) ? 3328 + (nd0 - 2816) : 2816 + (nd0 - 3072));
                dst = (bf16_t*)(p.ws + WS_WIN) + (size_t)l * NINP * DM; }
            else if (r < 1152) { r -= 896; const int kt = r / 16, nt = r % 16; src = p.w_out + (size_t)l * DM * DM; Ns = DM; Nvalid = DM; Kd = DM; k0 = kt * 64; nd0 = nt * 64; ns0 = nd0;
                dst = (bf16_t*)(p.ws + WS_WOUT) + (size_t)l * DM * DM; }
            else if (r < 2560) { r -= 1152; const int kt = r / 88, nt = r % 88; src = p.w_ffn_in + (size_t)l * DM * NF1; Ns = NF1; Nvalid = NF1; Kd = DM; k0 = kt * 64; nd0 = nt * 64;
                const int pn = nd0 >> 8, half = (nd0 >> 7) & 1, sub = nd0 & 127; ns0 = half * DFF + pn * 128 + sub;
                dst = (bf16_t*)(p.ws + WS_WF1) + (size_t)l * NF1 * DM; }
            else { r -= 2560; const int kt = r / 16, nt = r % 16; src = p.w_ffn_out + (size_t)l * DFF * DM; Ns = DM; Nvalid = DM; Kd = DFF; k0 = kt * 64; nd0 = nt * 64; ns0 = nd0;
                dst = (bf16_t*)(p.ws + WS_WF2) + (size_t)l * DM * DFF; }
            LAS float* tile = (LAS float*)L + tt * (64 * 65);
            const int kk = tid >> 4, c4 = (tid & 15) * 4;
            f32x4 v0 = {0.f, 0.f, 0.f, 0.f}, v1 = {0.f, 0.f, 0.f, 0.f};
            if (ns0 + c4 < Nvalid) { v0 = *(const f32x4*)(src + (size_t)(k0 + kk) * Ns + ns0 + c4); v1 = *(const f32x4*)(src + (size_t)(k0 + kk + 32) * Ns + ns0 + c4); }
            tile[kk * 65 + c4 + 0] = v0[0]; tile[kk * 65 + c4 + 1] = v0[1]; tile[kk * 65 + c4 + 2] = v0[2]; tile[kk * 65 + c4 + 3] = v0[3];
            tile[(kk + 32) * 65 + c4 + 0] = v1[0]; tile[(kk + 32) * 65 + c4 + 1] = v1[1]; tile[(kk + 32) * 65 + c4 + 2] = v1[2]; tile[(kk + 32) * 65 + c4 + 3] = v1[3];
            dstp[tt] = dst + (size_t)nd0 * Kd + k0; kd[tt] = Kd;
        }
        __syncthreads();
#pragma unroll
        for (int tt = 0; tt < 4; ++tt) {
            LAS float* tile = (LAS float*)L + tt * (64 * 65);
            const int nn = tid >> 3, k8 = (tid & 7) * 8; float f[8];
#pragma unroll
            for (int i = 0; i < 8; ++i) f[i] = tile[(k8 + i) * 65 + nn];
            *(u32x4*)(dstp[tt] + (size_t)nn * kd[tt] + k8) = pack8(f);
        }
    }
}

__device__ __forceinline__ void phase_norm(const int tidx, const float* xin, const float* g, const float* modl, int shoff, int scoff, bf16_t* hout) {
    const int wave = tidx >> 6, lane = tidx & 63;
    for (int row0 = (blockIdx.x * 8 + wave) * 2; row0 < MTOK; row0 += gridDim.x * 16) {
        const int b = row0 >> 12;
        f32x4 v[2][4], gg[4], sc[4], sh[4];
#pragma unroll
        for (int rr = 0; rr < 2; ++rr)
#pragma unroll
            for (int i = 0; i < 4; ++i) v[rr][i] = *(const f32x4*)(xin + (size_t)(row0 + rr) * DM + i * 256 + lane * 4);
#pragma unroll
        for (int i = 0; i < 4; ++i) { const int k = i * 256 + lane * 4;
            gg[i] = *(const f32x4*)(g + k); sc[i] = *(const f32x4*)(modl + (size_t)b * NMOD + scoff + k); sh[i] = *(const f32x4*)(modl + (size_t)b * NMOD + shoff + k); }
#pragma unroll
        for (int rr = 0; rr < 2; ++rr) {
            float ss = 0.f;
#pragma unroll
            for (int i = 0; i < 4; ++i) ss += v[rr][i][0] * v[rr][i][0] + v[rr][i][1] * v[rr][i][1] + v[rr][i][2] * v[rr][i][2] + v[rr][i][3] * v[rr][i][3];
            ss = wave_sum(ss);
            const float rinv = rsqrtf(ss * (1.f / DM) + 1e-6f);
#pragma unroll
            for (int i = 0; i < 4; ++i) { const int k = i * 256 + lane * 4;
                const f32x4 y = v[rr][i] * rinv * gg[i] * (sc[i] + 1.f) + sh[i];
                u32x2 w; w.x = pk2(y[0], y[1]); w.y = pk2(y[2], y[3]);
                *(u32x2*)(hout + (size_t)(row0 + rr) * DM + k) = w; }
        }
    }
}
__device__ __forceinline__ void phase_final(const int tidx, float* x, const float* g) {
    const int wave = tidx >> 6, lane = tidx & 63;
    for (int row0 = (blockIdx.x * 8 + wave) * 2; row0 < MTOK; row0 += gridDim.x * 16) {
        f32x4 v[2][4], gg[4];
#pragma unroll
        for (int rr = 0; rr < 2; ++rr)
#pragma unroll
            for (int i = 0; i < 4; ++i) v[rr][i] = *(const f32x4*)(x + (size_t)(row0 + rr) * DM + i * 256 + lane * 4);
#pragma unroll
        for (int i = 0; i < 4; ++i) gg[i] = *(const f32x4*)(g + i * 256 + lane * 4);
#pragma unroll
        for (int rr = 0; rr < 2; ++rr) {
            float ss = 0.f;
#pragma unroll
            for (int i = 0; i < 4; ++i) ss += v[rr][i][0] * v[rr][i][0] + v[rr][i][1] * v[rr][i][1] + v[rr][i][2] * v[rr][i][2] + v[rr][i][3] * v[rr][i][3];
            ss = wave_sum(ss);
            const float rinv = rsqrtf(ss * (1.f / DM) + 1e-6f);
#pragma unroll
            for (int i = 0; i < 4; ++i) *(f32x4*)(x + (size_t)(row0 + rr) * DM + i * 256 + lane * 4) = v[rr][i] * rinv * gg[i];
        }
    }
}

__device__ __forceinline__ void phase_dprep(const int tidx, const P& p, int l, LAS unsigned char* L) {
    LAS bf16_t* Qn = (LAS bf16_t*)(L + 0);
    LAS bf16_t* Kn = (LAS bf16_t*)(L + 17408);
    LAS bf16_t* KbgT = (LAS bf16_t*)(L + 34816);
    LAS bf16_t* KtlT = (LAS bf16_t*)(L + 53248);
    LAS bf16_t* VbT = (LAS bf16_t*)(L + 71680);
    LAS float* Lm = (LAS float*)(L + 90112);
    LAS bf16_t* Tm = (LAS bf16_t*)(L + 107520);
    LAS bf16_t* QKm = (LAS bf16_t*)(L + 116736);
    LAS float* gcs = (LAS float*)(L + 125952);
    LAS float* betas = gcs + 64;
    LAS float* cwl = (LAS float*)(L + LDS_CW_OFF);
    LAS float* Tf = (LAS float*)(L + LDS_TF_OFF);
    const bf16_t* proj = (const bf16_t*)(p.ws + WS_PROJ);
    float* alast = (float*)(p.ws + WS_ALAST);
    u32x4 rawA[7], rawB[7]; float cwreg[4], alpha_r = 0.f, beta_r = 0.f;
#define DP_ISSUE(it_, tid_) do { const int h_ = (it_) & 3, n_ = ((it_) >> 2) & 63, t0_ = ((it_) >> 8) * SEQ + n_ * 64; \
        const int tk0_ = (((tid_) >> 4) & 15) * 4, d0_ = ((tid_) & 15) * 8; \
        _Pragma("unroll") for (int rr = 0; rr < 7; ++rr) { const int pos = n_ * 64 + tk0_ - 3 + rr; \
            rawA[rr] = (u32x4){0u, 0u, 0u, 0u}; rawB[rr] = (u32x4){0u, 0u, 0u, 0u}; \
            if (pos >= 0) { const bf16_t* pr = proj + (size_t)(t0_ + tk0_ - 3 + rr) * NINP + 1280 + h_ * 128 + d0_; \
                rawA[rr] = *(const u32x4*)(pr + ((tid_) >> 8) * 512); \
                if ((tid_) < 256) rawB[rr] = *(const u32x4*)(pr + 1024); } } \
        if ((tid_) < 384) { _Pragma("unroll") for (int j = 0; j < 4; ++j) cwreg[j] = p.dn_conv_w[(size_t)(l * 4 + j) * 1536 + ((tid_) >> 7) * 512 + h_ * 128 + ((tid_) & 127)]; } \
        if (((tid_) >> 6) == 7) { const bf16_t* pr = proj + (size_t)(t0_ + ((tid_) & 63)) * NINP; alpha_r = bf2f(pr[2816 + h_]); beta_r = bf2f(pr[2820 + h_]); } } while (0)
    if ((int)blockIdx.x < 1024) DP_ISSUE((int)blockIdx.x, tidx);
    for (int item = blockIdx.x; item < 1024; item += gridDim.x) {
        __syncthreads();
        int tid = tidx; asm volatile("" : "+v"(tid));
        const int lane = tid & 63, wave = tid >> 6, r = lane & 15, q = lane >> 4;
        const int h = item & 3, n = (item >> 2) & 63, b = item >> 8;
        const int t0 = b * SEQ + n * 64;
        unsigned char* itp = p.ws + WS_DELTA + (size_t)item * ITEM_BYTES;
        const int run = (tid >> 4) & 15, d0 = (tid & 15) * 8, tk0 = run * 4, whichA = tid >> 8;
        if (tid < 384) {
#pragma unroll
            for (int j = 0; j < 4; ++j) cwl[j * 384 + tid] = cwreg[j];
        }
        if (wave == 7) {
            const float xx = alpha_r + p.dn_dt_bias[l * 4 + h];
            const float sp = fmaxf(xx, 0.f) + log1pf(__expf(-fabsf(xx)));
            float gc = -__expf(p.dn_a_log[l * 4 + h]) * sp;
#pragma unroll
            for (int o = 1; o < 64; o <<= 1) { const float tv = __shfl_up(gc, o); if (lane >= o) gc += tv; }
            gcs[lane] = gc; betas[lane] = sigmoid_f(beta_r);
        }
        __syncthreads();
        const float gl = gcs[63];
#pragma unroll
        for (int pass = 0; pass < 2; ++pass) {
            if (pass == 1 && tid >= 256) break;
            const int which = pass ? 2 : whichA;
            const LAS float* cw = cwl + which * 128 + d0;
            float y[4][8];
#pragma unroll
            for (int i = 0; i < 4; ++i)
#pragma unroll
                for (int d = 0; d < 8; ++d) y[i][d] = 0.f;
#pragma unroll
            for (int j = 0; j < 4; ++j) {
                const f32x4 w0 = *(const LAS f32x4*)(cw + j * 384), w1 = *(const LAS f32x4*)(cw + j * 384 + 4);
#pragma unroll
                for (int i = 0; i < 4; ++i) { float rf[8]; unpack8(pass ? rawB[i + j] : rawA[i + j], rf);
#pragma unroll
                    for (int d = 0; d < 4; ++d) { y[i][d] += w0[d] * rf[d]; y[i][4 + d] += w1[d] * rf[4 + d]; } }
            }
#pragma unroll
            for (int i = 0; i < 4; ++i) {
#pragma unroll
                for (int d = 0; d < 8; ++d) y[i][d] = silu_f(y[i][d]);
                if (which < 2) {
                    float ss = 0.f;
#pragma unroll
                    for (int d = 0; d < 8; ++d) ss += y[i][d] * y[i][d];
                    ss += __shfl_xor(ss, 1); ss += __shfl_xor(ss, 2); ss += __shfl_xor(ss, 4); ss += __shfl_xor(ss, 8);
                    float rinv = rsqrtf(ss + 1e-6f);
                    if (which == 0) rinv *= 0.08838834764831845f;
#pragma unroll
                    for (int d = 0; d < 8; ++d) y[i][d] *= rinv;
                }
            }
            if (which == 0) {
#pragma unroll
                for (int i = 0; i < 4; ++i) *(LAS u32x4*)(Qn + (tk0 + i) * 136 + d0) = pack8(y[i]);
            } else if (which == 1) {
                float f1[4], f2[4];
#pragma unroll
                for (int i = 0; i < 4; ++i) { const float gc = gcs[tk0 + i]; f1[i] = betas[tk0 + i] * __expf(gc); f2[i] = __expf(gl - gc); }
#pragma unroll
                for (int i = 0; i < 4; ++i) *(LAS u32x4*)(Kn + (tk0 + i) * 136 + d0) = pack8(y[i]);
#pragma unroll
                for (int d = 0; d < 8; ++d) {
                    u32x2 a, c; a.x = pk2(y[0][d] * f1[0], y[1][d] * f1[1]); a.y = pk2(y[2][d] * f1[2], y[3][d] * f1[3]); c.x = pk2(y[0][d] * f2[0], y[1][d] * f2[1]); c.y = pk2(y[2][d] * f2[2], y[3][d] * f2[3]);
                    *(LAS u32x2*)(KbgT + (d0 + d) * 72 + tk0) = a; *(LAS u32x2*)(KtlT + (d0 + d) * 72 + tk0) = c; }
            } else {
                float bt[4];
#pragma unroll
                for (int i = 0; i < 4; ++i) bt[i] = betas[tk0 + i];
#pragma unroll
                for (int d = 0; d < 8; ++d) { u32x2 a; a.x = pk2(y[0][d] * bt[0], y[1][d] * bt[1]); a.y = pk2(y[2][d] * bt[2], y[3][d] * bt[3]);
                    *(LAS u32x2*)(VbT + (d0 + d) * 72 + tk0) = a; }
            }
        }
        if (item + (int)gridDim.x < 1024) DP_ISSUE(item + (int)gridDim.x, tid);
        __syncthreads();
        {
            const int mat = wave >> 2, cb = wave & 3;
            LAS bf16_t* Asrc = mat ? Qn : Kn;
            bf16x8 a[4];
#pragma unroll
            for (int kb = 0; kb < 4; ++kb) a[kb] = *(LAS bf16x8*)(Asrc + (16 * cb + r) * 136 + 32 * kb + 8 * q);
#pragma unroll
            for (int sb = 0; sb < 4; ++sb) {
                f32x4 acc = {0.f, 0.f, 0.f, 0.f};
                if (sb <= cb) {
#pragma unroll
                    for (int kb = 0; kb < 4; ++kb) { const bf16x8 bb = *(LAS bf16x8*)(Kn + (16 * sb + r) * 136 + 32 * kb + 8 * q); acc = MFMA16(a[kb], bb, acc); }
                }
                const int s = 16 * sb + r; const float gs = gcs[s];
#pragma unroll
                for (int j = 0; j < 4; ++j) { const int c = 16 * cb + 4 * q + j; const float dec = __expf(gcs[c] - gs);
                    if (mat == 0) Lm[c * 68 + s] = (s < c) ? acc[j] * betas[c] * dec : 0.f;
                    else QKm[c * 72 + s] = f2bf((s <= c) ? acc[j] * dec : 0.f); }
            }
        }
        __syncthreads();
        if (wave < 4) {
            const int blk = wave, c = lane & 15;
            int zoff; asm volatile("v_mov_b32 %0, 0" : "=v"(zoff));
            LAS float* Lb = Lm + (16 * blk) * 68 + 16 * blk + zoff;
            float t[16];
            f32x4 rb[2][4];
            t[0] = (c == 0) ? 1.f : 0.f;
            rb[1][0] = *(LAS f32x4*)(Lb + 1 * 68);
#pragma unroll
            for (int i = 1; i < 16; ++i) {
                if (i + 1 < 16) {
#pragma unroll
                    for (int j4 = 0; j4 < (i + 4) / 4; ++j4) rb[(i + 1) & 1][j4] = *(LAS f32x4*)(Lb + (i + 1) * 68 + 4 * j4);
                }
                __builtin_amdgcn_sched_barrier(0);
                float acc0 = (i == c) ? 1.f : 0.f, acc1 = 0.f;
#pragma unroll
                for (int j = 0; j < i; ++j) { if (j & 1) acc1 -= rb[i & 1][j >> 2][j & 3] * t[j]; else acc0 -= rb[i & 1][j >> 2][j & 3] * t[j]; }
                t[i] = acc0 + acc1;
                __builtin_amdgcn_sched_barrier(0);
            }
            if (q == 0) {
#pragma unroll
                for (int i = 0; i < 16; ++i) { Tf[(16 * blk + i) * 68 + 16 * blk + c] = t[i]; Tm[(16 * blk + i) * 72 + 16 * blk + c] = f2bf(t[i]); }
            }
            for (int cb = blk + 1; cb < 4; ++cb) {
#pragma unroll
                for (int jj = 0; jj < 4; ++jj) Tm[(16 * blk + 4 * q + jj) * 72 + 16 * cb + r] = (bf16_t)0;
            }
        } else {
            if (wave == 4 && lane == 0) alast[item] = __expf(gl);
            for (int jb = wave - 4; jb < 40; jb += 4) {
                if (jb < 16) {
                    const int tb = jb >> 2, kb = jb & 3, tok = 16 * tb + r;
                    const u32x2 lo = *(LAS u32x2*)(Qn + tok * 136 + 32 * kb + 4 * q), hi = *(LAS u32x2*)(Qn + tok * 136 + 32 * kb + 16 + 4 * q);
                    const float e = __expf(gcs[tok]);
                    u32x4 w; w.x = pk2(lo16(lo.x) * e, hi16(lo.x) * e); w.y = pk2(lo16(lo.y) * e, hi16(lo.y) * e); w.z = pk2(lo16(hi.x) * e, hi16(hi.x) * e); w.w = pk2(lo16(hi.y) * e, hi16(hi.y) * e);
                    *(u32x4*)(itp + OFF_Q + (size_t)(jb * 64 + lane) * 16) = w;
                } else if (jb < 32) {
                    const int f = jb - 16, db = f >> 1, kb = f & 1, dk = 16 * db + r;
                    const u32x2 lo = *(LAS u32x2*)(KtlT + dk * 72 + 32 * kb + 4 * q), hi = *(LAS u32x2*)(KtlT + dk * 72 + 32 * kb + 16 + 4 * q);
                    u32x4 w; w.x = lo.x; w.y = lo.y; w.z = hi.x; w.w = hi.y;
                    *(u32x4*)(itp + OFF_KT + (size_t)(f * 64 + lane) * 16) = w;
                } else {
                    const int f = jb - 32, tb = f >> 1, kb = f & 1, tok = 16 * tb + r;
                    const u32x2 lo = *(LAS u32x2*)(QKm + tok * 72 + 32 * kb + 4 * q), hi = *(LAS u32x2*)(QKm + tok * 72 + 32 * kb + 16 + 4 * q);
                    u32x4 w; w.x = lo.x; w.y = lo.y; w.z = hi.x; w.w = hi.y;
                    *(u32x4*)(itp + OFF_QK + (size_t)(f * 64 + lane) * 16) = w;
                }
            }
        }
        __syncthreads();
#pragma unroll
        for (int d = 1; d < 4; ++d) {
            if (wave < 4 - d) {
                const int bj = wave, bi = wave + d;
                f32x4 M = {0.f, 0.f, 0.f, 0.f};
#pragma unroll
                for (int kk = 0; kk < d; ++kk) { const int bk = bj + kk;
#pragma unroll
                    for (int s = 0; s < 4; ++s) M = __builtin_amdgcn_mfma_f32_16x16x4f32(Lm[(16 * bi + r) * 68 + 16 * bk + 4 * s + q], Tf[(16 * bk + 4 * s + q) * 68 + 16 * bj + r], M, 0, 0, 0);
                }
                f32x4 Tn = {0.f, 0.f, 0.f, 0.f};
#pragma unroll
                for (int s = 0; s < 4; ++s) Tn = __builtin_amdgcn_mfma_f32_16x16x4f32(Tf[(16 * bi + r) * 68 + 16 * bi + 4 * q + s], M[s], Tn, 0, 0, 0);
#pragma unroll
                for (int jj = 0; jj < 4; ++jj) { Tf[(16 * bi + 4 * q + jj) * 68 + 16 * bj + r] = -Tn[jj]; Tm[(16 * bi + 4 * q + jj) * 72 + 16 * bj + r] = f2bf(-Tn[jj]); }
            }
            __syncthreads();
        }
        {
            const int s = wave;
            bf16x8 vb[2];
#pragma unroll
            for (int kb = 0; kb < 2; ++kb) vb[kb] = *(LAS bf16x8*)(VbT + (16 * s + r) * 72 + 32 * kb + 8 * q);
#pragma unroll
            for (int tb = 0; tb < 4; ++tb) {
                f32x4 acc = {0.f, 0.f, 0.f, 0.f};
#pragma unroll
                for (int kb = 0; kb < 2; ++kb) { const bf16x8 a = *(LAS bf16x8*)(Tm + (16 * tb + r) * 72 + 32 * kb + 8 * q); acc = MFMA16(a, vb[kb], acc); }
                *(f32x4*)(itp + OFF_U + (size_t)((s * 4 + tb) * 64 + lane) * 16) = acc;
            }
            const int kbp = wave & 3, tbh = wave >> 2;
            bf16x8 ka[2][2];
#pragma unroll
            for (int d = 0; d < 2; ++d)
#pragma unroll
                for (int kb = 0; kb < 2; ++kb) ka[d][kb] = *(LAS bf16x8*)(KbgT + (16 * (2 * kbp + d) + r) * 72 + 32 * kb + 8 * q);
#pragma unroll
            for (int tt = 0; tt < 2; ++tt) {
                const int tb = 2 * tbh + tt;
                f32x4 a0 = {0.f, 0.f, 0.f, 0.f}, a1 = {0.f, 0.f, 0.f, 0.f};
#pragma unroll
                for (int kb = 0; kb < 2; ++kb) { const bf16x8 tf = *(LAS bf16x8*)(Tm + (16 * tb + r) * 72 + 32 * kb + 8 * q); a0 = MFMA16(ka[0][kb], tf, a0); a1 = MFMA16(ka[1][kb], tf, a1); }
                u32x4 w; w.x = pk2(a0[0], a0[1]); w.y = pk2(a0[2], a0[3]); w.z = pk2(a1[0], a1[1]); w.w = pk2(a1[2], a1[3]);
                *(u32x4*)(itp + OFF_W + (size_t)((tb * 4 + kbp) * 64 + lane) * 16) = w;
            }
        }
    }
}

__device__ __forceinline__ void mixer_a(const int tidx, const P& p, int l, int blk, int nblk) {
    const bf16_t* proj = (const bf16_t*)(p.ws + WS_PROJ); bf16_t* ycat = (bf16_t*)(p.ws + WS_YCAT);
    for (int unit = blk * 512 + tidx; unit < MTOK * 32; unit += nblk * 512) {
        const int t = unit >> 5, c0 = (unit & 31) * 8, pos = t & (SEQ - 1);
        float acc[8];
#pragma unroll
        for (int i = 0; i < 8; ++i) acc[i] = 0.f;
#pragma unroll
        for (int j = 0; j < 3; ++j) {
            if (pos - 2 + j >= 0) {
                const bf16_t* pr = proj + (size_t)(t - 2 + j) * NINP;
                float fc[8], fv[8]; unpack8(*(const u32x4*)(pr + 256 + c0), fc); unpack8(*(const u32x4*)(pr + 512 + c0), fv);
                const float* wp = p.conv_a_w + (size_t)(l * 3 + j) * 256 + c0;
                const f32x4 w0 = *(const f32x4*)wp, w1 = *(const f32x4*)(wp + 4);
#pragma unroll
                for (int i = 0; i < 4; ++i) { acc[i] += w0[i] * fc[i] * fv[i]; acc[4 + i] += w1[i] * fc[4 + i] * fv[4 + i]; }
            }
        }
        float fb[8]; unpack8(*(const u32x4*)(proj + (size_t)t * NINP + c0), fb);
#pragma unroll
        for (int i = 0; i < 8; ++i) acc[i] *= fb[i];
        *(u32x4*)(ycat + (size_t)t * DM + c0) = pack8(acc);
    }
}
__device__ __forceinline__ void mixer_b(const int tidx, const P& p, int l, int blk, int nblk, LAS unsigned char* L) {
    const bf16_t* proj = (const bf16_t*)(p.ws + WS_PROJ); bf16_t* ycat = (bf16_t*)(p.ws + WS_YCAT);
    LAS float* ut = (LAS float*)L;
    LAS float* co = (LAS float*)(L + 63488);
    const int tid = tidx, wave = tid >> 6, lane = tid & 63;
    for (int run = blk; run < MTOK / 32; run += nblk) {
        __syncthreads();
        const int t0 = run * 32, pos0 = t0 & (SEQ - 1);
        {
            u32x4 ra[4], rg[4];
#pragma unroll
            for (int it = 0; it < 4; ++it) { const int idx = tid + 512 * it, rr = idx >> 5, c0 = (idx & 31) * 8;
                ra[it] = (u32x4){0u, 0u, 0u, 0u}; rg[it] = (u32x4){0u, 0u, 0u, 0u};
                if (idx < 62 * 32 && pos0 - 30 + rr >= 0) { const bf16_t* pr = proj + (size_t)(t0 - 30 + rr) * NINP; ra[it] = *(const u32x4*)(pr + 768 + c0); rg[it] = *(const u32x4*)(pr + 1024 + c0); } }
#pragma unroll
            for (int it = 0; it < 4; ++it) { const int idx = tid + 512 * it, rr = idx >> 5, c0 = (idx & 31) * 8;
                if (idx < 62 * 32) { float fa[8], fg[8], u[8]; unpack8(ra[it], fa); unpack8(rg[it], fg);
#pragma unroll
                    for (int i = 0; i < 8; ++i) u[i] = fa[i] * sigmoid_f(fg[i]);
                    *(LAS f32x4*)(ut + rr * 256 + c0) = (f32x4){u[0], u[1], u[2], u[3]}; *(LAS f32x4*)(ut + rr * 256 + c0 + 4) = (f32x4){u[4], u[5], u[6], u[7]}; } }
        }
        __syncthreads();
        {
            const int c = tid & 255, half = tid >> 8;
            float w[31], win[46];
#pragma unroll
            for (int j = 0; j < 31; ++j) w[j] = p.conf_dw_w[(size_t)(l * 31 + j) * 256 + c];
            const float bias = p.conf_dw_b[l * 256 + c];
#pragma unroll
            for (int k = 0; k < 46; ++k) win[k] = ut[(half * 16 + k) * 256 + c];
#pragma unroll
            for (int tt = 0; tt < 16; ++tt) { float acc = bias;
#pragma unroll
                for (int j = 0; j < 31; ++j) acc += w[j] * win[tt + j];
                co[(half * 16 + tt) * 256 + c] = acc; }
        }
        __syncthreads();
#pragma unroll
        for (int i = 0; i < 4; ++i) {
            const int tl = wave * 4 + i;
            const f32x4 v = *(LAS f32x4*)(co + tl * 256 + lane * 4);
            const float mean = wave_sum(v[0] + v[1] + v[2] + v[3]) * (1.f / 256.f);
            const f32x4 d = v - mean;
            const float var = wave_sum(d[0] * d[0] + d[1] * d[1] + d[2] * d[2] + d[3] * d[3]) * (1.f / 256.f);
            const float rs = rsqrtf(var + 1e-5f);
            const f32x4 gg = *(const f32x4*)(p.conf_ln_g + l * 256 + lane * 4), bb = *(const f32x4*)(p.conf_ln_b + l * 256 + lane * 4);
            const f32x4 y = d * rs * gg + bb;
            u32x2 wv; wv.x = pk2(silu_f(y[0]), silu_f(y[1])); wv.y = pk2(silu_f(y[2]), silu_f(y[3]));
            *(u32x2*)(ycat + (size_t)(t0 + tl) * DM + 256 + lane * 4) = wv;
        }
    }
}

constexpr int SCAN_BLOCKS = 128, SCAN_BUF = 64512;
__device__ __forceinline__ void phase_scan(const int tidx, const P& p, int l, LAS unsigned char* L) {
    const int tid = tidx, lane = tid & 63, wave = tid >> 6, r = lane & 15, q = lane >> 4;
    if ((int)blockIdx.x >= SCAN_BLOCKS) {
        const int blk = blockIdx.x - SCAN_BLOCKS, nblk = gridDim.x - SCAN_BLOCKS;
        mixer_a(tidx, p, l, blk, nblk);
        mixer_b(tidx, p, l, blk, nblk, L);
        __syncthreads();
        {
            pg8::Gemm g{(const bf16_t*)(p.ws + WS_H), (const bf16_t*)(p.ws + WS_WIN) + ((size_t)l * NINP + 3072) * DM, MTOK, 512, DM}; pg8::StaticOrder S; S.init(MTOK, 512, nblk, blk);
            pg8::EpiProj E{(bf16_t*)(p.ws + WS_PROJ) + 3072, NINP}; pg8::gemm_phase<pg8::EpiProj>(tidx, L, g, S, E);
        }
        if (l + 1 < NL) prep_transposes(tidx, p, L, l + 1, l + 2, blk, nblk);
        return;
    }
    const int item = blockIdx.x, xcd = item & 7, jj = item >> 3, s = jj & 7, bh = xcd * 2 + (jj >> 3), b = bh >> 2, h = bh & 3;
    const unsigned char* dl = p.ws + WS_DELTA;
    const float* alast = (const float*)(p.ws + WS_ALAST);
    bf16_t* obuf = (bf16_t*)(p.ws + WS_YCAT);
#define SB_ __builtin_amdgcn_sched_barrier(0)
#define SCAN_COMPUTE(buf, n_) do { \
            const float al = __builtin_bit_cast(float, __builtin_amdgcn_readlane(__builtin_bit_cast(int, al_all), (n_))); \
            const LAS bf16x8* Wf = (const LAS bf16x8*)((buf) + OFF_W) + lane; const LAS bf16x8* Qf = (const LAS bf16x8*)((buf) + OFF_Q) + lane; \
            const LAS bf16x8* Kf = (const LAS bf16x8*)((buf) + OFF_KT) + lane; const LAS bf16x8* QKf = (const LAS bf16x8*)((buf) + OFF_QK) + lane; \
            const LAS f32x4* Uf = (const LAS f32x4*)((buf) + OFF_U) + lane; \
            bf16x8 g0[8], g1[8]; f32x4 Uv[4]; \
            _Pragma("unroll") for (int f = 0; f < 8; ++f) g0[f] = Wf[((f >> 1) * 4 + (f & 1)) * 64];                \
            _Pragma("unroll") for (int f = 0; f < 8; ++f) g1[f] = Wf[((f >> 1) * 4 + 2 + (f & 1)) * 64];            \
            bf16x8 Sb[4]; \
            _Pragma("unroll") for (int kb = 0; kb < 4; ++kb) { u32x4 w; w.x = pk2(S[2 * kb][0], S[2 * kb][1]); w.y = pk2(S[2 * kb][2], S[2 * kb][3]); w.z = pk2(S[2 * kb + 1][0], S[2 * kb + 1][1]); w.w = pk2(S[2 * kb + 1][2], S[2 * kb + 1][3]); \
                Sb[kb] = __builtin_bit_cast(bf16x8, w); } \
            f32x4 Pv[4], O[4]; \
            _Pragma("unroll") for (int tb = 0; tb < 4; ++tb) { Pv[tb] = (f32x4){0.f, 0.f, 0.f, 0.f}; O[tb] = (f32x4){0.f, 0.f, 0.f, 0.f}; } \
            SB_; \
            _Pragma("unroll") for (int f = 0; f < 8; ++f) Pv[f >> 1] = MFMA16(g0[f], Sb[f & 1], Pv[f >> 1]); \
            _Pragma("unroll") for (int f = 0; f < 8; ++f) g0[f] = Qf[((f >> 1) * 4 + (f & 1)) * 64]; \
            SB_; \
            _Pragma("unroll") for (int f = 0; f < 8; ++f) Pv[f >> 1] = MFMA16(g1[f], Sb[2 + (f & 1)], Pv[f >> 1]); \
            _Pragma("unroll") for (int f = 0; f < 8; ++f) g1[f] = Qf[((f >> 1) * 4 + 2 + (f & 1)) * 64]; \
            _Pragma("unroll") for (int tb = 0; tb < 4; ++tb) Uv[tb] = Uf[tb * 64]; \
            SB_; \
            _Pragma("unroll") for (int f = 0; f < 8; ++f) O[f >> 1] = MFMA16(g0[f], Sb[f & 1], O[f >> 1]); \
            _Pragma("unroll") for (int f = 0; f < 8; ++f) g0[f] = Kf[(f * 2) * 64];                                  \
            SB_; \
            _Pragma("unroll") for (int f = 0; f < 8; ++f) O[f >> 1] = MFMA16(g1[f], Sb[2 + (f & 1)], O[f >> 1]); \
            _Pragma("unroll") for (int f = 0; f < 8; ++f) g1[f] = Kf[(f * 2 + 1) * 64];                              \
            _Pragma("unroll") for (int tb = 0; tb < 4; ++tb) Pv[tb] = Uv[tb] - Pv[tb]; \
            bf16x8 Vb[2]; \
            _Pragma("unroll") for (int kb = 0; kb < 2; ++kb) { u32x4 w; w.x = pk2(Pv[2 * kb][0], Pv[2 * kb][1]); w.y = pk2(Pv[2 * kb][2], Pv[2 * kb][3]); w.z = pk2(Pv[2 * kb + 1][0], Pv[2 * kb + 1][1]); w.w = pk2(Pv[2 * kb + 1][2], Pv[2 * kb + 1][3]); \
                Vb[kb] = __builtin_bit_cast(bf16x8, w); } \
            _Pragma("unroll") for (int db = 0; db < 8; ++db) S[db] = S[db] * al; \
            SB_; \
            _Pragma("unroll") for (int f = 0; f < 8; ++f) S[f] = MFMA16(g0[f], Vb[0], S[f]); \
            _Pragma("unroll") for (int f = 0; f < 8; ++f) if (f != 1 && f != 3) g0[f] = QKf[f * 64];                  \
            SB_; \
            _Pragma("unroll") for (int f = 0; f < 8; ++f) S[f] = MFMA16(g1[f], Vb[1], S[f]); \
            SB_; \
            _Pragma("unroll") for (int f = 0; f < 8; ++f) if (f != 1 && f != 3) O[f >> 1] = MFMA16(g0[f], Vb[f & 1], O[f >> 1]); \
            bf16_t* op = obuf + (size_t)(b * SEQ + (n_) * 64 + 4 * q) * DM + 512 + h * 128 + 16 * s + r; \
            _Pragma("unroll") for (int tb = 0; tb < 4; ++tb) \
                _Pragma("unroll") for (int j = 0; j < 4; ++j) op[(size_t)(16 * tb + j) * DM] = f2bf(O[tb][j]); \
        } while (0)
#define SCAN_BAR() do { asm volatile("s_waitcnt lgkmcnt(0)" ::: "memory"); __builtin_amdgcn_s_barrier(); asm volatile("" ::: "memory"); } while (0)
    LAS unsigned char* buf0 = L; LAS unsigned char* buf1 = L + SCAN_BUF;
    if (wave == 0) {
        const float al_all = alast[(b * 64 + lane) * 4 + h];
        f32x4 S[8];
#pragma unroll
        for (int i = 0; i < 8; ++i) S[i] = (f32x4){0.f, 0.f, 0.f, 0.f};
        SCAN_BAR();
        __builtin_amdgcn_s_setprio(3);
#pragma unroll 1
        for (int n = 0; n < 64; n += 2) {
            SCAN_COMPUTE(buf0, n);
            SCAN_BAR();
            SCAN_COMPUTE(buf1, n + 1);
            SCAN_BAR();
        }
        __builtin_amdgcn_s_setprio(0);
    } else {
        const int ct = tid - 64;
        const int off8 = (ct < 256) ? (OFF_U + s * 4096 + ct * 16) : ((ct - 256) * 16);
        const unsigned char* dlb = dl + (size_t)((b * 64) * 4 + h) * ITEM_BYTES;
        u32x4 R0[9], R1[9], R2[9], R3[9];
#define SCAN_LOAD(regs, n_) do { const int nn_ = ((n_) < 64) ? (n_) : 63; const unsigned char* itp_ = dlb + (size_t)nn_ * (4 * ITEM_BYTES); \
        _Pragma("unroll") for (int i_ = 0; i_ < 8; ++i_) regs[i_] = *(const u32x4*)(itp_ + (ct + 448 * i_) * 16); \
        regs[8] = *(const u32x4*)(itp_ + off8); __builtin_amdgcn_sched_barrier(0); } while (0)
#define SCAN_STORE(regs, buf_) do { _Pragma("unroll") for (int i_ = 0; i_ < 9; ++i_) *(LAS u32x4*)((buf_) + (ct + 448 * i_) * 16) = regs[i_]; } while (0)
        SCAN_LOAD(R0, 0); SCAN_LOAD(R1, 1); SCAN_LOAD(R2, 2); SCAN_LOAD(R3, 3);
        SCAN_STORE(R0, buf0);
        SCAN_BAR();
#pragma unroll 1
        for (int n = 0; n < 64; n += 4) {
            SCAN_LOAD(R0, n + 4); SCAN_STORE(R1, buf1); SCAN_BAR();
            SCAN_LOAD(R1, n + 5); SCAN_STORE(R2, buf0); SCAN_BAR();
            SCAN_LOAD(R2, n + 6); SCAN_STORE(R3, buf1); SCAN_BAR();
            SCAN_LOAD(R3, n + 7); SCAN_STORE(R0, buf0); SCAN_BAR();
        }
    }
#undef SCAN_COMPUTE
#undef SB_
#undef SCAN_BAR
#undef SCAN_LOAD
#undef SCAN_STORE
}

__device__ __forceinline__ void phase_onorm(const int tidx, const P& p, int l) {
    const bf16_t* proj = (const bf16_t*)(p.ws + WS_PROJ); bf16_t* ycat = (bf16_t*)(p.ws + WS_YCAT);
    const int sub = tidx & 15, d0 = sub * 8;
    const f32x4 g0 = *(const f32x4*)(p.dn_norm_g + l * 128 + d0), g1 = *(const f32x4*)(p.dn_norm_g + l * 128 + d0 + 4);
    for (int unit0 = (blockIdx.x * 32 + (tidx >> 4)) * 2; unit0 < MTOK * 4; unit0 += gridDim.x * 64) {
        u32x4 orw[2], zr[2];
#pragma unroll
        for (int uu = 0; uu < 2; ++uu) { const int t = (unit0 + uu) >> 2, h = (unit0 + uu) & 3;
            orw[uu] = *(const u32x4*)(ycat + (size_t)t * DM + 512 + h * 128 + d0);
            zr[uu] = *(const u32x4*)(proj + (size_t)t * NINP + 3072 + h * 128 + d0); }
#pragma unroll
        for (int uu = 0; uu < 2; ++uu) { const int t = (unit0 + uu) >> 2, h = (unit0 + uu) & 3;
            float o[8]; unpack8(orw[uu], o);
            float ss = 0.f;
#pragma unroll
            for (int i = 0; i < 8; ++i) ss += o[i] * o[i];
            ss += __shfl_xor(ss, 1); ss += __shfl_xor(ss, 2); ss += __shfl_xor(ss, 4); ss += __shfl_xor(ss, 8);
            const float rinv = rsqrtf(ss * (1.f / 128.f) + 1e-6f);
            float z[8]; unpack8(zr[uu], z);
            float y[8];
#pragma unroll
            for (int i = 0; i < 4; ++i) { y[i] = o[i] * rinv * g0[i] * silu_f(z[i]); y[4 + i] = o[4 + i] * rinv * g1[i] * silu_f(z[4 + i]); }
            *(u32x4*)(ycat + (size_t)t * DM + 512 + h * 128 + d0) = pack8(y); }
    }
}

#define XB_TMO      128
#define XB_XCNT(j)  (256  + 64 * (j))
#define XB_XSUB(j)  (1280 + 64 * (j))
#define XB_XGEN(j)  (2304 + 64 * (j))
#define XB_TOP      3328
#define XB_TOPGEN   3392
#define XCD_BAR_WORDS 3456
#define XB_SPIN_CAP (1u << 22)
__device__ __forceinline__ unsigned xb_ld(unsigned* p)              { return __hip_atomic_load(p, __ATOMIC_RELAXED, __HIP_MEMORY_SCOPE_AGENT); }
__device__ __forceinline__ unsigned xb_add(unsigned* p, unsigned v) { return __hip_atomic_fetch_add(p, v, __ATOMIC_RELAXED, __HIP_MEMORY_SCOPE_AGENT); }
__device__ __forceinline__ unsigned xb_xcc_id() { return (unsigned)__builtin_amdgcn_s_getreg((3 << 11) | 20) & 0xFu; }
#define XB_SPIN(cond, bar) do { unsigned _sp = 0; while (cond) { __builtin_amdgcn_s_sleep(1); \
    if ((++_sp & 255u) == 0u) { if (xb_ld(&(bar)[XB_TMO])) break; if (_sp > XB_SPIN_CAP) { atomicAdd(&(bar)[XB_TMO], 1u); break; } } } } while (0)
struct XcdBarrier { unsigned* bar; unsigned x; volatile LAS unsigned* st; };
__device__ __forceinline__ XcdBarrier xcd_barrier_post(unsigned* bar, volatile LAS unsigned* st) {
    XcdBarrier b; b.bar = bar; b.x = xb_xcc_id(); b.st = st;
    if (threadIdx.x == 0) (void)xb_add(&bar[XB_XCNT(b.x)], 1u);
    return b;
}
__device__ __forceinline__ void xcd_barrier_complete(unsigned* bar, unsigned x, unsigned& nloc, unsigned& nx) {
    const unsigned G = gridDim.x * gridDim.y * gridDim.z;
    unsigned sum, cnt, mine, sp = 0u;
    for (;;) {
        sum = 0u; cnt = 0u; mine = 0u;
#pragma unroll
        for (unsigned j = 0; j < 16; ++j) { const unsigned c = xb_ld(&bar[XB_XCNT(j)]); sum += c; cnt += (c > 0u) ? 1u : 0u; mine = (j == x) ? c : mine; }
        if (sum == G) break;
        __builtin_amdgcn_s_sleep(1);
        if ((++sp & 255u) == 0u) { if (xb_ld(&bar[XB_TMO])) break; if (sp > XB_SPIN_CAP) { atomicAdd(&bar[XB_TMO], 1u); break; } }
    }
    nloc = mine > 0u ? mine : 1u; nx = cnt > 0u ? cnt : 1u;
}
__device__ __forceinline__ void xcd_barrier(const XcdBarrier& b) {
    asm volatile("s_waitcnt vmcnt(0)" ::: "memory");
    __syncthreads();
    if (threadIdx.x == 0) {
        unsigned* bar = b.bar;
        __builtin_amdgcn_s_waitcnt(0);
        unsigned nloc = b.st[0], nx = b.st[1];
        if (nloc == 0u) { xcd_barrier_complete(bar, b.x, nloc, nx); b.st[0] = nloc; b.st[1] = nx; }
        const unsigned old = xb_add(&bar[XB_XSUB(b.x)], 1u);
        const unsigned gen = old / nloc;
        if (old + 1u == (gen + 1u) * nloc) {
            __builtin_amdgcn_fence(__ATOMIC_RELEASE, "agent");
            asm volatile("s_waitcnt vmcnt(0)" ::: "memory");
            const unsigned og = xb_add(&bar[XB_TOP], 1u);
            const unsigned tg = og / nx;
            if (og + 1u == (tg + 1u) * nx) xb_add(&bar[XB_TOPGEN], 1u);
            else XB_SPIN(xb_ld(&bar[XB_TOPGEN]) == tg, bar);
            __builtin_amdgcn_fence(__ATOMIC_ACQUIRE, "agent");
            xb_add(&bar[XB_XGEN(b.x)], 1u);
            asm volatile("s_waitcnt vmcnt(0)" ::: "memory");
        } else {
            XB_SPIN(xb_ld(&bar[XB_XGEN(b.x)]) == gen, bar);
            __builtin_amdgcn_fence(__ATOMIC_ACQUIRE, "agent");
            asm volatile("s_waitcnt vmcnt(0)" ::: "memory");
        }
    }
    __syncthreads();
}

template <int KIND>
__device__ __forceinline__ void run_kind(const int tidx, const P& p, int l, LAS unsigned char* L) {
    const float* modl = (const float*)(p.ws + WS_MOD) + (size_t)l * NB * NMOD;
    bf16_t* hbuf = (bf16_t*)(p.ws + WS_H); bf16_t* ycat = (bf16_t*)(p.ws + WS_YCAT); bf16_t* proj = (bf16_t*)(p.ws + WS_PROJ);
    const float* xin = (l == 0) ? p.x : p.out;
    if constexpr (KIND == 0) phase_prep(tidx, p, L);
    if constexpr (KIND == 1) phase_norm(tidx, xin, p.norm_mix_g + l * DM, modl, 0, DM, hbuf);
    if constexpr (KIND == 2) { pg8::Gemm g{hbuf, (const bf16_t*)(p.ws + WS_WIN) + (size_t)l * NINP * DM, MTOK, 3072, DM}; pg8::StaticOrder S; S.init(MTOK, 3072, gridDim.x, blockIdx.x);
        pg8::EpiProj E{proj, NINP}; pg8::gemm_phase<pg8::EpiProj>(tidx, L, g, S, E); }
    if constexpr (KIND == 3) phase_dprep(tidx, p, l, L);
    if constexpr (KIND == 4) phase_scan(tidx, p, l, L);
    if constexpr (KIND == 5) phase_onorm(tidx, p, l);
    if constexpr (KIND == 6) { pg8::Gemm g{ycat, (const bf16_t*)(p.ws + WS_WOUT) + (size_t)l * DM * DM, MTOK, DM, DM}; pg8::StaticOrder S; S.init(MTOK, DM, gridDim.x, blockIdx.x);
        pg8::EpiResid E{xin, p.out, modl + 2 * DM}; pg8::gemm_phase<pg8::EpiResid>(tidx, L, g, S, E); }
    if constexpr (KIND == 7) phase_norm(tidx, p.out, p.norm_ffn_g + l * DM, modl, 3 * DM, 4 * DM, hbuf);
    if constexpr (KIND == 8) { pg8::Gemm g{hbuf, (const bf16_t*)(p.ws + WS_WF1) + (size_t)l * NF1 * DM, MTOK, NF1, DM}; pg8::StaticOrder S; S.init(MTOK, NF1, gridDim.x, blockIdx.x);
        pg8::EpiSwiGLU E{proj}; pg8::gemm_phase<pg8::EpiSwiGLU>(tidx, L, g, S, E); }
    if constexpr (KIND == 9) { pg8::Gemm g{proj, (const bf16_t*)(p.ws + WS_WF2) + (size_t)l * DM * DFF, MTOK, DM, DFF}; pg8::StaticOrder S; S.init(MTOK, DM, gridDim.x, blockIdx.x);
        pg8::EpiResid E{p.out, p.out, modl + 5 * DM}; pg8::gemm_phase<pg8::EpiResid>(tidx, L, g, S, E); }
    if constexpr (KIND == 10) phase_final(tidx, p.out, p.final_norm_g);
}
__host__ __device__ inline void phase_decode(int ph, int& kind, int& l) {
    if (ph == 0) { kind = 0; l = 0; } else if (ph == NPH - 1) { kind = 10; l = 0; } else { l = (ph - 1) / 9; kind = 1 + (ph - 1) % 9; }
}

#if ONE_LAUNCH
__global__ void __launch_bounds__(512, 2) hymba_fwd(P p) {
    extern __shared__ __attribute__((aligned(16))) unsigned char lds_raw[];
    LAS unsigned char* L = (LAS unsigned char*)lds_raw;
    cg::grid_group grid = cg::this_grid();
    if (threadIdx.x < 16) ((LAS unsigned*)(L + LDS_BAR_OFF))[threadIdx.x] = 0u;
    __syncthreads();
    const XcdBarrier bar = xcd_barrier_post((unsigned*)(p.ws + WS_BAR), (volatile LAS unsigned*)(L + LDS_BAR_OFF));
    for (int ph = p.ph_lo; ph < p.ph_hi; ++ph) {
        if (p.ph_hi > NPH) grid.sync();
        if (ph > p.ph_lo) xcd_barrier(bar);
        int kind, l; phase_decode(ph, kind, l);
        int tidx = threadIdx.x; asm volatile("" : "+v"(tidx));
#if REPEAT_MASK
        if ((REPEAT_MASK >> kind) & 1) {
            switch (kind) { case 1: run_kind<1>(tidx, p, l, L); break; case 2: run_kind<2>(tidx, p, l, L); break; case 3: run_kind<3>(tidx, p, l, L); break; case 4: run_kind<4>(tidx, p, l, L); break;
                case 5: run_kind<5>(tidx, p, l, L); break; case 7: run_kind<7>(tidx, p, l, L); break; case 8: run_kind<8>(tidx, p, l, L); break; default: break; }
            __syncthreads();
        }
#endif
        switch (kind) {
        case 0: run_kind<0>(tidx, p, l, L); break; case 1: run_kind<1>(tidx, p, l, L); break; case 2: run_kind<2>(tidx, p, l, L); break; case 3: run_kind<3>(tidx, p, l, L); break;
        case 4: run_kind<4>(tidx, p, l, L); break; case 5: run_kind<5>(tidx, p, l, L); break; case 6: run_kind<6>(tidx, p, l, L); break; case 7: run_kind<7>(tidx, p, l, L); break;
        case 8: run_kind<8>(tidx, p, l, L); break; case 9: run_kind<9>(tidx, p, l, L); break; default: run_kind<10>(tidx, p, l, L); break;
        }
    }
}
#define LAUNCH_FN(kind) ((const void*)hymba_fwd)
#else
template <int KIND> __global__ void __launch_bounds__(512, 2) hymba_ph(P p) {
    extern __shared__ __attribute__((aligned(16))) unsigned char lds_raw[];
    run_kind<KIND>((int)threadIdx.x, p, p.ph_hi, (LAS unsigned char*)lds_raw);
}
static const void* ph_fn(int kind) {
    switch (kind) { case 0: return (const void*)hymba_ph<0>; case 1: return (const void*)hymba_ph<1>; case 2: return (const void*)hymba_ph<2>; case 3: return (const void*)hymba_ph<3>;
        case 4: return (const void*)hymba_ph<4>; case 5: return (const void*)hymba_ph<5>; case 6: return (const void*)hymba_ph<6>; case 7: return (const void*)hymba_ph<7>;
        case 8: return (const void*)hymba_ph<8>; case 9: return (const void*)hymba_ph<9>; default: return (const void*)hymba_ph<10>; }
}
#define LAUNCH_FN(kind) ph_fn(kind)
#endif

extern "C" void kernel_launch(void* const* d_in, const int* in_sizes, int n_in, void* d_out, int out_size, void* d_ws, size_t ws_size, hipStream_t stream) {
    static int grid = 0;
    if (grid == 0) {
        if (n_in != 20 || out_size != MTOK * DM || ws_size < WS_END) { fprintf(stderr, "kernel_launch: unexpected problem (n_in %d out %d ws %zu need %zu)\n", n_in, out_size, ws_size, (size_t)WS_END); grid = -1; return; }
        int dev = 0, cus = 0, per_cu = 0;
        (void)hipGetDevice(&dev); (void)hipDeviceGetAttribute(&cus, hipDeviceAttributeMultiprocessorCount, dev);
        for (int k = 0; k <= 10; ++k)
            if (hipFuncSetAttribute(LAUNCH_FN(k), hipFuncAttributeMaxDynamicSharedMemorySize, LDS_BYTES) != hipSuccess) { fprintf(stderr, "kernel_launch: hipFuncSetAttribute failed\n"); grid = -1; return; }
#if ONE_LAUNCH
        if (hipOccupancyMaxActiveBlocksPerMultiprocessor(&per_cu, (const void*)hymba_fwd, 512, LDS_BYTES) != hipSuccess || per_cu < 1) { fprintf(stderr, "kernel_launch: occupancy query failed (%d)\n", per_cu); (void)hipGetLastError(); per_cu = 1; }
#else
        per_cu = 1;
#endif
        grid = cus * per_cu;
        if (grid < SCAN_BLOCKS + 32) { fprintf(stderr, "kernel_launch: grid %d too small\n", grid); grid = -1; return; }
    }
    if (grid < 0) return;
    P p{};
    const float** pp = (const float**)&p;
    for (int i = 0; i < 20; ++i) pp[i] = (const float*)d_in[i];
    p.out = (float*)d_out; p.ws = (unsigned char*)d_ws;
#if ONE_LAUNCH
    p.ph_lo = 0; p.ph_hi = NPH;
    if (hipMemsetAsync((unsigned char*)d_ws + WS_BAR, 0, 16384, stream) != hipSuccess) { fprintf(stderr, "kernel_launch: memset of the barrier words failed\n"); return; }
    void* args[] = {&p};
    hipError_t e = hipLaunchCooperativeKernel((const void*)hymba_fwd, dim3(grid), dim3(512), args, LDS_BYTES, stream);
    if (e != hipSuccess) fprintf(stderr, "cooperative launch failed: %s (grid %d)\n", hipGetErrorString(e), grid);
#else
    for (int ph = 0; ph < NPH; ++ph) { int kind, l; phase_decode(ph, kind, l); p.ph_lo = kind; p.ph_hi = l; void* args[] = {&p};
        (void)hipLaunchKernel(ph_fn(kind), dim3(grid), dim3(512), args, LDS_BYTES, stream); }
#endif
}
```

```cpp
#include <hip/hip_runtime.h>
#include <hip/hip_cooperative_groups.h>
#include <cstdio>
namespace cg = cooperative_groups;

#ifndef ONE_LAUNCH
#define ONE_LAUNCH 1
#endif
#ifndef REPEAT_MASK
#define REPEAT_MASK 0
#endif

#define LAS __attribute__((address_space(3)))
typedef unsigned short bf16_t;
typedef short bf16x8 __attribute__((ext_vector_type(8)));
typedef float f32x4 __attribute__((ext_vector_type(4)));
typedef float f32x2 __attribute__((ext_vector_type(2)));
typedef unsigned u32x4 __attribute__((ext_vector_type(4)));
typedef unsigned u32x2 __attribute__((ext_vector_type(2)));
typedef __bf16 nbf16x2 __attribute__((ext_vector_type(2)));

constexpr int MTOK = 16384, DM = 1024, NL = 4, NB = 4, SEQ = 4096;
constexpr int NIN = 3336, NINP = 3584, DFF = 2816, NF1 = 2 * DFF, NMOD = 6 * DM;
constexpr int LDS_BYTES = 131072 + 64 + 6144 + 17408, LDS_BAR_OFF = 131072, LDS_CW_OFF = 131072 + 64, LDS_TF_OFF = LDS_CW_OFF + 6144;
constexpr int NPH = 1 + 9 * NL + 1;

constexpr size_t SZ_WIN = (size_t)NL * NINP * DM * 2, SZ_WOUT = (size_t)NL * DM * DM * 2, SZ_WF1 = (size_t)NL * NF1 * DM * 2, SZ_WF2 = (size_t)NL * DM * DFF * 2;
constexpr size_t WS_WIN = 0, WS_WOUT = WS_WIN + SZ_WIN, WS_WF1 = WS_WOUT + SZ_WOUT, WS_WF2 = WS_WF1 + SZ_WF1;
constexpr size_t WS_MOD = WS_WF2 + SZ_WF2;
constexpr size_t WS_ALAST = WS_MOD + (size_t)NL * NB * NMOD * 4;
constexpr size_t WS_H = WS_ALAST + 4096;
constexpr size_t WS_YCAT = WS_H + (size_t)MTOK * DM * 2;
constexpr size_t WS_PROJ = WS_YCAT + (size_t)MTOK * DM * 2;
constexpr int ITEM_BYTES = 90112, OFF_W = 0, OFF_Q = 16384, OFF_KT = 32768, OFF_QK = 49152, OFF_U = 57344;
constexpr size_t WS_DELTA = WS_PROJ + (size_t)MTOK * NINP * 2;
constexpr size_t WS_BAR = WS_DELTA + (size_t)1024 * ITEM_BYTES;
constexpr size_t WS_END = WS_BAR + 16384;

struct P {
    const float *x, *c, *w_ada, *b_ada, *norm_mix_g, *norm_ffn_g, *w_in, *conv_a_w, *conf_dw_w, *conf_dw_b, *conf_ln_g, *conf_ln_b,
        *dn_conv_w, *dn_a_log, *dn_dt_bias, *dn_norm_g, *w_out, *w_ffn_in, *w_ffn_out, *final_norm_g;
    float* out; unsigned char* ws; int ph_lo, ph_hi;
};

__device__ __forceinline__ float bf2f(bf16_t v) { return __uint_as_float(((unsigned)v) << 16); }
__device__ __forceinline__ unsigned pk2(float a, float b) { f32x2 v = {a, b}; nbf16x2 r = __builtin_convertvector(v, nbf16x2); return __builtin_bit_cast(unsigned, r); }
__device__ __forceinline__ bf16_t f2bf(float a) { return (bf16_t)(pk2(a, 0.f) & 0xffffu); }
__device__ __forceinline__ float lo16(unsigned w) { return __uint_as_float(w << 16); }
__device__ __forceinline__ float hi16(unsigned w) { return __uint_as_float(w & 0xffff0000u); }
__device__ __forceinline__ float sigmoid_f(float v) { return __builtin_amdgcn_rcpf(1.f + __expf(-v)); }
__device__ __forceinline__ float silu_f(float v) { return v * sigmoid_f(v); }
__device__ __forceinline__ float wave_sum(float v) {
#pragma unroll
    for (int o = 32; o; o >>= 1) v += __shfl_xor(v, o);
    return v;
}
__device__ __forceinline__ void unpack8(const u32x4 w, float (&f)[8]) {
    f[0] = lo16(w.x); f[1] = hi16(w.x); f[2] = lo16(w.y); f[3] = hi16(w.y); f[4] = lo16(w.z); f[5] = hi16(w.z); f[6] = lo16(w.w); f[7] = hi16(w.w);
}
__device__ __forceinline__ u32x4 pack8(const float (&f)[8]) { u32x4 w; w.x = pk2(f[0], f[1]); w.y = pk2(f[2], f[3]); w.z = pk2(f[4], f[5]); w.w = pk2(f[6], f[7]); return w; }
#define MFMA16(a, b, c) __builtin_amdgcn_mfma_f32_16x16x32_bf16((a), (b), (c), 0, 0, 0)

namespace pg8 {
constexpr int BM = 256, BK = 64, HALF = 128, HTB = HALF * BK * 2, STAGE_BYTES = 8 * HTB, NXCD = 8, WGM = 8;
__host__ __device__ __forceinline__ int lds_byte(int r, int c) { const int st = (r >> 4) * 2 + (c >> 5), rr = r & 15, cc = c & 31, ob = rr * 64 + cc * 2; return st * 1024 + (ob ^ (((ob >> 9) & 1) << 5)); }
__host__ __device__ __forceinline__ void stage_rc(int b, int& R, int& C) { const int st = b / 1024, sb = b % 1024, swz = sb ^ (((sb >> 9) & 1) << 5); R = (st >> 1) * 16 + swz / 64; C = (st & 1) * 32 + (swz % 64) / 2; }
__host__ __device__ __forceinline__ int perm32(int rho) { const int n = rho >> 4, i = rho & 15; return 8 * (i >> 2) + 4 * n + (i & 3); }
struct Unit { int pm, pn; };
struct Gemm { const bf16_t* A; const bf16_t* Bt; int M, N, K; };
struct StaticOrder {
    int nM, nN, nwg, G, c;
    __device__ void init(int M, int N, int G_, int c_) { nM = M / BM; nN = N / BM; nwg = nM * nN; G = G_; c = c_; }
    __device__ bool next(int i, Unit& u) const {
        const long L = (long)i * G + c; if (L >= nwg) return false;
        int wgid = (int)L; { const int q = nwg / NXCD, r = nwg % NXCD, xcd = wgid % NXCD, off = wgid / NXCD; wgid = (xcd < r ? xcd * (q + 1) : r * (q + 1) + (xcd - r) * q) + off; }
        const int nig = WGM * nN, gid = wgid / nig, fm = gid * WGM, gsz = (nM - fm) < WGM ? (nM - fm) : WGM;
        u.pm = fm + ((wgid % nig) % gsz); u.pn = (wgid % nig) / gsz; return true;
    }
};

struct EpiProj {
    static constexpr bool PERM = true;
    bf16_t* O; int ldc;
    __device__ __forceinline__ void operator()(const f32x4 (&acc)[2][2][4][2], const Unit& u, int wr, int wc, int fr, int fq) const {
        const int row0 = u.pm * BM + wr * 64 + fr, col0 = u.pn * BM + wc * 32 + 8 * fq;
#pragma unroll
        for (int ai = 0; ai < 2; ++ai)
#pragma unroll
            for (int m = 0; m < 4; ++m) { bf16_t* rowp = O + (size_t)(row0 + ai * HALF + m * 16) * ldc + col0;
#pragma unroll
                for (int bj = 0; bj < 2; ++bj) { const f32x4 v0 = acc[ai][bj][m][0], v1 = acc[ai][bj][m][1];
                    u32x4 w; w.x = pk2(v0[0], v0[1]); w.y = pk2(v0[2], v0[3]); w.z = pk2(v1[0], v1[1]); w.w = pk2(v1[2], v1[3]);
                    *(u32x4*)(rowp + bj * HALF) = w; } }
    }
};
struct EpiSwiGLU {
    static constexpr bool PERM = true;
    bf16_t* O;
    __device__ __forceinline__ void operator()(const f32x4 (&acc)[2][2][4][2], const Unit& u, int wr, int wc, int fr, int fq) const {
        const int row0 = u.pm * BM + wr * 64 + fr, col0 = u.pn * HALF + wc * 32 + 8 * fq;
#pragma unroll
        for (int ai = 0; ai < 2; ++ai)
#pragma unroll
            for (int m = 0; m < 4; ++m) {
                const f32x4 g0 = acc[ai][0][m][0], g1 = acc[ai][0][m][1], u0 = acc[ai][1][m][0], u1 = acc[ai][1][m][1];
                float v[8];
#pragma unroll
                for (int i = 0; i < 4; ++i) { v[i] = silu_f(g0[i]) * u0[i]; v[4 + i] = silu_f(g1[i]) * u1[i]; }
                *(u32x4*)(O + (size_t)(row0 + ai * HALF + m * 16) * DFF + col0) = pack8(v);
            }
    }
};
struct EpiResid {
    static constexpr bool PERM = false;
    const float* base; float* out; const float* gate;
    __device__ __forceinline__ void operator()(const f32x4 (&acc)[2][2][4][2], const Unit& u, int wr, int wc, int fr, int fq) const {
        const int row0 = u.pm * BM + wr * 64 + fr, col0 = u.pn * BM + wc * 32 + 4 * fq;
        const float* gp = gate + (size_t)(u.pm >> 4) * NMOD + col0;
        f32x4 gv[2][2];
#pragma unroll
        for (int bj = 0; bj < 2; ++bj)
#pragma unroll
            for (int n = 0; n < 2; ++n) gv[bj][n] = *(const f32x4*)(gp + bj * HALF + n * 16);
#pragma unroll
        for (int ai = 0; ai < 2; ++ai) {
            f32x4 bv[4][2][2];
#pragma unroll
            for (int m = 0; m < 4; ++m) { const size_t ro = (size_t)(row0 + ai * HALF + m * 16) * DM + col0;
#pragma unroll
                for (int bj = 0; bj < 2; ++bj)
#pragma unroll
                    for (int n = 0; n < 2; ++n) bv[m][bj][n] = *(const f32x4*)(base + ro + bj * HALF + n * 16); }
#pragma unroll
            for (int m = 0; m < 4; ++m) { const size_t ro = (size_t)(row0 + ai * HALF + m * 16) * DM + col0;
#pragma unroll
                for (int bj = 0; bj < 2; ++bj)
#pragma unroll
                    for (int n = 0; n < 2; ++n) *(f32x4*)(out + ro + bj * HALF + n * 16) = bv[m][bj][n] + gv[bj][n] * acc[ai][bj][m][n]; }
        }
    }
};

template <class Epi>
__device__ __forceinline__ void gemm_phase(const int tidx, LAS unsigned char* lds, const Gemm g, const StaticOrder& S, const Epi& E) {
    const int tid = tidx, wid = __builtin_amdgcn_readfirstlane(tid >> 6), lane = tid & 63, wr = wid >> 2, wc = wid & 3, fr = lane & 15, fq = lane >> 4;
    const int K = g.K, nt = K / BK;
    unsigned voffA[2], voffB[2];
#pragma unroll
    for (int i = 0; i < 2; ++i) { int R, C; stage_rc(tid * 16 + i * 8192, R, C); const int Rb = Epi::PERM ? ((R & ~31) + perm32(R & 31)) : R;
        voffA[i] = (unsigned)(R * K + C) * 2u; voffB[i] = (unsigned)(Rb * K + C) * 2u; }
    const size_t kstep = (size_t)(BK * 2);
    const size_t hstep = (size_t)HALF * K * 2;
    const size_t tstep = 2 * hstep;
    const unsigned ldsw = (unsigned)wid * 1024u;
    const int aoff = lds_byte(wr * 64 + fr, fq * 8), boff = lds_byte(wc * 32 + fr, fq * 8);
#define PG8_SA(b, h) (((b) * 2 + (h)) * HTB)
#define PG8_SB(b, h) ((4 + (b) * 2 + (h)) * HTB)
#define PG8_STAGE(bufoff, gbase, voff) do { _Pragma("unroll") for (int _i = 0; _i < 2; ++_i) \
        __builtin_amdgcn_global_load_lds((const unsigned*)((const char*)(gbase) + (voff)[_i]), (LAS unsigned*)(lds + (bufoff) + ldsw + _i * 8192), 16, 0, 0); } while (0)
#define PG8_LDA(dst, b, h) do { _Pragma("unroll") for (int m = 0; m < 4; ++m) _Pragma("unroll") for (int k = 0; k < 2; ++k) dst[m][k] = *(const LAS bf16x8*)(lds + PG8_SA(b, h) + aoff + m * 2048 + k * 1024); } while (0)
#define PG8_LDB(dst, b, h) do { _Pragma("unroll") for (int n = 0; n < 2; ++n) _Pragma("unroll") for (int k = 0; k < 2; ++k) dst[n][k] = *(const LAS bf16x8*)(lds + PG8_SB(b, h) + boff + n * 2048 + k * 1024); } while (0)
#define PG8_MMA(ai, bj, At, Bt) do { __builtin_amdgcn_s_setprio(1); _Pragma("unroll") for (int m = 0; m < 4; ++m) _Pragma("unroll") for (int n = 0; n < 2; ++n) _Pragma("unroll") for (int k = 0; k < 2; ++k) \
        acc[ai][bj][m][n] = __builtin_amdgcn_mfma_f32_16x16x32_bf16(Bt[n][k], At[m][k], acc[ai][bj][m][n], 0, 0, 0); __builtin_amdgcn_s_setprio(0); } while (0)
#define PG8_WAIT_V(n) asm volatile("s_waitcnt vmcnt(" #n ")" ::: "memory")
#define PG8_WAIT_L(n) asm volatile("s_waitcnt lgkmcnt(" #n ")" ::: "memory")
#define PG8_BAR __builtin_amdgcn_s_barrier()
#define PG8_SCHED __builtin_amdgcn_sched_barrier(0)
    Unit cur, nxt; int ui = 0;
    if (!S.next(0, cur)) return;
    f32x4 acc[2][2][4][2];
#pragma unroll
    for (int a = 0; a < 2; ++a)
#pragma unroll
        for (int b = 0; b < 2; ++b)
#pragma unroll
            for (int m = 0; m < 4; ++m)
#pragma unroll
                for (int n = 0; n < 2; ++n) acc[a][b][m][n] = (f32x4){0.f, 0.f, 0.f, 0.f};
    bf16x8 At[4][2], B0[2][2], B1[2][2];
    const char* cA = (const char*)g.A + (size_t)cur.pm * tstep; const char* cB = (const char*)g.Bt + (size_t)cur.pn * tstep;
    PG8_STAGE(PG8_SB(0, 0), cB, voffB); PG8_STAGE(PG8_SA(0, 0), cA, voffA); PG8_STAGE(PG8_SB(0, 1), cB + hstep, voffB); PG8_STAGE(PG8_SA(0, 1), cA + hstep, voffA);
    if (wr == 1) PG8_BAR;
    PG8_WAIT_V(4); PG8_BAR;
    PG8_STAGE(PG8_SB(1, 0), cB + kstep, voffB); PG8_STAGE(PG8_SA(1, 0), cA + kstep, voffA); PG8_STAGE(PG8_SB(1, 1), cB + hstep + kstep, voffB);
    PG8_WAIT_V(6); PG8_BAR;
    for (;;) {
        const bool has_next = S.next(ui + 1, nxt);
        const char* nA = has_next ? (const char*)g.A + (size_t)nxt.pm * tstep : cA; const char* nB = has_next ? (const char*)g.Bt + (size_t)nxt.pn * tstep : cB;
        for (int t = 0; t < nt; t += 2) {
            const bool last = (t == nt - 2);
            const char* a1 = cA + (size_t)(t + 1) * kstep;
            const char* a2 = last ? nA : cA + (size_t)(t + 2) * kstep; const char* b2 = last ? nB : cB + (size_t)(t + 2) * kstep;
            const char* a3 = a2 + kstep; const char* b3 = b2 + kstep;
            PG8_LDB(B0, 0, 0); PG8_SCHED; PG8_LDA(At, 0, 0); PG8_STAGE(PG8_SA(1, 1), a1 + hstep, voffA);
            PG8_WAIT_L(8); PG8_BAR; PG8_WAIT_L(0); PG8_MMA(0, 0, At, B0); PG8_BAR; PG8_SCHED;
            PG8_LDB(B1, 0, 1); PG8_STAGE(PG8_SB(0, 0), b2, voffB);
            PG8_BAR; PG8_WAIT_L(0); PG8_MMA(0, 1, At, B1); PG8_BAR;
            PG8_LDA(At, 0, 1); PG8_STAGE(PG8_SA(0, 0), a2, voffA);
            PG8_BAR; PG8_WAIT_L(0); PG8_MMA(1, 0, At, B0); PG8_BAR; PG8_SCHED;
            PG8_STAGE(PG8_SB(0, 1), b2 + hstep, voffB);
            PG8_WAIT_V(6); PG8_BAR; PG8_MMA(1, 1, At, B1); PG8_BAR;
            PG8_LDB(B0, 1, 0); PG8_SCHED; PG8_LDA(At, 1, 0); PG8_STAGE(PG8_SA(0, 1), a2 + hstep, voffA);
            PG8_WAIT_L(8); PG8_BAR; PG8_WAIT_L(0); PG8_MMA(0, 0, At, B0); PG8_BAR; PG8_SCHED;
            PG8_LDB(B1, 1, 1); PG8_STAGE(PG8_SB(1, 0), b3, voffB);
            PG8_BAR; PG8_WAIT_L(0); PG8_MMA(0, 1, At, B1); PG8_BAR;
            PG8_LDA(At, 1, 1); PG8_STAGE(PG8_SA(1, 0), a3, voffA);
            PG8_BAR; PG8_WAIT_L(0); PG8_MMA(1, 0, At, B0); PG8_BAR; PG8_SCHED;
            PG8_STAGE(PG8_SB(1, 1), b3 + hstep, voffB);
            PG8_WAIT_V(6); PG8_BAR; PG8_MMA(1, 1, At, B1); PG8_BAR;
        }
        E(acc, cur, wr, wc, fr, fq);
        if (!has_next) break;
#pragma unroll
        for (int a = 0; a < 2; ++a)
#pragma unroll
            for (int b = 0; b < 2; ++b)
#pragma unroll
                for (int m = 0; m < 4; ++m)
#pragma unroll
                    for (int n = 0; n < 2; ++n) acc[a][b][m][n] = (f32x4){0.f, 0.f, 0.f, 0.f};
        cur = nxt; cA = nA; cB = nB; ++ui;
    }
    PG8_WAIT_V(0);
    if (wr == 0) PG8_BAR;
    PG8_BAR;
#undef PG8_SA
#undef PG8_SB
#undef PG8_STAGE
#undef PG8_LDA
#undef PG8_LDB
#undef PG8_MMA
#undef PG8_WAIT_V
#undef PG8_WAIT_L
#undef PG8_BAR
#undef PG8_SCHED
}
}

__device__ __forceinline__ void prep_transposes(const int tidx, const P& p, LAS unsigned char* L, int l0, int l1, int blk, int nblk);
__device__ __forceinline__ void phase_prep(const int tidx, const P& p, LAS unsigned char* L) {
    const int tid = tidx;
    constexpr int NADA = NL * 96, TPL = 3264, TOTAL = NADA + NL * TPL;
    float* mod = (float*)(p.ws + WS_MOD);
    for (int it = blockIdx.x; it < NADA; it += gridDim.x) {
        __syncthreads();
        {
            const int l = it / 96, n0 = (it % 96) * 64;
            LAS float* cact = (LAS float*)L;
            LAS float* red = cact + 4096;
            for (int i = tid; i < 4096; i += 512) cact[i] = silu_f(p.c[i]);
            __syncthreads();
            const int kg = tid >> 6, nn = tid & 63;
            const float* w = p.w_ada + ((size_t)l * DM + kg * 128) * NMOD + n0 + nn;
            float a0 = 0.f, a1 = 0.f, a2 = 0.f, a3 = 0.f;
#pragma unroll 8
            for (int k = 0; k < 128; ++k) { const float wv = w[(size_t)k * NMOD]; const int kk = kg * 128 + k;
                a0 += cact[kk] * wv; a1 += cact[1024 + kk] * wv; a2 += cact[2048 + kk] * wv; a3 += cact[3072 + kk] * wv; }
            red[(kg * 4 + 0) * 64 + nn] = a0; red[(kg * 4 + 1) * 64 + nn] = a1; red[(kg * 4 + 2) * 64 + nn] = a2; red[(kg * 4 + 3) * 64 + nn] = a3;
            __syncthreads();
            if (tid < 256) { const int b = tid >> 6; float s = p.b_ada[l * NMOD + n0 + nn];
#pragma unroll
                for (int k2 = 0; k2 < 8; ++k2) s += red[(k2 * 4 + b) * 64 + nn];
                mod[(size_t)(l * NB + b) * NMOD + n0 + nn] = s; }
        }
    }
    prep_transposes(tidx, p, L, 0, 1, blockIdx.x, gridDim.x);
}
__device__ __forceinline__ void prep_transposes(const int tidx, const P& p, LAS unsigned char* L, int l0, int l1, int blk, int nblk) {
    const int tid = tidx;
    constexpr int TPL = 3264;
    for (int it0 = l0 * TPL + blk * 4; it0 < l1 * TPL; it0 += nblk * 4) {
        __syncthreads();
        bf16_t* dstp[4]; int kd[4];
#pragma unroll
        for (int tt = 0; tt < 4; ++tt) {
            const int j = it0 + tt, l = j / TPL; int r = j % TPL;
            const float* src; bf16_t* dst; int Ns, Nvalid, Kd, k0, ns0, nd0;
            if (r < 896) { const int kt = r / 56, nt = r % 56; src = p.w_in + (size_t)l * DM * NIN; Ns = NIN; Nvalid = NIN; Kd = DM; k0 = kt * 64; nd0 = nt * 64;
                ns0 = (nd0 < 2816) ? nd0 : ((nd0 < 3072) ? 3328 + (nd0 - 2816) : 2816 + (nd0 - 3072));
                dst = (bf16_t*)(p.ws + WS_WIN) + (size_t)l * NINP * DM; }
            else if (r < 1152) { r -= 896; const int kt = r / 16, nt = r % 16; src = p.w_out + (size_t)l * DM * DM; Ns = DM; Nvalid = DM; Kd = DM; k0 = kt * 64; nd0 = nt * 64; ns0 = nd0;
                dst = (bf16_t*)(p.ws + WS_WOUT) + (size_t)l * DM * DM; }
            else if (r < 2560) { r -= 1152; const int kt = r / 88, nt = r % 88; src = p.w_ffn_in + (size_t)l * DM * NF1; Ns = NF1; Nvalid = NF1; Kd = DM; k0 = kt * 64; nd0 = nt * 64;
                const int pn = nd0 >> 8, half = (nd0 >> 7) & 1, sub = nd0 & 127; ns0 = half * DFF + pn * 128 + sub;
                dst = (bf16_t*)(p.ws + WS_WF1) + (size_t)l * NF1 * DM; }
            else { r -= 2560; const int kt = r / 16, nt = r % 16; src = p.w_ffn_out + (size_t)l * DFF * DM; Ns = DM; Nvalid = DM; Kd = DFF; k0 = kt * 64; nd0 = nt * 64; ns0 = nd0;
                dst = (bf16_t*)(p.ws + WS_WF2) + (size_t)l * DM * DFF; }
            LAS float* tile = (LAS float*)L + tt * (64 * 65);
            const int kk = tid >> 4, c4 = (tid & 15) * 4;
            f32x4 v0 = {0.f, 0.f, 0.f, 0.f}, v1 = {0.f, 0.f, 0.f, 0.f};
            if (ns0 + c4 < Nvalid) { v0 = *(const f32x4*)(src + (size_t)(k0 + kk) * Ns + ns0 + c4); v1 = *(const f32x4*)(src + (size_t)(k0 + kk + 32) * Ns + ns0 + c4); }
            tile[kk * 65 + c4 + 0] = v0[0]; tile[kk * 65 + c4 + 1] = v0[1]; tile[kk * 65 + c4 + 2] = v0[2]; tile[kk * 65 + c4 + 3] = v0[3];
            tile[(kk + 32) * 65 + c4 + 0] = v1[0]; tile[(kk + 32) * 65 + c4 + 1] = v1[1]; tile[(kk + 32) * 65 + c4 + 2] = v1[2]; tile[(kk + 32) * 65 + c4 + 3] = v1[3];
            dstp[tt] = dst + (size_t)nd0 * Kd + k0; kd[tt] = Kd;
        }
        __syncthreads();
#pragma unroll
        for (int tt = 0; tt < 4; ++tt) {
            LAS float* tile = (LAS float*)L + tt * (64 * 65);
            const int nn = tid >> 3, k8 = (tid & 7) * 8; float f[8];
#pragma unroll
            for (int i = 0; i < 8; ++i) f[i] = tile[(k8 + i) * 65 + nn];
            *(u32x4*)(dstp[tt] + (size_t)nn * kd[tt] + k8) = pack8(f);
        }
    }
}

__device__ __forceinline__ void phase_norm(const int tidx, const float* xin, const float* g, const float* modl, int shoff, int scoff, bf16_t* hout) {
    const int wave = tidx >> 6, lane = tidx & 63;
    for (int row0 = (blockIdx.x * 8 + wave) * 2; row0 < MTOK; row0 += gridDim.x * 16) {
        const int b = row0 >> 12;
        f32x4 v[2][4], gg[4], sc[4], sh[4];
#pragma unroll
        for (int rr = 0; rr < 2; ++rr)
#pragma unroll
            for (int i = 0; i < 4; ++i) v[rr][i] = *(const f32x4*)(xin + (size_t)(row0 + rr) * DM + i * 256 + lane * 4);
#pragma unroll
        for (int i = 0; i < 4; ++i) { const int k = i * 256 + lane * 4;
            gg[i] = *(const f32x4*)(g + k); sc[i] = *(const f32x4*)(modl + (size_t)b * NMOD + scoff + k); sh[i] = *(const f32x4*)(modl + (size_t)b * NMOD + shoff + k); }
#pragma unroll
        for (int rr = 0; rr < 2; ++rr) {
            float ss = 0.f;
#pragma unroll
            for (int i = 0; i < 4; ++i) ss += v[rr][i][0] * v[rr][i][0] + v[rr][i][1] * v[rr][i][1] + v[rr][i][2] * v[rr][i][2] + v[rr][i][3] * v[rr][i][3];
            ss = wave_sum(ss);
            const float rinv = rsqrtf(ss * (1.f / DM) + 1e-6f);
#pragma unroll
            for (int i = 0; i < 4; ++i) { const int k = i * 256 + lane * 4;
                const f32x4 y = v[rr][i] * rinv * gg[i] * (sc[i] + 1.f) + sh[i];
                u32x2 w; w.x = pk2(y[0], y[1]); w.y = pk2(y[2], y[3]);
                *(u32x2*)(hout + (size_t)(row0 + rr) * DM + k) = w; }
        }
    }
}
__device__ __forceinline__ void phase_final(const int tidx, float* x, const float* g) {
    const int wave = tidx >> 6, lane = tidx & 63;
    for (int row0 = (blockIdx.x * 8 + wave) * 2; row0 < MTOK; row0 += gridDim.x * 16) {
        f32x4 v[2][4], gg[4];
#pragma unroll
        for (int rr = 0; rr < 2; ++rr)
#pragma unroll
            for (int i = 0; i < 4; ++i) v[rr][i] = *(const f32x4*)(x + (size_t)(row0 + rr) * DM + i * 256 + lane * 4);
#pragma unroll
        for (int i = 0; i < 4; ++i) gg[i] = *(const f32x4*)(g + i * 256 + lane * 4);
#pragma unroll
        for (int rr = 0; rr < 2; ++rr) {
            float ss = 0.f;
#pragma unroll
            for (int i = 0; i < 4; ++i) ss += v[rr][i][0] * v[rr][i][0] + v[rr][i][1] * v[rr][i][1] + v[rr][i][2] * v[rr][i][2] + v[rr][i][3] * v[rr][i][3];
            ss = wave_sum(ss);
            const float rinv = rsqrtf(ss * (1.f / DM) + 1e-6f);
#pragma unroll
            for (int i = 0; i < 4; ++i) *(f32x4*)(x + (size_t)(row0 + rr) * DM + i * 256 + lane * 4) = v[rr][i] * rinv * gg[i];
        }
    }
}

__device__ __forceinline__ void phase_dprep(const int tidx, const P& p, int l, LAS unsigned char* L) {
    LAS bf16_t* Qn = (LAS bf16_t*)(L + 0);
    LAS bf16_t* Kn = (LAS bf16_t*)(L + 17408);
    LAS bf16_t* KbgT = (LAS bf16_t*)(L + 34816);
    LAS bf16_t* KtlT = (LAS bf16_t*)(L + 53248);
    LAS bf16_t* VbT = (LAS bf16_t*)(L + 71680);
    LAS float* Lm = (LAS float*)(L + 90112);
    LAS bf16_t* Tm = (LAS bf16_t*)(L + 107520);
    LAS bf16_t* QKm = (LAS bf16_t*)(L + 116736);
    LAS float* gcs = (LAS float*)(L + 125952);
    LAS float* betas = gcs + 64;
    LAS float* cwl = (LAS float*)(L + LDS_CW_OFF);
    LAS float* Tf = (LAS float*)(L + LDS_TF_OFF);
    const bf16_t* proj = (const bf16_t*)(p.ws + WS_PROJ);
    float* alast = (float*)(p.ws + WS_ALAST);
    u32x4 rawA[7], rawB[7]; float cwreg[4], alpha_r = 0.f, beta_r = 0.f;
#define DP_ISSUE(it_, tid_) do { const int h_ = (it_) & 3, n_ = ((it_) >> 2) & 63, t0_ = ((it_) >> 8) * SEQ + n_ * 64; \
        const int tk0_ = (((tid_) >> 4) & 15) * 4, d0_ = ((tid_) & 15) * 8; \
        _Pragma("unroll") for (int rr = 0; rr < 7; ++rr) { const int pos = n_ * 64 + tk0_ - 3 + rr; \
            rawA[rr] = (u32x4){0u, 0u, 0u, 0u}; rawB[rr] = (u32x4){0u, 0u, 0u, 0u}; \
            if (pos >= 0) { const bf16_t* pr = proj + (size_t)(t0_ + tk0_ - 3 + rr) * NINP + 1280 + h_ * 128 + d0_; \
                rawA[rr] = *(const u32x4*)(pr + ((tid_) >> 8) * 512); \
                if ((tid_) < 256) rawB[rr] = *(const u32x4*)(pr + 1024); } } \
        if ((tid_) < 384) { _Pragma("unroll") for (int j = 0; j < 4; ++j) cwreg[j] = p.dn_conv_w[(size_t)(l * 4 + j) * 1536 + ((tid_) >> 7) * 512 + h_ * 128 + ((tid_) & 127)]; } \
        if (((tid_) >> 6) == 7) { const bf16_t* pr = proj + (size_t)(t0_ + ((tid_) & 63)) * NINP; alpha_r = bf2f(pr[2816 + h_]); beta_r = bf2f(pr[2820 + h_]); } } while (0)
    if ((int)blockIdx.x < 1024) DP_ISSUE((int)blockIdx.x, tidx);
    for (int item = blockIdx.x; item < 1024; item += gridDim.x) {
        __syncthreads();
        int tid = tidx; asm volatile("" : "+v"(tid));
        const int lane = tid & 63, wave = tid >> 6, r = lane & 15, q = lane >> 4;
        const int h = item & 3, n = (item >> 2) & 63, b = item >> 8;
        const int t0 = b * SEQ + n * 64;
        unsigned char* itp = p.ws + WS_DELTA + (size_t)item * ITEM_BYTES;
        const int run = (tid >> 4) & 15, d0 = (tid & 15) * 8, tk0 = run * 4, whichA = tid >> 8;
        if (tid < 384) {
#pragma unroll
            for (int j = 0; j < 4; ++j) cwl[j * 384 + tid] = cwreg[j];
        }
        if (wave == 7) {
            const float xx = alpha_r + p.dn_dt_bias[l * 4 + h];
            const float sp = fmaxf(xx, 0.f) + log1pf(__expf(-fabsf(xx)));
            float gc = -__expf(p.dn_a_log[l * 4 + h]) * sp;
#pragma unroll
            for (int o = 1; o < 64; o <<= 1) { const float tv = __shfl_up(gc, o); if (lane >= o) gc += tv; }
            gcs[lane] = gc; betas[lane] = sigmoid_f(beta_r);
        }
        __syncthreads();
        const float gl = gcs[63];
#pragma unroll
        for (int pass = 0; pass < 2; ++pass) {
            if (pass == 1 && tid >= 256) break;
            const int which = pass ? 2 : whichA;
            const LAS float* cw = cwl + which * 128 + d0;
            float y[4][8];
#pragma unroll
            for (int i = 0; i < 4; ++i)
#pragma unroll
                for (int d = 0; d < 8; ++d) y[i][d] = 0.f;
#pragma unroll
            for (int j = 0; j < 4; ++j) {
                const f32x4 w0 = *(const LAS f32x4*)(cw + j * 384), w1 = *(const LAS f32x4*)(cw + j * 384 + 4);
#pragma unroll
                for (int i = 0; i < 4; ++i) { float rf[8]; unpack8(pass ? rawB[i + j] : rawA[i + j], rf);
#pragma unroll
                    for (int d = 0; d < 4; ++d) { y[i][d] += w0[d] * rf[d]; y[i][4 + d] += w1[d] * rf[4 + d]; } }
            }
#pragma unroll
            for (int i = 0; i < 4; ++i) {
#pragma unroll
                for (int d = 0; d < 8; ++d) y[i][d] = silu_f(y[i][d]);
                if (which < 2) {
                    float ss = 0.f;
#pragma unroll
                    for (int d = 0; d < 8; ++d) ss += y[i][d] * y[i][d];
                    ss += __shfl_xor(ss, 1); ss += __shfl_xor(ss, 2); ss += __shfl_xor(ss, 4); ss += __shfl_xor(ss, 8);
                    float rinv = rsqrtf(ss + 1e-6f);
                    if (which == 0) rinv *= 0.08838834764831845f;
#pragma unroll
                    for (int d = 0; d < 8; ++d) y[i][d] *= rinv;
                }
            }
            if (which == 0) {
#pragma unroll
                for (int i = 0; i < 4; ++i) *(LAS u32x4*)(Qn + (tk0 + i) * 136 + d0) = pack8(y[i]);
            } else if (which == 1) {
                float f1[4], f2[4];
#pragma unroll
                for (int i = 0; i < 4; ++i) { const float gc = gcs[tk0 + i]; f1[i] = betas[tk0 + i] * __expf(gc); f2[i] = __expf(gl - gc); }
#pragma unroll
                for (int i = 0; i < 4; ++i) *(LAS u32x4*)(Kn + (tk0 + i) * 136 + d0) = pack8(y[i]);
#pragma unroll
                for (int d = 0; d < 8; ++d) {
                    u32x2 a, c; a.x = pk2(y[0][d] * f1[0], y[1][d] * f1[1]); a.y = pk2(y[2][d] * f1[2], y[3][d] * f1[3]); c.x = pk2(y[0][d] * f2[0], y[1][d] * f2[1]); c.y = pk2(y[2][d] * f2[2], y[3][d] * f2[3]);
                    *(LAS u32x2*)(KbgT + (d0 + d) * 72 + tk0) = a; *(LAS u32x2*)(KtlT + (d0 + d) * 72 + tk0) = c; }
            } else {
                float bt[4];
#pragma unroll
                for (int i = 0; i < 4; ++i) bt[i] = betas[tk0 + i];
#pragma unroll
                for (int d = 0; d < 8; ++d) { u32x2 a; a.x = pk2(y[0][d] * bt[0], y[1][d] * bt[1]); a.y = pk2(y[2][d] * bt[2], y[3][d] * bt[3]);
                    *(LAS u32x2*)(VbT + (d0 + d) * 72 + tk0) = a; }
            }
        }
        if (item + (int)gridDim.x < 1024) DP_ISSUE(item + (int)gridDim.x, tid);
        __syncthreads();
        {
            const int mat = wave >> 2, cb = wave & 3;
            LAS bf16_t* Asrc = mat ? Qn : Kn;
            bf16x8 a[4];
#pragma unroll
            for (int kb = 0; kb < 4; ++kb) a[kb] = *(LAS bf16x8*)(Asrc + (16 * cb + r) * 136 + 32 * kb + 8 * q);
#pragma unroll
            for (int sb = 0; sb < 4; ++sb) {
                f32x4 acc = {0.f, 0.f, 0.f, 0.f};
                if (sb <= cb) {
#pragma unroll
                    for (int kb = 0; kb < 4; ++kb) { const bf16x8 bb = *(LAS bf16x8*)(Kn + (16 * sb + r) * 136 + 32 * kb + 8 * q); acc = MFMA16(a[kb], bb, acc); }
                }
                const int s = 16 * sb + r; const float gs = gcs[s];
#pragma unroll
                for (int j = 0; j < 4; ++j) { const int c = 16 * cb + 4 * q + j; const float dec = __expf(gcs[c] - gs);
                    if (mat == 0) Lm[c * 68 + s] = (s < c) ? acc[j] * betas[c] * dec : 0.f;
                    else QKm[c * 72 + s] = f2bf((s <= c) ? acc[j] * dec : 0.f); }
            }
        }
        __syncthreads();
        if (wave < 4) {
            const int blk = wave, c = lane & 15;
            int zoff; asm volatile("v_mov_b32 %0, 0" : "=v"(zoff));
            LAS float* Lb = Lm + (16 * blk) * 68 + 16 * blk + zoff;
            float t[16];
            f32x4 rb[2][4];
            t[0] = (c == 0) ? 1.f : 0.f;
            rb[1][0] = *(LAS f32x4*)(Lb + 1 * 68);
#pragma unroll
            for (int i = 1; i < 16; ++i) {
                if (i + 1 < 16) {
#pragma unroll
                    for (int j4 = 0; j4 < (i + 4) / 4; ++j4) rb[(i + 1) & 1][j4] = *(LAS f32x4*)(Lb + (i + 1) * 68 + 4 * j4);
                }
                __builtin_amdgcn_sched_barrier(0);
                float acc0 = (i == c) ? 1.f : 0.f, acc1 = 0.f;
#pragma unroll
                for (int j = 0; j < i; ++j) { if (j & 1) acc1 -= rb[i & 1][j >> 2][j & 3] * t[j]; else acc0 -= rb[i & 1][j >> 2][j & 3] * t[j]; }
                t[i] = acc0 + acc1;
                __builtin_amdgcn_sched_barrier(0);
            }
            if (q == 0) {
#pragma unroll
                for (int i = 0; i < 16; ++i) { Tf[(16 * blk + i) * 68 + 16 * blk + c] = t[i]; Tm[(16 * blk + i) * 72 + 16 * blk + c] = f2bf(t[i]); }
            }
            for (int cb = blk + 1; cb < 4; ++cb) {
#pragma unroll
                for (int jj = 0; jj < 4; ++jj) Tm[(16 * blk + 4 * q + jj) * 72 + 16 * cb + r] = (bf16_t)0;
            }
        } else {
            if (wave == 4 && lane == 0) alast[item] = __expf(gl);
            for (int jb = wave - 4; jb < 40; jb += 4) {
                if (jb < 16) {
                    const int tb = jb >> 2, kb = jb & 3, tok = 16 * tb + r;
                    const u32x2 lo = *(LAS u32x2*)(Qn + tok * 136 + 32 * kb + 4 * q), hi = *(LAS u32x2*)(Qn + tok * 136 + 32 * kb + 16 + 4 * q);
                    const float e = __expf(gcs[tok]);
                    u32x4 w; w.x = pk2(lo16(lo.x) * e, hi16(lo.x) * e); w.y = pk2(lo16(lo.y) * e, hi16(lo.y) * e); w.z = pk2(lo16(hi.x) * e, hi16(hi.x) * e); w.w = pk2(lo16(hi.y) * e, hi16(hi.y) * e);
                    *(u32x4*)(itp + OFF_Q + (size_t)(jb * 64 + lane) * 16) = w;
                } else if (jb < 32) {
                    const int f = jb - 16, db = f >> 1, kb = f & 1, dk = 16 * db + r;
                    const u32x2 lo = *(LAS u32x2*)(KtlT + dk * 72 + 32 * kb + 4 * q), hi = *(LAS u32x2*)(KtlT + dk * 72 + 32 * kb + 16 + 4 * q);
                    u32x4 w; w.x = lo.x; w.y = lo.y; w.z = hi.x; w.w = hi.y;
                    *(u32x4*)(itp + OFF_KT + (size_t)(f * 64 + lane) * 16) = w;
                } else {
                    const int f = jb - 32, tb = f >> 1, kb = f & 1, tok = 16 * tb + r;
                    const u32x2 lo = *(LAS u32x2*)(QKm + tok * 72 + 32 * kb + 4 * q), hi = *(LAS u32x2*)(QKm + tok * 72 + 32 * kb + 16 + 4 * q);
                    u32x4 w; w.x = lo.x; w.y = lo.y; w.z = hi.x; w.w = hi.y;
                    *(u32x4*)(itp + OFF_QK + (size_t)(f * 64 + lane) * 16) = w;
                }
            }
        }
        __syncthreads();
#pragma unroll
        for (int d = 1; d < 4; ++d) {
            if (wave < 4 - d) {
                const int bj = wave, bi = wave + d;
                f32x4 M = {0.f, 0.f, 0.f, 0.f};
#pragma unroll
                for (int kk = 0; kk < d; ++kk) { const int bk = bj + kk;
#pragma unroll
                    for (int s = 0; s < 4; ++s) M = __builtin_amdgcn_mfma_f32_16x16x4f32(Lm[(16 * bi + r) * 68 + 16 * bk + 4 * s + q], Tf[(16 * bk + 4 * s + q) * 68 + 16 * bj + r], M, 0, 0, 0);
                }
                f32x4 Tn = {0.f, 0.f, 0.f, 0.f};
#pragma unroll
                for (int s = 0; s < 4; ++s) Tn = __builtin_amdgcn_mfma_f32_16x16x4f32(Tf[(16 * bi + r) * 68 + 16 * bi + 4 * q + s], M[s], Tn, 0, 0, 0);
#pragma unroll
                for (int jj = 0; jj < 4; ++jj) { Tf[(16 * bi + 4 * q + jj) * 68 + 16 * bj + r] = -Tn[jj]; Tm[(16 * bi + 4 * q + jj) * 72 + 16 * bj + r] = f2bf(-Tn[jj]); }
            }
            __syncthreads();
        }
        {
            const int s = wave;
            bf16x8 vb[2];
#pragma unroll
            for (int kb = 0; kb < 2; ++kb) vb[kb] = *(LAS bf16x8*)(VbT + (16 * s + r) * 72 + 32 * kb + 8 * q);
#pragma unroll
            for (int tb = 0; tb < 4; ++tb) {
                f32x4 acc = {0.f, 0.f, 0.f, 0.f};
#pragma unroll
                for (int kb = 0; kb < 2; ++kb) { const bf16x8 a = *(LAS bf16x8*)(Tm + (16 * tb + r) * 72 + 32 * kb + 8 * q); acc = MFMA16(a, vb[kb], acc); }
                *(f32x4*)(itp + OFF_U + (size_t)((s * 4 + tb) * 64 + lane) * 16) = acc;
            }
            const int kbp = wave & 3, tbh = wave >> 2;
            bf16x8 ka[2][2];
#pragma unroll
            for (int d = 0; d < 2; ++d)
#pragma unroll
                for (int kb = 0; kb < 2; ++kb) ka[d][kb] = *(LAS bf16x8*)(KbgT + (16 * (2 * kbp + d) + r) * 72 + 32 * kb + 8 * q);
#pragma unroll
            for (int tt = 0; tt < 2; ++tt) {
                const int tb = 2 * tbh + tt;
                f32x4 a0 = {0.f, 0.f, 0.f, 0.f}, a1 = {0.f, 0.f, 0.f, 0.f};
#pragma unroll
                for (int kb = 0; kb < 2; ++kb) { const bf16x8 tf = *(LAS bf16x8*)(Tm + (16 * tb + r) * 72 + 32 * kb + 8 * q); a0 = MFMA16(ka[0][kb], tf, a0); a1 = MFMA16(ka[1][kb], tf, a1); }
                u32x4 w; w.x = pk2(a0[0], a0[1]); w.y = pk2(a0[2], a0[3]); w.z = pk2(a1[0], a1[1]); w.w = pk2(a1[2], a1[3]);
                *(u32x4*)(itp + OFF_W + (size_t)((tb * 4 + kbp) * 64 + lane) * 16) = w;
            }
        }
    }
}

__device__ __forceinline__ void mixer_a(const int tidx, const P& p, int l, int blk, int nblk) {
    const bf16_t* proj = (const bf16_t*)(p.ws + WS_PROJ); bf16_t* ycat = (bf16_t*)(p.ws + WS_YCAT);
    const int stride = nblk * 512;
    for (int unit0 = blk * 512 + tidx; unit0 < MTOK * 32; unit0 += 2 * stride) {
        u32x4 rc[2][3], rv[2][3], rb[2];
#pragma unroll
        for (int uu = 0; uu < 2; ++uu) { const int unit = unit0 + uu * stride; const bool ok = unit < MTOK * 32;
            const int t = unit >> 5, c0 = (unit & 31) * 8, pos = t & (SEQ - 1);
#pragma unroll
            for (int j = 0; j < 3; ++j) { rc[uu][j] = (u32x4){0u, 0u, 0u, 0u}; rv[uu][j] = (u32x4){0u, 0u, 0u, 0u};
                if (ok && pos - 2 + j >= 0) { const bf16_t* pr = proj + (size_t)(t - 2 + j) * NINP; rc[uu][j] = *(const u32x4*)(pr + 256 + c0); rv[uu][j] = *(const u32x4*)(pr + 512 + c0); } }
            rb[uu] = (u32x4){0u, 0u, 0u, 0u};
            if (ok) rb[uu] = *(const u32x4*)(proj + (size_t)t * NINP + c0); }
#pragma unroll
        for (int uu = 0; uu < 2; ++uu) { const int unit = unit0 + uu * stride;
            if (unit < MTOK * 32) { const int t = unit >> 5, c0 = (unit & 31) * 8;
                float acc[8];
#pragma unroll
                for (int i = 0; i < 8; ++i) acc[i] = 0.f;
#pragma unroll
                for (int j = 0; j < 3; ++j) { float fc[8], fv[8]; unpack8(rc[uu][j], fc); unpack8(rv[uu][j], fv);
                    const float* wp = p.conv_a_w + (size_t)(l * 3 + j) * 256 + c0;
                    const f32x4 w0 = *(const f32x4*)wp, w1 = *(const f32x4*)(wp + 4);
#pragma unroll
                    for (int i = 0; i < 4; ++i) { acc[i] += w0[i] * fc[i] * fv[i]; acc[4 + i] += w1[i] * fc[4 + i] * fv[4 + i]; } }
                float fb[8]; unpack8(rb[uu], fb);
#pragma unroll
                for (int i = 0; i < 8; ++i) acc[i] *= fb[i];
                *(u32x4*)(ycat + (size_t)t * DM + c0) = pack8(acc); } }
    }
}
__device__ __forceinline__ void mixer_b(const int tidx, const P& p, int l, int blk, int nblk, LAS unsigned char* L) {
    const bf16_t* proj = (const bf16_t*)(p.ws + WS_PROJ); bf16_t* ycat = (bf16_t*)(p.ws + WS_YCAT);
    LAS float* ut = (LAS float*)L;
    LAS float* co = (LAS float*)(L + 63488);
    const int tid = tidx, wave = tid >> 6, lane = tid & 63;
    for (int run = blk; run < MTOK / 32; run += nblk) {
        __syncthreads();
        const int t0 = run * 32, pos0 = t0 & (SEQ - 1);
        {
            u32x4 ra[4], rg[4];
#pragma unroll
            for (int it = 0; it < 4; ++it) { const int idx = tid + 512 * it, rr = idx >> 5, c0 = (idx & 31) * 8;
                ra[it] = (u32x4){0u, 0u, 0u, 0u}; rg[it] = (u32x4){0u, 0u, 0u, 0u};
                if (idx < 62 * 32 && pos0 - 30 + rr >= 0) { const bf16_t* pr = proj + (size_t)(t0 - 30 + rr) * NINP; ra[it] = *(const u32x4*)(pr + 768 + c0); rg[it] = *(const u32x4*)(pr + 1024 + c0); } }
#pragma unroll
            for (int it = 0; it < 4; ++it) { const int idx = tid + 512 * it, rr = idx >> 5, c0 = (idx & 31) * 8;
                if (idx < 62 * 32) { float fa[8], fg[8], u[8]; unpack8(ra[it], fa); unpack8(rg[it], fg);
#pragma unroll
                    for (int i = 0; i < 8; ++i) u[i] = fa[i] * sigmoid_f(fg[i]);
                    *(LAS f32x4*)(ut + rr * 256 + c0) = (f32x4){u[0], u[1], u[2], u[3]}; *(LAS f32x4*)(ut + rr * 256 + c0 + 4) = (f32x4){u[4], u[5], u[6], u[7]}; } }
        }
        __syncthreads();
        {
            const int c = tid & 255, half = tid >> 8;
            float w[31], win[46];
#pragma unroll
            for (int j = 0; j < 31; ++j) w[j] = p.conf_dw_w[(size_t)(l * 31 + j) * 256 + c];
            const float bias = p.conf_dw_b[l * 256 + c];
#pragma unroll
            for (int k = 0; k < 46; ++k) win[k] = ut[(half * 16 + k) * 256 + c];
#pragma unroll
            for (int tt = 0; tt < 16; ++tt) { float acc = bias;
#pragma unroll
                for (int j = 0; j < 31; ++j) acc += w[j] * win[tt + j];
                co[(half * 16 + tt) * 256 + c] = acc; }
        }
        __syncthreads();
#pragma unroll
        for (int i = 0; i < 4; ++i) {
            const int tl = wave * 4 + i;
            const f32x4 v = *(LAS f32x4*)(co + tl * 256 + lane * 4);
            const float mean = wave_sum(v[0] + v[1] + v[2] + v[3]) * (1.f / 256.f);
            const f32x4 d = v - mean;
            const float var = wave_sum(d[0] * d[0] + d[1] * d[1] + d[2] * d[2] + d[3] * d[3]) * (1.f / 256.f);
            const float rs = rsqrtf(var + 1e-5f);
            const f32x4 gg = *(const f32x4*)(p.conf_ln_g + l * 256 + lane * 4), bb = *(const f32x4*)(p.conf_ln_b + l * 256 + lane * 4);
            const f32x4 y = d * rs * gg + bb;
            u32x2 wv; wv.x = pk2(silu_f(y[0]), silu_f(y[1])); wv.y = pk2(silu_f(y[2]), silu_f(y[3]));
            *(u32x2*)(ycat + (size_t)(t0 + tl) * DM + 256 + lane * 4) = wv;
        }
    }
}

constexpr int SCAN_BLOCKS = 128, SCAN_BUF = 64512;
__device__ __forceinline__ void phase_scan(const int tidx, const P& p, int l, LAS unsigned char* L) {
    const int tid = tidx, lane = tid & 63, wave = tid >> 6, r = lane & 15, q = lane >> 4;
    if ((int)blockIdx.x >= SCAN_BLOCKS) {
        const int blk = blockIdx.x - SCAN_BLOCKS, nblk = gridDim.x - SCAN_BLOCKS;
        mixer_a(tidx, p, l, blk, nblk);
        mixer_b(tidx, p, l, blk, nblk, L);
        __syncthreads();
        {
            pg8::Gemm g{(const bf16_t*)(p.ws + WS_H), (const bf16_t*)(p.ws + WS_WIN) + ((size_t)l * NINP + 3072) * DM, MTOK, 512, DM}; pg8::StaticOrder S; S.init(MTOK, 512, nblk, blk);
            pg8::EpiProj E{(bf16_t*)(p.ws + WS_PROJ) + 3072, NINP}; pg8::gemm_phase<pg8::EpiProj>(tidx, L, g, S, E);
        }
        if (l + 1 < NL && ((MTOK / 256) * (NF1 / 256)) % (int)gridDim.x == 0) prep_transposes(tidx, p, L, l + 1, l + 2, blk, nblk);
        return;
    }
    const int item = blockIdx.x, xcd = item & 7, jj = item >> 3, s = jj & 7, bh = xcd * 2 + (jj >> 3), b = bh >> 2, h = bh & 3;
    const unsigned char* dl = p.ws + WS_DELTA;
    const float* alast = (const float*)(p.ws + WS_ALAST);
    bf16_t* obuf = (bf16_t*)(p.ws + WS_YCAT);
#define SB_ __builtin_amdgcn_sched_barrier(0)
#define SCAN_COMPUTE(buf, n_) do { \
            const float al = __builtin_bit_cast(float, __builtin_amdgcn_readlane(__builtin_bit_cast(int, al_all), (n_))); \
            const LAS bf16x8* Wf = (const LAS bf16x8*)((buf) + OFF_W) + lane; const LAS bf16x8* Qf = (const LAS bf16x8*)((buf) + OFF_Q) + lane; \
            const LAS bf16x8* Kf = (const LAS bf16x8*)((buf) + OFF_KT) + lane; const LAS bf16x8* QKf = (const LAS bf16x8*)((buf) + OFF_QK) + lane; \
            const LAS f32x4* Uf = (const LAS f32x4*)((buf) + OFF_U) + lane; \
            bf16x8 g0[8], g1[8]; f32x4 Uv[4]; \
            _Pragma("unroll") for (int f = 0; f < 8; ++f) g0[f] = Wf[((f >> 1) * 4 + (f & 1)) * 64];                \
            _Pragma("unroll") for (int f = 0; f < 8; ++f) g1[f] = Wf[((f >> 1) * 4 + 2 + (f & 1)) * 64];            \
            bf16x8 Sb[4]; \
            _Pragma("unroll") for (int kb = 0; kb < 4; ++kb) { u32x4 w; w.x = pk2(S[2 * kb][0], S[2 * kb][1]); w.y = pk2(S[2 * kb][2], S[2 * kb][3]); w.z = pk2(S[2 * kb + 1][0], S[2 * kb + 1][1]); w.w = pk2(S[2 * kb + 1][2], S[2 * kb + 1][3]); \
                Sb[kb] = __builtin_bit_cast(bf16x8, w); } \
            f32x4 Pv[4], O[4]; \
            _Pragma("unroll") for (int tb = 0; tb < 4; ++tb) { Pv[tb] = (f32x4){0.f, 0.f, 0.f, 0.f}; O[tb] = (f32x4){0.f, 0.f, 0.f, 0.f}; } \
            SB_; \
            _Pragma("unroll") for (int f = 0; f < 8; ++f) Pv[f >> 1] = MFMA16(g0[f], Sb[f & 1], Pv[f >> 1]); \
            _Pragma("unroll") for (int f = 0; f < 8; ++f) g0[f] = Qf[((f >> 1) * 4 + (f & 1)) * 64]; \
            SB_; \
            _Pragma("unroll") for (int f = 0; f < 8; ++f) Pv[f >> 1] = MFMA16(g1[f], Sb[2 + (f & 1)], Pv[f >> 1]); \
            _Pragma("unroll") for (int f = 0; f < 8; ++f) g1[f] = Qf[((f >> 1) * 4 + 2 + (f & 1)) * 64]; \
            _Pragma("unroll") for (int tb = 0; tb < 4; ++tb) Uv[tb] = Uf[tb * 64]; \
            SB_; \
            _Pragma("unroll") for (int f = 0; f < 8; ++f) O[f >> 1] = MFMA16(g0[f], Sb[f & 1], O[f >> 1]); \
            _Pragma("unroll") for (int f = 0; f < 8; ++f) g0[f] = Kf[(f * 2) * 64];                                  \
            SB_; \
            _Pragma("unroll") for (int f = 0; f < 8; ++f) O[f >> 1] = MFMA16(g1[f], Sb[2 + (f & 1)], O[f >> 1]); \
            _Pragma("unroll") for (int f = 0; f < 8; ++f) g1[f] = Kf[(f * 2 + 1) * 64];                              \
            _Pragma("unroll") for (int tb = 0; tb < 4; ++tb) Pv[tb] = Uv[tb] - Pv[tb]; \
            bf16x8 Vb[2]; \
            _Pragma("unroll") for (int kb = 0; kb < 2; ++kb) { u32x4 w; w.x = pk2(Pv[2 * kb][0], Pv[2 * kb][1]); w.y = pk2(Pv[2 * kb][2], Pv[2 * kb][3]); w.z = pk2(Pv[2 * kb + 1][0], Pv[2 * kb + 1][1]); w.w = pk2(Pv[2 * kb + 1][2], Pv[2 * kb + 1][3]); \
                Vb[kb] = __builtin_bit_cast(bf16x8, w); } \
            _Pragma("unroll") for (int db = 0; db < 8; ++db) S[db] = S[db] * al; \
            SB_; \
            _Pragma("unroll") for (int f = 0; f < 8; ++f) S[f] = MFMA16(g0[f], Vb[0], S[f]); \
            _Pragma("unroll") for (int f = 0; f < 8; ++f) if (f != 1 && f != 3) g0[f] = QKf[f * 64];                  \
            SB_; \
            _Pragma("unroll") for (int f = 0; f < 8; ++f) S[f] = MFMA16(g1[f], Vb[1], S[f]); \
            SB_; \
            _Pragma("unroll") for (int f = 0; f < 8; ++f) if (f != 1 && f != 3) O[f >> 1] = MFMA16(g0[f], Vb[f & 1], O[f >> 1]); \
            bf16_t* op = obuf + (size_t)(b * SEQ + (n_) * 64 + 4 * q) * DM + 512 + h * 128 + 16 * s + r; \
            _Pragma("unroll") for (int tb = 0; tb < 4; ++tb) \
                _Pragma("unroll") for (int j = 0; j < 4; ++j) op[(size_t)(16 * tb + j) * DM] = f2bf(O[tb][j]); \
        } while (0)
#define SCAN_BAR() do { asm volatile("s_waitcnt lgkmcnt(0)" ::: "memory"); __builtin_amdgcn_s_barrier(); asm volatile("" ::: "memory"); } while (0)
    LAS unsigned char* buf0 = L; LAS unsigned char* buf1 = L + SCAN_BUF;
    if (wave == 0) {
        const float al_all = alast[(b * 64 + lane) * 4 + h];
        f32x4 S[8];
#pragma unroll
        for (int i = 0; i < 8; ++i) S[i] = (f32x4){0.f, 0.f, 0.f, 0.f};
        SCAN_BAR();
        __builtin_amdgcn_s_setprio(3);
#pragma unroll 1
        for (int n = 0; n < 64; n += 2) {
            SCAN_COMPUTE(buf0, n);
            SCAN_BAR();
            SCAN_COMPUTE(buf1, n + 1);
            SCAN_BAR();
        }
        __builtin_amdgcn_s_setprio(0);
    } else {
        const int ct = tid - 64;
        const int off8 = (ct < 256) ? (OFF_U + s * 4096 + ct * 16) : ((ct - 256) * 16);
        const unsigned char* dlb = dl + (size_t)((b * 64) * 4 + h) * ITEM_BYTES;
        u32x4 R0[9], R1[9], R2[9], R3[9];
#define SCAN_LOAD(regs, n_) do { const int nn_ = ((n_) < 64) ? (n_) : 63; const unsigned char* itp_ = dlb + (size_t)nn_ * (4 * ITEM_BYTES); \
        _Pragma("unroll") for (int i_ = 0; i_ < 8; ++i_) regs[i_] = *(const u32x4*)(itp_ + (ct + 448 * i_) * 16); \
        regs[8] = *(const u32x4*)(itp_ + off8); __builtin_amdgcn_sched_barrier(0); } while (0)
#define SCAN_STORE(regs, buf_) do { _Pragma("unroll") for (int i_ = 0; i_ < 9; ++i_) *(LAS u32x4*)((buf_) + (ct + 448 * i_) * 16) = regs[i_]; } while (0)
        SCAN_LOAD(R0, 0); SCAN_LOAD(R1, 1); SCAN_LOAD(R2, 2); SCAN_LOAD(R3, 3);
        SCAN_STORE(R0, buf0);
        SCAN_BAR();
#pragma unroll 1
        for (int n = 0; n < 64; n += 4) {
            SCAN_LOAD(R0, n + 4); SCAN_STORE(R1, buf1); SCAN_BAR();
            SCAN_LOAD(R1, n + 5); SCAN_STORE(R2, buf0); SCAN_BAR();
            SCAN_LOAD(R2, n + 6); SCAN_STORE(R3, buf1); SCAN_BAR();
            SCAN_LOAD(R3, n + 7); SCAN_STORE(R0, buf0); SCAN_BAR();
        }
    }
#undef SCAN_COMPUTE
#undef SB_
#undef SCAN_BAR
#undef SCAN_LOAD
#undef SCAN_STORE
}

__device__ __forceinline__ void phase_onorm(const int tidx, const P& p, int l) {
    const bf16_t* proj = (const bf16_t*)(p.ws + WS_PROJ); bf16_t* ycat = (bf16_t*)(p.ws + WS_YCAT);
    const int sub = tidx & 15, d0 = sub * 8;
    const f32x4 g0 = *(const f32x4*)(p.dn_norm_g + l * 128 + d0), g1 = *(const f32x4*)(p.dn_norm_g + l * 128 + d0 + 4);
    for (int unit0 = (blockIdx.x * 32 + (tidx >> 4)) * 2; unit0 < MTOK * 4; unit0 += gridDim.x * 64) {
        u32x4 orw[2], zr[2];
#pragma unroll
        for (int uu = 0; uu < 2; ++uu) { const int t = (unit0 + uu) >> 2, h = (unit0 + uu) & 3;
            orw[uu] = *(const u32x4*)(ycat + (size_t)t * DM + 512 + h * 128 + d0);
            zr[uu] = *(const u32x4*)(proj + (size_t)t * NINP + 3072 + h * 128 + d0); }
#pragma unroll
        for (int uu = 0; uu < 2; ++uu) { const int t = (unit0 + uu) >> 2, h = (unit0 + uu) & 3;
            float o[8]; unpack8(orw[uu], o);
            float ss = 0.f;
#pragma unroll
            for (int i = 0; i < 8; ++i) ss += o[i] * o[i];
            ss += __shfl_xor(ss, 1); ss += __shfl_xor(ss, 2); ss += __shfl_xor(ss, 4); ss += __shfl_xor(ss, 8);
            const float rinv = rsqrtf(ss * (1.f / 128.f) + 1e-6f);
            float z[8]; unpack8(zr[uu], z);
            float y[8];
#pragma unroll
            for (int i = 0; i < 4; ++i) { y[i] = o[i] * rinv * g0[i] * silu_f(z[i]); y[4 + i] = o[4 + i] * rinv * g1[i] * silu_f(z[4 + i]); }
            *(u32x4*)(ycat + (size_t)t * DM + 512 + h * 128 + d0) = pack8(y); }
    }
}

#define XB_TMO      128
#define XB_XCNT(j)  (256  + 64 * (j))
#define XB_XSUB(j)  (1280 + 64 * (j))
#define XB_XGEN(j)  (2304 + 64 * (j))
#define XB_TOP      3328
#define XB_TOPGEN   3392
#define XCD_BAR_WORDS 3456
#define XB_SPIN_CAP (1u << 22)
__device__ __forceinline__ unsigned xb_ld(unsigned* p)              { return __hip_atomic_load(p, __ATOMIC_RELAXED, __HIP_MEMORY_SCOPE_AGENT); }
__device__ __forceinline__ unsigned xb_add(unsigned* p, unsigned v) { return __hip_atomic_fetch_add(p, v, __ATOMIC_RELAXED, __HIP_MEMORY_SCOPE_AGENT); }
__device__ __forceinline__ unsigned xb_xcc_id() { return (unsigned)__builtin_amdgcn_s_getreg((3 << 11) | 20) & 0xFu; }
#define XB_SPIN(cond, bar) do { unsigned _sp = 0; while (cond) { __builtin_amdgcn_s_sleep(1); \
    if ((++_sp & 255u) == 0u) { if (xb_ld(&(bar)[XB_TMO])) break; if (_sp > XB_SPIN_CAP) { atomicAdd(&(bar)[XB_TMO], 1u); break; } } } } while (0)
struct XcdBarrier { unsigned* bar; unsigned x; volatile LAS unsigned* st; };
__device__ __forceinline__ XcdBarrier xcd_barrier_post(unsigned* bar, volatile LAS unsigned* st) {
    XcdBarrier b; b.bar = bar; b.x = xb_xcc_id(); b.st = st;
    if (threadIdx.x == 0) (void)xb_add(&bar[XB_XCNT(b.x)], 1u);
    return b;
}
__device__ __forceinline__ void xcd_barrier_complete(unsigned* bar, unsigned x, unsigned& nloc, unsigned& nx) {
    const unsigned G = gridDim.x * gridDim.y * gridDim.z;
    unsigned sum, cnt, mine, sp = 0u;
    for (;;) {
        sum = 0u; cnt = 0u; mine = 0u;
#pragma unroll
        for (unsigned j = 0; j < 16; ++j) { const unsigned c = xb_ld(&bar[XB_XCNT(j)]); sum += c; cnt += (c > 0u) ? 1u : 0u; mine = (j == x) ? c : mine; }
        if (sum == G) break;
        __builtin_amdgcn_s_sleep(1);
        if ((++sp & 255u) == 0u) { if (xb_ld(&bar[XB_TMO])) break; if (sp > XB_SPIN_CAP) { atomicAdd(&bar[XB_TMO], 1u); break; } }
    }
    nloc = mine > 0u ? mine : 1u; nx = cnt > 0u ? cnt : 1u;
}
__device__ __forceinline__ void xcd_barrier(const XcdBarrier& b) {
    asm volatile("s_waitcnt vmcnt(0)" ::: "memory");
    __syncthreads();
    if (threadIdx.x == 0) {
        unsigned* bar = b.bar;
        __builtin_amdgcn_s_waitcnt(0);
        unsigned nloc = b.st[0], nx = b.st[1];
        if (nloc == 0u) { xcd_barrier_complete(bar, b.x, nloc, nx); b.st[0] = nloc; b.st[1] = nx; }
        const unsigned old = xb_add(&bar[XB_XSUB(b.x)], 1u);
        const unsigned gen = old / nloc;
        if (old + 1u == (gen + 1u) * nloc) {
            __builtin_amdgcn_fence(__ATOMIC_RELEASE, "agent");
            asm volatile("s_waitcnt vmcnt(0)" ::: "memory");
            const unsigned og = xb_add(&bar[XB_TOP], 1u);
            const unsigned tg = og / nx;
            if (og + 1u == (tg + 1u) * nx) xb_add(&bar[XB_TOPGEN], 1u);
            else XB_SPIN(xb_ld(&bar[XB_TOPGEN]) == tg, bar);
            __builtin_amdgcn_fence(__ATOMIC_ACQUIRE, "agent");
            xb_add(&bar[XB_XGEN(b.x)], 1u);
            asm volatile("s_waitcnt vmcnt(0)" ::: "memory");
        } else {
            XB_SPIN(xb_ld(&bar[XB_XGEN(b.x)]) == gen, bar);
            __builtin_amdgcn_fence(__ATOMIC_ACQUIRE, "agent");
            asm volatile("s_waitcnt vmcnt(0)" ::: "memory");
        }
    }
    __syncthreads();
}

template <int KIND>
__device__ __forceinline__ void run_kind(const int tidx, const P& p, int l, LAS unsigned char* L) {
    const float* modl = (const float*)(p.ws + WS_MOD) + (size_t)l * NB * NMOD;
    bf16_t* hbuf = (bf16_t*)(p.ws + WS_H); bf16_t* ycat = (bf16_t*)(p.ws + WS_YCAT); bf16_t* proj = (bf16_t*)(p.ws + WS_PROJ);
    const float* xin = (l == 0) ? p.x : p.out;
    if constexpr (KIND == 0) phase_prep(tidx, p, L);
    if constexpr (KIND == 1) phase_norm(tidx, xin, p.norm_mix_g + l * DM, modl, 0, DM, hbuf);
    if constexpr (KIND == 2) { pg8::Gemm g{hbuf, (const bf16_t*)(p.ws + WS_WIN) + (size_t)l * NINP * DM, MTOK, 3072, DM}; pg8::StaticOrder S; S.init(MTOK, 3072, gridDim.x, blockIdx.x);
        pg8::EpiProj E{proj, NINP}; pg8::gemm_phase<pg8::EpiProj>(tidx, L, g, S, E); }
    if constexpr (KIND == 3) phase_dprep(tidx, p, l, L);
    if constexpr (KIND == 4) phase_scan(tidx, p, l, L);
    if constexpr (KIND == 5) phase_onorm(tidx, p, l);
    if constexpr (KIND == 6) { pg8::Gemm g{ycat, (const bf16_t*)(p.ws + WS_WOUT) + (size_t)l * DM * DM, MTOK, DM, DM}; pg8::StaticOrder S; S.init(MTOK, DM, gridDim.x, blockIdx.x);
        pg8::EpiResid E{xin, p.out, modl + 2 * DM}; pg8::gemm_phase<pg8::EpiResid>(tidx, L, g, S, E); }
    if constexpr (KIND == 7) phase_norm(tidx, p.out, p.norm_ffn_g + l * DM, modl, 3 * DM, 4 * DM, hbuf);
    if constexpr (KIND == 8) { pg8::Gemm g{hbuf, (const bf16_t*)(p.ws + WS_WF1) + (size_t)l * NF1 * DM, MTOK, NF1, DM}; pg8::StaticOrder S; S.init(MTOK, NF1, gridDim.x, blockIdx.x);
        pg8::EpiSwiGLU E{proj}; pg8::gemm_phase<pg8::EpiSwiGLU>(tidx, L, g, S, E);
        const int rem = S.nwg % (int)gridDim.x;
        if (l + 1 < NL && rem != 0 && (int)blockIdx.x >= rem) prep_transposes(tidx, p, L, l + 1, l + 2, (int)blockIdx.x - rem, (int)gridDim.x - rem); }
    if constexpr (KIND == 9) { pg8::Gemm g{proj, (const bf16_t*)(p.ws + WS_WF2) + (size_t)l * DM * DFF, MTOK, DM, DFF}; pg8::StaticOrder S; S.init(MTOK, DM, gridDim.x, blockIdx.x);
        pg8::EpiResid E{p.out, p.out, modl + 5 * DM}; pg8::gemm_phase<pg8::EpiResid>(tidx, L, g, S, E); }
    if constexpr (KIND == 10) phase_final(tidx, p.out, p.final_norm_g);
}
__host__ __device__ inline void phase_decode(int ph, int& kind, int& l) {
    if (ph == 0) { kind = 0; l = 0; } else if (ph == NPH - 1) { kind = 10; l = 0; } else { l = (ph - 1) / 9; kind = 1 + (ph - 1) % 9; }
}

#if ONE_LAUNCH
__global__ void __launch_bounds__(512, 2) hymba_fwd(P p) {
    extern __shared__ __attribute__((aligned(16))) unsigned char lds_raw[];
    LAS unsigned char* L = (LAS unsigned char*)lds_raw;
    cg::grid_group grid = cg::this_grid();
    if (threadIdx.x < 16) ((LAS unsigned*)(L + LDS_BAR_OFF))[threadIdx.x] = 0u;
    __syncthreads();
    const XcdBarrier bar = xcd_barrier_post((unsigned*)(p.ws + WS_BAR), (volatile LAS unsigned*)(L + LDS_BAR_OFF));
    for (int ph = p.ph_lo; ph < p.ph_hi; ++ph) {
        if (p.ph_hi > NPH) grid.sync();
        if (ph > p.ph_lo) xcd_barrier(bar);
        int kind, l; phase_decode(ph, kind, l);
        int tidx = threadIdx.x; asm volatile("" : "+v"(tidx));
#if REPEAT_MASK
        if ((REPEAT_MASK >> kind) & 1) {
            switch (kind) { case 1: run_kind<1>(tidx, p, l, L); break; case 2: run_kind<2>(tidx, p, l, L); break; case 3: run_kind<3>(tidx, p, l, L); break; case 4: run_kind<4>(tidx, p, l, L); break;
                case 5: run_kind<5>(tidx, p, l, L); break; case 7: run_kind<7>(tidx, p, l, L); break; case 8: run_kind<8>(tidx, p, l, L); break; default: break; }
            __syncthreads();
        }
#endif
        switch (kind) {
        case 0: run_kind<0>(tidx, p, l, L); break; case 1: run_kind<1>(tidx, p, l, L); break; case 2: run_kind<2>(tidx, p, l, L); break; case 3: run_kind<3>(tidx, p, l, L); break;
        case 4: run_kind<4>(tidx, p, l, L); break; case 5: run_kind<5>(tidx, p, l, L); break; case 6: run_kind<6>(tidx, p, l, L); break; case 7: run_kind<7>(tidx, p, l, L); break;
        case 8: run_kind<8>(tidx, p, l, L); break; case 9: run_kind<9>(tidx, p, l, L); break; default: run_kind<10>(tidx, p, l, L); break;
        }
    }
}
#define LAUNCH_FN(kind) ((const void*)hymba_fwd)
#else
template <int KIND> __global__ void __launch_bounds__(512, 2) hymba_ph(P p) {
    extern __shared__ __attribute__((aligned(16))) unsigned char lds_raw[];
    run_kind<KIND>((int)threadIdx.x, p, p.ph_hi, (LAS unsigned char*)lds_raw);
}
static const void* ph_fn(int kind) {
    switch (kind) { case 0: return (const void*)hymba_ph<0>; case 1: return (const void*)hymba_ph<1>; case 2: return (const void*)hymba_ph<2>; case 3: return (const void*)hymba_ph<3>;
        case 4: return (const void*)hymba_ph<4>; case 5: return (const void*)hymba_ph<5>; case 6: return (const void*)hymba_ph<6>; case 7: return (const void*)hymba_ph<7>;
        case 8: return (const void*)hymba_ph<8>; case 9: return (const void*)hymba_ph<9>; default: return (const void*)hymba_ph<10>; }
}
#define LAUNCH_FN(kind) ph_fn(kind)
#endif

extern "C" void kernel_launch(void* const* d_in, const int* in_sizes, int n_in, void* d_out, int out_size, void* d_ws, size_t ws_size, hipStream_t stream) {
    static int grid = 0;
    if (grid == 0) {
        if (n_in != 20 || out_size != MTOK * DM || ws_size < WS_END) { fprintf(stderr, "kernel_launch: unexpected problem (n_in %d out %d ws %zu need %zu)\n", n_in, out_size, ws_size, (size_t)WS_END); grid = -1; return; }
        int dev = 0, cus = 0, per_cu = 0;
        (void)hipGetDevice(&dev); (void)hipDeviceGetAttribute(&cus, hipDeviceAttributeMultiprocessorCount, dev);
        for (int k = 0; k <= 10; ++k)
            if (hipFuncSetAttribute(LAUNCH_FN(k), hipFuncAttributeMaxDynamicSharedMemorySize, LDS_BYTES) != hipSuccess) { fprintf(stderr, "kernel_launch: hipFuncSetAttribute failed\n"); grid = -1; return; }
#if ONE_LAUNCH
        if (hipOccupancyMaxActiveBlocksPerMultiprocessor(&per_cu, (const void*)hymba_fwd, 512, LDS_BYTES) != hipSuccess || per_cu < 1) { fprintf(stderr, "kernel_launch: occupancy query failed (%d)\n", per_cu); (void)hipGetLastError(); per_cu = 1; }
#else
        per_cu = 1;
#endif
        grid = cus * per_cu;
        if (grid < SCAN_BLOCKS + 32) { fprintf(stderr, "kernel_launch: grid %d too small\n", grid); grid = -1; return; }
    }
    if (grid < 0) return;
    P p{};
    const float** pp = (const float**)&p;
    for (int i = 0; i < 20; ++i) pp[i] = (const float*)d_in[i];
    p.out = (float*)d_out; p.ws = (unsigned char*)d_ws;
#if ONE_LAUNCH
    p.ph_lo = 0; p.ph_hi = NPH;
    if (hipMemsetAsync((unsigned char*)d_ws + WS_BAR, 0, 16384, stream) != hipSuccess) { fprintf(stderr, "kernel_launch: memset of the barrier words failed\n"); return; }
    void* args[] = {&p};
    hipError_t e = hipLaunchCooperativeKernel((const void*)hymba_fwd, dim3(grid), dim3(512), args, LDS_BYTES, stream);
    if (e != hipSuccess) fprintf(stderr, "cooperative launch failed: %s (grid %d)\n", hipGetErrorString(e), grid);
#else
    for (int ph = 0; ph < NPH; ++ph) { int kind, l; phase_decode(ph, kind, l); p.ph_lo = kind; p.ph_hi = l; void* args[] = {&p};
        (void)hipLaunchKernel(ph_fn(kind), dim3(grid), dim3(512), args, LDS_BYTES, stream); }
#endif
}
```

```cpp
#include <hip/hip_runtime.h>
#include <hip/hip_cooperative_groups.h>
#include <cstdio>
namespace cg = cooperative_groups;

#ifndef ONE_LAUNCH
#define ONE_LAUNCH 1
#endif
#ifndef REPEAT_MASK
#define REPEAT_MASK 0
#endif

#define LAS __attribute__((address_space(3)))
typedef unsigned short bf16_t;
typedef short bf16x8 __attribute__((ext_vector_type(8)));
typedef float f32x4 __attribute__((ext_vector_type(4)));
typedef float f32x2 __attribute__((ext_vector_type(2)));
typedef unsigned u32x4 __attribute__((ext_vector_type(4)));
typedef unsigned u32x2 __attribute__((ext_vector_type(2)));
typedef __bf16 nbf16x2 __attribute__((ext_vector_type(2)));

constexpr int MTOK = 16384, DM = 1024, NL = 4, NB = 4, SEQ = 4096;
constexpr int NIN = 3336, NINP = 3584, DFF = 2816, NF1 = 2 * DFF, NMOD = 6 * DM;
constexpr int LDS_BYTES = 131072 + 64 + 6144 + 17408, LDS_BAR_OFF = 131072, LDS_CW_OFF = 131072 + 64, LDS_TF_OFF = LDS_CW_OFF + 6144;
constexpr int NPH = 1 + 9 * NL + 1;

constexpr size_t SZ_WIN = (size_t)NL * NINP * DM * 2, SZ_WOUT = (size_t)NL * DM * DM * 2, SZ_WF1 = (size_t)NL * NF1 * DM * 2, SZ_WF2 = (size_t)NL * DM * DFF * 2;
constexpr size_t WS_WIN = 0, WS_WOUT = WS_WIN + SZ_WIN, WS_WF1 = WS_WOUT + SZ_WOUT, WS_WF2 = WS_WF1 + SZ_WF1;
constexpr size_t WS_MOD = WS_WF2 + SZ_WF2;
constexpr size_t WS_ALAST = WS_MOD + (size_t)NL * NB * NMOD * 4;
constexpr size_t WS_H = WS_ALAST + 4096;
constexpr size_t WS_YCAT = WS_H + (size_t)MTOK * DM * 2;
constexpr size_t WS_PROJ = WS_YCAT + (size_t)MTOK * DM * 2;
constexpr int ITEM_BYTES = 90112, OFF_W = 0, OFF_Q = 16384, OFF_KT = 32768, OFF_QK = 49152, OFF_U = 57344;
constexpr size_t WS_DELTA = WS_PROJ + (size_t)MTOK * NINP * 2;
constexpr size_t WS_BAR = WS_DELTA + (size_t)1024 * ITEM_BYTES;
constexpr size_t WS_END = WS_BAR + 16384;

struct P {
    const float *x, *c, *w_ada, *b_ada, *norm_mix_g, *norm_ffn_g, *w_in, *conv_a_w, *conf_dw_w, *conf_dw_b, *conf_ln_g, *conf_ln_b,
        *dn_conv_w, *dn_a_log, *dn_dt_bias, *dn_norm_g, *w_out, *w_ffn_in, *w_ffn_out, *final_norm_g;
    float* out; unsigned char* ws; int ph_lo, ph_hi;
};

__device__ __forceinline__ float bf2f(bf16_t v) { return __uint_as_float(((unsigned)v) << 16); }
__device__ __forceinline__ unsigned pk2(float a, float b) { f32x2 v = {a, b}; nbf16x2 r = __builtin_convertvector(v, nbf16x2); return __builtin_bit_cast(unsigned, r); }
__device__ __forceinline__ bf16_t f2bf(float a) { return (bf16_t)(pk2(a, 0.f) & 0xffffu); }
__device__ __forceinline__ float lo16(unsigned w) { return __uint_as_float(w << 16); }
__device__ __forceinline__ float hi16(unsigned w) { return __uint_as_float(w & 0xffff0000u); }
__device__ __forceinline__ float sigmoid_f(float v) { return __builtin_amdgcn_rcpf(1.f + __expf(-v)); }
__device__ __forceinline__ float silu_f(float v) { return v * sigmoid_f(v); }
__device__ __forceinline__ float wave_sum(float v) {
#pragma unroll
    for (int o = 32; o; o >>= 1) v += __shfl_xor(v, o);
    return v;
}
__device__ __forceinline__ void unpack8(const u32x4 w, float (&f)[8]) {
    f[0] = lo16(w.x); f[1] = hi16(w.x); f[2] = lo16(w.y); f[3] = hi16(w.y); f[4] = lo16(w.z); f[5] = hi16(w.z); f[6] = lo16(w.w); f[7] = hi16(w.w);
}
__device__ __forceinline__ u32x4 pack8(const float (&f)[8]) { u32x4 w; w.x = pk2(f[0], f[1]); w.y = pk2(f[2], f[3]); w.z = pk2(f[4], f[5]); w.w = pk2(f[6], f[7]); return w; }
#define MFMA16(a, b, c) __builtin_amdgcn_mfma_f32_16x16x32_bf16((a), (b), (c), 0, 0, 0)

namespace pg8 {
constexpr int BM = 256, BK = 64, HALF = 128, HTB = HALF * BK * 2, STAGE_BYTES = 8 * HTB, NXCD = 8, WGM = 8;
__host__ __device__ __forceinline__ int lds_byte(int r, int c) { const int st = (r >> 4) * 2 + (c >> 5), rr = r & 15, cc = c & 31, ob = rr * 64 + cc * 2; return st * 1024 + (ob ^ (((ob >> 9) & 1) << 5)); }
__host__ __device__ __forceinline__ void stage_rc(int b, int& R, int& C) { const int st = b / 1024, sb = b % 1024, swz = sb ^ (((sb >> 9) & 1) << 5); R = (st >> 1) * 16 + swz / 64; C = (st & 1) * 32 + (swz % 64) / 2; }
__host__ __device__ __forceinline__ int perm32(int rho) { const int n = rho >> 4, i = rho & 15; return 8 * (i >> 2) + 4 * n + (i & 3); }
struct Unit { int pm, pn; };
struct Gemm { const bf16_t* A; const bf16_t* Bt; int M, N, K; };
struct StaticOrder {
    int nM, nN, nwg, G, c;
    __device__ void init(int M, int N, int G_, int c_) { nM = M / BM; nN = N / BM; nwg = nM * nN; G = G_; c = c_; }
    __device__ bool next(int i, Unit& u) const {
        const long L = (long)i * G + c; if (L >= nwg) return false;
        int wgid = (int)L; { const int q = nwg / NXCD, r = nwg % NXCD, xcd = wgid % NXCD, off = wgid / NXCD; wgid = (xcd < r ? xcd * (q + 1) : r * (q + 1) + (xcd - r) * q) + off; }
        const int nig = WGM * nN, gid = wgid / nig, fm = gid * WGM, gsz = (nM - fm) < WGM ? (nM - fm) : WGM;
        u.pm = fm + ((wgid % nig) % gsz); u.pn = (wgid % nig) / gsz; return true;
    }
};

struct EpiProj {
    static constexpr bool PERM = true;
    bf16_t* O; int ldc;
    __device__ __forceinline__ void operator()(const f32x4 (&acc)[2][2][4][2], const Unit& u, int wr, int wc, int fr, int fq) const {
        const int row0 = u.pm * BM + wr * 64 + fr, col0 = u.pn * BM + wc * 32 + 8 * fq;
#pragma unroll
        for (int ai = 0; ai < 2; ++ai)
#pragma unroll
            for (int m = 0; m < 4; ++m) { bf16_t* rowp = O + (size_t)(row0 + ai * HALF + m * 16) * ldc + col0;
#pragma unroll
                for (int bj = 0; bj < 2; ++bj) { const f32x4 v0 = acc[ai][bj][m][0], v1 = acc[ai][bj][m][1];
                    u32x4 w; w.x = pk2(v0[0], v0[1]); w.y = pk2(v0[2], v0[3]); w.z = pk2(v1[0], v1[1]); w.w = pk2(v1[2], v1[3]);
                    *(u32x4*)(rowp + bj * HALF) = w; } }
    }
};
struct EpiSwiGLU {
    static constexpr bool PERM = true;
    bf16_t* O;
    __device__ __forceinline__ void operator()(const f32x4 (&acc)[2][2][4][2], const Unit& u, int wr, int wc, int fr, int fq) const {
        const int row0 = u.pm * BM + wr * 64 + fr, col0 = u.pn * HALF + wc * 32 + 8 * fq;
#pragma unroll
        for (int ai = 0; ai < 2; ++ai)
#pragma unroll
            for (int m = 0; m < 4; ++m) {
                const f32x4 g0 = acc[ai][0][m][0], g1 = acc[ai][0][m][1], u0 = acc[ai][1][m][0], u1 = acc[ai][1][m][1];
                float v[8];
#pragma unroll
                for (int i = 0; i < 4; ++i) { v[i] = silu_f(g0[i]) * u0[i]; v[4 + i] = silu_f(g1[i]) * u1[i]; }
                *(u32x4*)(O + (size_t)(row0 + ai * HALF + m * 16) * DFF + col0) = pack8(v);
            }
    }
};
struct EpiResid {
    static constexpr bool PERM = false;
    const float* base; float* out; const float* gate;
    __device__ __forceinline__ void operator()(const f32x4 (&acc)[2][2][4][2], const Unit& u, int wr, int wc, int fr, int fq) const {
        const int row0 = u.pm * BM + wr * 64 + fr, col0 = u.pn * BM + wc * 32 + 4 * fq;
        const float* gp = gate + (size_t)(u.pm >> 4) * NMOD + col0;
        f32x4 gv[2][2];
#pragma unroll
        for (int bj = 0; bj < 2; ++bj)
#pragma unroll
            for (int n = 0; n < 2; ++n) gv[bj][n] = *(const f32x4*)(gp + bj * HALF + n * 16);
#pragma unroll
        for (int ai = 0; ai < 2; ++ai) {
            f32x4 bv[4][2][2];
#pragma unroll
            for (int m = 0; m < 4; ++m) { const size_t ro = (size_t)(row0 + ai * HALF + m * 16) * DM + col0;
#pragma unroll
                for (int bj = 0; bj < 2; ++bj)
#pragma unroll
                    for (int n = 0; n < 2; ++n) bv[m][bj][n] = *(const f32x4*)(base + ro + bj * HALF + n * 16); }
#pragma unroll
            for (int m = 0; m < 4; ++m) { const size_t ro = (size_t)(row0 + ai * HALF + m * 16) * DM + col0;
#pragma unroll
                for (int bj = 0; bj < 2; ++bj)
#pragma unroll
                    for (int n = 0; n < 2; ++n) *(f32x4*)(out + ro + bj * HALF + n * 16) = bv[m][bj][n] + gv[bj][n] * acc[ai][bj][m][n]; }
        }
    }
};

template <class Epi>
__device__ __forceinline__ void gemm_phase(const int tidx, LAS unsigned char* lds, const Gemm g, const StaticOrder& S, const Epi& E) {
    const int tid = tidx, wid = __builtin_amdgcn_readfirstlane(tid >> 6), lane = tid & 63, wr = wid >> 2, wc = wid & 3, fr = lane & 15, fq = lane >> 4;
    const int K = g.K, nt = K / BK;
    unsigned voffA[2], voffB[2];
#pragma unroll
    for (int i = 0; i < 2; ++i) { int R, C; stage_rc(tid * 16 + i * 8192, R, C); const int Rb = Epi::PERM ? ((R & ~31) + perm32(R & 31)) : R;
        voffA[i] = (unsigned)(R * K + C) * 2u; voffB[i] = (unsigned)(Rb * K + C) * 2u; }
    const size_t kstep = (size_t)(BK * 2);
    const size_t hstep = (size_t)HALF * K * 2;
    const size_t tstep = 2 * hstep;
    const unsigned ldsw = (unsigned)wid * 1024u;
    const int aoff = lds_byte(wr * 64 + fr, fq * 8), boff = lds_byte(wc * 32 + fr, fq * 8);
#define PG8_SA(b, h) (((b) * 2 + (h)) * HTB)
#define PG8_SB(b, h) ((4 + (b) * 2 + (h)) * HTB)
#define PG8_STAGE(bufoff, gbase, voff) do { _Pragma("unroll") for (int _i = 0; _i < 2; ++_i) \
        __builtin_amdgcn_global_load_lds((const unsigned*)((const char*)(gbase) + (voff)[_i]), (LAS unsigned*)(lds + (bufoff) + ldsw + _i * 8192), 16, 0, 0); } while (0)
#define PG8_LDA(dst, b, h) do { _Pragma("unroll") for (int m = 0; m < 4; ++m) _Pragma("unroll") for (int k = 0; k < 2; ++k) dst[m][k] = *(const LAS bf16x8*)(lds + PG8_SA(b, h) + aoff + m * 2048 + k * 1024); } while (0)
#define PG8_LDB(dst, b, h) do { _Pragma("unroll") for (int n = 0; n < 2; ++n) _Pragma("unroll") for (int k = 0; k < 2; ++k) dst[n][k] = *(const LAS bf16x8*)(lds + PG8_SB(b, h) + boff + n * 2048 + k * 1024); } while (0)
#define PG8_MMA(ai, bj, At, Bt) do { __builtin_amdgcn_s_setprio(1); _Pragma("unroll") for (int m = 0; m < 4; ++m) _Pragma("unroll") for (int n = 0; n < 2; ++n) _Pragma("unroll") for (int k = 0; k < 2; ++k) \
        acc[ai][bj][m][n] = __builtin_amdgcn_mfma_f32_16x16x32_bf16(Bt[n][k], At[m][k], acc[ai][bj][m][n], 0, 0, 0); __builtin_amdgcn_s_setprio(0); } while (0)
#define PG8_WAIT_V(n) asm volatile("s_waitcnt vmcnt(" #n ")" ::: "memory")
#define PG8_WAIT_L(n) asm volatile("s_waitcnt lgkmcnt(" #n ")" ::: "memory")
#define PG8_BAR __builtin_amdgcn_s_barrier()
#define PG8_SCHED __builtin_amdgcn_sched_barrier(0)
    Unit cur, nxt; int ui = 0;
    if (!S.next(0, cur)) return;
    f32x4 acc[2][2][4][2];
#pragma unroll
    for (int a = 0; a < 2; ++a)
#pragma unroll
        for (int b = 0; b < 2; ++b)
#pragma unroll
            for (int m = 0; m < 4; ++m)
#pragma unroll
                for (int n = 0; n < 2; ++n) acc[a][b][m][n] = (f32x4){0.f, 0.f, 0.f, 0.f};
    bf16x8 At[4][2], B0[2][2], B1[2][2];
    const char* cA = (const char*)g.A + (size_t)cur.pm * tstep; const char* cB = (const char*)g.Bt + (size_t)cur.pn * tstep;
    PG8_STAGE(PG8_SB(0, 0), cB, voffB); PG8_STAGE(PG8_SA(0, 0), cA, voffA); PG8_STAGE(PG8_SB(0, 1), cB + hstep, voffB); PG8_STAGE(PG8_SA(0, 1), cA + hstep, voffA);
    if (wr == 1) PG8_BAR;
    PG8_WAIT_V(4); PG8_BAR;
    PG8_STAGE(PG8_SB(1, 0), cB + kstep, voffB); PG8_STAGE(PG8_SA(1, 0), cA + kstep, voffA); PG8_STAGE(PG8_SB(1, 1), cB + hstep + kstep, voffB);
    PG8_WAIT_V(6); PG8_BAR;
    for (;;) {
        const bool has_next = S.next(ui + 1, nxt);
        const char* nA = has_next ? (const char*)g.A + (size_t)nxt.pm * tstep : cA; const char* nB = has_next ? (const char*)g.Bt + (size_t)nxt.pn * tstep : cB;
        for (int t = 0; t < nt; t += 2) {
            const bool last = (t == nt - 2);
            const char* a1 = cA + (size_t)(t + 1) * kstep;
            const char* a2 = last ? nA : cA + (size_t)(t + 2) * kstep; const char* b2 = last ? nB : cB + (size_t)(t + 2) * kstep;
            const char* a3 = a2 + kstep; const char* b3 = b2 + kstep;
            PG8_LDB(B0, 0, 0); PG8_SCHED; PG8_LDA(At, 0, 0); PG8_STAGE(PG8_SA(1, 1), a1 + hstep, voffA);
            PG8_WAIT_L(8); PG8_BAR; PG8_WAIT_L(0); PG8_MMA(0, 0, At, B0); PG8_BAR; PG8_SCHED;
            PG8_LDB(B1, 0, 1); PG8_STAGE(PG8_SB(0, 0), b2, voffB);
            PG8_BAR; PG8_WAIT_L(0); PG8_MMA(0, 1, At, B1); PG8_BAR;
            PG8_LDA(At, 0, 1); PG8_STAGE(PG8_SA(0, 0), a2, voffA);
            PG8_BAR; PG8_WAIT_L(0); PG8_MMA(1, 0, At, B0); PG8_BAR; PG8_SCHED;
            PG8_STAGE(PG8_SB(0, 1), b2 + hstep, voffB);
            PG8_WAIT_V(6); PG8_BAR; PG8_MMA(1, 1, At, B1); PG8_BAR;
            PG8_LDB(B0, 1, 0); PG8_SCHED; PG8_LDA(At, 1, 0); PG8_STAGE(PG8_SA(0, 1), a2 + hstep, voffA);
            PG8_WAIT_L(8); PG8_BAR; PG8_WAIT_L(0); PG8_MMA(0, 0, At, B0); PG8_BAR; PG8_SCHED;
            PG8_LDB(B1, 1, 1); PG8_STAGE(PG8_SB(1, 0), b3, voffB);
            PG8_BAR; PG8_WAIT_L(0); PG8_MMA(0, 1, At, B1); PG8_BAR;
            PG8_LDA(At, 1, 1); PG8_STAGE(PG8_SA(1, 0), a3, voffA);
            PG8_BAR; PG8_WAIT_L(0); PG8_MMA(1, 0, At, B0); PG8_BAR; PG8_SCHED;
            PG8_STAGE(PG8_SB(1, 1), b3 + hstep, voffB);
            PG8_WAIT_V(6); PG8_BAR; PG8_MMA(1, 1, At, B1); PG8_BAR;
        }
        E(acc, cur, wr, wc, fr, fq);
        if (!has_next) break;
#pragma unroll
        for (int a = 0; a < 2; ++a)
#pragma unroll
            for (int b = 0; b < 2; ++b)
#pragma unroll
                for (int m = 0; m < 4; ++m)
#pragma unroll
                    for (int n = 0; n < 2; ++n) acc[a][b][m][n] = (f32x4){0.f, 0.f, 0.f, 0.f};
        cur = nxt; cA = nA; cB = nB; ++ui;
    }
    PG8_WAIT_V(0);
    if (wr == 0) PG8_BAR;
    PG8_BAR;
#undef PG8_SA
#undef PG8_SB
#undef PG8_STAGE
#undef PG8_LDA
#undef PG8_LDB
#undef PG8_MMA
#undef PG8_WAIT_V
#undef PG8_WAIT_L
#undef PG8_BAR
#undef PG8_SCHED
}
}

__device__ __forceinline__ void prep_transposes(const int tidx, const P& p, LAS unsigned char* L, int l0, int l1, int blk, int nblk);
__device__ __forceinline__ void phase_prep(const int tidx, const P& p, LAS unsigned char* L) {
    const int tid = tidx;
    constexpr int NADA = NL * 96, TPL = 3264, TOTAL = NADA + NL * TPL;
    float* mod = (float*)(p.ws + WS_MOD);
    for (int it = blockIdx.x; it < NADA; it += gridDim.x) {
        __syncthreads();
        {
            const int l = it / 96, n0 = (it % 96) * 64;
            LAS float* cact = (LAS float*)L;
            LAS float* red = cact + 4096;
            for (int i = tid; i < 4096; i += 512) cact[i] = silu_f(p.c[i]);
            __syncthreads();
            const int kg = tid >> 6, nn = tid & 63;
            const float* w = p.w_ada + ((size_t)l * DM + kg * 128) * NMOD + n0 + nn;
            float a0 = 0.f, a1 = 0.f, a2 = 0.f, a3 = 0.f;
#pragma unroll 8
            for (int k = 0; k < 128; ++k) { const float wv = w[(size_t)k * NMOD]; const int kk = kg * 128 + k;
                a0 += cact[kk] * wv; a1 += cact[1024 + kk] * wv; a2 += cact[2048 + kk] * wv; a3 += cact[3072 + kk] * wv; }
            red[(kg * 4 + 0) * 64 + nn] = a0; red[(kg * 4 + 1) * 64 + nn] = a1; red[(kg * 4 + 2) * 64 + nn] = a2; red[(kg * 4 + 3) * 64 + nn] = a3;
            __syncthreads();
            if (tid < 256) { const int b = tid >> 6; float s = p.b_ada[l * NMOD + n0 + nn];
#pragma unroll
                for (int k2 = 0; k2 < 8; ++k2) s += red[(k2 * 4 + b) * 64 + nn];
                mod[(size_t)(l * NB + b) * NMOD + n0 + nn] = s; }
        }
    }
    prep_transposes(tidx, p, L, 0, 1, blockIdx.x, gridDim.x);
}
__device__ __forceinline__ void prep_transposes(const int tidx, const P& p, LAS unsigned char* L, int l0, int l1, int blk, int nblk) {
    const int tid = tidx;
    constexpr int TPL = 3264;
    for (int it0 = l0 * TPL + blk * 4; it0 < l1 * TPL; it0 += nblk * 4) {
        __syncthreads();
        bf16_t* dstp[4]; int kd[4];
#pragma unroll
        for (int tt = 0; tt < 4; ++tt) {
            const int j = it0 + tt, l = j / TPL; int r = j % TPL;
            const float* src; bf16_t* dst; int Ns, Nvalid, Kd, k0, ns0, nd0;
            if (r < 896) { const int kt = r / 56, nt = r % 56; src = p.w_in + (size_t)l * DM * NIN; Ns = NIN; Nvalid = NIN; Kd = DM; k0 = kt * 64; nd0 = nt * 64;
                ns0 = (nd0 < 2816) ? nd0 : ((nd0 < 3072) ? 3328 + (nd0 - 2816) : 2816 + (nd0 - 3072));
                dst = (bf16_t*)(p.ws + WS_WIN) + (size_t)l * NINP * DM; }
            else if (r < 1152) { r -= 896; const int kt = r / 16, nt = r % 16; src = p.w_out + (size_t)l * DM * DM; Ns = DM; Nvalid = DM; Kd = DM; k0 = kt * 64; nd0 = nt * 64; ns0 = nd0;
                dst = (bf16_t*)(p.ws + WS_WOUT) + (size_t)l * DM * DM; }
            else if (r < 2560) { r -= 1152; const int kt = r / 88, nt = r % 88; src = p.w_ffn_in + (size_t)l * DM * NF1; Ns = NF1; Nvalid = NF1; Kd = DM; k0 = kt * 64; nd0 = nt * 64;
                const int pn = nd0 >> 8, half = (nd0 >> 7) & 1, sub = nd0 & 127; ns0 = half * DFF + pn * 128 + sub;
                dst = (bf16_t*)(p.ws + WS_WF1) + (size_t)l * NF1 * DM; }
            else { r -= 2560; const int kt = r / 16, nt = r % 16; src = p.w_ffn_out + (size_t)l * DFF * DM; Ns = DM; Nvalid = DM; Kd = DFF; k0 = kt * 64; nd0 = nt * 64; ns0 = nd0;
                dst = (bf16_t*)(p.ws + WS_WF2) + (size_t)l * DM * DFF; }
            LAS float* tile = (LAS float*)L + tt * (64 * 65);
            const int kk = tid >> 4, c4 = (tid & 15) * 4;
            f32x4 v0 = {0.f, 0.f, 0.f, 0.f}, v1 = {0.f, 0.f, 0.f, 0.f};
            if (ns0 + c4 < Nvalid) { v0 = *(const f32x4*)(src + (size_t)(k0 + kk) * Ns + ns0 + c4); v1 = *(const f32x4*)(src + (size_t)(k0 + kk + 32) * Ns + ns0 + c4); }
            tile[kk * 65 + c4 + 0] = v0[0]; tile[kk * 65 + c4 + 1] = v0[1]; tile[kk * 65 + c4 + 2] = v0[2]; tile[kk * 65 + c4 + 3] = v0[3];
            tile[(kk + 32) * 65 + c4 + 0] = v1[0]; tile[(kk + 32) * 65 + c4 + 1] = v1[1]; tile[(kk + 32) * 65 + c4 + 2] = v1[2]; tile[(kk + 32) * 65 + c4 + 3] = v1[3];
            dstp[tt] = dst + (size_t)nd0 * Kd + k0; kd[tt] = Kd;
        }
        __syncthreads();
#pragma unroll
        for (int tt = 0; tt < 4; ++tt) {
            LAS float* tile = (LAS float*)L + tt * (64 * 65);
            const int nn = tid >> 3, k8 = (tid & 7) * 8; float f[8];
#pragma unroll
            for (int i = 0; i < 8; ++i) f[i] = tile[(k8 + i) * 65 + nn];
            *(u32x4*)(dstp[tt] + (size_t)nn * kd[tt] + k8) = pack8(f);
        }
    }
}

__device__ __forceinline__ void phase_norm(const int tidx, const float* xin, const float* g, const float* modl, int shoff, int scoff, bf16_t* hout) {
    const int wave = tidx >> 6, lane = tidx & 63;
    constexpr int NR = 4;
    for (int row0 = (blockIdx.x * 8 + wave) * NR; row0 < MTOK; row0 += gridDim.x * 8 * NR) {
        const int b = row0 >> 12;
        f32x4 v[NR][4], gg[4], sc[4], sh[4];
#pragma unroll
        for (int rr = 0; rr < NR; ++rr)
#pragma unroll
            for (int i = 0; i < 4; ++i) v[rr][i] = *(const f32x4*)(xin + (size_t)(row0 + rr) * DM + i * 256 + lane * 4);
#pragma unroll
        for (int i = 0; i < 4; ++i) { const int k = i * 256 + lane * 4;
            gg[i] = *(const f32x4*)(g + k); sc[i] = *(const f32x4*)(modl + (size_t)b * NMOD + scoff + k); sh[i] = *(const f32x4*)(modl + (size_t)b * NMOD + shoff + k); }
#pragma unroll
        for (int rr = 0; rr < NR; ++rr) {
            float ss = 0.f;
#pragma unroll
            for (int i = 0; i < 4; ++i) ss += v[rr][i][0] * v[rr][i][0] + v[rr][i][1] * v[rr][i][1] + v[rr][i][2] * v[rr][i][2] + v[rr][i][3] * v[rr][i][3];
            ss = wave_sum(ss);
            const float rinv = rsqrtf(ss * (1.f / DM) + 1e-6f);
#pragma unroll
            for (int i = 0; i < 4; ++i) { const int k = i * 256 + lane * 4;
                const f32x4 y = v[rr][i] * rinv * gg[i] * (sc[i] + 1.f) + sh[i];
                u32x2 w; w.x = pk2(y[0], y[1]); w.y = pk2(y[2], y[3]);
                *(u32x2*)(hout + (size_t)(row0 + rr) * DM + k) = w; }
        }
    }
}
__device__ __forceinline__ void phase_final(const int tidx, float* x, const float* g) {
    const int wave = tidx >> 6, lane = tidx & 63;
    constexpr int NR = 4;
    for (int row0 = (blockIdx.x * 8 + wave) * NR; row0 < MTOK; row0 += gridDim.x * 8 * NR) {
        f32x4 v[NR][4], gg[4];
#pragma unroll
        for (int rr = 0; rr < NR; ++rr)
#pragma unroll
            for (int i = 0; i < 4; ++i) v[rr][i] = *(const f32x4*)(x + (size_t)(row0 + rr) * DM + i * 256 + lane * 4);
#pragma unroll
        for (int i = 0; i < 4; ++i) gg[i] = *(const f32x4*)(g + i * 256 + lane * 4);
#pragma unroll
        for (int rr = 0; rr < NR; ++rr) {
            float ss = 0.f;
#pragma unroll
            for (int i = 0; i < 4; ++i) ss += v[rr][i][0] * v[rr][i][0] + v[rr][i][1] * v[rr][i][1] + v[rr][i][2] * v[rr][i][2] + v[rr][i][3] * v[rr][i][3];
            ss = wave_sum(ss);
            const float rinv = rsqrtf(ss * (1.f / DM) + 1e-6f);
#pragma unroll
            for (int i = 0; i < 4; ++i) *(f32x4*)(x + (size_t)(row0 + rr) * DM + i * 256 + lane * 4) = v[rr][i] * rinv * gg[i];
        }
    }
}

__device__ __forceinline__ void phase_dprep(const int tidx, const P& p, int l, LAS unsigned char* L) {
    LAS bf16_t* Qn = (LAS bf16_t*)(L + 0);
    LAS bf16_t* Kn = (LAS bf16_t*)(L + 17408);
    LAS bf16_t* KbgT = (LAS bf16_t*)(L + 34816);
    LAS bf16_t* KtlT = (LAS bf16_t*)(L + 53248);
    LAS bf16_t* VbT = (LAS bf16_t*)(L + 71680);
    LAS float* Lm = (LAS float*)(L + 90112);
    LAS bf16_t* Tm = (LAS bf16_t*)(L + 107520);
    LAS bf16_t* QKm = (LAS bf16_t*)(L + 116736);
    LAS float* gcs = (LAS float*)(L + 125952);
    LAS float* betas = gcs + 64;
    LAS float* cwl = (LAS float*)(L + LDS_CW_OFF);
    LAS float* Tf = (LAS float*)(L + LDS_TF_OFF);
    const bf16_t* proj = (const bf16_t*)(p.ws + WS_PROJ);
    float* alast = (float*)(p.ws + WS_ALAST);
    u32x4 rawA[7], rawB[7]; float cwreg[4], alpha_r = 0.f, beta_r = 0.f;
#define DP_ISSUE(it_, tid_) do { const int h_ = (it_) & 3, n_ = ((it_) >> 2) & 63, t0_ = ((it_) >> 8) * SEQ + n_ * 64; \
        const int tk0_ = (((tid_) >> 4) & 15) * 4, d0_ = ((tid_) & 15) * 8; \
        _Pragma("unroll") for (int rr = 0; rr < 7; ++rr) { const int pos = n_ * 64 + tk0_ - 3 + rr; \
            rawA[rr] = (u32x4){0u, 0u, 0u, 0u}; rawB[rr] = (u32x4){0u, 0u, 0u, 0u}; \
            if (pos >= 0) { const bf16_t* pr = proj + (size_t)(t0_ + tk0_ - 3 + rr) * NINP + 1280 + h_ * 128 + d0_; \
                rawA[rr] = *(const u32x4*)(pr + ((tid_) >> 8) * 512); \
                if ((tid_) < 256) rawB[rr] = *(const u32x4*)(pr + 1024); } } \
        if ((tid_) < 384) { _Pragma("unroll") for (int j = 0; j < 4; ++j) cwreg[j] = p.dn_conv_w[(size_t)(l * 4 + j) * 1536 + ((tid_) >> 7) * 512 + h_ * 128 + ((tid_) & 127)]; } \
        if (((tid_) >> 6) == 7) { const bf16_t* pr = proj + (size_t)(t0_ + ((tid_) & 63)) * NINP; alpha_r = bf2f(pr[2816 + h_]); beta_r = bf2f(pr[2820 + h_]); } } while (0)
    if ((int)blockIdx.x < 1024) DP_ISSUE((int)blockIdx.x, tidx);
    for (int item = blockIdx.x; item < 1024; item += gridDim.x) {
        __syncthreads();
        int tid = tidx; asm volatile("" : "+v"(tid));
        const int lane = tid & 63, wave = tid >> 6, r = lane & 15, q = lane >> 4;
        const int h = item & 3, n = (item >> 2) & 63, b = item >> 8;
        const int t0 = b * SEQ + n * 64;
        unsigned char* itp = p.ws + WS_DELTA + (size_t)item * ITEM_BYTES;
        const int run = (tid >> 4) & 15, d0 = (tid & 15) * 8, tk0 = run * 4, whichA = tid >> 8;
        if (tid < 384) {
#pragma unroll
            for (int j = 0; j < 4; ++j) cwl[j * 384 + tid] = cwreg[j];
        }
        if (wave == 7) {
            const float xx = alpha_r + p.dn_dt_bias[l * 4 + h];
            const float sp = fmaxf(xx, 0.f) + log1pf(__expf(-fabsf(xx)));
            float gc = -__expf(p.dn_a_log[l * 4 + h]) * sp;
#pragma unroll
            for (int o = 1; o < 64; o <<= 1) { const float tv = __shfl_up(gc, o); if (lane >= o) gc += tv; }
            gcs[lane] = gc; betas[lane] = sigmoid_f(beta_r);
        }
        __syncthreads();
        const float gl = gcs[63];
#pragma unroll
        for (int pass = 0; pass < 2; ++pass) {
            if (pass == 1 && tid >= 256) break;
            const int which = pass ? 2 : whichA;
            const LAS float* cw = cwl + which * 128 + d0;
            float y[4][8];
#pragma unroll
            for (int i = 0; i < 4; ++i)
#pragma unroll
                for (int d = 0; d < 8; ++d) y[i][d] = 0.f;
#pragma unroll
            for (int j = 0; j < 4; ++j) {
                const f32x4 w0 = *(const LAS f32x4*)(cw + j * 384), w1 = *(const LAS f32x4*)(cw + j * 384 + 4);
#pragma unroll
                for (int i = 0; i < 4; ++i) { float rf[8]; unpack8(pass ? rawB[i + j] : rawA[i + j], rf);
#pragma unroll
                    for (int d = 0; d < 4; ++d) { y[i][d] += w0[d] * rf[d]; y[i][4 + d] += w1[d] * rf[4 + d]; } }
            }
#pragma unroll
            for (int i = 0; i < 4; ++i) {
#pragma unroll
                for (int d = 0; d < 8; ++d) y[i][d] = silu_f(y[i][d]);
                if (which < 2) {
                    float ss = 0.f;
#pragma unroll
                    for (int d = 0; d < 8; ++d) ss += y[i][d] * y[i][d];
                    ss += __shfl_xor(ss, 1); ss += __shfl_xor(ss, 2); ss += __shfl_xor(ss, 4); ss += __shfl_xor(ss, 8);
                    float rinv = rsqrtf(ss + 1e-6f);
                    if (which == 0) rinv *= 0.08838834764831845f;
#pragma unroll
                    for (int d = 0; d < 8; ++d) y[i][d] *= rinv;
                }
            }
            if (which == 0) {
#pragma unroll
                for (int i = 0; i < 4; ++i) *(LAS u32x4*)(Qn + (tk0 + i) * 136 + d0) = pack8(y[i]);
            } else if (which == 1) {
                float f1[4], f2[4];
#pragma unroll
                for (int i = 0; i < 4; ++i) { const float gc = gcs[tk0 + i]; f1[i] = betas[tk0 + i] * __expf(gc); f2[i] = __expf(gl - gc); }
#pragma unroll
                for (int i = 0; i < 4; ++i) *(LAS u32x4*)(Kn + (tk0 + i) * 136 + d0) = pack8(y[i]);
#pragma unroll
                for (int d = 0; d < 8; ++d) {
                    u32x2 a, c; a.x = pk2(y[0][d] * f1[0], y[1][d] * f1[1]); a.y = pk2(y[2][d] * f1[2], y[3][d] * f1[3]); c.x = pk2(y[0][d] * f2[0], y[1][d] * f2[1]); c.y = pk2(y[2][d] * f2[2], y[3][d] * f2[3]);
                    *(LAS u32x2*)(KbgT + (d0 + d) * 72 + tk0) = a; *(LAS u32x2*)(KtlT + (d0 + d) * 72 + tk0) = c; }
            } else {
                float bt[4];
#pragma unroll
                for (int i = 0; i < 4; ++i) bt[i] = betas[tk0 + i];
#pragma unroll
                for (int d = 0; d < 8; ++d) { u32x2 a; a.x = pk2(y[0][d] * bt[0], y[1][d] * bt[1]); a.y = pk2(y[2][d] * bt[2], y[3][d] * bt[3]);
                    *(LAS u32x2*)(VbT + (d0 + d) * 72 + tk0) = a; }
            }
        }
        if (item + (int)gridDim.x < 1024) DP_ISSUE(item + (int)gridDim.x, tid);
        __syncthreads();
        {
            const int mat = wave >> 2, cb = wave & 3;
            LAS bf16_t* Asrc = mat ? Qn : Kn;
            bf16x8 a[4];
#pragma unroll
            for (int kb = 0; kb < 4; ++kb) a[kb] = *(LAS bf16x8*)(Asrc + (16 * cb + r) * 136 + 32 * kb + 8 * q);
#pragma unroll
            for (int sb = 0; sb < 4; ++sb) {
                f32x4 acc = {0.f, 0.f, 0.f, 0.f};
                if (sb <= cb) {
#pragma unroll
                    for (int kb = 0; kb < 4; ++kb) { const bf16x8 bb = *(LAS bf16x8*)(Kn + (16 * sb + r) * 136 + 32 * kb + 8 * q); acc = MFMA16(a[kb], bb, acc); }
                }
                const int s = 16 * sb + r; const float gs = gcs[s];
#pragma unroll
                for (int j = 0; j < 4; ++j) { const int c = 16 * cb + 4 * q + j; const float dec = __expf(gcs[c] - gs);
                    if (mat == 0) Lm[c * 68 + s] = (s < c) ? acc[j] * betas[c] * dec : 0.f;
                    else QKm[c * 72 + s] = f2bf((s <= c) ? acc[j] * dec : 0.f); }
            }
        }
        __syncthreads();
        if (wave < 4) {
            const int blk = wave, c = lane & 15;
            int zoff; asm volatile("v_mov_b32 %0, 0" : "=v"(zoff));
            LAS float* Lb = Lm + (16 * blk) * 68 + 16 * blk + zoff;
            float t[16];
            f32x4 rb[2][4];
            t[0] = (c == 0) ? 1.f : 0.f;
            rb[1][0] = *(LAS f32x4*)(Lb + 1 * 68);
#pragma unroll
            for (int i = 1; i < 16; ++i) {
                if (i + 1 < 16) {
#pragma unroll
                    for (int j4 = 0; j4 < (i + 4) / 4; ++j4) rb[(i + 1) & 1][j4] = *(LAS f32x4*)(Lb + (i + 1) * 68 + 4 * j4);
                }
                __builtin_amdgcn_sched_barrier(0);
                float acc0 = (i == c) ? 1.f : 0.f, acc1 = 0.f;
#pragma unroll
                for (int j = 0; j < i; ++j) { if (j & 1) acc1 -= rb[i & 1][j >> 2][j & 3] * t[j]; else acc0 -= rb[i & 1][j >> 2][j & 3] * t[j]; }
                t[i] = acc0 + acc1;
                __builtin_amdgcn_sched_barrier(0);
            }
            if (q == 0) {
#pragma unroll
                for (int i = 0; i < 16; ++i) { Tf[(16 * blk + i) * 68 + 16 * blk + c] = t[i]; Tm[(16 * blk + i) * 72 + 16 * blk + c] = f2bf(t[i]); }
            }
            for (int cb = blk + 1; cb < 4; ++cb) {
#pragma unroll
                for (int jj = 0; jj < 4; ++jj) Tm[(16 * blk + 4 * q + jj) * 72 + 16 * cb + r] = (bf16_t)0;
            }
        } else {
            if (wave == 4 && lane == 0) alast[item] = __expf(gl);
            for (int jb = wave - 4; jb < 40; jb += 4) {
                if (jb < 16) {
                    const int tb = jb >> 2, kb = jb & 3, tok = 16 * tb + r;
                    const u32x2 lo = *(LAS u32x2*)(Qn + tok * 136 + 32 * kb + 4 * q), hi = *(LAS u32x2*)(Qn + tok * 136 + 32 * kb + 16 + 4 * q);
                    const float e = __expf(gcs[tok]);
                    u32x4 w; w.x = pk2(lo16(lo.x) * e, hi16(lo.x) * e); w.y = pk2(lo16(lo.y) * e, hi16(lo.y) * e); w.z = pk2(lo16(hi.x) * e, hi16(hi.x) * e); w.w = pk2(lo16(hi.y) * e, hi16(hi.y) * e);
                    *(u32x4*)(itp + OFF_Q + (size_t)(jb * 64 + lane) * 16) = w;
                } else if (jb < 32) {
                    const int f = jb - 16, db = f >> 1, kb = f & 1, dk = 16 * db + r;
                    const u32x2 lo = *(LAS u32x2*)(KtlT + dk * 72 + 32 * kb + 4 * q), hi = *(LAS u32x2*)(KtlT + dk * 72 + 32 * kb + 16 + 4 * q);
                    u32x4 w; w.x = lo.x; w.y = lo.y; w.z = hi.x; w.w = hi.y;
                    *(u32x4*)(itp + OFF_KT + (size_t)(f * 64 + lane) * 16) = w;
                } else {
                    const int f = jb - 32, tb = f >> 1, kb = f & 1, tok = 16 * tb + r;
                    const u32x2 lo = *(LAS u32x2*)(QKm + tok * 72 + 32 * kb + 4 * q), hi = *(LAS u32x2*)(QKm + tok * 72 + 32 * kb + 16 + 4 * q);
                    u32x4 w; w.x = lo.x; w.y = lo.y; w.z = hi.x; w.w = hi.y;
                    *(u32x4*)(itp + OFF_QK + (size_t)(f * 64 + lane) * 16) = w;
                }
            }
        }
        __syncthreads();
#pragma unroll
        for (int d = 1; d < 4; ++d) {
            if (wave < 4 - d) {
                const int bj = wave, bi = wave + d;
                f32x4 M = {0.f, 0.f, 0.f, 0.f};
#pragma unroll
                for (int kk = 0; kk < d; ++kk) { const int bk = bj + kk;
#pragma unroll
                    for (int s = 0; s < 4; ++s) M = __builtin_amdgcn_mfma_f32_16x16x4f32(Lm[(16 * bi + r) * 68 + 16 * bk + 4 * s + q], Tf[(16 * bk + 4 * s + q) * 68 + 16 * bj + r], M, 0, 0, 0);
                }
                f32x4 Tn = {0.f, 0.f, 0.f, 0.f};
#pragma unroll
                for (int s = 0; s < 4; ++s) Tn = __builtin_amdgcn_mfma_f32_16x16x4f32(Tf[(16 * bi + r) * 68 + 16 * bi + 4 * q + s], M[s], Tn, 0, 0, 0);
#pragma unroll
                for (int jj = 0; jj < 4; ++jj) { Tf[(16 * bi + 4 * q + jj) * 68 + 16 * bj + r] = -Tn[jj]; Tm[(16 * bi + 4 * q + jj) * 72 + 16 * bj + r] = f2bf(-Tn[jj]); }
            }
            __syncthreads();
        }
        {
            const int s = wave;
            bf16x8 vb[2];
#pragma unroll
            for (int kb = 0; kb < 2; ++kb) vb[kb] = *(LAS bf16x8*)(VbT + (16 * s + r) * 72 + 32 * kb + 8 * q);
#pragma unroll
            for (int tb = 0; tb < 4; ++tb) {
                f32x4 acc = {0.f, 0.f, 0.f, 0.f};
#pragma unroll
                for (int kb = 0; kb < 2; ++kb) { const bf16x8 a = *(LAS bf16x8*)(Tm + (16 * tb + r) * 72 + 32 * kb + 8 * q); acc = MFMA16(a, vb[kb], acc); }
                *(f32x4*)(itp + OFF_U + (size_t)((s * 4 + tb) * 64 + lane) * 16) = acc;
            }
            const int kbp = wave & 3, tbh = wave >> 2;
            bf16x8 ka[2][2];
#pragma unroll
            for (int d = 0; d < 2; ++d)
#pragma unroll
                for (int kb = 0; kb < 2; ++kb) ka[d][kb] = *(LAS bf16x8*)(KbgT + (16 * (2 * kbp + d) + r) * 72 + 32 * kb + 8 * q);
#pragma unroll
            for (int tt = 0; tt < 2; ++tt) {
                const int tb = 2 * tbh + tt;
                f32x4 a0 = {0.f, 0.f, 0.f, 0.f}, a1 = {0.f, 0.f, 0.f, 0.f};
#pragma unroll
                for (int kb = 0; kb < 2; ++kb) { const bf16x8 tf = *(LAS bf16x8*)(Tm + (16 * tb + r) * 72 + 32 * kb + 8 * q); a0 = MFMA16(ka[0][kb], tf, a0); a1 = MFMA16(ka[1][kb], tf, a1); }
                u32x4 w; w.x = pk2(a0[0], a0[1]); w.y = pk2(a0[2], a0[3]); w.z = pk2(a1[0], a1[1]); w.w = pk2(a1[2], a1[3]);
                *(u32x4*)(itp + OFF_W + (size_t)((tb * 4 + kbp) * 64 + lane) * 16) = w;
            }
        }
    }
}

__device__ __forceinline__ void mixer_a(const int tidx, const P& p, int l, int blk, int nblk) {
    const bf16_t* proj = (const bf16_t*)(p.ws + WS_PROJ); bf16_t* ycat = (bf16_t*)(p.ws + WS_YCAT);
    const int stride = nblk * 512;
    for (int unit0 = blk * 512 + tidx; unit0 < MTOK * 32; unit0 += 2 * stride) {
        u32x4 rc[2][3], rv[2][3], rb[2];
#pragma unroll
        for (int uu = 0; uu < 2; ++uu) { const int unit = unit0 + uu * stride; const bool ok = unit < MTOK * 32;
            const int t = unit >> 5, c0 = (unit & 31) * 8, pos = t & (SEQ - 1);
#pragma unroll
            for (int j = 0; j < 3; ++j) { rc[uu][j] = (u32x4){0u, 0u, 0u, 0u}; rv[uu][j] = (u32x4){0u, 0u, 0u, 0u};
                if (ok && pos - 2 + j >= 0) { const bf16_t* pr = proj + (size_t)(t - 2 + j) * NINP; rc[uu][j] = *(const u32x4*)(pr + 256 + c0); rv[uu][j] = *(const u32x4*)(pr + 512 + c0); } }
            rb[uu] = (u32x4){0u, 0u, 0u, 0u};
            if (ok) rb[uu] = *(const u32x4*)(proj + (size_t)t * NINP + c0); }
#pragma unroll
        for (int uu = 0; uu < 2; ++uu) { const int unit = unit0 + uu * stride;
            if (unit < MTOK * 32) { const int t = unit >> 5, c0 = (unit & 31) * 8;
                float acc[8];
#pragma unroll
                for (int i = 0; i < 8; ++i) acc[i] = 0.f;
#pragma unroll
                for (int j = 0; j < 3; ++j) { float fc[8], fv[8]; unpack8(rc[uu][j], fc); unpack8(rv[uu][j], fv);
                    const float* wp = p.conv_a_w + (size_t)(l * 3 + j) * 256 + c0;
                    const f32x4 w0 = *(const f32x4*)wp, w1 = *(const f32x4*)(wp + 4);
#pragma unroll
                    for (int i = 0; i < 4; ++i) { acc[i] += w0[i] * fc[i] * fv[i]; acc[4 + i] += w1[i] * fc[4 + i] * fv[4 + i]; } }
                float fb[8]; unpack8(rb[uu], fb);
#pragma unroll
                for (int i = 0; i < 8; ++i) acc[i] *= fb[i];
                *(u32x4*)(ycat + (size_t)t * DM + c0) = pack8(acc); } }
    }
}
__device__ __forceinline__ void mixer_b(const int tidx, const P& p, int l, int blk, int nblk, LAS unsigned char* L) {
    const bf16_t* proj = (const bf16_t*)(p.ws + WS_PROJ); bf16_t* ycat = (bf16_t*)(p.ws + WS_YCAT);
    LAS float* ut = (LAS float*)L;
    LAS float* co = (LAS float*)(L + 63488);
    const int tid = tidx, wave = tid >> 6, lane = tid & 63;
    for (int run = blk; run < MTOK / 32; run += nblk) {
        __syncthreads();
        const int t0 = run * 32, pos0 = t0 & (SEQ - 1);
        {
            u32x4 ra[4], rg[4];
#pragma unroll
            for (int it = 0; it < 4; ++it) { const int idx = tid + 512 * it, rr = idx >> 5, c0 = (idx & 31) * 8;
                ra[it] = (u32x4){0u, 0u, 0u, 0u}; rg[it] = (u32x4){0u, 0u, 0u, 0u};
                if (idx < 62 * 32 && pos0 - 30 + rr >= 0) { const bf16_t* pr = proj + (size_t)(t0 - 30 + rr) * NINP; ra[it] = *(const u32x4*)(pr + 768 + c0); rg[it] = *(const u32x4*)(pr + 1024 + c0); } }
#pragma unroll
            for (int it = 0; it < 4; ++it) { const int idx = tid + 512 * it, rr = idx >> 5, c0 = (idx & 31) * 8;
                if (idx < 62 * 32) { float fa[8], fg[8], u[8]; unpack8(ra[it], fa); unpack8(rg[it], fg);
#pragma unroll
                    for (int i = 0; i < 8; ++i) u[i] = fa[i] * sigmoid_f(fg[i]);
                    *(LAS f32x4*)(ut + rr * 256 + c0) = (f32x4){u[0], u[1], u[2], u[3]}; *(LAS f32x4*)(ut + rr * 256 + c0 + 4) = (f32x4){u[4], u[5], u[6], u[7]}; } }
        }
        __syncthreads();
        {
            const int c = tid & 255, half = tid >> 8;
            float w[31], win[46];
#pragma unroll
            for (int j = 0; j < 31; ++j) w[j] = p.conf_dw_w[(size_t)(l * 31 + j) * 256 + c];
            const float bias = p.conf_dw_b[l * 256 + c];
#pragma unroll
            for (int k = 0; k < 46; ++k) win[k] = ut[(half * 16 + k) * 256 + c];
#pragma unroll
            for (int tt = 0; tt < 16; ++tt) { float acc = bias;
#pragma unroll
                for (int j = 0; j < 31; ++j) acc += w[j] * win[tt + j];
                co[(half * 16 + tt) * 256 + c] = acc; }
        }
        __syncthreads();
#pragma unroll
        for (int i = 0; i < 4; ++i) {
            const int tl = wave * 4 + i;
            const f32x4 v = *(LAS f32x4*)(co + tl * 256 + lane * 4);
            const float mean = wave_sum(v[0] + v[1] + v[2] + v[3]) * (1.f / 256.f);
            const f32x4 d = v - mean;
            const float var = wave_sum(d[0] * d[0] + d[1] * d[1] + d[2] * d[2] + d[3] * d[3]) * (1.f / 256.f);
            const float rs = rsqrtf(var + 1e-5f);
            const f32x4 gg = *(const f32x4*)(p.conf_ln_g + l * 256 + lane * 4), bb = *(const f32x4*)(p.conf_ln_b + l * 256 + lane * 4);
            const f32x4 y = d * rs * gg + bb;
            u32x2 wv; wv.x = pk2(silu_f(y[0]), silu_f(y[1])); wv.y = pk2(silu_f(y[2]), silu_f(y[3]));
            *(u32x2*)(ycat + (size_t)(t0 + tl) * DM + 256 + lane * 4) = wv;
        }
    }
}

constexpr int SCAN_BLOCKS = 128, SCAN_BUF = 64512;
__device__ __forceinline__ void phase_scan(const int tidx, const P& p, int l, LAS unsigned char* L) {
    const int tid = tidx, lane = tid & 63, wave = tid >> 6, r = lane & 15, q = lane >> 4;
    if ((int)blockIdx.x >= SCAN_BLOCKS) {
        const int blk = blockIdx.x - SCAN_BLOCKS, nblk = gridDim.x - SCAN_BLOCKS;
        mixer_a(tidx, p, l, blk, nblk);
        mixer_b(tidx, p, l, blk, nblk, L);
        __syncthreads();
        {
            pg8::Gemm g{(const bf16_t*)(p.ws + WS_H), (const bf16_t*)(p.ws + WS_WIN) + ((size_t)l * NINP + 3072) * DM, MTOK, 512, DM}; pg8::StaticOrder S; S.init(MTOK, 512, nblk, blk);
            pg8::EpiProj E{(bf16_t*)(p.ws + WS_PROJ) + 3072, NINP}; pg8::gemm_phase<pg8::EpiProj>(tidx, L, g, S, E);
        }
        if (l + 1 < NL && ((MTOK / 256) * (NF1 / 256)) % (int)gridDim.x == 0) prep_transposes(tidx, p, L, l + 1, l + 2, blk, nblk);
        return;
    }
    const int item = blockIdx.x, xcd = item & 7, jj = item >> 3, s = jj & 7, bh = xcd * 2 + (jj >> 3), b = bh >> 2, h = bh & 3;
    const unsigned char* dl = p.ws + WS_DELTA;
    const float* alast = (const float*)(p.ws + WS_ALAST);
    bf16_t* obuf = (bf16_t*)(p.ws + WS_YCAT);
#define SB_ __builtin_amdgcn_sched_barrier(0)
#define SCAN_COMPUTE(buf, n_) do { \
            const float al = __builtin_bit_cast(float, __builtin_amdgcn_readlane(__builtin_bit_cast(int, al_all), (n_))); \
            const LAS bf16x8* Wf = (const LAS bf16x8*)((buf) + OFF_W) + lane; const LAS bf16x8* Qf = (const LAS bf16x8*)((buf) + OFF_Q) + lane; \
            const LAS bf16x8* Kf = (const LAS bf16x8*)((buf) + OFF_KT) + lane; const LAS bf16x8* QKf = (const LAS bf16x8*)((buf) + OFF_QK) + lane; \
            const LAS f32x4* Uf = (const LAS f32x4*)((buf) + OFF_U) + lane; \
            bf16x8 g0[8], g1[8]; f32x4 Uv[4]; \
            _Pragma("unroll") for (int f = 0; f < 8; ++f) g0[f] = Wf[((f >> 1) * 4 + (f & 1)) * 64];                \
            _Pragma("unroll") for (int f = 0; f < 8; ++f) g1[f] = Wf[((f >> 1) * 4 + 2 + (f & 1)) * 64];            \
            bf16x8 Sb[4]; \
            _Pragma("unroll") for (int kb = 0; kb < 4; ++kb) { u32x4 w; w.x = pk2(S[2 * kb][0], S[2 * kb][1]); w.y = pk2(S[2 * kb][2], S[2 * kb][3]); w.z = pk2(S[2 * kb + 1][0], S[2 * kb + 1][1]); w.w = pk2(S[2 * kb + 1][2], S[2 * kb + 1][3]); \
                Sb[kb] = __builtin_bit_cast(bf16x8, w); } \
            f32x4 Pv[4], O[4]; \
            _Pragma("unroll") for (int tb = 0; tb < 4; ++tb) { Pv[tb] = (f32x4){0.f, 0.f, 0.f, 0.f}; O[tb] = (f32x4){0.f, 0.f, 0.f, 0.f}; } \
            SB_; \
            _Pragma("unroll") for (int f = 0; f < 8; ++f) Pv[f >> 1] = MFMA16(g0[f], Sb[f & 1], Pv[f >> 1]); \
            _Pragma("unroll") for (int f = 0; f < 8; ++f) g0[f] = Qf[((f >> 1) * 4 + (f & 1)) * 64]; \
            SB_; \
            _Pragma("unroll") for (int f = 0; f < 8; ++f) Pv[f >> 1] = MFMA16(g1[f], Sb[2 + (f & 1)], Pv[f >> 1]); \
            _Pragma("unroll") for (int f = 0; f < 8; ++f) g1[f] = Qf[((f >> 1) * 4 + 2 + (f & 1)) * 64]; \
            _Pragma("unroll") for (int tb = 0; tb < 4; ++tb) Uv[tb] = Uf[tb * 64]; \
            SB_; \
            _Pragma("unroll") for (int f = 0; f < 8; ++f) O[f >> 1] = MFMA16(g0[f], Sb[f & 1], O[f >> 1]); \
            _Pragma("unroll") for (int f = 0; f < 8; ++f) g0[f] = Kf[(f * 2) * 64];                                  \
            SB_; \
            _Pragma("unroll") for (int f = 0; f < 8; ++f) O[f >> 1] = MFMA16(g1[f], Sb[2 + (f & 1)], O[f >> 1]); \
            _Pragma("unroll") for (int f = 0; f < 8; ++f) g1[f] = Kf[(f * 2 + 1) * 64];                              \
            _Pragma("unroll") for (int tb = 0; tb < 4; ++tb) Pv[tb] = Uv[tb] - Pv[tb]; \
            bf16x8 Vb[2]; \
            _Pragma("unroll") for (int kb = 0; kb < 2; ++kb) { u32x4 w; w.x = pk2(Pv[2 * kb][0], Pv[2 * kb][1]); w.y = pk2(Pv[2 * kb][2], Pv[2 * kb][3]); w.z = pk2(Pv[2 * kb + 1][0], Pv[2 * kb + 1][1]); w.w = pk2(Pv[2 * kb + 1][2], Pv[2 * kb + 1][3]); \
                Vb[kb] = __builtin_bit_cast(bf16x8, w); } \
            _Pragma("unroll") for (int db = 0; db < 8; ++db) S[db] = S[db] * al; \
            SB_; \
            _Pragma("unroll") for (int f = 0; f < 8; ++f) S[f] = MFMA16(g0[f], Vb[0], S[f]); \
            _Pragma("unroll") for (int f = 0; f < 8; ++f) if (f != 1 && f != 3) g0[f] = QKf[f * 64];                  \
            SB_; \
            _Pragma("unroll") for (int f = 0; f < 8; ++f) S[f] = MFMA16(g1[f], Vb[1], S[f]); \
            SB_; \
            _Pragma("unroll") for (int f = 0; f < 8; ++f) if (f != 1 && f != 3) O[f >> 1] = MFMA16(g0[f], Vb[f & 1], O[f >> 1]); \
            bf16_t* op = obuf + (size_t)(b * SEQ + (n_) * 64 + 4 * q) * DM + 512 + h * 128 + 16 * s + r; \
            _Pragma("unroll") for (int tb = 0; tb < 4; ++tb) \
                _Pragma("unroll") for (int j = 0; j < 4; ++j) op[(size_t)(16 * tb + j) * DM] = f2bf(O[tb][j]); \
        } while (0)
#define SCAN_BAR() do { asm volatile("s_waitcnt lgkmcnt(0)" ::: "memory"); __builtin_amdgcn_s_barrier(); asm volatile("" ::: "memory"); } while (0)
    LAS unsigned char* buf0 = L; LAS unsigned char* buf1 = L + SCAN_BUF;
    if (wave == 0) {
        const float al_all = alast[(b * 64 + lane) * 4 + h];
        f32x4 S[8];
#pragma unroll
        for (int i = 0; i < 8; ++i) S[i] = (f32x4){0.f, 0.f, 0.f, 0.f};
        SCAN_BAR();
        __builtin_amdgcn_s_setprio(3);
#pragma unroll 1
        for (int n = 0; n < 64; n += 2) {
            SCAN_COMPUTE(buf0, n);
            SCAN_BAR();
            SCAN_COMPUTE(buf1, n + 1);
            SCAN_BAR();
        }
        __builtin_amdgcn_s_setprio(0);
    } else {
        const int ct = tid - 64;
        const int off8 = (ct < 256) ? (OFF_U + s * 4096 + ct * 16) : ((ct - 256) * 16);
        const unsigned char* dlb = dl + (size_t)((b * 64) * 4 + h) * ITEM_BYTES;
        u32x4 R0[9], R1[9], R2[9], R3[9];
#define SCAN_LOAD(regs, n_) do { const int nn_ = ((n_) < 64) ? (n_) : 63; const unsigned char* itp_ = dlb + (size_t)nn_ * (4 * ITEM_BYTES); \
        _Pragma("unroll") for (int i_ = 0; i_ < 8; ++i_) regs[i_] = *(const u32x4*)(itp_ + (ct + 448 * i_) * 16); \
        regs[8] = *(const u32x4*)(itp_ + off8); __builtin_amdgcn_sched_barrier(0); } while (0)
#define SCAN_STORE(regs, buf_) do { _Pragma("unroll") for (int i_ = 0; i_ < 9; ++i_) *(LAS u32x4*)((buf_) + (ct + 448 * i_) * 16) = regs[i_]; } while (0)
        SCAN_LOAD(R0, 0); SCAN_LOAD(R1, 1); SCAN_LOAD(R2, 2); SCAN_LOAD(R3, 3);
        SCAN_STORE(R0, buf0);
        SCAN_BAR();
#pragma unroll 1
        for (int n = 0; n < 64; n += 4) {
            SCAN_LOAD(R0, n + 4); SCAN_STORE(R1, buf1); SCAN_BAR();
            SCAN_LOAD(R1, n + 5); SCAN_STORE(R2, buf0); SCAN_BAR();
            SCAN_LOAD(R2, n + 6); SCAN_STORE(R3, buf1); SCAN_BAR();
            SCAN_LOAD(R3, n + 7); SCAN_STORE(R0, buf0); SCAN_BAR();
        }
    }
#undef SCAN_COMPUTE
#undef SB_
#undef SCAN_BAR
#undef SCAN_LOAD
#undef SCAN_STORE
}

__device__ __forceinline__ void phase_onorm(const int tidx, const P& p, int l) {
    const bf16_t* proj = (const bf16_t*)(p.ws + WS_PROJ); bf16_t* ycat = (bf16_t*)(p.ws + WS_YCAT);
    const int sub = tidx & 15, d0 = sub * 8;
    const f32x4 g0 = *(const f32x4*)(p.dn_norm_g + l * 128 + d0), g1 = *(const f32x4*)(p.dn_norm_g + l * 128 + d0 + 4);
    for (int unit0 = (blockIdx.x * 32 + (tidx >> 4)) * 2; unit0 < MTOK * 4; unit0 += gridDim.x * 64) {
        u32x4 orw[2], zr[2];
#pragma unroll
        for (int uu = 0; uu < 2; ++uu) { const int t = (unit0 + uu) >> 2, h = (unit0 + uu) & 3;
            orw[uu] = *(const u32x4*)(ycat + (size_t)t * DM + 512 + h * 128 + d0);
            zr[uu] = *(const u32x4*)(proj + (size_t)t * NINP + 3072 + h * 128 + d0); }
#pragma unroll
        for (int uu = 0; uu < 2; ++uu) { const int t = (unit0 + uu) >> 2, h = (unit0 + uu) & 3;
            float o[8]; unpack8(orw[uu], o);
            float ss = 0.f;
#pragma unroll
            for (int i = 0; i < 8; ++i) ss += o[i] * o[i];
            ss += __shfl_xor(ss, 1); ss += __shfl_xor(ss, 2); ss += __shfl_xor(ss, 4); ss += __shfl_xor(ss, 8);
            const float rinv = rsqrtf(ss * (1.f / 128.f) + 1e-6f);
            float z[8]; unpack8(zr[uu], z);
            float y[8];
#pragma unroll
            for (int i = 0; i < 4; ++i) { y[i] = o[i] * rinv * g0[i] * silu_f(z[i]); y[4 + i] = o[4 + i] * rinv * g1[i] * silu_f(z[4 + i]); }
            *(u32x4*)(ycat + (size_t)t * DM + 512 + h * 128 + d0) = pack8(y); }
    }
}

#define XB_TMO      128
#define XB_XCNT(j)  (256  + 64 * (j))
#define XB_XSUB(j)  (1280 + 64 * (j))
#define XB_XGEN(j)  (2304 + 64 * (j))
#define XB_TOP      3328
#define XB_TOPGEN   3392
#define XCD_BAR_WORDS 3456
#define XB_SPIN_CAP (1u << 22)
__device__ __forceinline__ unsigned xb_ld(unsigned* p)              { return __hip_atomic_load(p, __ATOMIC_RELAXED, __HIP_MEMORY_SCOPE_AGENT); }
__device__ __forceinline__ unsigned xb_add(unsigned* p, unsigned v) { return __hip_atomic_fetch_add(p, v, __ATOMIC_RELAXED, __HIP_MEMORY_SCOPE_AGENT); }
__device__ __forceinline__ unsigned xb_xcc_id() { return (unsigned)__builtin_amdgcn_s_getreg((3 << 11) | 20) & 0xFu; }
#define XB_SPIN(cond, bar) do { unsigned _sp = 0; while (cond) { __builtin_amdgcn_s_sleep(1); \
    if ((++_sp & 255u) == 0u) { if (xb_ld(&(bar)[XB_TMO])) break; if (_sp > XB_SPIN_CAP) { atomicAdd(&(bar)[XB_TMO], 1u); break; } } } } while (0)
struct XcdBarrier { unsigned* bar; unsigned x; volatile LAS unsigned* st; };
__device__ __forceinline__ XcdBarrier xcd_barrier_post(unsigned* bar, volatile LAS unsigned* st) {
    XcdBarrier b; b.bar = bar; b.x = xb_xcc_id(); b.st = st;
    if (threadIdx.x == 0) (void)xb_add(&bar[XB_XCNT(b.x)], 1u);
    return b;
}
__device__ __forceinline__ void xcd_barrier_complete(unsigned* bar, unsigned x, unsigned& nloc, unsigned& nx) {
    const unsigned G = gridDim.x * gridDim.y * gridDim.z;
    unsigned sum, cnt, mine, sp = 0u;
    for (;;) {
        sum = 0u; cnt = 0u; mine = 0u;
#pragma unroll
        for (unsigned j = 0; j < 16; ++j) { const unsigned c = xb_ld(&bar[XB_XCNT(j)]); sum += c; cnt += (c > 0u) ? 1u : 0u; mine = (j == x) ? c : mine; }
        if (sum == G) break;
        __builtin_amdgcn_s_sleep(1);
        if ((++sp & 255u) == 0u) { if (xb_ld(&bar[XB_TMO])) break; if (sp > XB_SPIN_CAP) { atomicAdd(&bar[XB_TMO], 1u); break; } }
    }
    nloc = mine > 0u ? mine : 1u; nx = cnt > 0u ? cnt : 1u;
}
__device__ __forceinline__ void xcd_barrier(const XcdBarrier& b) {
    asm volatile("s_waitcnt vmcnt(0)" ::: "memory");
    __syncthreads();
    if (threadIdx.x == 0) {
        unsigned* bar = b.bar;
        __builtin_amdgcn_s_waitcnt(0);
        unsigned nloc = b.st[0], nx = b.st[1];
        if (nloc == 0u) { xcd_barrier_complete(bar, b.x, nloc, nx); b.st[0] = nloc; b.st[1] = nx; }
        const unsigned old = xb_add(&bar[XB_XSUB(b.x)], 1u);
        const unsigned gen = old / nloc;
        if (old + 1u == (gen + 1u) * nloc) {
            __builtin_amdgcn_fence(__ATOMIC_RELEASE, "agent");
            asm volatile("s_waitcnt vmcnt(0)" ::: "memory");
            const unsigned og = xb_add(&bar[XB_TOP], 1u);
            const unsigned tg = og / nx;
            if (og + 1u == (tg + 1u) * nx) xb_add(&bar[XB_TOPGEN], 1u);
            else XB_SPIN(xb_ld(&bar[XB_TOPGEN]) == tg, bar);
            __builtin_amdgcn_fence(__ATOMIC_ACQUIRE, "agent");
            xb_add(&bar[XB_XGEN(b.x)], 1u);
            asm volatile("s_waitcnt vmcnt(0)" ::: "memory");
        } else {
            XB_SPIN(xb_ld(&bar[XB_XGEN(b.x)]) == gen, bar);
            __builtin_amdgcn_fence(__ATOMIC_ACQUIRE, "agent");
            asm volatile("s_waitcnt vmcnt(0)" ::: "memory");
        }
    }
    __syncthreads();
}

template <int KIND>
__device__ __forceinline__ void run_kind(const int tidx, const P& p, int l, LAS unsigned char* L) {
    const float* modl = (const float*)(p.ws + WS_MOD) + (size_t)l * NB * NMOD;
    bf16_t* hbuf = (bf16_t*)(p.ws + WS_H); bf16_t* ycat = (bf16_t*)(p.ws + WS_YCAT); bf16_t* proj = (bf16_t*)(p.ws + WS_PROJ);
    const float* xin = (l == 0) ? p.x : p.out;
    if constexpr (KIND == 0) phase_prep(tidx, p, L);
    if constexpr (KIND == 1) phase_norm(tidx, xin, p.norm_mix_g + l * DM, modl, 0, DM, hbuf);
    if constexpr (KIND == 2) { pg8::Gemm g{hbuf, (const bf16_t*)(p.ws + WS_WIN) + (size_t)l * NINP * DM, MTOK, 3072, DM}; pg8::StaticOrder S; S.init(MTOK, 3072, gridDim.x, blockIdx.x);
        pg8::EpiProj E{proj, NINP}; pg8::gemm_phase<pg8::EpiProj>(tidx, L, g, S, E); }
    if constexpr (KIND == 3) phase_dprep(tidx, p, l, L);
    if constexpr (KIND == 4) phase_scan(tidx, p, l, L);
    if constexpr (KIND == 5) phase_onorm(tidx, p, l);
    if constexpr (KIND == 6) { pg8::Gemm g{ycat, (const bf16_t*)(p.ws + WS_WOUT) + (size_t)l * DM * DM, MTOK, DM, DM}; pg8::StaticOrder S; S.init(MTOK, DM, gridDim.x, blockIdx.x);
        pg8::EpiResid E{xin, p.out, modl + 2 * DM}; pg8::gemm_phase<pg8::EpiResid>(tidx, L, g, S, E); }
    if constexpr (KIND == 7) phase_norm(tidx, p.out, p.norm_ffn_g + l * DM, modl, 3 * DM, 4 * DM, hbuf);
    if constexpr (KIND == 8) { pg8::Gemm g{hbuf, (const bf16_t*)(p.ws + WS_WF1) + (size_t)l * NF1 * DM, MTOK, NF1, DM}; pg8::StaticOrder S; S.init(MTOK, NF1, gridDim.x, blockIdx.x);
        pg8::EpiSwiGLU E{proj}; pg8::gemm_phase<pg8::EpiSwiGLU>(tidx, L, g, S, E);
        const int rem = S.nwg % (int)gridDim.x;
        if (l + 1 < NL && rem != 0 && (int)blockIdx.x >= rem) prep_transposes(tidx, p, L, l + 1, l + 2, (int)blockIdx.x - rem, (int)gridDim.x - rem); }
    if constexpr (KIND == 9) { pg8::Gemm g{proj, (const bf16_t*)(p.ws + WS_WF2) + (size_t)l * DM * DFF, MTOK, DM, DFF}; pg8::StaticOrder S; S.init(MTOK, DM, gridDim.x, blockIdx.x);
        pg8::EpiResid E{p.out, p.out, modl + 5 * DM}; pg8::gemm_phase<pg8::EpiResid>(tidx, L, g, S, E); }
    if constexpr (KIND == 10) phase_final(tidx, p.out, p.final_norm_g);
}
__host__ __device__ inline void phase_decode(int ph, int& kind, int& l) {
    if (ph == 0) { kind = 0; l = 0; } else if (ph == NPH - 1) { kind = 10; l = 0; } else { l = (ph - 1) / 9; kind = 1 + (ph - 1) % 9; }
}

#if ONE_LAUNCH
__global__ void __launch_bounds__(512, 2) hymba_fwd(P p) {
    extern __shared__ __attribute__((aligned(16))) unsigned char lds_raw[];
    LAS unsigned char* L = (LAS unsigned char*)lds_raw;
    cg::grid_group grid = cg::this_grid();
    if (threadIdx.x < 16) ((LAS unsigned*)(L + LDS_BAR_OFF))[threadIdx.x] = 0u;
    __syncthreads();
    const XcdBarrier bar = xcd_barrier_post((unsigned*)(p.ws + WS_BAR), (volatile LAS unsigned*)(L + LDS_BAR_OFF));
    for (int ph = p.ph_lo; ph < p.ph_hi; ++ph) {
        if (p.ph_hi > NPH) grid.sync();
        if (ph > p.ph_lo) xcd_barrier(bar);
        int kind, l; phase_decode(ph, kind, l);
        int tidx = threadIdx.x; asm volatile("" : "+v"(tidx));
#if REPEAT_MASK
        if ((REPEAT_MASK >> kind) & 1) {
            switch (kind) { case 1: run_kind<1>(tidx, p, l, L); break; case 2: run_kind<2>(tidx, p, l, L); break; case 3: run_kind<3>(tidx, p, l, L); break; case 4: run_kind<4>(tidx, p, l, L); break;
                case 5: run_kind<5>(tidx, p, l, L); break; case 7: run_kind<7>(tidx, p, l, L); break; case 8: run_kind<8>(tidx, p, l, L); break; default: break; }
            __syncthreads();
        }
#endif
        switch (kind) {
        case 0: run_kind<0>(tidx, p, l, L); break; case 1: run_kind<1>(tidx, p, l, L); break; case 2: run_kind<2>(tidx, p, l, L); break; case 3: run_kind<3>(tidx, p, l, L); break;
        case 4: run_kind<4>(tidx, p, l, L); break; case 5: run_kind<5>(tidx, p, l, L); break; case 6: run_kind<6>(tidx, p, l, L); break; case 7: run_kind<7>(tidx, p, l, L); break;
        case 8: run_kind<8>(tidx, p, l, L); break; case 9: run_kind<9>(tidx, p, l, L); break; default: run_kind<10>(tidx, p, l, L); break;
        }
    }
}
#define LAUNCH_FN(kind) ((const void*)hymba_fwd)
#else
template <int KIND> __global__ void __launch_bounds__(512, 2) hymba_ph(P p) {
    extern __shared__ __attribute__((aligned(16))) unsigned char lds_raw[];
    run_kind<KIND>((int)threadIdx.x, p, p.ph_hi, (LAS unsigned char*)lds_raw);
}
static const void* ph_fn(int kind) {
    switch (kind) { case 0: return (const void*)hymba_ph<0>; case 1: return (const void*)hymba_ph<1>; case 2: return (const void*)hymba_ph<2>; case 3: return (const void*)hymba_ph<3>;
        case 4: return (const void*)hymba_ph<4>; case 5: return (const void*)hymba_ph<5>; case 6: return (const void*)hymba_ph<6>; case 7: return (const void*)hymba_ph<7>;
        case 8: return (const void*)hymba_ph<8>; case 9: return (const void*)hymba_ph<9>; default: return (const void*)hymba_ph<10>; }
}
#define LAUNCH_FN(kind) ph_fn(kind)
#endif

extern "C" void kernel_launch(void* const* d_in, const int* in_sizes, int n_in, void* d_out, int out_size, void* d_ws, size_t ws_size, hipStream_t stream) {
    static int grid = 0;
    if (grid == 0) {
        if (n_in != 20 || out_size != MTOK * DM || ws_size < WS_END) { fprintf(stderr, "kernel_launch: unexpected problem (n_in %d out %d ws %zu need %zu)\n", n_in, out_size, ws_size, (size_t)WS_END); grid = -1; return; }
        int dev = 0, cus = 0, per_cu = 0;
        (void)hipGetDevice(&dev); (void)hipDeviceGetAttribute(&cus, hipDeviceAttributeMultiprocessorCount, dev);
        for (int k = 0; k <= 10; ++k)
            if (hipFuncSetAttribute(LAUNCH_FN(k), hipFuncAttributeMaxDynamicSharedMemorySize, LDS_BYTES) != hipSuccess) { fprintf(stderr, "kernel_launch: hipFuncSetAttribute failed\n"); grid = -1; return; }
#if ONE_LAUNCH
        if (hipOccupancyMaxActiveBlocksPerMultiprocessor(&per_cu, (const void*)hymba_fwd, 512, LDS_BYTES) != hipSuccess || per_cu < 1) { fprintf(stderr, "kernel_launch: occupancy query failed (%d)\n", per_cu); (void)hipGetLastError(); per_cu = 1; }
#else
        per_cu = 1;
#endif
        grid = cus * per_cu;
        if (grid < SCAN_BLOCKS + 32) { fprintf(stderr, "kernel_launch: grid %d too small\n", grid); grid = -1; return; }
    }
    if (grid < 0) return;
    P p{};
    const float** pp = (const float**)&p;
    for (int i = 0; i < 20; ++i) pp[i] = (const float*)d_in[i];
    p.out = (float*)d_out; p.ws = (unsigned char*)d_ws;
#if ONE_LAUNCH
    p.ph_lo = 0; p.ph_hi = NPH;
    if (hipMemsetAsync((unsigned char*)d_ws + WS_BAR, 0, 16384, stream) != hipSuccess) { fprintf(stderr, "kernel_launch: memset of the barrier words failed\n"); return; }
    void* args[] = {&p};
    hipError_t e = hipLaunchCooperativeKernel((const void*)hymba_fwd, dim3(grid), dim3(512), args, LDS_BYTES, stream);
    if (e != hipSuccess) fprintf(stderr, "cooperative launch failed: %s (grid %d)\n", hipGetErrorString(e), grid);
#else
    for (int ph = 0; ph < NPH; ++ph) { int kind, l; phase_decode(ph, kind, l); p.ph_lo = kind; p.ph_hi = l; void* args[] = {&p};
        (void)hipLaunchKernel(ph_fn(kind), dim3(grid), dim3(512), args, LDS_BYTES, stream); }
#endif
}
```

```cpp
#include <hip/hip_runtime.h>
#include <hip/hip_cooperative_groups.h>
#include <cstdio>
namespace cg = cooperative_groups;

#ifndef ONE_LAUNCH
#define ONE_LAUNCH 1
#endif
#ifndef REPEAT_MASK
#define REPEAT_MASK 0
#endif

#define LAS __attribute__((address_space(3)))
typedef unsigned short bf16_t;
typedef short bf16x8 __attribute__((ext_vector_type(8)));
typedef float f32x4 __attribute__((ext_vector_type(4)));
typedef float f32x2 __attribute__((ext_vector_type(2)));
typedef unsigned u32x4 __attribute__((ext_vector_type(4)));
typedef unsigned u32x2 __attribute__((ext_vector_type(2)));
typedef __bf16 nbf16x2 __attribute__((ext_vector_type(2)));

constexpr int MTOK = 16384, DM = 1024, NL = 4, NB = 4, SEQ = 4096;
constexpr int NIN = 3336, NINP = 3584, DFF = 2816, NF1 = 2 * DFF, NMOD = 6 * DM;
constexpr int LDS_BYTES = 131072 + 64 + 6144 + 17408, LDS_BAR_OFF = 131072, LDS_CW_OFF = 131072 + 64, LDS_TF_OFF = LDS_CW_OFF + 6144;
constexpr int NPH = 1 + 9 * NL + 1;

constexpr size_t SZ_WIN = (size_t)NL * NINP * DM * 2, SZ_WOUT = (size_t)NL * DM * DM * 2, SZ_WF1 = (size_t)NL * NF1 * DM * 2, SZ_WF2 = (size_t)NL * DM * DFF * 2;
constexpr size_t WS_WIN = 0, WS_WOUT = WS_WIN + SZ_WIN, WS_WF1 = WS_WOUT + SZ_WOUT, WS_WF2 = WS_WF1 + SZ_WF1;
constexpr size_t WS_MOD = WS_WF2 + SZ_WF2;
constexpr size_t WS_ALAST = WS_MOD + (size_t)NL * NB * NMOD * 4;
constexpr size_t WS_H = WS_ALAST + 4096;
constexpr size_t WS_YCAT = WS_H + (size_t)MTOK * DM * 2;
constexpr size_t WS_PROJ = WS_YCAT + (size_t)MTOK * DM * 2;
constexpr int ITEM_BYTES = 90112, OFF_W = 0, OFF_Q = 16384, OFF_KT = 32768, OFF_QK = 49152, OFF_U = 57344;
constexpr size_t WS_DELTA = WS_PROJ + (size_t)MTOK * NINP * 2;
constexpr size_t WS_BAR = WS_DELTA + (size_t)1024 * ITEM_BYTES;
constexpr size_t WS_END = WS_BAR + 32768;

struct P {
    const float *x, *c, *w_ada, *b_ada, *norm_mix_g, *norm_ffn_g, *w_in, *conv_a_w, *conf_dw_w, *conf_dw_b, *conf_ln_g, *conf_ln_b,
        *dn_conv_w, *dn_a_log, *dn_dt_bias, *dn_norm_g, *w_out, *w_ffn_in, *w_ffn_out, *final_norm_g;
    float* out; unsigned char* ws; int ph_lo, ph_hi;
};

__device__ __forceinline__ float bf2f(bf16_t v) { return __uint_as_float(((unsigned)v) << 16); }
__device__ __forceinline__ unsigned pk2(float a, float b) { f32x2 v = {a, b}; nbf16x2 r = __builtin_convertvector(v, nbf16x2); return __builtin_bit_cast(unsigned, r); }
__device__ __forceinline__ bf16_t f2bf(float a) { return (bf16_t)(pk2(a, 0.f) & 0xffffu); }
__device__ __forceinline__ float lo16(unsigned w) { return __uint_as_float(w << 16); }
__device__ __forceinline__ float hi16(unsigned w) { return __uint_as_float(w & 0xffff0000u); }
__device__ __forceinline__ float sigmoid_f(float v) { return __builtin_amdgcn_rcpf(1.f + __expf(-v)); }
__device__ __forceinline__ float silu_f(float v) { return v * sigmoid_f(v); }
__device__ __forceinline__ float wave_sum(float v) {
#pragma unroll
    for (int o = 32; o; o >>= 1) v += __shfl_xor(v, o);
    return v;
}
__device__ __forceinline__ void unpack8(const u32x4 w, float (&f)[8]) {
    f[0] = lo16(w.x); f[1] = hi16(w.x); f[2] = lo16(w.y); f[3] = hi16(w.y); f[4] = lo16(w.z); f[5] = hi16(w.z); f[6] = lo16(w.w); f[7] = hi16(w.w);
}
__device__ __forceinline__ u32x4 pack8(const float (&f)[8]) { u32x4 w; w.x = pk2(f[0], f[1]); w.y = pk2(f[2], f[3]); w.z = pk2(f[4], f[5]); w.w = pk2(f[6], f[7]); return w; }
#define MFMA16(a, b, c) __builtin_amdgcn_mfma_f32_16x16x32_bf16((a), (b), (c), 0, 0, 0)

namespace pg8 {
constexpr int BM = 256, BK = 64, HALF = 128, HTB = HALF * BK * 2, STAGE_BYTES = 8 * HTB, NXCD = 8, WGM = 8;
__host__ __device__ __forceinline__ int lds_byte(int r, int c) { const int st = (r >> 4) * 2 + (c >> 5), rr = r & 15, cc = c & 31, ob = rr * 64 + cc * 2; return st * 1024 + (ob ^ (((ob >> 9) & 1) << 5)); }
__host__ __device__ __forceinline__ void stage_rc(int b, int& R, int& C) { const int st = b / 1024, sb = b % 1024, swz = sb ^ (((sb >> 9) & 1) << 5); R = (st >> 1) * 16 + swz / 64; C = (st & 1) * 32 + (swz % 64) / 2; }
__host__ __device__ __forceinline__ int perm32(int rho) { const int n = rho >> 4, i = rho & 15; return 8 * (i >> 2) + 4 * n + (i & 3); }
struct Unit { int pm, pn; };
struct Gemm { const bf16_t* A; const bf16_t* Bt; int M, N, K; };
struct StaticOrder {
    int nM, nN, nwg, G, c;
    __device__ void init(int M, int N, int G_, int c_) { nM = M / BM; nN = N / BM; nwg = nM * nN; G = G_; c = c_; }
    __device__ bool next(int i, Unit& u) const {
        const long L = (long)i * G + c; if (L >= nwg) return false;
        int wgid = (int)L; { const int q = nwg / NXCD, r = nwg % NXCD, xcd = wgid % NXCD, off = wgid / NXCD; wgid = (xcd < r ? xcd * (q + 1) : r * (q + 1) + (xcd - r) * q) + off; }
        const int nig = WGM * nN, gid = wgid / nig, fm = gid * WGM, gsz = (nM - fm) < WGM ? (nM - fm) : WGM;
        u.pm = fm + ((wgid % nig) % gsz); u.pn = (wgid % nig) / gsz; return true;
    }
};

struct EpiProj {
    static constexpr bool PERM = true;
    bf16_t* O; int ldc;
    __device__ __forceinline__ void operator()(const f32x4 (&acc)[2][2][4][2], const Unit& u, int wr, int wc, int fr, int fq) const {
        const int row0 = u.pm * BM + wr * 64 + fr, col0 = u.pn * BM + wc * 32 + 8 * fq;
#pragma unroll
        for (int ai = 0; ai < 2; ++ai)
#pragma unroll
            for (int m = 0; m < 4; ++m) { bf16_t* rowp = O + (size_t)(row0 + ai * HALF + m * 16) * ldc + col0;
#pragma unroll
                for (int bj = 0; bj < 2; ++bj) { const f32x4 v0 = acc[ai][bj][m][0], v1 = acc[ai][bj][m][1];
                    u32x4 w; w.x = pk2(v0[0], v0[1]); w.y = pk2(v0[2], v0[3]); w.z = pk2(v1[0], v1[1]); w.w = pk2(v1[2], v1[3]);
                    *(u32x4*)(rowp + bj * HALF) = w; } }
    }
};
struct EpiSwiGLU {
    static constexpr bool PERM = true;
    bf16_t* O;
    __device__ __forceinline__ void operator()(const f32x4 (&acc)[2][2][4][2], const Unit& u, int wr, int wc, int fr, int fq) const {
        const int row0 = u.pm * BM + wr * 64 + fr, col0 = u.pn * HALF + wc * 32 + 8 * fq;
#pragma unroll
        for (int ai = 0; ai < 2; ++ai)
#pragma unroll
            for (int m = 0; m < 4; ++m) {
                const f32x4 g0 = acc[ai][0][m][0], g1 = acc[ai][0][m][1], u0 = acc[ai][1][m][0], u1 = acc[ai][1][m][1];
                float v[8];
#pragma unroll
                for (int i = 0; i < 4; ++i) { v[i] = silu_f(g0[i]) * u0[i]; v[4 + i] = silu_f(g1[i]) * u1[i]; }
                *(u32x4*)(O + (size_t)(row0 + ai * HALF + m * 16) * DFF + col0) = pack8(v);
            }
    }
};
struct EpiResid {
    static constexpr bool PERM = false;
    const float* base; float* out; const float* gate;
    __device__ __forceinline__ void operator()(const f32x4 (&acc)[2][2][4][2], const Unit& u, int wr, int wc, int fr, int fq) const {
        const int row0 = u.pm * BM + wr * 64 + fr, col0 = u.pn * BM + wc * 32 + 4 * fq;
        const float* gp = gate + (size_t)(u.pm >> 4) * NMOD + col0;
        f32x4 gv[2][2];
#pragma unroll
        for (int bj = 0; bj < 2; ++bj)
#pragma unroll
            for (int n = 0; n < 2; ++n) gv[bj][n] = *(const f32x4*)(gp + bj * HALF + n * 16);
#pragma unroll
        for (int ai = 0; ai < 2; ++ai) {
            f32x4 bv[4][2][2];
#pragma unroll
            for (int m = 0; m < 4; ++m) { const size_t ro = (size_t)(row0 + ai * HALF + m * 16) * DM + col0;
#pragma unroll
                for (int bj = 0; bj < 2; ++bj)
#pragma unroll
                    for (int n = 0; n < 2; ++n) bv[m][bj][n] = *(const f32x4*)(base + ro + bj * HALF + n * 16); }
#pragma unroll
            for (int m = 0; m < 4; ++m) { const size_t ro = (size_t)(row0 + ai * HALF + m * 16) * DM + col0;
#pragma unroll
                for (int bj = 0; bj < 2; ++bj)
#pragma unroll
                    for (int n = 0; n < 2; ++n) *(f32x4*)(out + ro + bj * HALF + n * 16) = bv[m][bj][n] + gv[bj][n] * acc[ai][bj][m][n]; }
        }
    }
};

template <class Epi>
__device__ __forceinline__ void gemm_phase(const int tidx, LAS unsigned char* lds, const Gemm g, const StaticOrder& S, const Epi& E) {
    const int tid = tidx, wid = __builtin_amdgcn_readfirstlane(tid >> 6), lane = tid & 63, wr = wid >> 2, wc = wid & 3, fr = lane & 15, fq = lane >> 4;
    const int K = g.K, nt = K / BK;
    unsigned voffA[2], voffB[2];
#pragma unroll
    for (int i = 0; i < 2; ++i) { int R, C; stage_rc(tid * 16 + i * 8192, R, C); const int Rb = Epi::PERM ? ((R & ~31) + perm32(R & 31)) : R;
        voffA[i] = (unsigned)(R * K + C) * 2u; voffB[i] = (unsigned)(Rb * K + C) * 2u; }
    const size_t kstep = (size_t)(BK * 2);
    const size_t hstep = (size_t)HALF * K * 2;
    const size_t tstep = 2 * hstep;
    const unsigned ldsw = (unsigned)wid * 1024u;
    const int aoff = lds_byte(wr * 64 + fr, fq * 8), boff = lds_byte(wc * 32 + fr, fq * 8);
#define PG8_SA(b, h) (((b) * 2 + (h)) * HTB)
#define PG8_SB(b, h) ((4 + (b) * 2 + (h)) * HTB)
#define PG8_STAGE(bufoff, gbase, voff) do { _Pragma("unroll") for (int _i = 0; _i < 2; ++_i) \
        __builtin_amdgcn_global_load_lds((const unsigned*)((const char*)(gbase) + (voff)[_i]), (LAS unsigned*)(lds + (bufoff) + ldsw + _i * 8192), 16, 0, 0); } while (0)
#define PG8_LDA(dst, b, h) do { _Pragma("unroll") for (int m = 0; m < 4; ++m) _Pragma("unroll") for (int k = 0; k < 2; ++k) dst[m][k] = *(const LAS bf16x8*)(lds + PG8_SA(b, h) + aoff + m * 2048 + k * 1024); } while (0)
#define PG8_LDB(dst, b, h) do { _Pragma("unroll") for (int n = 0; n < 2; ++n) _Pragma("unroll") for (int k = 0; k < 2; ++k) dst[n][k] = *(const LAS bf16x8*)(lds + PG8_SB(b, h) + boff + n * 2048 + k * 1024); } while (0)
#define PG8_MMA(ai, bj, At, Bt) do { __builtin_amdgcn_s_setprio(1); _Pragma("unroll") for (int m = 0; m < 4; ++m) _Pragma("unroll") for (int n = 0; n < 2; ++n) _Pragma("unroll") for (int k = 0; k < 2; ++k) \
        acc[ai][bj][m][n] = __builtin_amdgcn_mfma_f32_16x16x32_bf16(Bt[n][k], At[m][k], acc[ai][bj][m][n], 0, 0, 0); __builtin_amdgcn_s_setprio(0); } while (0)
#define PG8_WAIT_V(n) asm volatile("s_waitcnt vmcnt(" #n ")" ::: "memory")
#define PG8_WAIT_L(n) asm volatile("s_waitcnt lgkmcnt(" #n ")" ::: "memory")
#define PG8_BAR __builtin_amdgcn_s_barrier()
#define PG8_SCHED __builtin_amdgcn_sched_barrier(0)
    Unit cur, nxt; int ui = 0;
    if (!S.next(0, cur)) return;
    f32x4 acc[2][2][4][2];
#pragma unroll
    for (int a = 0; a < 2; ++a)
#pragma unroll
        for (int b = 0; b < 2; ++b)
#pragma unroll
            for (int m = 0; m < 4; ++m)
#pragma unroll
                for (int n = 0; n < 2; ++n) acc[a][b][m][n] = (f32x4){0.f, 0.f, 0.f, 0.f};
    bf16x8 At[4][2], B0[2][2], B1[2][2];
    const char* cA = (const char*)g.A + (size_t)cur.pm * tstep; const char* cB = (const char*)g.Bt + (size_t)cur.pn * tstep;
    PG8_STAGE(PG8_SB(0, 0), cB, voffB); PG8_STAGE(PG8_SA(0, 0), cA, voffA); PG8_STAGE(PG8_SB(0, 1), cB + hstep, voffB); PG8_STAGE(PG8_SA(0, 1), cA + hstep, voffA);
    if (wr == 1) PG8_BAR;
    PG8_WAIT_V(4); PG8_BAR;
    PG8_STAGE(PG8_SB(1, 0), cB + kstep, voffB); PG8_STAGE(PG8_SA(1, 0), cA + kstep, voffA); PG8_STAGE(PG8_SB(1, 1), cB + hstep + kstep, voffB);
    PG8_WAIT_V(6); PG8_BAR;
    for (;;) {
        const bool has_next = S.next(ui + 1, nxt);
        const char* nA = has_next ? (const char*)g.A + (size_t)nxt.pm * tstep : cA; const char* nB = has_next ? (const char*)g.Bt + (size_t)nxt.pn * tstep : cB;
        for (int t = 0; t < nt; t += 2) {
            const bool last = (t == nt - 2);
            const char* a1 = cA + (size_t)(t + 1) * kstep;
            const char* a2 = last ? nA : cA + (size_t)(t + 2) * kstep; const char* b2 = last ? nB : cB + (size_t)(t + 2) * kstep;
            const char* a3 = a2 + kstep; const char* b3 = b2 + kstep;
            PG8_LDB(B0, 0, 0); PG8_SCHED; PG8_LDA(At, 0, 0); PG8_STAGE(PG8_SA(1, 1), a1 + hstep, voffA);
            PG8_WAIT_L(8); PG8_BAR; PG8_WAIT_L(0); PG8_MMA(0, 0, At, B0); PG8_BAR; PG8_SCHED;
            PG8_LDB(B1, 0, 1); PG8_STAGE(PG8_SB(0, 0), b2, voffB);
            PG8_BAR; PG8_WAIT_L(0); PG8_MMA(0, 1, At, B1); PG8_BAR;
            PG8_LDA(At, 0, 1); PG8_STAGE(PG8_SA(0, 0), a2, voffA);
            PG8_BAR; PG8_WAIT_L(0); PG8_MMA(1, 0, At, B0); PG8_BAR; PG8_SCHED;
            PG8_STAGE(PG8_SB(0, 1), b2 + hstep, voffB);
            PG8_WAIT_V(6); PG8_BAR; PG8_MMA(1, 1, At, B1); PG8_BAR;
            PG8_LDB(B0, 1, 0); PG8_SCHED; PG8_LDA(At, 1, 0); PG8_STAGE(PG8_SA(0, 1), a2 + hstep, voffA);
            PG8_WAIT_L(8); PG8_BAR; PG8_WAIT_L(0); PG8_MMA(0, 0, At, B0); PG8_BAR; PG8_SCHED;
            PG8_LDB(B1, 1, 1); PG8_STAGE(PG8_SB(1, 0), b3, voffB);
            PG8_BAR; PG8_WAIT_L(0); PG8_MMA(0, 1, At, B1); PG8_BAR;
            PG8_LDA(At, 1, 1); PG8_STAGE(PG8_SA(1, 0), a3, voffA);
            PG8_BAR; PG8_WAIT_L(0); PG8_MMA(1, 0, At, B0); PG8_BAR; PG8_SCHED;
            PG8_STAGE(PG8_SB(1, 1), b3 + hstep, voffB);
            PG8_WAIT_V(6); PG8_BAR; PG8_MMA(1, 1, At, B1); PG8_BAR;
        }
        E(acc, cur, wr, wc, fr, fq);
        if (!has_next) break;
#pragma unroll
        for (int a = 0; a < 2; ++a)
#pragma unroll
            for (int b = 0; b < 2; ++b)
#pragma unroll
                for (int m = 0; m < 4; ++m)
#pragma unroll
                    for (int n = 0; n < 2; ++n) acc[a][b][m][n] = (f32x4){0.f, 0.f, 0.f, 0.f};
        cur = nxt; cA = nA; cB = nB; ++ui;
    }
    PG8_WAIT_V(0);
    if (wr == 0) PG8_BAR;
    PG8_BAR;
#undef PG8_SA
#undef PG8_SB
#undef PG8_STAGE
#undef PG8_LDA
#undef PG8_LDB
#undef PG8_MMA
#undef PG8_WAIT_V
#undef PG8_WAIT_L
#undef PG8_BAR
#undef PG8_SCHED
}
}

__device__ __forceinline__ void prep_transposes(const int tidx, const P& p, LAS unsigned char* L, int l0, int l1, int blk, int nblk);
__device__ __forceinline__ void phase_prep(const int tidx, const P& p, LAS unsigned char* L) {
    const int tid = tidx;
    constexpr int NADA = NL * 96, TPL = 3264, TOTAL = NADA + NL * TPL;
    float* mod = (float*)(p.ws + WS_MOD);
    for (int it = blockIdx.x; it < NADA; it += gridDim.x) {
        __syncthreads();
        {
            const int l = it / 96, n0 = (it % 96) * 64;
            LAS float* cact = (LAS float*)L;
            LAS float* red = cact + 4096;
            for (int i = tid; i < 4096; i += 512) cact[i] = silu_f(p.c[i]);
            __syncthreads();
            const int kg = tid >> 6, nn = tid & 63;
            const float* w = p.w_ada + ((size_t)l * DM + kg * 128) * NMOD + n0 + nn;
            float a0 = 0.f, a1 = 0.f, a2 = 0.f, a3 = 0.f;
#pragma unroll 8
            for (int k = 0; k < 128; ++k) { const float wv = w[(size_t)k * NMOD]; const int kk = kg * 128 + k;
                a0 += cact[kk] * wv; a1 += cact[1024 + kk] * wv; a2 += cact[2048 + kk] * wv; a3 += cact[3072 + kk] * wv; }
            red[(kg * 4 + 0) * 64 + nn] = a0; red[(kg * 4 + 1) * 64 + nn] = a1; red[(kg * 4 + 2) * 64 + nn] = a2; red[(kg * 4 + 3) * 64 + nn] = a3;
            __syncthreads();
            if (tid < 256) { const int b = tid >> 6; float s = p.b_ada[l * NMOD + n0 + nn];
#pragma unroll
                for (int k2 = 0; k2 < 8; ++k2) s += red[(k2 * 4 + b) * 64 + nn];
                mod[(size_t)(l * NB + b) * NMOD + n0 + nn] = s; }
        }
    }
    prep_transposes(tidx, p, L, 0, 1, blockIdx.x, gridDim.x);
}
__device__ __forceinline__ void prep_transposes(const int tidx, const P& p, LAS unsigned char* L, int l0, int l1, int blk, int nblk) {
    const int tid = tidx;
    constexpr int TPL = 3264;
    for (int it0 = l0 * TPL + blk * 4; it0 < l1 * TPL; it0 += nblk * 4) {
        __syncthreads();
        bf16_t* dstp[4]; int kd[4];
#pragma unroll
        for (int tt = 0; tt < 4; ++tt) {
            const int j = it0 + tt, l = j / TPL; int r = j % TPL;
            const float* src; bf16_t* dst; int Ns, Nvalid, Kd, k0, ns0, nd0;
            if (r < 896) { const int kt = r / 56, nt = r % 56; src = p.w_in + (size_t)l * DM * NIN; Ns = NIN; Nvalid = NIN; Kd = DM; k0 = kt * 64; nd0 = nt * 64;
                ns0 = (nd0 < 2816) ? nd0 : ((nd0 < 3072) ? 3328 + (nd0 - 2816) : 2816 + (nd0 - 3072));
                dst = (bf16_t*)(p.ws + WS_WIN) + (size_t)l * NINP * DM; }
            else if (r < 1152) { r -= 896; const int kt = r / 16, nt = r % 16; src = p.w_out + (size_t)l * DM * DM; Ns = DM; Nvalid = DM; Kd = DM; k0 = kt * 64; nd0 = nt * 64; ns0 = nd0;
                dst = (bf16_t*)(p.ws + WS_WOUT) + (size_t)l * DM * DM; }
            else if (r < 2560) { r -= 1152; const int kt = r / 88, nt = r % 88; src = p.w_ffn_in + (size_t)l * DM * NF1; Ns = NF1; Nvalid = NF1; Kd = DM; k0 = kt * 64; nd0 = nt * 64;
                const int pn = nd0 >> 8, half = (nd0 >> 7) & 1, sub = nd0 & 127; ns0 = half * DFF + pn * 128 + sub;
                dst = (bf16_t*)(p.ws + WS_WF1) + (size_t)l * NF1 * DM; }
            else { r -= 2560; const int kt = r / 16, nt = r % 16; src = p.w_ffn_out + (size_t)l * DFF * DM; Ns = DM; Nvalid = DM; Kd = DFF; k0 = kt * 64; nd0 = nt * 64; ns0 = nd0;
                dst = (bf16_t*)(p.ws + WS_WF2) + (size_t)l * DM * DFF; }
            LAS float* tile = (LAS float*)L + tt * (64 * 65);
            const int kk = tid >> 4, c4 = (tid & 15) * 4;
            f32x4 v0 = {0.f, 0.f, 0.f, 0.f}, v1 = {0.f, 0.f, 0.f, 0.f};
            if (ns0 + c4 < Nvalid) { v0 = *(const f32x4*)(src + (size_t)(k0 + kk) * Ns + ns0 + c4); v1 = *(const f32x4*)(src + (size_t)(k0 + kk + 32) * Ns + ns0 + c4); }
            tile[kk * 65 + c4 + 0] = v0[0]; tile[kk * 65 + c4 + 1] = v0[1]; tile[kk * 65 + c4 + 2] = v0[2]; tile[kk * 65 + c4 + 3] = v0[3];
            tile[(kk + 32) * 65 + c4 + 0] = v1[0]; tile[(kk + 32) * 65 + c4 + 1] = v1[1]; tile[(kk + 32) * 65 + c4 + 2] = v1[2]; tile[(kk + 32) * 65 + c4 + 3] = v1[3];
            dstp[tt] = dst + (size_t)nd0 * Kd + k0; kd[tt] = Kd;
        }
        __syncthreads();
#pragma unroll
        for (int tt = 0; tt < 4; ++tt) {
            LAS float* tile = (LAS float*)L + tt * (64 * 65);
            const int nn = tid >> 3, k8 = (tid & 7) * 8; float f[8];
#pragma unroll
            for (int i = 0; i < 8; ++i) f[i] = tile[(k8 + i) * 65 + nn];
            *(u32x4*)(dstp[tt] + (size_t)nn * kd[tt] + k8) = pack8(f);
        }
    }
}

__device__ __forceinline__ void phase_norm(const int tidx, const float* xin, const float* g, const float* modl, int shoff, int scoff, bf16_t* hout) {
    const int wave = tidx >> 6, lane = tidx & 63;
    constexpr int NR = 4;
    const bool own = (gridDim.x == 256);
    const int rbeg = (((int)blockIdx.x & 7) * 8) * 256 + ((int)blockIdx.x >> 3) * 64;
    for (int it = 0; ; ++it) {
        int row0;
        if (own) { if (it >= 8 / NR) break; row0 = rbeg + wave * 8 + it * NR; }
        else { row0 = ((int)blockIdx.x * 8 + wave) * NR + it * (int)gridDim.x * 8 * NR; if (row0 >= MTOK) break; }
        const int b = row0 >> 12;
        f32x4 v[NR][4], gg[4], sc[4], sh[4];
#pragma unroll
        for (int rr = 0; rr < NR; ++rr)
#pragma unroll
            for (int i = 0; i < 4; ++i) v[rr][i] = *(const f32x4*)(xin + (size_t)(row0 + rr) * DM + i * 256 + lane * 4);
#pragma unroll
        for (int i = 0; i < 4; ++i) { const int k = i * 256 + lane * 4;
            gg[i] = *(const f32x4*)(g + k); sc[i] = *(const f32x4*)(modl + (size_t)b * NMOD + scoff + k); sh[i] = *(const f32x4*)(modl + (size_t)b * NMOD + shoff + k); }
#pragma unroll
        for (int rr = 0; rr < NR; ++rr) {
            float ss = 0.f;
#pragma unroll
            for (int i = 0; i < 4; ++i) ss += v[rr][i][0] * v[rr][i][0] + v[rr][i][1] * v[rr][i][1] + v[rr][i][2] * v[rr][i][2] + v[rr][i][3] * v[rr][i][3];
            ss = wave_sum(ss);
            const float rinv = rsqrtf(ss * (1.f / DM) + 1e-6f);
#pragma unroll
            for (int i = 0; i < 4; ++i) { const int k = i * 256 + lane * 4;
                const f32x4 y = v[rr][i] * rinv * gg[i] * (sc[i] + 1.f) + sh[i];
                u32x2 w; w.x = pk2(y[0], y[1]); w.y = pk2(y[2], y[3]);
                *(u32x2*)(hout + (size_t)(row0 + rr) * DM + k) = w; }
        }
    }
}
__device__ __forceinline__ void phase_final(const int tidx, float* x, const float* g) {
    const int wave = tidx >> 6, lane = tidx & 63;
    constexpr int NR = 4;
    for (int row0 = (blockIdx.x * 8 + wave) * NR; row0 < MTOK; row0 += gridDim.x * 8 * NR) {
        f32x4 v[NR][4], gg[4];
#pragma unroll
        for (int rr = 0; rr < NR; ++rr)
#pragma unroll
            for (int i = 0; i < 4; ++i) v[rr][i] = *(const f32x4*)(x + (size_t)(row0 + rr) * DM + i * 256 + lane * 4);
#pragma unroll
        for (int i = 0; i < 4; ++i) gg[i] = *(const f32x4*)(g + i * 256 + lane * 4);
#pragma unroll
        for (int rr = 0; rr < NR; ++rr) {
            float ss = 0.f;
#pragma unroll
            for (int i = 0; i < 4; ++i) ss += v[rr][i][0] * v[rr][i][0] + v[rr][i][1] * v[rr][i][1] + v[rr][i][2] * v[rr][i][2] + v[rr][i][3] * v[rr][i][3];
            ss = wave_sum(ss);
            const float rinv = rsqrtf(ss * (1.f / DM) + 1e-6f);
#pragma unroll
            for (int i = 0; i < 4; ++i) *(f32x4*)(x + (size_t)(row0 + rr) * DM + i * 256 + lane * 4) = v[rr][i] * rinv * gg[i];
        }
    }
}

__device__ __forceinline__ void phase_dprep(const int tidx, const P& p, int l, LAS unsigned char* L) {
    LAS bf16_t* Qn = (LAS bf16_t*)(L + 0);
    LAS bf16_t* Kn = (LAS bf16_t*)(L + 17408);
    LAS bf16_t* KbgT = (LAS bf16_t*)(L + 34816);
    LAS bf16_t* KtlT = (LAS bf16_t*)(L + 53248);
    LAS bf16_t* VbT = (LAS bf16_t*)(L + 71680);
    LAS float* Lm = (LAS float*)(L + 90112);
    LAS bf16_t* Tm = (LAS bf16_t*)(L + 107520);
    LAS bf16_t* QKm = (LAS bf16_t*)(L + 116736);
    LAS float* gcs = (LAS float*)(L + 125952);
    LAS float* betas = gcs + 64;
    LAS float* cwl = (LAS float*)(L + LDS_CW_OFF);
    LAS float* Tf = (LAS float*)(L + LDS_TF_OFF);
    const bf16_t* proj = (const bf16_t*)(p.ws + WS_PROJ);
    float* alast = (float*)(p.ws + WS_ALAST);
    u32x4 rawA[7], rawB[7]; float cwreg[4], alpha_r = 0.f, beta_r = 0.f;
#define DP_ISSUE(it_, tid_) do { const int h_ = (it_) & 3, n_ = ((it_) >> 2) & 63, t0_ = ((it_) >> 8) * SEQ + n_ * 64; \
        const int tk0_ = (((tid_) >> 4) & 15) * 4, d0_ = ((tid_) & 15) * 8; \
        _Pragma("unroll") for (int rr = 0; rr < 7; ++rr) { const int pos = n_ * 64 + tk0_ - 3 + rr; \
            rawA[rr] = (u32x4){0u, 0u, 0u, 0u}; rawB[rr] = (u32x4){0u, 0u, 0u, 0u}; \
            if (pos >= 0) { const bf16_t* pr = proj + (size_t)(t0_ + tk0_ - 3 + rr) * NINP + 1280 + h_ * 128 + d0_; \
                rawA[rr] = *(const u32x4*)(pr + ((tid_) >> 8) * 512); \
                if ((tid_) < 256) rawB[rr] = *(const u32x4*)(pr + 1024); } } \
        if ((tid_) < 384) { _Pragma("unroll") for (int j = 0; j < 4; ++j) cwreg[j] = p.dn_conv_w[(size_t)(l * 4 + j) * 1536 + ((tid_) >> 7) * 512 + h_ * 128 + ((tid_) & 127)]; } \
        if (((tid_) >> 6) == 7) { const bf16_t* pr = proj + (size_t)(t0_ + ((tid_) & 63)) * NINP; alpha_r = bf2f(pr[2816 + h_]); beta_r = bf2f(pr[2820 + h_]); } } while (0)
    if ((int)blockIdx.x < 1024) DP_ISSUE((int)blockIdx.x, tidx);
    for (int item = blockIdx.x; item < 1024; item += gridDim.x) {
        __syncthreads();
        int tid = tidx; asm volatile("" : "+v"(tid));
        const int lane = tid & 63, wave = tid >> 6, r = lane & 15, q = lane >> 4;
        const int h = item & 3, n = (item >> 2) & 63, b = item >> 8;
        const int t0 = b * SEQ + n * 64;
        unsigned char* itp = p.ws + WS_DELTA + (size_t)item * ITEM_BYTES;
        const int run = (tid >> 4) & 15, d0 = (tid & 15) * 8, tk0 = run * 4, whichA = tid >> 8;
        if (tid < 384) {
#pragma unroll
            for (int j = 0; j < 4; ++j) cwl[j * 384 + tid] = cwreg[j];
        }
        if (wave == 7) {
            const float xx = alpha_r + p.dn_dt_bias[l * 4 + h];
            const float sp = fmaxf(xx, 0.f) + log1pf(__expf(-fabsf(xx)));
            float gc = -__expf(p.dn_a_log[l * 4 + h]) * sp;
#pragma unroll
            for (int o = 1; o < 64; o <<= 1) { const float tv = __shfl_up(gc, o); if (lane >= o) gc += tv; }
            gcs[lane] = gc; betas[lane] = sigmoid_f(beta_r);
        }
        __syncthreads();
        const float gl = gcs[63];
#pragma unroll
        for (int pass = 0; pass < 2; ++pass) {
            if (pass == 1 && tid >= 256) break;
            const int which = pass ? 2 : whichA;
            const LAS float* cw = cwl + which * 128 + d0;
            float y[4][8];
#pragma unroll
            for (int i = 0; i < 4; ++i)
#pragma unroll
                for (int d = 0; d < 8; ++d) y[i][d] = 0.f;
#pragma unroll
            for (int j = 0; j < 4; ++j) {
                const f32x4 w0 = *(const LAS f32x4*)(cw + j * 384), w1 = *(const LAS f32x4*)(cw + j * 384 + 4);
#pragma unroll
                for (int i = 0; i < 4; ++i) { float rf[8]; unpack8(pass ? rawB[i + j] : rawA[i + j], rf);
#pragma unroll
                    for (int d = 0; d < 4; ++d) { y[i][d] += w0[d] * rf[d]; y[i][4 + d] += w1[d] * rf[4 + d]; } }
            }
#pragma unroll
            for (int i = 0; i < 4; ++i) {
#pragma unroll
                for (int d = 0; d < 8; ++d) y[i][d] = silu_f(y[i][d]);
                if (which < 2) {
                    float ss = 0.f;
#pragma unroll
                    for (int d = 0; d < 8; ++d) ss += y[i][d] * y[i][d];
                    ss += __shfl_xor(ss, 1); ss += __shfl_xor(ss, 2); ss += __shfl_xor(ss, 4); ss += __shfl_xor(ss, 8);
                    float rinv = rsqrtf(ss + 1e-6f);
                    if (which == 0) rinv *= 0.08838834764831845f;
#pragma unroll
                    for (int d = 0; d < 8; ++d) y[i][d] *= rinv;
                }
            }
            if (which == 0) {
#pragma unroll
                for (int i = 0; i < 4; ++i) *(LAS u32x4*)(Qn + (tk0 + i) * 136 + d0) = pack8(y[i]);
            } else if (which == 1) {
                float f1[4], f2[4];
#pragma unroll
                for (int i = 0; i < 4; ++i) { const float gc = gcs[tk0 + i]; f1[i] = betas[tk0 + i] * __expf(gc); f2[i] = __expf(gl - gc); }
#pragma unroll
                for (int i = 0; i < 4; ++i) *(LAS u32x4*)(Kn + (tk0 + i) * 136 + d0) = pack8(y[i]);
#pragma unroll
                for (int d = 0; d < 8; ++d) {
                    u32x2 a, c; a.x = pk2(y[0][d] * f1[0], y[1][d] * f1[1]); a.y = pk2(y[2][d] * f1[2], y[3][d] * f1[3]); c.x = pk2(y[0][d] * f2[0], y[1][d] * f2[1]); c.y = pk2(y[2][d] * f2[2], y[3][d] * f2[3]);
                    *(LAS u32x2*)(KbgT + (d0 + d) * 72 + tk0) = a; *(LAS u32x2*)(KtlT + (d0 + d) * 72 + tk0) = c; }
            } else {
                float bt[4];
#pragma unroll
                for (int i = 0; i < 4; ++i) bt[i] = betas[tk0 + i];
#pragma unroll
                for (int d = 0; d < 8; ++d) { u32x2 a; a.x = pk2(y[0][d] * bt[0], y[1][d] * bt[1]); a.y = pk2(y[2][d] * bt[2], y[3][d] * bt[3]);
                    *(LAS u32x2*)(VbT + (d0 + d) * 72 + tk0) = a; }
            }
        }
        if (item + (int)gridDim.x < 1024) DP_ISSUE(item + (int)gridDim.x, tid);
        __syncthreads();
        {
            const int mat = wave >> 2, cb = wave & 3;
            LAS bf16_t* Asrc = mat ? Qn : Kn;
            bf16x8 a[4];
#pragma unroll
            for (int kb = 0; kb < 4; ++kb) a[kb] = *(LAS bf16x8*)(Asrc + (16 * cb + r) * 136 + 32 * kb + 8 * q);
#pragma unroll
            for (int sb = 0; sb < 4; ++sb) {
                f32x4 acc = {0.f, 0.f, 0.f, 0.f};
                if (sb <= cb) {
#pragma unroll
                    for (int kb = 0; kb < 4; ++kb) { const bf16x8 bb = *(LAS bf16x8*)(Kn + (16 * sb + r) * 136 + 32 * kb + 8 * q); acc = MFMA16(a[kb], bb, acc); }
                }
                const int s = 16 * sb + r; const float gs = gcs[s];
#pragma unroll
                for (int j = 0; j < 4; ++j) { const int c = 16 * cb + 4 * q + j; const float dec = __expf(gcs[c] - gs);
                    if (mat == 0) Lm[c * 68 + s] = (s < c) ? acc[j] * betas[c] * dec : 0.f;
                    else QKm[c * 72 + s] = f2bf((s <= c) ? acc[j] * dec : 0.f); }
            }
        }
        __syncthreads();
        if (wave < 4) {
            const int blk = wave, c = lane & 15;
            int zoff; asm volatile("v_mov_b32 %0, 0" : "=v"(zoff));
            LAS float* Lb = Lm + (16 * blk) * 68 + 16 * blk + zoff;
            float t[16];
            f32x4 rb[2][4];
            t[0] = (c == 0) ? 1.f : 0.f;
            rb[1][0] = *(LAS f32x4*)(Lb + 1 * 68);
#pragma unroll
            for (int i = 1; i < 16; ++i) {
                if (i + 1 < 16) {
#pragma unroll
                    for (int j4 = 0; j4 < (i + 4) / 4; ++j4) rb[(i + 1) & 1][j4] = *(LAS f32x4*)(Lb + (i + 1) * 68 + 4 * j4);
                }
                __builtin_amdgcn_sched_barrier(0);
                float acc0 = (i == c) ? 1.f : 0.f, acc1 = 0.f;
#pragma unroll
                for (int j = 0; j < i; ++j) { if (j & 1) acc1 -= rb[i & 1][j >> 2][j & 3] * t[j]; else acc0 -= rb[i & 1][j >> 2][j & 3] * t[j]; }
                t[i] = acc0 + acc1;
                __builtin_amdgcn_sched_barrier(0);
            }
            if (q == 0) {
#pragma unroll
                for (int i = 0; i < 16; ++i) { Tf[(16 * blk + i) * 68 + 16 * blk + c] = t[i]; Tm[(16 * blk + i) * 72 + 16 * blk + c] = f2bf(t[i]); }
            }
            for (int cb = blk + 1; cb < 4; ++cb) {
#pragma unroll
                for (int jj = 0; jj < 4; ++jj) Tm[(16 * blk + 4 * q + jj) * 72 + 16 * cb + r] = (bf16_t)0;
            }
        } else {
            if (wave == 4 && lane == 0) alast[item] = __expf(gl);
            for (int jb = wave - 4; jb < 40; jb += 4) {
                if (jb < 16) {
                    const int tb = jb >> 2, kb = jb & 3, tok = 16 * tb + r;
                    const u32x2 lo = *(LAS u32x2*)(Qn + tok * 136 + 32 * kb + 4 * q), hi = *(LAS u32x2*)(Qn + tok * 136 + 32 * kb + 16 + 4 * q);
                    const float e = __expf(gcs[tok]);
                    u32x4 w; w.x = pk2(lo16(lo.x) * e, hi16(lo.x) * e); w.y = pk2(lo16(lo.y) * e, hi16(lo.y) * e); w.z = pk2(lo16(hi.x) * e, hi16(hi.x) * e); w.w = pk2(lo16(hi.y) * e, hi16(hi.y) * e);
                    *(u32x4*)(itp + OFF_Q + (size_t)(jb * 64 + lane) * 16) = w;
                } else if (jb < 32) {
                    const int f = jb - 16, db = f >> 1, kb = f & 1, dk = 16 * db + r;
                    const u32x2 lo = *(LAS u32x2*)(KtlT + dk * 72 + 32 * kb + 4 * q), hi = *(LAS u32x2*)(KtlT + dk * 72 + 32 * kb + 16 + 4 * q);
                    u32x4 w; w.x = lo.x; w.y = lo.y; w.z = hi.x; w.w = hi.y;
                    *(u32x4*)(itp + OFF_KT + (size_t)(f * 64 + lane) * 16) = w;
                } else {
                    const int f = jb - 32, tb = f >> 1, kb = f & 1, tok = 16 * tb + r;
                    const u32x2 lo = *(LAS u32x2*)(QKm + tok * 72 + 32 * kb + 4 * q), hi = *(LAS u32x2*)(QKm + tok * 72 + 32 * kb + 16 + 4 * q);
                    u32x4 w; w.x = lo.x; w.y = lo.y; w.z = hi.x; w.w = hi.y;
                    *(u32x4*)(itp + OFF_QK + (size_t)(f * 64 + lane) * 16) = w;
                }
            }
        }
        __syncthreads();
#pragma unroll
        for (int d = 1; d < 4; ++d) {
            if (wave < 4 - d) {
                const int bj = wave, bi = wave + d;
                f32x4 M = {0.f, 0.f, 0.f, 0.f};
#pragma unroll
                for (int kk = 0; kk < d; ++kk) { const int bk = bj + kk;
#pragma unroll
                    for (int s = 0; s < 4; ++s) M = __builtin_amdgcn_mfma_f32_16x16x4f32(Lm[(16 * bi + r) * 68 + 16 * bk + 4 * s + q], Tf[(16 * bk + 4 * s + q) * 68 + 16 * bj + r], M, 0, 0, 0);
                }
                f32x4 Tn = {0.f, 0.f, 0.f, 0.f};
#pragma unroll
                for (int s = 0; s < 4; ++s) Tn = __builtin_amdgcn_mfma_f32_16x16x4f32(Tf[(16 * bi + r) * 68 + 16 * bi + 4 * q + s], M[s], Tn, 0, 0, 0);
#pragma unroll
                for (int jj = 0; jj < 4; ++jj) { Tf[(16 * bi + 4 * q + jj) * 68 + 16 * bj + r] = -Tn[jj]; Tm[(16 * bi + 4 * q + jj) * 72 + 16 * bj + r] = f2bf(-Tn[jj]); }
            }
            __syncthreads();
        }
        {
            const int s = wave;
            bf16x8 vb[2];
#pragma unroll
            for (int kb = 0; kb < 2; ++kb) vb[kb] = *(LAS bf16x8*)(VbT + (16 * s + r) * 72 + 32 * kb + 8 * q);
#pragma unroll
            for (int tb = 0; tb < 4; ++tb) {
                f32x4 acc = {0.f, 0.f, 0.f, 0.f};
#pragma unroll
                for (int kb = 0; kb < 2; ++kb) { const bf16x8 a = *(LAS bf16x8*)(Tm + (16 * tb + r) * 72 + 32 * kb + 8 * q); acc = MFMA16(a, vb[kb], acc); }
                *(f32x4*)(itp + OFF_U + (size_t)((s * 4 + tb) * 64 + lane) * 16) = acc;
            }
            const int kbp = wave & 3, tbh = wave >> 2;
            bf16x8 ka[2][2];
#pragma unroll
            for (int d = 0; d < 2; ++d)
#pragma unroll
                for (int kb = 0; kb < 2; ++kb) ka[d][kb] = *(LAS bf16x8*)(KbgT + (16 * (2 * kbp + d) + r) * 72 + 32 * kb + 8 * q);
#pragma unroll
            for (int tt = 0; tt < 2; ++tt) {
                const int tb = 2 * tbh + tt;
                f32x4 a0 = {0.f, 0.f, 0.f, 0.f}, a1 = {0.f, 0.f, 0.f, 0.f};
#pragma unroll
                for (int kb = 0; kb < 2; ++kb) { const bf16x8 tf = *(LAS bf16x8*)(Tm + (16 * tb + r) * 72 + 32 * kb + 8 * q); a0 = MFMA16(ka[0][kb], tf, a0); a1 = MFMA16(ka[1][kb], tf, a1); }
                u32x4 w; w.x = pk2(a0[0], a0[1]); w.y = pk2(a0[2], a0[3]); w.z = pk2(a1[0], a1[1]); w.w = pk2(a1[2], a1[3]);
                *(u32x4*)(itp + OFF_W + (size_t)((tb * 4 + kbp) * 64 + lane) * 16) = w;
            }
        }
    }
}

__device__ __forceinline__ void mixer_a(const int tidx, const P& p, int l, int blk, int nblk) {
    const bf16_t* proj = (const bf16_t*)(p.ws + WS_PROJ); bf16_t* ycat = (bf16_t*)(p.ws + WS_YCAT);
    const int stride = nblk * 512;
    for (int unit0 = blk * 512 + tidx; unit0 < MTOK * 32; unit0 += 2 * stride) {
        u32x4 rc[2][3], rv[2][3], rb[2];
#pragma unroll
        for (int uu = 0; uu < 2; ++uu) { const int unit = unit0 + uu * stride; const bool ok = unit < MTOK * 32;
            const int t = unit >> 5, c0 = (unit & 31) * 8, pos = t & (SEQ - 1);
#pragma unroll
            for (int j = 0; j < 3; ++j) { rc[uu][j] = (u32x4){0u, 0u, 0u, 0u}; rv[uu][j] = (u32x4){0u, 0u, 0u, 0u};
                if (ok && pos - 2 + j >= 0) { const bf16_t* pr = proj + (size_t)(t - 2 + j) * NINP; rc[uu][j] = *(const u32x4*)(pr + 256 + c0); rv[uu][j] = *(const u32x4*)(pr + 512 + c0); } }
            rb[uu] = (u32x4){0u, 0u, 0u, 0u};
            if (ok) rb[uu] = *(const u32x4*)(proj + (size_t)t * NINP + c0); }
#pragma unroll
        for (int uu = 0; uu < 2; ++uu) { const int unit = unit0 + uu * stride;
            if (unit < MTOK * 32) { const int t = unit >> 5, c0 = (unit & 31) * 8;
                float acc[8];
#pragma unroll
                for (int i = 0; i < 8; ++i) acc[i] = 0.f;
#pragma unroll
                for (int j = 0; j < 3; ++j) { float fc[8], fv[8]; unpack8(rc[uu][j], fc); unpack8(rv[uu][j], fv);
                    const float* wp = p.conv_a_w + (size_t)(l * 3 + j) * 256 + c0;
                    const f32x4 w0 = *(const f32x4*)wp, w1 = *(const f32x4*)(wp + 4);
#pragma unroll
                    for (int i = 0; i < 4; ++i) { acc[i] += w0[i] * fc[i] * fv[i]; acc[4 + i] += w1[i] * fc[4 + i] * fv[4 + i]; } }
                float fb[8]; unpack8(rb[uu], fb);
#pragma unroll
                for (int i = 0; i < 8; ++i) acc[i] *= fb[i];
                *(u32x4*)(ycat + (size_t)t * DM + c0) = pack8(acc); } }
    }
}
__device__ __forceinline__ void mixer_b(const int tidx, const P& p, int l, int blk, int nblk, LAS unsigned char* L) {
    const bf16_t* proj = (const bf16_t*)(p.ws + WS_PROJ); bf16_t* ycat = (bf16_t*)(p.ws + WS_YCAT);
    LAS float* ut = (LAS float*)L;
    LAS float* co = (LAS float*)(L + 63488);
    const int tid = tidx, wave = tid >> 6, lane = tid & 63;
    for (int run = blk; run < MTOK / 32; run += nblk) {
        __syncthreads();
        const int t0 = run * 32, pos0 = t0 & (SEQ - 1);
        {
            u32x4 ra[4], rg[4];
#pragma unroll
            for (int it = 0; it < 4; ++it) { const int idx = tid + 512 * it, rr = idx >> 5, c0 = (idx & 31) * 8;
                ra[it] = (u32x4){0u, 0u, 0u, 0u}; rg[it] = (u32x4){0u, 0u, 0u, 0u};
                if (idx < 62 * 32 && pos0 - 30 + rr >= 0) { const bf16_t* pr = proj + (size_t)(t0 - 30 + rr) * NINP; ra[it] = *(const u32x4*)(pr + 768 + c0); rg[it] = *(const u32x4*)(pr + 1024 + c0); } }
#pragma unroll
            for (int it = 0; it < 4; ++it) { const int idx = tid + 512 * it, rr = idx >> 5, c0 = (idx & 31) * 8;
                if (idx < 62 * 32) { float fa[8], fg[8], u[8]; unpack8(ra[it], fa); unpack8(rg[it], fg);
#pragma unroll
                    for (int i = 0; i < 8; ++i) u[i] = fa[i] * sigmoid_f(fg[i]);
                    *(LAS f32x4*)(ut + rr * 256 + c0) = (f32x4){u[0], u[1], u[2], u[3]}; *(LAS f32x4*)(ut + rr * 256 + c0 + 4) = (f32x4){u[4], u[5], u[6], u[7]}; } }
        }
        __syncthreads();
        {
            const int c = tid & 255, half = tid >> 8;
            float w[31], win[46];
#pragma unroll
            for (int j = 0; j < 31; ++j) w[j] = p.conf_dw_w[(size_t)(l * 31 + j) * 256 + c];
            const float bias = p.conf_dw_b[l * 256 + c];
#pragma unroll
            for (int k = 0; k < 46; ++k) win[k] = ut[(half * 16 + k) * 256 + c];
#pragma unroll
            for (int tt = 0; tt < 16; ++tt) { float acc = bias;
#pragma unroll
                for (int j = 0; j < 31; ++j) acc += w[j] * win[tt + j];
                co[(half * 16 + tt) * 256 + c] = acc; }
        }
        __syncthreads();
#pragma unroll
        for (int i = 0; i < 4; ++i) {
            const int tl = wave * 4 + i;
            const f32x4 v = *(LAS f32x4*)(co + tl * 256 + lane * 4);
            const float mean = wave_sum(v[0] + v[1] + v[2] + v[3]) * (1.f / 256.f);
            const f32x4 d = v - mean;
            const float var = wave_sum(d[0] * d[0] + d[1] * d[1] + d[2] * d[2] + d[3] * d[3]) * (1.f / 256.f);
            const float rs = rsqrtf(var + 1e-5f);
            const f32x4 gg = *(const f32x4*)(p.conf_ln_g + l * 256 + lane * 4), bb = *(const f32x4*)(p.conf_ln_b + l * 256 + lane * 4);
            const f32x4 y = d * rs * gg + bb;
            u32x2 wv; wv.x = pk2(silu_f(y[0]), silu_f(y[1])); wv.y = pk2(silu_f(y[2]), silu_f(y[3]));
            *(u32x2*)(ycat + (size_t)(t0 + tl) * DM + 256 + lane * 4) = wv;
        }
    }
}

constexpr int SCAN_BLOCKS = 128, SCAN_BUF = 64512;
__device__ __forceinline__ void phase_scan(const int tidx, const P& p, int l, LAS unsigned char* L) {
    const int tid = tidx, lane = tid & 63, wave = tid >> 6, r = lane & 15, q = lane >> 4;
    if ((int)blockIdx.x >= SCAN_BLOCKS) {
        const int blk = blockIdx.x - SCAN_BLOCKS, nblk = gridDim.x - SCAN_BLOCKS;
        mixer_a(tidx, p, l, blk, nblk);
        mixer_b(tidx, p, l, blk, nblk, L);
        __syncthreads();
        {
            pg8::Gemm g{(const bf16_t*)(p.ws + WS_H), (const bf16_t*)(p.ws + WS_WIN) + ((size_t)l * NINP + 3072) * DM, MTOK, 512, DM}; pg8::StaticOrder S; S.init(MTOK, 512, nblk, blk);
            pg8::EpiProj E{(bf16_t*)(p.ws + WS_PROJ) + 3072, NINP}; pg8::gemm_phase<pg8::EpiProj>(tidx, L, g, S, E);
        }
        if (l + 1 < NL && ((MTOK / 256) * (NF1 / 256)) % (int)gridDim.x == 0) prep_transposes(tidx, p, L, l + 1, l + 2, blk, nblk);
        return;
    }
    const int item = blockIdx.x, xcd = item & 7, jj = item >> 3, s = jj & 7, bh = xcd * 2 + (jj >> 3), b = bh >> 2, h = bh & 3;
    const unsigned char* dl = p.ws + WS_DELTA;
    const float* alast = (const float*)(p.ws + WS_ALAST);
    bf16_t* obuf = (bf16_t*)(p.ws + WS_YCAT);
#define SB_ __builtin_amdgcn_sched_barrier(0)
#define SCAN_COMPUTE(buf, n_) do { \
            const float al = __builtin_bit_cast(float, __builtin_amdgcn_readlane(__builtin_bit_cast(int, al_all), (n_))); \
            const LAS bf16x8* Wf = (const LAS bf16x8*)((buf) + OFF_W) + lane; const LAS bf16x8* Qf = (const LAS bf16x8*)((buf) + OFF_Q) + lane; \
            const LAS bf16x8* Kf = (const LAS bf16x8*)((buf) + OFF_KT) + lane; const LAS bf16x8* QKf = (const LAS bf16x8*)((buf) + OFF_QK) + lane; \
            const LAS f32x4* Uf = (const LAS f32x4*)((buf) + OFF_U) + lane; \
            bf16x8 g0[8], g1[8]; f32x4 Uv[4]; \
            _Pragma("unroll") for (int f = 0; f < 8; ++f) g0[f] = Wf[((f >> 1) * 4 + (f & 1)) * 64];                \
            _Pragma("unroll") for (int f = 0; f < 8; ++f) g1[f] = Wf[((f >> 1) * 4 + 2 + (f & 1)) * 64];            \
            bf16x8 Sb[4]; \
            _Pragma("unroll") for (int kb = 0; kb < 4; ++kb) { u32x4 w; w.x = pk2(S[2 * kb][0], S[2 * kb][1]); w.y = pk2(S[2 * kb][2], S[2 * kb][3]); w.z = pk2(S[2 * kb + 1][0], S[2 * kb + 1][1]); w.w = pk2(S[2 * kb + 1][2], S[2 * kb + 1][3]); \
                Sb[kb] = __builtin_bit_cast(bf16x8, w); } \
            f32x4 Pv[4], O[4]; \
            _Pragma("unroll") for (int tb = 0; tb < 4; ++tb) { Pv[tb] = (f32x4){0.f, 0.f, 0.f, 0.f}; O[tb] = (f32x4){0.f, 0.f, 0.f, 0.f}; } \
            SB_; \
            _Pragma("unroll") for (int f = 0; f < 8; ++f) Pv[f >> 1] = MFMA16(g0[f], Sb[f & 1], Pv[f >> 1]); \
            _Pragma("unroll") for (int f = 0; f < 8; ++f) g0[f] = Qf[((f >> 1) * 4 + (f & 1)) * 64]; \
            SB_; \
            _Pragma("unroll") for (int f = 0; f < 8; ++f) Pv[f >> 1] = MFMA16(g1[f], Sb[2 + (f & 1)], Pv[f >> 1]); \
            _Pragma("unroll") for (int f = 0; f < 8; ++f) g1[f] = Qf[((f >> 1) * 4 + 2 + (f & 1)) * 64]; \
            _Pragma("unroll") for (int tb = 0; tb < 4; ++tb) Uv[tb] = Uf[tb * 64]; \
            SB_; \
            _Pragma("unroll") for (int f = 0; f < 8; ++f) O[f >> 1] = MFMA16(g0[f], Sb[f & 1], O[f >> 1]); \
            _Pragma("unroll") for (int f = 0; f < 8; ++f) g0[f] = Kf[(f * 2) * 64];                                  \
            SB_; \
            _Pragma("unroll") for (int f = 0; f < 8; ++f) O[f >> 1] = MFMA16(g1[f], Sb[2 + (f & 1)], O[f >> 1]); \
            _Pragma("unroll") for (int f = 0; f < 8; ++f) g1[f] = Kf[(f * 2 + 1) * 64];                              \
            _Pragma("unroll") for (int tb = 0; tb < 4; ++tb) Pv[tb] = Uv[tb] - Pv[tb]; \
            bf16x8 Vb[2]; \
            _Pragma("unroll") for (int kb = 0; kb < 2; ++kb) { u32x4 w; w.x = pk2(Pv[2 * kb][0], Pv[2 * kb][1]); w.y = pk2(Pv[2 * kb][2], Pv[2 * kb][3]); w.z = pk2(Pv[2 * kb + 1][0], Pv[2 * kb + 1][1]); w.w = pk2(Pv[2 * kb + 1][2], Pv[2 * kb + 1][3]); \
                Vb[kb] = __builtin_bit_cast(bf16x8, w); } \
            _Pragma("unroll") for (int db = 0; db < 8; ++db) S[db] = S[db] * al; \
            SB_; \
            _Pragma("unroll") for (int f = 0; f < 8; ++f) S[f] = MFMA16(g0[f], Vb[0], S[f]); \
            _Pragma("unroll") for (int f = 0; f < 8; ++f) if (f != 1 && f != 3) g0[f] = QKf[f * 64];                  \
            SB_; \
            _Pragma("unroll") for (int f = 0; f < 8; ++f) S[f] = MFMA16(g1[f], Vb[1], S[f]); \
            SB_; \
            _Pragma("unroll") for (int f = 0; f < 8; ++f) if (f != 1 && f != 3) O[f >> 1] = MFMA16(g0[f], Vb[f & 1], O[f >> 1]); \
            bf16_t* op = obuf + (size_t)(b * SEQ + (n_) * 64 + 4 * q) * DM + 512 + h * 128 + 16 * s + r; \
            _Pragma("unroll") for (int tb = 0; tb < 4; ++tb) \
                _Pragma("unroll") for (int j = 0; j < 4; ++j) op[(size_t)(16 * tb + j) * DM] = f2bf(O[tb][j]); \
        } while (0)
#define SCAN_BAR() do { asm volatile("s_waitcnt lgkmcnt(0)" ::: "memory"); __builtin_amdgcn_s_barrier(); asm volatile("" ::: "memory"); } while (0)
    LAS unsigned char* buf0 = L; LAS unsigned char* buf1 = L + SCAN_BUF;
    if (wave == 0) {
        const float al_all = alast[(b * 64 + lane) * 4 + h];
        f32x4 S[8];
#pragma unroll
        for (int i = 0; i < 8; ++i) S[i] = (f32x4){0.f, 0.f, 0.f, 0.f};
        SCAN_BAR();
        __builtin_amdgcn_s_setprio(3);
#pragma unroll 1
        for (int n = 0; n < 64; n += 2) {
            SCAN_COMPUTE(buf0, n);
            SCAN_BAR();
            SCAN_COMPUTE(buf1, n + 1);
            SCAN_BAR();
        }
        __builtin_amdgcn_s_setprio(0);
    } else {
        const int ct = tid - 64;
        const int off8 = (ct < 256) ? (OFF_U + s * 4096 + ct * 16) : ((ct - 256) * 16);
        const unsigned char* dlb = dl + (size_t)((b * 64) * 4 + h) * ITEM_BYTES;
        u32x4 R0[9], R1[9], R2[9], R3[9];
#define SCAN_LOAD(regs, n_) do { const int nn_ = ((n_) < 64) ? (n_) : 63; const unsigned char* itp_ = dlb + (size_t)nn_ * (4 * ITEM_BYTES); \
        _Pragma("unroll") for (int i_ = 0; i_ < 8; ++i_) regs[i_] = *(const u32x4*)(itp_ + (ct + 448 * i_) * 16); \
        regs[8] = *(const u32x4*)(itp_ + off8); __builtin_amdgcn_sched_barrier(0); } while (0)
#define SCAN_STORE(regs, buf_) do { _Pragma("unroll") for (int i_ = 0; i_ < 9; ++i_) *(LAS u32x4*)((buf_) + (ct + 448 * i_) * 16) = regs[i_]; } while (0)
        SCAN_LOAD(R0, 0); SCAN_LOAD(R1, 1); SCAN_LOAD(R2, 2); SCAN_LOAD(R3, 3);
        SCAN_STORE(R0, buf0);
        SCAN_BAR();
#pragma unroll 1
        for (int n = 0; n < 64; n += 4) {
            SCAN_LOAD(R0, n + 4); SCAN_STORE(R1, buf1); SCAN_BAR();
            SCAN_LOAD(R1, n + 5); SCAN_STORE(R2, buf0); SCAN_BAR();
            SCAN_LOAD(R2, n + 6); SCAN_STORE(R3, buf1); SCAN_BAR();
            SCAN_LOAD(R3, n + 7); SCAN_STORE(R0, buf0); SCAN_BAR();
        }
    }
#undef SCAN_COMPUTE
#undef SB_
#undef SCAN_BAR
#undef SCAN_LOAD
#undef SCAN_STORE
}

__device__ __forceinline__ void phase_onorm(const int tidx, const P& p, int l) {
    const bf16_t* proj = (const bf16_t*)(p.ws + WS_PROJ); bf16_t* ycat = (bf16_t*)(p.ws + WS_YCAT);
    const int sub = tidx & 15, d0 = sub * 8;
    const f32x4 g0 = *(const f32x4*)(p.dn_norm_g + l * 128 + d0), g1 = *(const f32x4*)(p.dn_norm_g + l * 128 + d0 + 4);
    const bool own = (gridDim.x == 256);
    const int tbeg = (((int)blockIdx.x & 7) * 8) * 256 + ((int)blockIdx.x >> 3) * 64;
    for (int it = 0; ; ++it) {
        int unit0;
        if (own) { if (it >= 4) break; unit0 = (tbeg + (tidx >> 4) * 2 + (it >> 1)) * 4 + (it & 1) * 2; }
        else { unit0 = ((int)blockIdx.x * 32 + (tidx >> 4)) * 2 + it * (int)gridDim.x * 64; if (unit0 >= MTOK * 4) break; }
        u32x4 orw[2], zr[2];
#pragma unroll
        for (int uu = 0; uu < 2; ++uu) { const int t = (unit0 + uu) >> 2, h = (unit0 + uu) & 3;
            orw[uu] = *(const u32x4*)(ycat + (size_t)t * DM + 512 + h * 128 + d0);
            zr[uu] = *(const u32x4*)(proj + (size_t)t * NINP + 3072 + h * 128 + d0); }
#pragma unroll
        for (int uu = 0; uu < 2; ++uu) { const int t = (unit0 + uu) >> 2, h = (unit0 + uu) & 3;
            float o[8]; unpack8(orw[uu], o);
            float ss = 0.f;
#pragma unroll
            for (int i = 0; i < 8; ++i) ss += o[i] * o[i];
            ss += __shfl_xor(ss, 1); ss += __shfl_xor(ss, 2); ss += __shfl_xor(ss, 4); ss += __shfl_xor(ss, 8);
            const float rinv = rsqrtf(ss * (1.f / 128.f) + 1e-6f);
            float z[8]; unpack8(zr[uu], z);
            float y[8];
#pragma unroll
            for (int i = 0; i < 4; ++i) { y[i] = o[i] * rinv * g0[i] * silu_f(z[i]); y[4 + i] = o[4 + i] * rinv * g1[i] * silu_f(z[4 + i]); }
            *(u32x4*)(ycat + (size_t)t * DM + 512 + h * 128 + d0) = pack8(y); }
    }
}

#define XB_TMO      128
#define XB_XCNT(j)  (256  + 64 * (j))
#define XB_XSUB(j)  (1280 + 64 * (j))
#define XB_XGEN(j)  (2304 + 64 * (j))
#define XB_TOP      3328
#define XB_TOPGEN   3392
#define XCD_BAR_WORDS 3456
#define XB_SPIN_CAP (1u << 22)
__device__ __forceinline__ unsigned xb_ld(unsigned* p)              { return __hip_atomic_load(p, __ATOMIC_RELAXED, __HIP_MEMORY_SCOPE_AGENT); }
__device__ __forceinline__ unsigned xb_add(unsigned* p, unsigned v) { return __hip_atomic_fetch_add(p, v, __ATOMIC_RELAXED, __HIP_MEMORY_SCOPE_AGENT); }
__device__ __forceinline__ unsigned xb_xcc_id() { return (unsigned)__builtin_amdgcn_s_getreg((3 << 11) | 20) & 0xFu; }
#define XB_SPIN(cond, bar) do { unsigned _sp = 0; while (cond) { __builtin_amdgcn_s_sleep(1); \
    if ((++_sp & 255u) == 0u) { if (xb_ld(&(bar)[XB_TMO])) break; if (_sp > XB_SPIN_CAP) { atomicAdd(&(bar)[XB_TMO], 1u); break; } } } } while (0)
struct XcdBarrier { unsigned* bar; unsigned x; volatile LAS unsigned* st; };
__device__ __forceinline__ XcdBarrier xcd_barrier_post(unsigned* bar, volatile LAS unsigned* st) {
    XcdBarrier b; b.bar = bar; b.x = xb_xcc_id(); b.st = st;
    if (threadIdx.x == 0) (void)xb_add(&bar[XB_XCNT(b.x)], 1u);
    return b;
}
__device__ __forceinline__ void xcd_barrier_complete(unsigned* bar, unsigned x, unsigned& nloc, unsigned& nx) {
    const unsigned G = gridDim.x * gridDim.y * gridDim.z;
    unsigned sum, cnt, mine, sp = 0u;
    for (;;) {
        sum = 0u; cnt = 0u; mine = 0u;
#pragma unroll
        for (unsigned j = 0; j < 16; ++j) { const unsigned c = xb_ld(&bar[XB_XCNT(j)]); sum += c; cnt += (c > 0u) ? 1u : 0u; mine = (j == x) ? c : mine; }
        if (sum == G) break;
        __builtin_amdgcn_s_sleep(1);
        if ((++sp & 255u) == 0u) { if (xb_ld(&bar[XB_TMO])) break; if (sp > XB_SPIN_CAP) { atomicAdd(&bar[XB_TMO], 1u); break; } }
    }
    nloc = mine > 0u ? mine : 1u; nx = cnt > 0u ? cnt : 1u;
}
__device__ __forceinline__ void xcd_barrier(const XcdBarrier& b) {
    asm volatile("s_waitcnt vmcnt(0)" ::: "memory");
    __syncthreads();
    if (threadIdx.x == 0) {
        unsigned* bar = b.bar;
        __builtin_amdgcn_s_waitcnt(0);
        unsigned nloc = b.st[0], nx = b.st[1];
        if (nloc == 0u) { xcd_barrier_complete(bar, b.x, nloc, nx); b.st[0] = nloc; b.st[1] = nx; }
        const unsigned old = xb_add(&bar[XB_XSUB(b.x)], 1u);
        const unsigned gen = old / nloc;
        if (old + 1u == (gen + 1u) * nloc) {
            __builtin_amdgcn_fence(__ATOMIC_RELEASE, "agent");
            asm volatile("s_waitcnt vmcnt(0)" ::: "memory");
            const unsigned og = xb_add(&bar[XB_TOP], 1u);
            const unsigned tg = og / nx;
            if (og + 1u == (tg + 1u) * nx) xb_add(&bar[XB_TOPGEN], 1u);
            else XB_SPIN(xb_ld(&bar[XB_TOPGEN]) == tg, bar);
            __builtin_amdgcn_fence(__ATOMIC_ACQUIRE, "agent");
            xb_add(&bar[XB_XGEN(b.x)], 1u);
            asm volatile("s_waitcnt vmcnt(0)" ::: "memory");
        } else {
            XB_SPIN(xb_ld(&bar[XB_XGEN(b.x)]) == gen, bar);
            __builtin_amdgcn_fence(__ATOMIC_ACQUIRE, "agent");
            asm volatile("s_waitcnt vmcnt(0)" ::: "memory");
        }
    }
    __syncthreads();
}

#define XB_LSUB(j)  (4096 + 64 * (j))
#define XB_LGEN(j)  (5120 + 64 * (j))
#define XB_TABLE    6144
__device__ __forceinline__ void xcd_barrier_local(const XcdBarrier& b) {
    asm volatile("s_waitcnt vmcnt(0)" ::: "memory");
    __syncthreads();
    if (threadIdx.x == 0) {
        unsigned* bar = b.bar;
        __builtin_amdgcn_s_waitcnt(0);
        const unsigned nloc = b.st[0];
        const unsigned old = xb_add(&bar[XB_LSUB(b.x)], 1u);
        const unsigned gen = old / nloc;
        if (old + 1u == (gen + 1u) * nloc) xb_add(&bar[XB_LGEN(b.x)], 1u);
        else XB_SPIN(xb_ld(&bar[XB_LGEN(b.x)]) == gen, bar);
        __builtin_amdgcn_fence(__ATOMIC_ACQUIRE, "agent");
        asm volatile("s_waitcnt vmcnt(0)" ::: "memory");
    }
    __syncthreads();
}

template <int KIND>
__device__ __forceinline__ void run_kind(const int tidx, const P& p, int l, LAS unsigned char* L) {
    const float* modl = (const float*)(p.ws + WS_MOD) + (size_t)l * NB * NMOD;
    bf16_t* hbuf = (bf16_t*)(p.ws + WS_H); bf16_t* ycat = (bf16_t*)(p.ws + WS_YCAT); bf16_t* proj = (bf16_t*)(p.ws + WS_PROJ);
    const float* xin = (l == 0) ? p.x : p.out;
    if constexpr (KIND == 0) phase_prep(tidx, p, L);
    if constexpr (KIND == 1) phase_norm(tidx, xin, p.norm_mix_g + l * DM, modl, 0, DM, hbuf);
    if constexpr (KIND == 2) { pg8::Gemm g{hbuf, (const bf16_t*)(p.ws + WS_WIN) + (size_t)l * NINP * DM, MTOK, 3072, DM}; pg8::StaticOrder S; S.init(MTOK, 3072, gridDim.x, blockIdx.x);
        pg8::EpiProj E{proj, NINP}; pg8::gemm_phase<pg8::EpiProj>(tidx, L, g, S, E); }
    if constexpr (KIND == 3) phase_dprep(tidx, p, l, L);
    if constexpr (KIND == 4) phase_scan(tidx, p, l, L);
    if constexpr (KIND == 5) phase_onorm(tidx, p, l);
    if constexpr (KIND == 6) { pg8::Gemm g{ycat, (const bf16_t*)(p.ws + WS_WOUT) + (size_t)l * DM * DM, MTOK, DM, DM}; pg8::StaticOrder S; S.init(MTOK, DM, gridDim.x, blockIdx.x);
        pg8::EpiResid E{xin, p.out, modl + 2 * DM}; pg8::gemm_phase<pg8::EpiResid>(tidx, L, g, S, E); }
    if constexpr (KIND == 7) phase_norm(tidx, p.out, p.norm_ffn_g + l * DM, modl, 3 * DM, 4 * DM, hbuf);
    if constexpr (KIND == 8) { pg8::Gemm g{hbuf, (const bf16_t*)(p.ws + WS_WF1) + (size_t)l * NF1 * DM, MTOK, NF1, DM}; pg8::StaticOrder S; S.init(MTOK, NF1, gridDim.x, blockIdx.x);
        pg8::EpiSwiGLU E{proj}; pg8::gemm_phase<pg8::EpiSwiGLU>(tidx, L, g, S, E);
        const int rem = S.nwg % (int)gridDim.x;
        if (l + 1 < NL && rem != 0 && (int)blockIdx.x >= rem) prep_transposes(tidx, p, L, l + 1, l + 2, (int)blockIdx.x - rem, (int)gridDim.x - rem); }
    if constexpr (KIND == 9) { pg8::Gemm g{proj, (const bf16_t*)(p.ws + WS_WF2) + (size_t)l * DM * DFF, MTOK, DM, DFF}; pg8::StaticOrder S; S.init(MTOK, DM, gridDim.x, blockIdx.x);
        pg8::EpiResid E{p.out, p.out, modl + 5 * DM}; pg8::gemm_phase<pg8::EpiResid>(tidx, L, g, S, E); }
    if constexpr (KIND == 10) phase_final(tidx, p.out, p.final_norm_g);
}
__host__ __device__ inline void phase_decode(int ph, int& kind, int& l) {
    if (ph == 0) { kind = 0; l = 0; } else if (ph == NPH - 1) { kind = 10; l = 0; } else { l = (ph - 1) / 9; kind = 1 + (ph - 1) % 9; }
}

#if ONE_LAUNCH
__global__ void __launch_bounds__(512, 2) hymba_fwd(P p) {
    extern __shared__ __attribute__((aligned(16))) unsigned char lds_raw[];
    LAS unsigned char* L = (LAS unsigned char*)lds_raw;
    cg::grid_group grid = cg::this_grid();
    if (threadIdx.x < 16) ((LAS unsigned*)(L + LDS_BAR_OFF))[threadIdx.x] = 0u;
    __syncthreads();
    const XcdBarrier bar = xcd_barrier_post((unsigned*)(p.ws + WS_BAR), (volatile LAS unsigned*)(L + LDS_BAR_OFF));
    if (threadIdx.x == 0) ((unsigned*)(p.ws + WS_BAR))[XB_TABLE + blockIdx.x] = bar.x + 1u;
    {
        xcd_barrier(bar);
        int okv = (gridDim.x == 256);
        unsigned* tab = (unsigned*)(p.ws + WS_BAR) + XB_TABLE;
        if (okv && threadIdx.x < 256) { const unsigned v = xb_ld(tab + threadIdx.x), r8 = xb_ld(tab + (threadIdx.x & 7));
            okv = (v != 0u) && (v == r8);
            if (threadIdx.x < 8) for (unsigned u = 0; u < threadIdx.x; ++u) okv &= (xb_ld(tab + u) != v);
            if (threadIdx.x == 0) okv &= (bar.st[0] == 32u) && (bar.st[1] == 8u); }
        const int allok = __syncthreads_and(okv);
        if (threadIdx.x == 0) ((volatile LAS unsigned*)(L + LDS_BAR_OFF))[4] = allok ? 1u : 0u;
        __syncthreads();
    }
    for (int ph = p.ph_lo; ph < p.ph_hi; ++ph) {
        if (p.ph_hi > NPH) grid.sync();
        int kind, l; phase_decode(ph, kind, l);
        if (ph > p.ph_lo) {
            const bool local_seam = (kind == 2 || (kind >= 6 && kind <= 9));
            if (local_seam && ((volatile LAS unsigned*)(L + LDS_BAR_OFF))[4] != 0u) xcd_barrier_local(bar); else xcd_barrier(bar);
        }
        int tidx = threadIdx.x; asm volatile("" : "+v"(tidx));
#if REPEAT_MASK
        if ((REPEAT_MASK >> kind) & 1) {
            switch (kind) { case 1: run_kind<1>(tidx, p, l, L); break; case 2: run_kind<2>(tidx, p, l, L); break; case 3: run_kind<3>(tidx, p, l, L); break; case 4: run_kind<4>(tidx, p, l, L); break;
                case 5: run_kind<5>(tidx, p, l, L); break; case 7: run_kind<7>(tidx, p, l, L); break; case 8: run_kind<8>(tidx, p, l, L); break; default: break; }
            __syncthreads();
        }
#endif
        switch (kind) {
        case 0: run_kind<0>(tidx, p, l, L); break; case 1: run_kind<1>(tidx, p, l, L); break; case 2: run_kind<2>(tidx, p, l, L); break; case 3: run_kind<3>(tidx, p, l, L); break;
        case 4: run_kind<4>(tidx, p, l, L); break; case 5: run_kind<5>(tidx, p, l, L); break; case 6: run_kind<6>(tidx, p, l, L); break; case 7: run_kind<7>(tidx, p, l, L); break;
        case 8: run_kind<8>(tidx, p, l, L); break; case 9: run_kind<9>(tidx, p, l, L); break; default: run_kind<10>(tidx, p, l, L); break;
        }
    }
}
#define LAUNCH_FN(kind) ((const void*)hymba_fwd)
#else
template <int KIND> __global__ void __launch_bounds__(512, 2) hymba_ph(P p) {
    extern __shared__ __attribute__((aligned(16))) unsigned char lds_raw[];
    run_kind<KIND>((int)threadIdx.x, p, p.ph_hi, (LAS unsigned char*)lds_raw);
}
static const void* ph_fn(int kind) {
    switch (kind) { case 0: return (const void*)hymba_ph<0>; case 1: return (const void*)hymba_ph<1>; case 2: return (const void*)hymba_ph<2>; case 3: return (const void*)hymba_ph<3>;
        case 4: return (const void*)hymba_ph<4>; case 5: return (const void*)hymba_ph<5>; case 6: return (const void*)hymba_ph<6>; case 7: return (const void*)hymba_ph<7>;
        case 8: return (const void*)hymba_ph<8>; case 9: return (const void*)hymba_ph<9>; default: return (const void*)hymba_ph<10>; }
}
#define LAUNCH_FN(kind) ph_fn(kind)
#endif

extern "C" void kernel_launch(void* const* d_in, const int* in_sizes, int n_in, void* d_out, int out_size, void* d_ws, size_t ws_size, hipStream_t stream) {
    static int grid = 0;
    if (grid == 0) {
        if (n_in != 20 || out_size != MTOK * DM || ws_size < WS_END) { fprintf(stderr, "kernel_launch: unexpected problem (n_in %d out %d ws %zu need %zu)\n", n_in, out_size, ws_size, (size_t)WS_END); grid = -1; return; }
        int dev = 0, cus = 0, per_cu = 0;
        (void)hipGetDevice(&dev); (void)hipDeviceGetAttribute(&cus, hipDeviceAttributeMultiprocessorCount, dev);
        for (int k = 0; k <= 10; ++k)
            if (hipFuncSetAttribute(LAUNCH_FN(k), hipFuncAttributeMaxDynamicSharedMemorySize, LDS_BYTES) != hipSuccess) { fprintf(stderr, "kernel_launch: hipFuncSetAttribute failed\n"); grid = -1; return; }
#if ONE_LAUNCH
        if (hipOccupancyMaxActiveBlocksPerMultiprocessor(&per_cu, (const void*)hymba_fwd, 512, LDS_BYTES) != hipSuccess || per_cu < 1) { fprintf(stderr, "kernel_launch: occupancy query failed (%d)\n", per_cu); (void)hipGetLastError(); per_cu = 1; }
#else
        per_cu = 1;
#endif
        grid = cus * per_cu;
        if (grid < SCAN_BLOCKS + 32) { fprintf(stderr, "kernel_launch: grid %d too small\n", grid); grid = -1; return; }
    }
    if (grid < 0) return;
    P p{};
    const float** pp = (const float**)&p;
    for (int i = 0; i < 20; ++i) pp[i] = (const float*)d_in[i];
    p.out = (float*)d_out; p.ws = (unsigned char*)d_ws;
#if ONE_LAUNCH
    p.ph_lo = 0; p.ph_hi = NPH;
    if (hipMemsetAsync((unsigned char*)d_ws + WS_BAR, 0, 32768, stream) != hipSuccess) { fprintf(stderr, "kernel_launch: memset of the barrier words failed\n"); return; }
    void* args[] = {&p};
    hipError_t e = hipLaunchCooperativeKernel((const void*)hymba_fwd, dim3(grid), dim3(512), args, LDS_BYTES, stream);
    if (e != hipSuccess) fprintf(stderr, "cooperative launch failed: %s (grid %d)\n", hipGetErrorString(e), grid);
#else
    for (int ph = 0; ph < NPH; ++ph) { int kind, l; phase_decode(ph, kind, l); p.ph_lo = kind; p.ph_hi = l; void* args[] = {&p};
        (void)hipLaunchKernel(ph_fn(kind), dim3(grid), dim3(512), args, LDS_BYTES, stream); }
#endif
}
```
